# Optimizing an MI355X kernel written in HIP

```python
import math
import jax
import jax.numpy as jnp
from jax import lax
import numpy as np

D_MODEL = 1024
BATCH = 8
SEQ = 2048
DEPTH = 2

MIX_WIDTH = D_MODEL
GDN_HEADS = 4
GDN_DK = D_MODEL // 8
GDN_DV = D_MODEL // 8
GDN_CONV = 4
GDN_CHUNK = 64
GDN_QK = GDN_HEADS * GDN_DK
GDN_V = GDN_HEADS * GDN_DV
SC_WIDTH = D_MODEL // 4
SC_CONV = 3
DIFF_HEADS = 4
DIFF_DV = D_MODEL // 16
DIFF_DQK = DIFF_DV // 2
DIFF_QK = DIFF_HEADS * 2 * DIFF_DQK
DIFF_V = DIFF_HEADS * DIFF_DV
ATTN_BLOCK = 128
REL_BUCKETS = 32
REL_MAX_DIST = 128
PEER_HEADS = 8
PEER_KEYS = 128
PEER_EXPERTS = PEER_KEYS * PEER_KEYS
PEER_TOPK = 16
PEER_DKEY = D_MODEL // 4
PEER_BLOCK = 128
EPS = 1e-6
IN_SPLITS = (GDN_QK, GDN_QK, GDN_V, GDN_V, GDN_HEADS, GDN_HEADS,
             SC_WIDTH, SC_WIDTH, SC_WIDTH,
             DIFF_QK, DIFF_QK, DIFF_V)
IN_WIDTH = 2 * GDN_QK + 2 * GDN_V + 2 * GDN_HEADS + 3 * SC_WIDTH + 2 * DIFF_QK + DIFF_V

kernel_name = 'hybrid_gdn_shortconv_diffattn_peer'


def rms_norm(x, gain):
    xf = x.astype(jnp.float32)
    y = xf * lax.rsqrt(jnp.mean(xf * xf, axis=-1, keepdims=True) + EPS)
    return (y * gain.astype(jnp.float32)).astype(x.dtype)


def l2_norm(x):
    xf = x.astype(jnp.float32)
    return (xf * lax.rsqrt(jnp.sum(xf * xf, axis=-1, keepdims=True) + EPS)).astype(x.dtype)


def causal_depthwise_conv(x, w):
    width, ch = w.shape
    return lax.conv_general_dilated(
        x, w[:, None, :].astype(x.dtype), window_strides=(1,), padding=[(width - 1, 0)],
        dimension_numbers=('NWC', 'WIO', 'NWC'), feature_group_count=ch)


def gated_delta_rule(q, k, v, g, beta):
    b, s, h, dk = q.shape
    dv = v.shape[-1]
    nc = s // GDN_CHUNK
    f32 = jnp.float32

    def chunks(t):
        t = t.reshape((b, nc, GDN_CHUNK, h) + t.shape[3:])
        return jnp.moveaxis(t, (1, 3), (0, 2))

    qc = chunks(q.astype(f32) * (dk ** -0.5))
    kc = chunks(k.astype(f32))
    vc = chunks(v.astype(f32))
    gc = jnp.cumsum(chunks(g.astype(f32)), axis=-1)
    bc = chunks(beta.astype(f32))
    idx = jnp.arange(GDN_CHUNK)
    tril = idx[:, None] >= idx[None, :]
    strict = idx[:, None] > idx[None, :]
    decay = jnp.exp(jnp.where(tril, gc[..., :, None] - gc[..., None, :], -jnp.inf))
    kb = kc * bc[..., None]
    vb = vc * bc[..., None]
    lower = jnp.where(strict, jnp.einsum('nbhid,nbhjd->nbhij', kb, kc) * decay, 0.0)
    eye = jnp.eye(GDN_CHUNK, dtype=f32)
    tmat = lax.linalg.triangular_solve(eye + lower, jnp.broadcast_to(eye, lower.shape),
                                       left_side=True, lower=True, unit_diagonal=True)
    u = jnp.einsum('nbhij,nbhjd->nbhid', tmat, vb)
    w = jnp.einsum('nbhij,nbhjd->nbhid', tmat, kb * jnp.exp(gc)[..., None])
    qk_intra = jnp.where(tril, jnp.einsum('nbhid,nbhjd->nbhij', qc, kc) * decay, 0.0)

    def step(state, inp):
        q_i, k_i, u_i, w_i, g_i, a_i = inp
        v_new = u_i - jnp.einsum('bhcd,bhde->bhce', w_i, state)
        o = (jnp.einsum('bhcd,bhde->bhce', q_i * jnp.exp(g_i)[..., None], state)
             + jnp.einsum('bhij,bhje->bhie', a_i, v_new))
        g_last = g_i[..., -1]
        state = (state * jnp.exp(g_last)[..., None, None]
                 + jnp.einsum('bhcd,bhce->bhde', k_i * jnp.exp(g_last[..., None] - g_i)[..., None], v_new))
        return state, o

    state0 = jnp.zeros((b, h, dk, dv), f32)
    _, o = lax.scan(step, state0, (qc, kc, u, w, gc, qk_intra))
    return jnp.moveaxis(o, (0, 2), (1, 3)).reshape(b, s, h, dv)


def gdn_mixer(q, k, v, z, b_logit, a_logit, conv_w, a_log, dt_bias, out_norm):
    bsz, s, _ = q.shape
    dt = q.dtype
    qkv = jax.nn.silu(causal_depthwise_conv(jnp.concatenate([q, k, v], axis=-1), conv_w))
    q, k, v = jnp.split(qkv, [GDN_QK, 2 * GDN_QK], axis=-1)
    q = l2_norm(q.reshape(bsz, s, GDN_HEADS, GDN_DK))
    k = l2_norm(k.reshape(bsz, s, GDN_HEADS, GDN_DK))
    v = v.reshape(bsz, s, GDN_HEADS, GDN_DV)
    beta = jax.nn.sigmoid(b_logit.astype(jnp.float32))
    g = -jnp.exp(a_log.astype(jnp.float32)) * jax.nn.softplus(a_logit.astype(jnp.float32) + dt_bias.astype(jnp.float32))
    o = gated_delta_rule(q, k, v, g, beta)
    o = rms_norm(o, out_norm) * jax.nn.silu(z.reshape(bsz, s, GDN_HEADS, GDN_DV).astype(jnp.float32))
    return o.reshape(bsz, s, GDN_V).astype(dt)


def short_conv_mixer(gate_b, gate_c, hx, conv_w):
    return gate_b * causal_depthwise_conv(gate_c * hx, conv_w)


def rel_bucket(rel):
    max_exact = REL_BUCKETS // 2
    n = jnp.maximum(rel, 0)
    large = max_exact + (jnp.log(jnp.maximum(n, max_exact).astype(jnp.float32) / max_exact)
                         / math.log(REL_MAX_DIST / max_exact) * (REL_BUCKETS - max_exact)).astype(jnp.int32)
    large = jnp.minimum(large, REL_BUCKETS - 1)
    return jnp.where(n < max_exact, n, large)


def diff_attention(q, k, v, q_gain, k_gain, lam_params, subln, rel_bias, lambda_init):
    bsz, s, _ = q.shape
    f32 = jnp.float32
    q = rms_norm(q.reshape(bsz, s, DIFF_HEADS, 2, DIFF_DQK), q_gain) * (DIFF_DQK ** -0.5)
    k = rms_norm(k.reshape(bsz, s, DIFF_HEADS, 2, DIFF_DQK), k_gain)
    v = v.reshape(bsz, s, DIFF_HEADS, DIFF_DV)
    lp = lam_params.astype(f32)
    lam = jnp.exp(jnp.sum(lp[0] * lp[1])) - jnp.exp(jnp.sum(lp[2] * lp[3])) + lambda_init
    nqb = s // ATTN_BLOCK
    qb = q.reshape(bsz, nqb, ATTN_BLOCK, DIFF_HEADS, 2, DIFF_DQK).transpose(1, 0, 3, 4, 2, 5)
    kt = k.transpose(0, 2, 3, 1, 4)
    vt = v.transpose(0, 2, 1, 3)
    k_pos = jnp.arange(s)

    def block(args):
        q_blk, i = args
        q_pos = i * ATTN_BLOCK + jnp.arange(ATTN_BLOCK)
        rel = q_pos[:, None] - k_pos[None, :]
        bias = jnp.moveaxis(rel_bias[rel_bucket(rel)], -1, 0).astype(f32)
        logits = jnp.einsum('bhmqd,bhmkd->bhmqk', q_blk, kt).astype(f32) + bias[None, :, None]
        logits = jnp.where(rel >= 0, logits, -jnp.inf)
        p = jax.nn.softmax(logits, axis=-1)
        attn = p[:, :, 0] - lam * p[:, :, 1]
        return jnp.einsum('bhqk,bhkd->bhqd', attn.astype(vt.dtype), vt)

    o = lax.map(block, (qb, jnp.arange(nqb)))
    o = o.transpose(1, 0, 3, 2, 4).reshape(bsz, s, DIFF_HEADS, DIFF_DV)
    o = rms_norm(o, subln) * (1.0 - lambda_init)
    return o.reshape(bsz, s, DIFF_V)


def peer_ffn(x, w_q, sub_keys, u_tab, v_tab):
    bsz, s, d = x.shape
    t = bsz * s
    xf = x.reshape(t, d)
    q = (xf @ w_q).reshape(t, PEER_HEADS, 2, PEER_DKEY // 2)
    scores = jnp.einsum('thpd,hpnd->thpn', q, sub_keys).astype(jnp.float32)
    s_top, i_top = lax.top_k(scores, PEER_TOPK)
    cand = (s_top[:, :, 0, :, None] + s_top[:, :, 1, None, :]).reshape(t, PEER_HEADS, PEER_TOPK * PEER_TOPK)
    cand_idx = (i_top[:, :, 0, :, None] * PEER_KEYS + i_top[:, :, 1, None, :]).reshape(t, PEER_HEADS, PEER_TOPK * PEER_TOPK)
    best, pos = lax.top_k(cand, PEER_TOPK)
    expert_idx = jnp.take_along_axis(cand_idx, pos, axis=-1)
    gates = jax.nn.softmax(best, axis=-1)
    nb = t // PEER_BLOCK

    def block(args):
        x_blk, idx_blk, g_blk = args
        hid = jax.nn.gelu(jnp.einsum('td,thkd->thk', x_blk, u_tab[idx_blk]), approximate=False)
        coef = (g_blk * hid.astype(jnp.float32)).astype(x_blk.dtype)
        return jnp.einsum('thk,thkd->td', coef, v_tab[idx_blk])

    out = lax.map(block, (xf.reshape(nb, PEER_BLOCK, d),
                          expert_idx.reshape(nb, PEER_BLOCK, PEER_HEADS, PEER_TOPK),
                          gates.reshape(nb, PEER_BLOCK, PEER_HEADS, PEER_TOPK)))
    return out.reshape(bsz, s, d)


def setup_inputs(seed: int = 0) -> dict:
    key = jax.random.key(seed)
    ks = jax.random.split(key, 20)
    f32 = jnp.float32

    def nrm(k, shape, scale):
        return jax.random.normal(k, shape, f32) * scale

    dt = jnp.exp(jax.random.uniform(ks[6], (DEPTH, GDN_HEADS), f32, math.log(1e-3), math.log(1e-1)))
    return {
        'x': nrm(ks[0], (BATCH, SEQ, D_MODEL), 1.0),
        'rel_bias': nrm(ks[1], (REL_BUCKETS, DIFF_HEADS), 0.5),
        'attn_norm': 1.0 + nrm(ks[2], (DEPTH, D_MODEL), 0.02),
        'w_in': nrm(ks[3], (DEPTH, D_MODEL, IN_WIDTH), D_MODEL ** -0.5),
        'gdn_conv': nrm(ks[4], (DEPTH, GDN_CONV, 2 * GDN_QK + GDN_V), GDN_CONV ** -0.5),
        'gdn_a_log': jnp.log(jax.random.uniform(ks[5], (DEPTH, GDN_HEADS), f32, 1.0, 16.0)),
        'gdn_dt_bias': dt + jnp.log(-jnp.expm1(-dt)),
        'gdn_out_norm': 1.0 + nrm(ks[7], (DEPTH, GDN_DV), 0.02),
        'sc_conv': nrm(ks[8], (DEPTH, SC_CONV, SC_WIDTH), SC_CONV ** -0.5),
        'diff_q_norm': 1.0 + nrm(ks[9], (DEPTH, DIFF_DQK), 0.02),
        'diff_k_norm': 1.0 + nrm(ks[10], (DEPTH, DIFF_DQK), 0.02),
        'diff_lambda': nrm(ks[11], (DEPTH, 4, DIFF_DQK), 0.1),
        'diff_subln': 1.0 + nrm(ks[12], (DEPTH, DIFF_DV), 0.02),
        'w_out': nrm(ks[13], (DEPTH, MIX_WIDTH, D_MODEL), MIX_WIDTH ** -0.5),
        'ffn_norm': 1.0 + nrm(ks[14], (DEPTH, D_MODEL), 0.02),
        'peer_wq': nrm(ks[15], (DEPTH, D_MODEL, PEER_HEADS * PEER_DKEY), D_MODEL ** -0.5),
        'peer_keys': nrm(ks[16], (DEPTH, PEER_HEADS, 2, PEER_KEYS, PEER_DKEY // 2), (PEER_DKEY // 2) ** -0.5),
        'peer_u': nrm(ks[17], (DEPTH, PEER_EXPERTS, D_MODEL), D_MODEL ** -0.5),
        'peer_v': nrm(ks[18], (DEPTH, PEER_EXPERTS, D_MODEL), 0.25),
    }


def reference(x, rel_bias, attn_norm, w_in, gdn_conv, gdn_a_log, gdn_dt_bias, gdn_out_norm,
              sc_conv, diff_q_norm, diff_k_norm, diff_lambda, diff_subln, w_out, ffn_norm,
              peer_wq, peer_keys, peer_u, peer_v):
    offsets = np.cumsum(IN_SPLITS)[:-1].tolist()
    h = x
    for l in range(DEPTH):
        lambda_init = 0.8 - 0.6 * math.exp(-0.3 * l)
        n = rms_norm(h, attn_norm[l])
        proj = n @ w_in[l]
        gq, gk, gv, gz, gb, ga, sb, sc, sh, dq, dk, dv = jnp.split(proj, offsets, axis=-1)
        y_gdn = gdn_mixer(gq, gk, gv, gz, gb, ga, gdn_conv[l], gdn_a_log[l], gdn_dt_bias[l], gdn_out_norm[l])
        y_sc = short_conv_mixer(sb, sc, sh, sc_conv[l])
        y_diff = diff_attention(dq, dk, dv, diff_q_norm[l], diff_k_norm[l], diff_lambda[l],
                                diff_subln[l], rel_bias, lambda_init)
        mixed = jnp.concatenate([y_gdn.astype(h.dtype), y_sc.astype(h.dtype), y_diff.astype(h.dtype)], axis=-1)
        h = h + mixed @ w_out[l]
        h = h + peer_ffn(rms_norm(h, ffn_norm[l]), peer_wq[l], peer_keys[l], peer_u[l], peer_v[l])
    return h
```

```cpp
#include <hip/hip_runtime.h>
#include <cstdio>
#include <cstdint>
#include <cstring>

#ifndef KO
#define KO 0
#endif
#ifndef MK_ONE_LAUNCH
#define MK_ONE_LAUNCH 0
#endif

namespace pg8 {
#define PG8_LAS __attribute__((address_space(3)))
typedef unsigned short bf16_t;
typedef short bf16x8 __attribute__((ext_vector_type(8)));
typedef float f32x4 __attribute__((ext_vector_type(4)));
typedef unsigned u32x4 __attribute__((ext_vector_type(4)));
constexpr int BM = 256, BK = 64, HALF = 128, HTB = HALF * BK * 2  , STAGE_BYTES = 8 * HTB, NXCD = 8, WGM = 8;

__host__ __device__ __forceinline__ int lds_byte(int r, int c) { const int st = (r >> 4) * 2 + (c >> 5), rr = r & 15, cc = c & 31, ob = rr * 64 + cc * 2; return st * 1024 + (ob ^ (((ob >> 9) & 1) << 5)); }
__host__ __device__ __forceinline__ void stage_rc(int b, int& R, int& C) { const int st = b / 1024, sb = b % 1024, swz = sb ^ (((sb >> 9) & 1) << 5); R = (st >> 1) * 16 + swz / 64; C = (st & 1) * 32 + (swz % 64) / 2; }
__host__ __device__ __forceinline__ int perm32(int rho) { const int n = rho >> 4, i = rho & 15; return 8 * (i >> 2) + 4 * n + (i & 3); }

struct Unit { int pm, pn; };
struct Gemm { const bf16_t* A; const bf16_t* Bt; int M, N, K; };

struct StaticOrder {
    int nM, nN, nwg, G, c;
    __host__ __device__ void init(int M, int N, int G_, int c_) { nM = M / BM; nN = N / BM; nwg = nM * nN; G = G_; c = c_; }
    __host__ __device__ bool next(int i, Unit& u) const {
        const long L = (long)i * G + c; if (L >= nwg) return false;
        int wgid = (int)L; { const int q = nwg / NXCD, r = nwg % NXCD, xcd = wgid % NXCD, off = wgid / NXCD; wgid = (xcd < r ? xcd * (q + 1) : r * (q + 1) + (xcd - r) * q) + off; }
        const int nig = WGM * nN, gid = wgid / nig, fm = gid * WGM, gsz = (nM - fm) < WGM ? (nM - fm) : WGM;
        u.pm = fm + ((wgid % nig) % gsz); u.pn = (wgid % nig) / gsz; return true;
    }
    __device__ __forceinline__ void a_ready(const Unit&) const {}
    __device__ __forceinline__ void done(const Unit&) const {}
};
__device__ __forceinline__ unsigned cvt_pk_bf16(float lo, float hi) { unsigned r; asm volatile("v_cvt_pk_bf16_f32 %0, %1, %2" : "=v"(r) : "v"(lo), "v"(hi)); return r; }
struct EpiResF32 {
    static constexpr bool PERM = false, AFTER_DRAIN = false;
    const float* R; float* C; int ldc;
    __device__ __forceinline__ void operator()(const f32x4 (&acc)[2][2][4][2], const Unit& u, int wr, int wc, int fr, int fq) const {
        const int row0 = u.pm * BM + wr * 64 + fr, col0 = u.pn * BM + wc * 32 + 4 * fq;
#pragma unroll
        for (int ai = 0; ai < 2; ++ai)
#pragma unroll
            for (int m = 0; m < 4; ++m) { const size_t ro = (size_t)(row0 + ai * HALF + m * 16) * ldc + col0;
#pragma unroll
                for (int bj = 0; bj < 2; ++bj)
#pragma unroll
                    for (int n = 0; n < 2; ++n) { const f32x4 r = *(const f32x4*)(R + ro + bj * HALF + n * 16); *(f32x4*)(C + ro + bj * HALF + n * 16) = acc[ai][bj][m][n] + r; } }
    }
};
struct EpiBf16 {
    static constexpr bool PERM = true, AFTER_DRAIN = false;
    bf16_t* O; int ldc;
    __device__ __forceinline__ void operator()(const f32x4 (&acc)[2][2][4][2], const Unit& u, int wr, int wc, int fr, int fq) const {
        const int row0 = u.pm * BM + wr * 64 + fr; const int col0 = u.pn * BM + wc * 32 + 8 * fq;
#pragma unroll
        for (int ai = 0; ai < 2; ++ai)
#pragma unroll
            for (int m = 0; m < 4; ++m) { bf16_t* rowp = O + (size_t)(row0 + ai * HALF + m * 16) * ldc + col0;
#pragma unroll
                for (int bj = 0; bj < 2; ++bj) { const f32x4 v0 = acc[ai][bj][m][0], v1 = acc[ai][bj][m][1];
                    u32x4 w; w.x = cvt_pk_bf16(v0[0], v0[1]); w.y = cvt_pk_bf16(v0[2], v0[3]); w.z = cvt_pk_bf16(v1[0], v1[1]); w.w = cvt_pk_bf16(v1[2], v1[3]);
                    *(u32x4*)(rowp + bj * HALF) = w; } }
    }
};

template <class Epi, class Sched, bool STAMP = false>
__device__ __forceinline__ void gemm_phase(PG8_LAS unsigned char* lds, const Gemm g, const Sched& S, const Epi& E, unsigned long long* stamps) {
    int tid_ = threadIdx.x; asm volatile("" : "+v"(tid_));
    const int tid = tid_, wid = __builtin_amdgcn_readfirstlane(tid >> 6), lane = tid & 63, wr = wid >> 2, wc = wid & 3, fr = lane & 15, fq = lane >> 4;
    const int K = g.K, nt = K / BK;
    int ts_lo = 0, ts_hi = 0, nts = 0; const unsigned long long rt_entry = STAMP ? (unsigned long long)wall_clock64() : 0ull;
#define PG8_STAMP() do { if (STAMP && wid == 0 && nts < 64) { const unsigned long long _c = (unsigned long long)clock64(); \
        ts_lo = (lane == nts) ? (int)(unsigned)_c : ts_lo; ts_hi = (lane == nts) ? (int)(unsigned)(_c >> 32) : ts_hi; ++nts; } } while (0)
    PG8_STAMP();
    unsigned voffA[2], voffB[2];
#pragma unroll
    for (int i = 0; i < 2; ++i) { int R, C; stage_rc(tid * 16 + i * 8192, R, C); const int Rb = Epi::PERM ? ((R & ~31) + perm32(R & 31)) : R;
        voffA[i] = (unsigned)(R * K + C) * 2u; voffB[i] = (unsigned)(Rb * K + C) * 2u; }
    const size_t kstep = (size_t)(BK * 2);
    const size_t hstep = (size_t)HALF * K * 2;
    const size_t tstep = 2 * hstep;
    const unsigned ldsw = (unsigned)wid * 1024u;
    const int aoff = lds_byte(wr * 64 + fr, fq * 8), boff = lds_byte(wc * 32 + fr, fq * 8);
#define PG8_SA(b, h) (((b) * 2 + (h)) * HTB)
#define PG8_SB(b, h) ((4 + (b) * 2 + (h)) * HTB)
#define PG8_STAGE(bufoff, gbase, voff) do { _Pragma("unroll") for (int _i = 0; _i < 2; ++_i) \
        __builtin_amdgcn_global_load_lds((const unsigned*)((const char*)(gbase) + (voff)[_i]), (PG8_LAS unsigned*)(lds + (bufoff) + ldsw + _i * 8192), 16, 0, 0); } while (0)
#define PG8_LDA(dst, b, h) do { _Pragma("unroll") for (int m = 0; m < 4; ++m) _Pragma("unroll") for (int k = 0; k < 2; ++k) dst[m][k] = *(const PG8_LAS bf16x8*)(lds + PG8_SA(b, h) + aoff + m * 2048 + k * 1024); } while (0)
#define PG8_LDB(dst, b, h) do { _Pragma("unroll") for (int n = 0; n < 2; ++n) _Pragma("unroll") for (int k = 0; k < 2; ++k) dst[n][k] = *(const PG8_LAS bf16x8*)(lds + PG8_SB(b, h) + boff + n * 2048 + k * 1024); } while (0)
#define PG8_MMA(ai, bj, At, Bt) do { __builtin_amdgcn_s_setprio(1); _Pragma("unroll") for (int m = 0; m < 4; ++m) _Pragma("unroll") for (int n = 0; n < 2; ++n) _Pragma("unroll") for (int k = 0; k < 2; ++k) \
        acc[ai][bj][m][n] = __builtin_amdgcn_mfma_f32_16x16x32_bf16(Bt[n][k], At[m][k], acc[ai][bj][m][n], 0, 0, 0); __builtin_amdgcn_s_setprio(0); } while (0)
#define PG8_WAIT_V(n) asm volatile("s_waitcnt vmcnt(" #n ")" ::: "memory")
#define PG8_WAIT_L(n) asm volatile("s_waitcnt lgkmcnt(" #n ")" ::: "memory")
#define PG8_BAR __builtin_amdgcn_s_barrier()
#define PG8_SCHED __builtin_amdgcn_sched_barrier(0)
    Unit cur, nxt; int ui = 0;
    if (!S.next(0, cur)) return;
    f32x4 acc[2][2][4][2];
#pragma unroll
    for (int a = 0; a < 2; ++a)
#pragma unroll
        for (int b = 0; b < 2; ++b)
#pragma unroll
            for (int m = 0; m < 4; ++m)
#pragma unroll
                for (int n = 0; n < 2; ++n) acc[a][b][m][n] = (f32x4){0.f, 0.f, 0.f, 0.f};
    bf16x8 At[4][2], B0[2][2], B1[2][2];
    const char* cA = (const char*)g.A + (size_t)cur.pm * tstep; const char* cB = (const char*)g.Bt + (size_t)cur.pn * tstep;
    S.a_ready(cur);
    PG8_STAGE(PG8_SB(0, 0), cB, voffB); PG8_STAGE(PG8_SA(0, 0), cA, voffA); PG8_STAGE(PG8_SB(0, 1), cB + hstep, voffB); PG8_STAGE(PG8_SA(0, 1), cA + hstep, voffA);
    if (wr == 1) PG8_BAR;
    PG8_WAIT_V(4); PG8_BAR;
    PG8_STAGE(PG8_SB(1, 0), cB + kstep, voffB); PG8_STAGE(PG8_SA(1, 0), cA + kstep, voffA); PG8_STAGE(PG8_SB(1, 1), cB + hstep + kstep, voffB);
    PG8_WAIT_V(6); PG8_BAR;
    PG8_STAMP();
    for (;;) {
        const bool has_next = S.next(ui + 1, nxt);
        const char* nA = has_next ? (const char*)g.A + (size_t)nxt.pm * tstep : cA; const char* nB = has_next ? (const char*)g.Bt + (size_t)nxt.pn * tstep : cB;
        for (int t = 0; t < nt; t += 2) {
            const bool last = (t == nt - 2);
            const char* a1 = cA + (size_t)(t + 1) * kstep;
            const char* a2 = last ? nA : cA + (size_t)(t + 2) * kstep; const char* b2 = last ? nB : cB + (size_t)(t + 2) * kstep;
            const char* a3 = a2 + kstep; const char* b3 = b2 + kstep;
            if (last && has_next) S.a_ready(nxt);
            PG8_LDB(B0, 0, 0); PG8_SCHED; PG8_LDA(At, 0, 0); PG8_STAGE(PG8_SA(1, 1), a1 + hstep, voffA);
            PG8_WAIT_L(8); PG8_BAR; PG8_WAIT_L(0); PG8_MMA(0, 0, At, B0); PG8_BAR; PG8_SCHED;
            PG8_LDB(B1, 0, 1); PG8_STAGE(PG8_SB(0, 0), b2, voffB);
            PG8_BAR; PG8_WAIT_L(0); PG8_MMA(0, 1, At, B1); PG8_BAR;
            PG8_LDA(At, 0, 1); PG8_STAGE(PG8_SA(0, 0), a2, voffA);
            PG8_BAR; PG8_WAIT_L(0); PG8_MMA(1, 0, At, B0); PG8_BAR; PG8_SCHED;
            PG8_STAGE(PG8_SB(0, 1), b2 + hstep, voffB);
            PG8_WAIT_V(6); PG8_BAR; PG8_MMA(1, 1, At, B1); PG8_BAR;
            PG8_LDB(B0, 1, 0); PG8_SCHED; PG8_LDA(At, 1, 0); PG8_STAGE(PG8_SA(0, 1), a2 + hstep, voffA);
            PG8_WAIT_L(8); PG8_BAR; PG8_WAIT_L(0); PG8_MMA(0, 0, At, B0); PG8_BAR; PG8_SCHED;
            PG8_LDB(B1, 1, 1); PG8_STAGE(PG8_SB(1, 0), b3, voffB);
            PG8_BAR; PG8_WAIT_L(0); PG8_MMA(0, 1, At, B1); PG8_BAR;
            PG8_LDA(At, 1, 1); PG8_STAGE(PG8_SA(1, 0), a3, voffA);
            PG8_BAR; PG8_WAIT_L(0); PG8_MMA(1, 0, At, B0); PG8_BAR; PG8_SCHED;
            PG8_STAGE(PG8_SB(1, 1), b3 + hstep, voffB);
            PG8_WAIT_V(6); PG8_BAR; PG8_MMA(1, 1, At, B1); PG8_BAR;
        }
        PG8_STAMP();
        if constexpr (!Epi::AFTER_DRAIN) { E(acc, cur, wr, wc, fr, fq); S.done(cur); }
        PG8_STAMP();
        if (!has_next) break;
#pragma unroll
        for (int a = 0; a < 2; ++a)
#pragma unroll
            for (int b = 0; b < 2; ++b)
#pragma unroll
                for (int m = 0; m < 4; ++m)
#pragma unroll
                    for (int n = 0; n < 2; ++n) acc[a][b][m][n] = (f32x4){0.f, 0.f, 0.f, 0.f};
        cur = nxt; cA = nA; cB = nB; ++ui;
    }
    PG8_WAIT_V(0);
    if (wr == 0) PG8_BAR;
    PG8_BAR;
    if constexpr (Epi::AFTER_DRAIN) { E.fused(acc, cur, wr, wc, fr, fq, lds, wid, lane); S.done(cur); }
    PG8_STAMP();
    if (STAMP && wid == 0) { stamps[lane] = lane < nts ? (((unsigned long long)(unsigned)ts_hi << 32) | (unsigned)ts_lo) : 0ull;
        if (lane == 62) stamps[62] = rt_entry; if (lane == 63) stamps[63] = (unsigned long long)wall_clock64(); }
#undef PG8_STAMP
#undef PG8_SA
#undef PG8_SB
#undef PG8_STAGE
#undef PG8_LDA
#undef PG8_LDB
#undef PG8_MMA
#undef PG8_WAIT_V
#undef PG8_WAIT_L
#undef PG8_BAR
#undef PG8_SCHED
}
}

using pg8::bf16_t; using pg8::bf16x8; using pg8::f32x4; using pg8::u32x4;
typedef unsigned u32x2 __attribute__((ext_vector_type(2)));
constexpr int T = 16384, D = 1024, SEQ = 2048, NPROJ = 3584, NINW = 3592, NEXP = 16384;
constexpr int C_GQ = 0, C_GK = 512, C_GV = 1024, C_GZ = 1536, C_SB = 2048, C_SC = 2304, C_SH = 2560, C_DQ = 2816, C_DK = 3072, C_DV = 3328;
constexpr size_t MiB = 1u << 20;
constexpr size_t WS_CTL = 0, CTL_BYTES = 1 * MiB, WS_WIN = 2 * MiB, WS_WOUT = 16 * MiB, WS_WQ = 20 * MiB, WS_KEYS = 28 * MiB, WS_WGATE = 29 * MiB,
    WS_UT = 32 * MiB, WS_VT = 96 * MiB, WS_NBUF = 160 * MiB, WS_PROJ = 192 * MiB, WS_QP = 192 * MiB, WS_QKVC = 304 * MiB, WS_MIXED = 352 * MiB, WS_GB = 384 * MiB,
    WS_AQ = 385 * MiB, WS_AK = 393 * MiB, WS_OGDN = 401 * MiB, WS_ATT = 433 * MiB, WS_END = 465 * MiB;
constexpr int CW_BAR = 4096;
constexpr int LDS_BYTES = 155648;
constexpr int MISC_OFF = 155648 - 256;
constexpr int NPHASE = 19;

__device__ __forceinline__ float bf_lo(unsigned w) { return __uint_as_float(w << 16); }
__device__ __forceinline__ float bf_hi(unsigned w) { return __uint_as_float(w & 0xffff0000u); }
__device__ __forceinline__ unsigned f2bf(float f) { unsigned u = __float_as_uint(f); return (u + 0x7fffu + ((u >> 16) & 1u)) >> 16; }
__device__ __forceinline__ unsigned pk2(float lo, float hi) { return f2bf(lo) | (f2bf(hi) << 16); }
__device__ __forceinline__ float wave_sum(float v) {
#pragma unroll
    for (int o = 1; o < 64; o <<= 1) v += __shfl_xor(v, o);
    return v;
}
__device__ __forceinline__ float silu_f(float x) { return x / (1.0f + __expf(-x)); }

#define XB_TMO      128
#define XB_XCNT(j)  (256  + 64 * (j))
#define XB_XSUB(j)  (1280 + 64 * (j))
#define XB_XGEN(j)  (2304 + 64 * (j))
#define XB_TOP      3328
#define XB_TOPGEN   3392
#define XCD_BAR_WORDS 3456
#define XB_SPIN_CAP (1u << 18)
#define LAS __attribute__((address_space(3)))

__device__ __forceinline__ unsigned xb_ld(unsigned* p)              { return __hip_atomic_load(p, __ATOMIC_RELAXED, __HIP_MEMORY_SCOPE_AGENT); }
__device__ __forceinline__ unsigned xb_add(unsigned* p, unsigned v) { return __hip_atomic_fetch_add(p, v, __ATOMIC_RELAXED, __HIP_MEMORY_SCOPE_AGENT); }
__device__ __forceinline__ unsigned xb_xcc_id() { return (unsigned)__builtin_amdgcn_s_getreg((3 << 11) | 20) & 0xFu; }
#define XB_SPIN(cond, bar) do { unsigned _sp = 0; while (cond) { __builtin_amdgcn_s_sleep(1); \
    if ((++_sp & 255u) == 0u) { if (xb_ld(&(bar)[XB_TMO])) break; if (_sp > XB_SPIN_CAP) { atomicAdd(&(bar)[XB_TMO], 1u); break; } } } } while (0)

struct XcdBarrier {
    unsigned* bar; unsigned x;
    volatile LAS unsigned* st;
};

__device__ __forceinline__ XcdBarrier xcd_barrier_post(unsigned* bar, volatile LAS unsigned* st) {
    XcdBarrier b; b.bar = bar; b.x = xb_xcc_id(); b.st = st;
    if (threadIdx.x == 0) (void)xb_add(&bar[XB_XCNT(b.x)], 1u);
    return b;
}
__device__ __forceinline__ void xcd_barrier_complete(unsigned* bar, unsigned x, unsigned& nloc, unsigned& nx) {
    const unsigned G = gridDim.x * gridDim.y * gridDim.z;
    unsigned sum, cnt, mine, sp = 0u;
    for (;;) {
        sum = 0u; cnt = 0u; mine = 0u;
#pragma unroll
        for (unsigned j = 0; j < 16; ++j) { const unsigned c = xb_ld(&bar[XB_XCNT(j)]); sum += c; cnt += (c > 0u) ? 1u : 0u; mine = (j == x) ? c : mine; }
        if (sum == G) break;
        __builtin_amdgcn_s_sleep(1);
        if ((++sp & 255u) == 0u) { if (xb_ld(&bar[XB_TMO])) break; if (sp > XB_SPIN_CAP) { atomicAdd(&bar[XB_TMO], 1u); break; } }
    }
    nloc = mine > 0u ? mine : 1u; nx = cnt > 0u ? cnt : 1u;
}

__device__ __forceinline__ void xcd_barrier(const XcdBarrier& b) {
    asm volatile("s_waitcnt vmcnt(0)" ::: "memory");
    __syncthreads();
    if (threadIdx.x == 0) {
        unsigned* bar = b.bar;
        __builtin_amdgcn_s_waitcnt(0);
        unsigned nloc = b.st[0], nx = b.st[1];
        if (nloc == 0u) { xcd_barrier_complete(bar, b.x, nloc, nx); b.st[0] = nloc; b.st[1] = nx; }
        const unsigned old = xb_add(&bar[XB_XSUB(b.x)], 1u);
        const unsigned gen = old / nloc;
        if (old + 1u == (gen + 1u) * nloc) {
            __builtin_amdgcn_fence(__ATOMIC_RELEASE, "agent");
            asm volatile("s_waitcnt vmcnt(0)" ::: "memory");
            const unsigned og = xb_add(&bar[XB_TOP], 1u);
            const unsigned tg = og / nx;
            if (og + 1u == (tg + 1u) * nx) xb_add(&bar[XB_TOPGEN], 1u);
            else XB_SPIN(xb_ld(&bar[XB_TOPGEN]) == tg, bar);
            __builtin_amdgcn_fence(__ATOMIC_ACQUIRE, "agent");
            xb_add(&bar[XB_XGEN(b.x)], 1u);
            asm volatile("s_waitcnt vmcnt(0)" ::: "memory");
        } else {
            XB_SPIN(xb_ld(&bar[XB_XGEN(b.x)]) == gen, bar);
            __builtin_amdgcn_fence(__ATOMIC_ACQUIRE, "agent");
            asm volatile("s_waitcnt vmcnt(0)" ::: "memory");
        }
    }
    __syncthreads();
}

struct Args { const float* in[19]; float* out; unsigned char* ws; int ph_lo, ph_hi; };
struct Ctx {
    LAS unsigned char* lds; int tid, lane, wave, G, bid;
};

__device__ __forceinline__ void cvt_flat8(const float* src, unsigned char* dst, size_t n8, size_t gt, size_t NT) {
    const float4* s = (const float4*)src; u32x4* d = (u32x4*)dst;
    for (size_t i = gt; i < n8; i += NT) { const float4 a = s[2 * i], b = s[2 * i + 1]; u32x4 w; w.x = pk2(a.x, a.y); w.y = pk2(a.z, a.w); w.z = pk2(b.x, b.y); w.w = pk2(b.z, b.w); d[i] = w; }
}
__device__ __forceinline__ void cvt_transpose(const float* w, bf16_t* dst, int N, size_t gt, size_t NT) {
    const size_t items = (size_t)2 * 128 * N;
    for (size_t i = gt; i < items; i += NT) {
        const int cc = (int)(i % N), kb = (int)((i / N) % 128), l = (int)(i / ((size_t)N * 128));
        const float* s = w + ((size_t)l * 1024 + kb * 8) * N + cc; float v[8];
#pragma unroll
        for (int j = 0; j < 8; ++j) v[j] = s[(size_t)j * N];
        u32x4 o; o.x = pk2(v[0], v[1]); o.y = pk2(v[2], v[3]); o.z = pk2(v[4], v[5]); o.w = pk2(v[6], v[7]);
        *(u32x4*)(dst + ((size_t)l * N + cc) * 1024 + kb * 8) = o;
    }
}
__device__ __forceinline__ void p0_prologue(Ctx& c, const Args& A) {
    const size_t gt = (size_t)c.bid * 512 + c.tid, NT = (size_t)c.G * 512;
    cvt_flat8(A.in[17], A.ws + WS_UT, (size_t)2 * NEXP * 1024 / 8, gt, NT);
    cvt_flat8(A.in[18], A.ws + WS_VT, (size_t)2 * NEXP * 1024 / 8, gt, NT);
    cvt_flat8(A.in[16], A.ws + WS_KEYS, (size_t)2 * 8 * 2 * 128 * 128 / 8, gt, NT);
    cvt_transpose(A.in[13], (bf16_t*)(A.ws + WS_WOUT), 1024, gt, NT);
    cvt_transpose(A.in[15], (bf16_t*)(A.ws + WS_WQ), 2048, gt, NT);
    {
        const float* w = A.in[3]; const size_t items = (size_t)2 * 128 * NINW;
        for (size_t i = gt; i < items; i += NT) {
            const int cc = (int)(i % NINW), kb = (int)((i / NINW) % 128), l = (int)(i / ((size_t)NINW * 128));
            const float* s = w + ((size_t)l * 1024 + kb * 8) * NINW + cc; float v[8];
#pragma unroll
            for (int j = 0; j < 8; ++j) v[j] = s[(size_t)j * NINW];
            if (cc >= 2048 && cc < 2056) { float* d = (float*)(A.ws + WS_WGATE) + ((size_t)l * 8 + (cc - 2048)) * 1024 + kb * 8;
                *(float4*)d = make_float4(v[0], v[1], v[2], v[3]); *(float4*)(d + 4) = make_float4(v[4], v[5], v[6], v[7]); }
            else { const int c2 = cc < 2048 ? cc : cc - 8; u32x4 o; o.x = pk2(v[0], v[1]); o.y = pk2(v[2], v[3]); o.z = pk2(v[4], v[5]); o.w = pk2(v[6], v[7]);
                *(u32x4*)((bf16_t*)(A.ws + WS_WIN) + ((size_t)l * NPROJ + c2) * 1024 + kb * 8) = o; }
        }
    }
}

__device__ __forceinline__ void phase_norm(Ctx& c, const Args& A, const float* src, const float* gain, bf16_t* dst, const float* wgate, const float* a_log, const float* dt_bias, float* GB) {
    const int gw = c.bid * 8 + c.wave, NGW = c.G * 8, lane = c.lane;
    for (int m = gw; m < T; m += NGW) {
        const float4* xr = (const float4*)(src + (size_t)m * D) + lane; float4 v[4]; float s = 0.f;
#pragma unroll
        for (int j = 0; j < 4; ++j) { v[j] = xr[64 * j]; s += (v[j].x * v[j].x + v[j].y * v[j].y) + (v[j].z * v[j].z + v[j].w * v[j].w); }
        const float rstd = rsqrtf(wave_sum(s) * (1.0f / D) + 1e-6f);
        u32x2* o8 = (u32x2*)(dst + (size_t)m * D) + lane;
#pragma unroll
        for (int j = 0; j < 4; ++j) { const float4 g = ((const float4*)gain)[lane + 64 * j];
            v[j].x *= rstd * g.x; v[j].y *= rstd * g.y; v[j].z *= rstd * g.z; v[j].w *= rstd * g.w;
            u32x2 w; w.x = pk2(v[j].x, v[j].y); w.y = pk2(v[j].z, v[j].w); o8[64 * j] = w; }
        if (wgate) {
            float r = 0.f;
#pragma unroll
            for (int q = 0; q < 8; ++q) { float d = 0.f;
#pragma unroll
                for (int j = 0; j < 4; ++j) { const float4 w = ((const float4*)(wgate + q * 1024))[lane + 64 * j]; d += (v[j].x * w.x + v[j].y * w.y) + (v[j].z * w.z + v[j].w * w.w); }
                d = wave_sum(d); if (lane == q) r = d; }
            if (lane < 8) { float o;
                if (lane < 4) o = 1.0f / (1.0f + __expf(-r));
                else { const float z = r + dt_bias[lane - 4]; const float sp = z > 20.f ? z : log1pf(__expf(z)); o = -__expf(a_log[lane - 4]) * sp; }
                GB[(size_t)m * 8 + lane] = o; }
        }
    }
}

__device__ __forceinline__ void phase_prep(Ctx& c, const Args& A, int l) {
    const int gw = c.bid * 8 + c.wave, NGW = c.G * 8, lane = c.lane;
    const bf16_t* PROJ = (const bf16_t*)(A.ws + WS_PROJ);
    bf16_t* QKVC = (bf16_t*)(A.ws + WS_QKVC); bf16_t* AQ = (bf16_t*)(A.ws + WS_AQ); bf16_t* AK = (bf16_t*)(A.ws + WS_AK); bf16_t* MIXED = (bf16_t*)(A.ws + WS_MIXED);
    const float* gconv = A.in[4] + (size_t)l * 4 * 1536; const float* sconv = A.in[8] + (size_t)l * 3 * 256;
    const float* qg = A.in[9] + l * 32; const float* kg = A.in[10] + l * 32;
    for (int t = gw; t < T; t += NGW) {
        const int s = t & (SEQ - 1);
#pragma unroll 1
        for (int grp = 0; grp < 12; ++grp) {
            const int ch = grp * 128 + 2 * lane; float a0 = 0.f, a1 = 0.f;
#pragma unroll
            for (int j = 0; j < 4; ++j) { if (s - 3 + j >= 0) { const unsigned w = *(const unsigned*)(PROJ + (size_t)(t - 3 + j) * NPROJ + ch); const float2 cw = *(const float2*)(gconv + j * 1536 + ch);
                a0 += cw.x * bf_lo(w); a1 += cw.y * bf_hi(w); } }
            a0 = silu_f(a0); a1 = silu_f(a1);
            if (grp < 8) { const float r = rsqrtf(wave_sum(a0 * a0 + a1 * a1) + 1e-6f); a0 *= r; a1 *= r; }
            *(unsigned*)(QKVC + (size_t)t * 1536 + ch) = pk2(a0, a1);
        }
        {
            const u32x2 wq = *(const u32x2*)(PROJ + (size_t)t * NPROJ + C_DQ + 4 * lane), wk = *(const u32x2*)(PROJ + (size_t)t * NPROJ + C_DK + 4 * lane);
            float q[4] = {bf_lo(wq.x), bf_hi(wq.x), bf_lo(wq.y), bf_hi(wq.y)}, k[4] = {bf_lo(wk.x), bf_hi(wk.x), bf_lo(wk.y), bf_hi(wk.y)};
            float sq = (q[0] * q[0] + q[1] * q[1]) + (q[2] * q[2] + q[3] * q[3]), sk = (k[0] * k[0] + k[1] * k[1]) + (k[2] * k[2] + k[3] * k[3]);
#pragma unroll
            for (int o = 1; o < 8; o <<= 1) { sq += __shfl_xor(sq, o); sk += __shfl_xor(sk, o); }
            const float rq = rsqrtf(sq * (1.0f / 32.0f) + 1e-6f) * 0.17677669529663687f, rk = rsqrtf(sk * (1.0f / 32.0f) + 1e-6f);
            const float4 g4 = *(const float4*)(qg + 4 * (lane & 7)), h4 = *(const float4*)(kg + 4 * (lane & 7));
            u32x2 oq, ok; oq.x = pk2(q[0] * rq * g4.x, q[1] * rq * g4.y); oq.y = pk2(q[2] * rq * g4.z, q[3] * rq * g4.w);
            ok.x = pk2(k[0] * rk * h4.x, k[1] * rk * h4.y); ok.y = pk2(k[2] * rk * h4.z, k[3] * rk * h4.w);
            *(u32x2*)(AQ + (size_t)t * 256 + 4 * lane) = oq; *(u32x2*)(AK + (size_t)t * 256 + 4 * lane) = ok;
        }
        {
            const int ch = 4 * lane; float a[4] = {0.f, 0.f, 0.f, 0.f};
#pragma unroll
            for (int j = 0; j < 3; ++j) { if (s - 2 + j >= 0) { const bf16_t* r = PROJ + (size_t)(t - 2 + j) * NPROJ;
                const u32x2 wc = *(const u32x2*)(r + C_SC + ch), wh = *(const u32x2*)(r + C_SH + ch); const float4 cw = *(const float4*)(sconv + j * 256 + ch);
                a[0] += cw.x * (bf_lo(wc.x) * bf_lo(wh.x)); a[1] += cw.y * (bf_hi(wc.x) * bf_hi(wh.x)); a[2] += cw.z * (bf_lo(wc.y) * bf_lo(wh.y)); a[3] += cw.w * (bf_hi(wc.y) * bf_hi(wh.y)); } }
            const u32x2 wb = *(const u32x2*)(PROJ + (size_t)t * NPROJ + C_SB + ch);
            u32x2 o; o.x = pk2(bf_lo(wb.x) * a[0], bf_hi(wb.x) * a[1]); o.y = pk2(bf_lo(wb.y) * a[2], bf_hi(wb.y) * a[3]);
            *(u32x2*)(MIXED + (size_t)t * 1024 + 512 + ch) = o;
        }
    }
}

__device__ __forceinline__ void gdn_seq_unit(Ctx& c, const Args& A, int u) {
    const int bh = u >> 1, j0 = (u & 1) * 64, b = bh >> 2, h = bh & 3, tid = c.tid, lane = c.lane;
    const bf16_t* QKVC = (const bf16_t*)(A.ws + WS_QKVC); const float* GB = (const float*)(A.ws + WS_GB); float* OG = (float*)(A.ws + WS_OGDN);
    LAS float* kq = (LAS float*)c.lds;
    LAS float* vv = (LAS float*)(c.lds + 65536);
    LAS float* bg = (LAS float*)(c.lds + 65536 + 16384);
    float S[128];
#pragma unroll
    for (int d = 0; d < 128; ++d) S[d] = 0.f;
    for (int ck = 0; ck < 32; ++ck) {
        const int t0 = b * SEQ + ck * 64;
        __syncthreads();
        for (int e = tid; e < 64 * 128; e += 512) { const int i = e >> 7, p = (e & 127) * 2;
            const int col = p < 128 ? (C_GK + h * 128 + p) : (C_GQ + h * 128 + (p - 128));
            const unsigned w = *(const unsigned*)(QKVC + (size_t)(t0 + i) * 1536 + col); kq[i * 256 + p] = bf_lo(w); kq[i * 256 + p + 1] = bf_hi(w); }
        for (int e = tid; e < 64 * 32; e += 512) { const int i = e >> 5, p = (e & 31) * 2; const unsigned w = *(const unsigned*)(QKVC + (size_t)(t0 + i) * 1536 + C_GV + h * 128 + j0 + p); vv[i * 64 + p] = bf_lo(w); vv[i * 64 + p + 1] = bf_hi(w); }
        if (tid < 64) { bg[tid] = GB[(size_t)(t0 + tid) * 8 + h]; bg[64 + tid] = __expf(GB[(size_t)(t0 + tid) * 8 + 4 + h]); }
        __syncthreads();
        if (c.wave == 0) {
            for (int i = 0; i < 64; ++i) {
                const float beta = bg[i], al = bg[64 + i]; const LAS f32x4* kr = (const LAS f32x4*)(kq + i * 256); const LAS f32x4* qr = kr + 32;
                float ks = 0.f;
#pragma unroll
                for (int dg = 0; dg < 4; ++dg) {
#pragma unroll
                    for (int dd = 0; dd < 8; ++dd) { const int d4 = dg * 8 + dd; const f32x4 k4 = kr[d4]; ks += (k4.x * S[4 * d4] + k4.y * S[4 * d4 + 1]) + (k4.z * S[4 * d4 + 2] + k4.w * S[4 * d4 + 3]); }
                    asm volatile("" ::: "memory"); }
                const float delta = beta * (vv[i * 64 + lane] - al * ks); float o = 0.f;
#pragma unroll
                for (int dg = 0; dg < 8; ++dg) {
#pragma unroll
                    for (int dd = 0; dd < 4; ++dd) { const int d4 = dg * 4 + dd; const f32x4 k4 = kr[d4], q4 = qr[d4];
                        S[4 * d4] = al * S[4 * d4] + k4.x * delta; S[4 * d4 + 1] = al * S[4 * d4 + 1] + k4.y * delta; S[4 * d4 + 2] = al * S[4 * d4 + 2] + k4.z * delta; S[4 * d4 + 3] = al * S[4 * d4 + 3] + k4.w * delta;
                        o += (q4.x * S[4 * d4] + q4.y * S[4 * d4 + 1]) + (q4.z * S[4 * d4 + 2] + q4.w * S[4 * d4 + 3]); }
                    asm volatile("" ::: "memory"); }
                OG[(size_t)(t0 + i) * 512 + h * 128 + j0 + lane] = o * 0.08838834764831845f;
            }
        }
    }
    __syncthreads();
}
__device__ __forceinline__ int rel_bucket(int n) {
    if (n < 16) return n;
    const int v = 16 + (int)(__logf((float)n * (1.0f / 16.0f)) / 2.0794415416798357f * 16.0f);
    return v < 31 ? v : 31;
}
__device__ __forceinline__ void attn_naive_rows(Ctx& c, const Args& A, int l, int first_block, int nblocks) {
    const bf16_t* PROJ = (const bf16_t*)(A.ws + WS_PROJ); const bf16_t* AQ = (const bf16_t*)(A.ws + WS_AQ); const bf16_t* AK = (const bf16_t*)(A.ws + WS_AK); float* ATT = (float*)(A.ws + WS_ATT);
    LAS float* bt = (LAS float*)c.lds;
    LAS float* cs = bt + 512;
    const float* rel_bias = A.in[1];
    __syncthreads();
    { const int n = c.tid & 127, hh = c.tid >> 7; bt[hh * 128 + n] = rel_bias[rel_bucket(n) * 4 + hh]; }
    if (c.tid == 0) {
        float mq = 0.f, mk = 0.f, mb = 0.f;
        for (int d = 0; d < 32; ++d) { mq = fmaxf(mq, fabsf(A.in[9][l * 32 + d])); mk = fmaxf(mk, fabsf(A.in[10][l * 32 + d])); }
        for (int i = 0; i < 128; ++i) mb = fmaxf(mb, fabsf(rel_bias[i]));
        cs[0] = 5.656854249492381f * mq * mk + mb;
    }
    __syncthreads();
    const float cshift = cs[0];
    for (int r = (c.bid - first_block) * 512 + c.tid; r < 4 * 8 * 2 * SEQ; r += nblocks * 512) {
        const int bhm = __builtin_amdgcn_readfirstlane(r >> 11), qpos = r & (SEQ - 1), mp = bhm & 1, bh = bhm >> 1, b = bh >> 2, h = bh & 3; const int t = b * SEQ + qpos;
        float q[32], o[64]; float lsum = 0.f;
        { const u32x4* qp = (const u32x4*)(AQ + (size_t)t * 256 + h * 64 + mp * 32);
#pragma unroll
          for (int i = 0; i < 4; ++i) { const u32x4 w = qp[i]; q[8 * i] = bf_lo(w.x); q[8 * i + 1] = bf_hi(w.x); q[8 * i + 2] = bf_lo(w.y); q[8 * i + 3] = bf_hi(w.y); q[8 * i + 4] = bf_lo(w.z); q[8 * i + 5] = bf_hi(w.z); q[8 * i + 6] = bf_lo(w.w); q[8 * i + 7] = bf_hi(w.w); } }
#pragma unroll
        for (int d = 0; d < 64; ++d) o[d] = 0.f;
        const int jmax = __builtin_amdgcn_readfirstlane(qpos | 63);
        for (int j = 0; j <= jmax; ++j) {
            const size_t tk = (size_t)(b * SEQ + j);
            const unsigned* kp = (const unsigned*)(AK + tk * 256 + h * 64 + mp * 32); const unsigned* vp = (const unsigned*)(PROJ + tk * NPROJ + C_DV + h * 64);
            float s0 = 0.f;
#pragma unroll
            for (int i = 0; i < 16; ++i) { const unsigned w0 = kp[i]; s0 += q[2 * i] * bf_lo(w0) + q[2 * i + 1] * bf_hi(w0); }
            const int n = qpos - j; const float bias = bt[h * 128 + (n < 127 ? (n < 0 ? 0 : n) : 127)];
            const float p0 = n >= 0 ? __expf(s0 + bias - cshift) : 0.f;
            lsum += p0;
#pragma unroll
            for (int i = 0; i < 32; ++i) { const unsigned w = vp[i]; o[2 * i] += p0 * bf_lo(w); o[2 * i + 1] += p0 * bf_hi(w); }
        }
        const float inv = 1.0f / lsum;
        float4* op = (float4*)(ATT + ((size_t)t * 8 + h * 2 + mp) * 64);
#pragma unroll
        for (int i = 0; i < 16; ++i) op[i] = make_float4(o[4 * i] * inv, o[4 * i + 1] * inv, o[4 * i + 2] * inv, o[4 * i + 3] * inv);
    }
    __syncthreads();
}
__device__ __forceinline__ void phase_gdn_out(Ctx& c, const Args& A, int l) {
    const int gw = c.bid * 8 + c.wave, NGW = c.G * 8, lane = c.lane;
    const bf16_t* PROJ = (const bf16_t*)(A.ws + WS_PROJ); const float* OG = (const float*)(A.ws + WS_OGDN); bf16_t* MIXED = (bf16_t*)(A.ws + WS_MIXED);
    const float2 gn = *(const float2*)(A.in[7] + l * 128 + 2 * lane);
    const float* ATT = (const float*)(A.ws + WS_ATT); const float* lamp = A.in[11] + l * 128; const float* subln = A.in[12] + l * 64;
    const float lambda_init = 0.8f - 0.6f * __expf(-0.3f * (float)l);
    float lam; { float s01 = lamp[lane & 31] * lamp[32 + (lane & 31)], s23 = lamp[64 + (lane & 31)] * lamp[96 + (lane & 31)];
#pragma unroll
        for (int of = 1; of < 32; of <<= 1) { s01 += __shfl_xor(s01, of); s23 += __shfl_xor(s23, of); }
        lam = __expf(s01) - __expf(s23) + lambda_init; }
    for (int t = gw; t < T; t += NGW) {
#pragma unroll
        for (int h = 0; h < 4; ++h) {
            const float2 o = *(const float2*)(OG + (size_t)t * 512 + h * 128 + 2 * lane);
            const float r = rsqrtf(wave_sum(o.x * o.x + o.y * o.y) * (1.0f / 128.0f) + 1e-6f);
            const unsigned z = *(const unsigned*)(PROJ + (size_t)t * NPROJ + C_GZ + h * 128 + 2 * lane);
            *(unsigned*)(MIXED + (size_t)t * 1024 + h * 128 + 2 * lane) = pk2(o.x * r * gn.x * silu_f(bf_lo(z)), o.y * r * gn.y * silu_f(bf_hi(z)));
        }
        {
            const int h = lane >> 4, d4 = (lane & 15) * 4;
            const float4 a0 = *(const float4*)(ATT + ((size_t)t * 8 + h * 2) * 64 + d4), a1 = *(const float4*)(ATT + ((size_t)t * 8 + h * 2 + 1) * 64 + d4);
            const float o0 = a0.x - lam * a1.x, o1 = a0.y - lam * a1.y, o2 = a0.z - lam * a1.z, o3 = a0.w - lam * a1.w;
            float ss = (o0 * o0 + o1 * o1) + (o2 * o2 + o3 * o3);
#pragma unroll
            for (int of = 1; of < 16; of <<= 1) ss += __shfl_xor(ss, of);
            const float rn = rsqrtf(ss * (1.0f / 64.0f) + 1e-6f) * (1.0f - lambda_init); const float4 sg = *(const float4*)(subln + d4);
            u32x2 w; w.x = pk2(o0 * rn * sg.x, o1 * rn * sg.y); w.y = pk2(o2 * rn * sg.z, o3 * rn * sg.w);
            *(u32x2*)(MIXED + (size_t)t * 1024 + 768 + h * 64 + d4) = w;
        }
    }
}

__device__ __forceinline__ unsigned ord_key(float f) { const unsigned u = __float_as_uint(f); return (u & 0x80000000u) ? ~u : (u | 0x80000000u); }
__device__ __forceinline__ float ord_val(unsigned o) { return __uint_as_float((o & 0x80000000u) ? (o & 0x7fffffffu) : ~o); }
__device__ __forceinline__ float gelu_erf(float x) { return 0.5f * x * (1.0f + erff(x * 0.7071067811865476f)); }
constexpr int PEER_SC_STRIDE = 129, PEER_TK_OFF = 256 * 129 * 4;
__device__ __forceinline__ void phase_peer(Ctx& c, const Args& A, int l) {
    const int tid = c.tid, lane = c.lane, wave = c.wave, fr = lane & 15, fq = lane >> 4;
    const bf16_t* QP = (const bf16_t*)(A.ws + WS_QP); const bf16_t* KEYS = (const bf16_t*)(A.ws + WS_KEYS) + (size_t)l * 16 * 128 * 128;
    const bf16_t* XF = (const bf16_t*)(A.ws + WS_NBUF); const bf16_t* UT = (const bf16_t*)(A.ws + WS_UT) + (size_t)l * NEXP * 1024; const bf16_t* VT = (const bf16_t*)(A.ws + WS_VT) + (size_t)l * NEXP * 1024;
    LAS unsigned* sc = (LAS unsigned*)c.lds;
    LAS unsigned* tk = (LAS unsigned*)(c.lds + PEER_TK_OFF);
    LAS int* eidx = (LAS int*)c.lds;
    LAS float* egate = (LAS float*)(c.lds + 8192);
    for (int tile = c.bid; tile < T / 16; tile += c.G) {
        const int t0 = tile * 16;
#pragma unroll 1
        for (int hh = 0; hh < 2; ++hh) {
            const int hp = wave * 2 + hh;
            f32x4 acc[8];
#pragma unroll
            for (int nb = 0; nb < 8; ++nb) acc[nb] = (f32x4){0.f, 0.f, 0.f, 0.f};
#pragma unroll
            for (int ks = 0; ks < 4; ++ks) {
                const bf16x8 qf = *(const bf16x8*)(QP + (size_t)(t0 + fr) * 2048 + hp * 128 + ks * 32 + 8 * fq);
#pragma unroll
                for (int nb = 0; nb < 8; ++nb) { const bf16x8 kf = *(const bf16x8*)(KEYS + ((size_t)hp * 128 + nb * 16 + fr) * 128 + ks * 32 + 8 * fq);
                    acc[nb] = __builtin_amdgcn_mfma_f32_16x16x32_bf16(kf, qf, acc[nb], 0, 0, 0); }
            }
            LAS unsigned* row = sc + (fr * 16 + hp) * PEER_SC_STRIDE;
#pragma unroll
            for (int nb = 0; nb < 8; ++nb)
#pragma unroll
                for (int r = 0; r < 4; ++r) { const int n = nb * 16 + 4 * fq + r; row[n] = (ord_key(acc[nb][r]) & ~127u) | (unsigned)(127 - n); }
        }
        __syncthreads();
        if (tid < 256) {
            const LAS unsigned* row = sc + tid * PEER_SC_STRIDE; unsigned prev = 0xFFFFFFFFu;
#pragma unroll 1
            for (int r = 0; r < 16; ++r) { unsigned m = 0u;
#pragma unroll 16
                for (int n = 0; n < 128; ++n) { unsigned v = row[n]; v = v < prev ? v : 0u; m = v > m ? v : m; }
                tk[tid * 16 + r] = m; prev = m; }
        }
        __syncthreads();
        if (tid < 128) {
            const int tl = tid >> 3, h = tid & 7; const LAS unsigned* a = tk + (tl * 16 + 2 * h) * 16; const LAS unsigned* b = a + 16;
            float s0[16], s1[16];
#pragma unroll
            for (int i = 0; i < 16; ++i) { s0[i] = ord_val(a[i] & ~127u); s1[i] = ord_val(b[i] & ~127u); }
            unsigned prev = 0xFFFFFFFFu; float mx = 0.f, sum = 0.f;
#pragma unroll 1
            for (int r = 0; r < 16; ++r) { unsigned m = 0u;
#pragma unroll
                for (int i = 0; i < 16; ++i)
#pragma unroll
                    for (int j = 0; j < 16 / (i + 1); ++j) { unsigned v = (ord_key(s0[i] + s1[j]) & ~255u) | (unsigned)(255 - (i * 16 + j)); v = v < prev ? v : 0u; m = v > m ? v : m; }
                prev = m; const int pos = 255 - (int)(m & 255u), pi = pos >> 4, pj = pos & 15;
                const float val = ord_val(m & ~255u); if (r == 0) mx = val; const float e = __expf(val - mx); sum += e;
                eidx[tl * 128 + h * 16 + r] = (127 - (int)(a[pi] & 127u)) * 128 + (127 - (int)(b[pj] & 127u)); egate[tl * 128 + h * 16 + r] = e; }
            const float inv = 1.0f / sum;
#pragma unroll 1
            for (int r = 0; r < 16; ++r) egate[tl * 128 + h * 16 + r] *= inv;
        }
        __syncthreads();
#pragma unroll 1
        for (int tt = 0; tt < 2; ++tt) {
            const int tl = wave * 2 + tt; const size_t t = (size_t)(t0 + tl);
            float x[16], out[16];
            { const u32x4 xa = *(const u32x4*)(XF + t * 1024 + 8 * lane), xb = *(const u32x4*)(XF + t * 1024 + 512 + 8 * lane);
              x[0] = bf_lo(xa.x); x[1] = bf_hi(xa.x); x[2] = bf_lo(xa.y); x[3] = bf_hi(xa.y); x[4] = bf_lo(xa.z); x[5] = bf_hi(xa.z); x[6] = bf_lo(xa.w); x[7] = bf_hi(xa.w);
              x[8] = bf_lo(xb.x); x[9] = bf_hi(xb.x); x[10] = bf_lo(xb.y); x[11] = bf_hi(xb.y); x[12] = bf_lo(xb.z); x[13] = bf_hi(xb.z); x[14] = bf_lo(xb.w); x[15] = bf_hi(xb.w); }
#pragma unroll
            for (int i = 0; i < 16; ++i) out[i] = 0.f;
            const int idx_lo = eidx[tl * 128 + lane], idx_hi = eidx[tl * 128 + 64 + lane];
            const int g_lo = __float_as_int(egate[tl * 128 + lane]), g_hi = __float_as_int(egate[tl * 128 + 64 + lane]);
#pragma unroll 1
            for (int jb = 0; jb < 128; jb += 4) {
                u32x4 ua[4], ub[4], va[4], vb[4]; float gs[4];
                const int isrc = jb < 64 ? idx_lo : idx_hi, gsrc = jb < 64 ? g_lo : g_hi;
#pragma unroll
                for (int e = 0; e < 4; ++e) { const int ex = __builtin_amdgcn_readlane(isrc, (jb & 63) + e); gs[e] = __int_as_float(__builtin_amdgcn_readlane(gsrc, (jb & 63) + e));
                    const u32x4* up = (const u32x4*)(UT + (size_t)ex * 1024); const u32x4* vp = (const u32x4*)(VT + (size_t)ex * 1024);
                    ua[e] = up[lane]; ub[e] = up[64 + lane]; va[e] = vp[lane]; vb[e] = vp[64 + lane]; }
#pragma unroll
                for (int e = 0; e < 4; ++e) {
                    float d = (x[0] * bf_lo(ua[e].x) + x[1] * bf_hi(ua[e].x)) + (x[2] * bf_lo(ua[e].y) + x[3] * bf_hi(ua[e].y)) + (x[4] * bf_lo(ua[e].z) + x[5] * bf_hi(ua[e].z)) + (x[6] * bf_lo(ua[e].w) + x[7] * bf_hi(ua[e].w))
                            + (x[8] * bf_lo(ub[e].x) + x[9] * bf_hi(ub[e].x)) + (x[10] * bf_lo(ub[e].y) + x[11] * bf_hi(ub[e].y)) + (x[12] * bf_lo(ub[e].z) + x[13] * bf_hi(ub[e].z)) + (x[14] * bf_lo(ub[e].w) + x[15] * bf_hi(ub[e].w));
                    d = wave_sum(d);
                    const float cf = gs[e] * gelu_erf(d);
                    out[0] += cf * bf_lo(va[e].x); out[1] += cf * bf_hi(va[e].x); out[2] += cf * bf_lo(va[e].y); out[3] += cf * bf_hi(va[e].y); out[4] += cf * bf_lo(va[e].z); out[5] += cf * bf_hi(va[e].z); out[6] += cf * bf_lo(va[e].w); out[7] += cf * bf_hi(va[e].w);
                    out[8] += cf * bf_lo(vb[e].x); out[9] += cf * bf_hi(vb[e].x); out[10] += cf * bf_lo(vb[e].y); out[11] += cf * bf_hi(vb[e].y); out[12] += cf * bf_lo(vb[e].z); out[13] += cf * bf_hi(vb[e].z); out[14] += cf * bf_lo(vb[e].w); out[15] += cf * bf_hi(vb[e].w);
                }
            }
            float* hp = A.out + t * 1024;
            float4 h0 = *(float4*)(hp + 8 * lane), h1 = *(float4*)(hp + 8 * lane + 4), h2 = *(float4*)(hp + 512 + 8 * lane), h3 = *(float4*)(hp + 512 + 8 * lane + 4);
            h0.x += out[0]; h0.y += out[1]; h0.z += out[2]; h0.w += out[3]; h1.x += out[4]; h1.y += out[5]; h1.z += out[6]; h1.w += out[7];
            h2.x += out[8]; h2.y += out[9]; h2.z += out[10]; h2.w += out[11]; h3.x += out[12]; h3.y += out[13]; h3.z += out[14]; h3.w += out[15];
            *(float4*)(hp + 8 * lane) = h0; *(float4*)(hp + 8 * lane + 4) = h1; *(float4*)(hp + 512 + 8 * lane) = h2; *(float4*)(hp + 512 + 8 * lane + 4) = h3;
        }
        __syncthreads();
    }
}

__device__ __forceinline__ bool relaunder(Ctx& c) { int t = threadIdx.x; asm volatile("" : "+v"(t)); c.tid = t; c.lane = t & 63; c.wave = __builtin_amdgcn_readfirstlane(t >> 6); return true; }
__global__ void __launch_bounds__(512, 2) fwd(Args a) {
    extern __shared__ __attribute__((aligned(16))) unsigned char lds_raw[];
    Ctx c; c.lds = (LAS unsigned char*)lds_raw; c.tid = threadIdx.x; c.lane = c.tid & 63; c.wave = __builtin_amdgcn_readfirstlane(c.tid >> 6); c.G = gridDim.x; c.bid = blockIdx.x;
    const Args& A = a;
    volatile LAS unsigned* MISC = (volatile LAS unsigned*)(c.lds + MISC_OFF);
    if (c.tid < 64) MISC[c.tid] = 0u;
    __syncthreads();
    const int lo = a.ph_lo, hi = a.ph_hi;
    XcdBarrier bar; bar.bar = (unsigned*)(A.ws + WS_CTL) + CW_BAR; bar.x = 0; bar.st = MISC + 8;
    if (hi - lo > 1) bar = xcd_barrier_post((unsigned*)(A.ws + WS_CTL) + CW_BAR, MISC + 8);
#define IN(k) (lo <= (k) && (k) < hi && relaunder(c))
#define INR(k) (lo <= (k) && (k) < hi)
#define SEAM(k) do { if (INR(k) && INR((k) + 1)) xcd_barrier(bar); } while (0)
    bf16_t* NBUF = (bf16_t*)(A.ws + WS_NBUF); bf16_t* PROJ = (bf16_t*)(A.ws + WS_PROJ); bf16_t* MIXED = (bf16_t*)(A.ws + WS_MIXED); bf16_t* QP = (bf16_t*)(A.ws + WS_QP);
    float* GB = (float*)(A.ws + WS_GB);
    if (IN(0)) p0_prologue(c, a);
    SEAM(0);
#pragma unroll 1
    for (int l = 0; l < 2; ++l) {
        const int pb = 1 + 9 * l;
        if (IN(pb + 0) && !(KO & (1 << 0))) phase_norm(c, a, l == 0 ? A.in[0] : A.out, A.in[2] + l * 1024, NBUF, (const float*)(A.ws + WS_WGATE) + l * 8 * 1024, A.in[5] + l * 4, A.in[6] + l * 4, GB);
        SEAM(pb + 0);
        if (IN(pb + 1) && !(KO & (1 << 1))) { pg8::Gemm g{NBUF, (const bf16_t*)(A.ws + WS_WIN) + (size_t)l * NPROJ * 1024, T, NPROJ, 1024}; pg8::StaticOrder S; S.init(T, NPROJ, c.G, c.bid); pg8::EpiBf16 E{PROJ, NPROJ};
            pg8::gemm_phase<pg8::EpiBf16, pg8::StaticOrder>(c.lds, g, S, E, nullptr); }
        SEAM(pb + 1);
        if (IN(pb + 2) && !(KO & (1 << 2))) phase_prep(c, a, l);
        SEAM(pb + 2);
        if (IN(pb + 3) && !(KO & (1 << 3))) { if (c.bid < 64) gdn_seq_unit(c, a, c.bid); else attn_naive_rows(c, a, l, 64, c.G - 64); }
        SEAM(pb + 3);
        if (IN(pb + 4) && !(KO & (1 << 4))) phase_gdn_out(c, a, l);
        SEAM(pb + 4);
        if (IN(pb + 5) && !(KO & (1 << 5))) { pg8::Gemm g{MIXED, (const bf16_t*)(A.ws + WS_WOUT) + (size_t)l * 1024 * 1024, T, 1024, 1024}; pg8::StaticOrder S; S.init(T, 1024, c.G, c.bid); pg8::EpiResF32 E{l == 0 ? A.in[0] : A.out, A.out, 1024};
            pg8::gemm_phase<pg8::EpiResF32, pg8::StaticOrder>(c.lds, g, S, E, nullptr); }
        SEAM(pb + 5);
        if (IN(pb + 6) && !(KO & (1 << 6))) phase_norm(c, a, A.out, A.in[14] + l * 1024, NBUF, nullptr, nullptr, nullptr, nullptr);
        SEAM(pb + 6);
        if (IN(pb + 7) && !(KO & (1 << 7))) { pg8::Gemm g{NBUF, (const bf16_t*)(A.ws + WS_WQ) + (size_t)l * 2048 * 1024, T, 2048, 1024}; pg8::StaticOrder S; S.init(T, 2048, c.G, c.bid); pg8::EpiBf16 E{QP, 2048};
            pg8::gemm_phase<pg8::EpiBf16, pg8::StaticOrder>(c.lds, g, S, E, nullptr); }
        SEAM(pb + 7);
        if (IN(pb + 8) && !(KO & (1 << 8))) phase_peer(c, a, l);
        SEAM(pb + 8);
    }
#undef IN
#undef INR
#undef SEAM
}

extern "C" void kernel_launch(void* const* d_in, const int* in_sizes, int n_in, void* d_out, int out_size, void* d_ws, size_t ws_size, hipStream_t stream) {
    static int grid = 0;
    if (grid == 0) {
        if (n_in != 19 || out_size != T * D || ws_size < WS_END) { fprintf(stderr, "kernel_launch: unexpected shapes (n_in %d out %d ws %zu)\n", n_in, out_size, ws_size); grid = -1; return; }
        if (hipFuncSetAttribute((const void*)fwd, hipFuncAttributeMaxDynamicSharedMemorySize, LDS_BYTES) != hipSuccess) { fprintf(stderr, "kernel_launch: hipFuncSetAttribute failed\n"); grid = -1; return; }
        int dev = 0, cus = 0, per_cu = 0;
        (void)hipGetDevice(&dev); (void)hipDeviceGetAttribute(&cus, hipDeviceAttributeMultiprocessorCount, dev);
        (void)hipOccupancyMaxActiveBlocksPerMultiprocessor(&per_cu, (const void*)fwd, 512, LDS_BYTES);
        (void)hipGetLastError();
        if (per_cu < 1) fprintf(stderr, "kernel_launch: occupancy query reports %d blocks per CU\n", per_cu);
        grid = cus > 0 ? cus : 256;
    }
    if (grid < 0) return;
    (void)hipMemsetAsync((char*)d_ws + WS_CTL, 0, CTL_BYTES, stream);
    Args a{};
    for (int i = 0; i < 19; ++i) a.in[i] = (const float*)d_in[i];
    a.out = (float*)d_out; a.ws = (unsigned char*)d_ws;
#if MK_ONE_LAUNCH
    a.ph_lo = 0; a.ph_hi = NPHASE;
    hipLaunchKernelGGL(fwd, dim3(grid), dim3(512), LDS_BYTES, stream, a);
#else
    for (int p = 0; p < NPHASE; ++p) { a.ph_lo = p; a.ph_hi = p + 1; hipLaunchKernelGGL(fwd, dim3(grid), dim3(512), LDS_BYTES, stream, a); }
#endif
}
```

```cpp
#include <hip/hip_runtime.h>
#include <cstdio>
#include <cstdint>
#include <cstring>

#ifndef KO
#define KO 0
#endif
#ifndef DUP
#define DUP 0
#endif
#define REP(k) for (int rep = 0; rep < 1 + ((DUP >> (k)) & 1); ++rep)
#define LASTREP(k) (rep == ((DUP >> (k)) & 1))
#ifndef MK_ONE_LAUNCH
#define MK_ONE_LAUNCH 1
#endif

template <int CTRL> __device__ __forceinline__ int dpp_i(int x) { return __builtin_amdgcn_mov_dpp(x, CTRL, 0xf, 0xf, true); }
template <int N> __device__ __forceinline__ int lxi(int x) {
    if constexpr (N == 1) return dpp_i<0xB1>(x);
    else if constexpr (N == 2) return dpp_i<0x4E>(x);
    else if constexpr (N == 4) return dpp_i<0x1B>(dpp_i<0x141>(x));
    else if constexpr (N == 8) return dpp_i<0x128>(x);
    else if constexpr (N == 16) { const auto r = __builtin_amdgcn_permlane16_swap((unsigned)x, (unsigned)x, false, false); return (int)((threadIdx.x & 16) ? r[0] : r[1]); }
    else { const auto r = __builtin_amdgcn_permlane32_swap((unsigned)x, (unsigned)x, false, false); return (int)((threadIdx.x & 32) ? r[0] : r[1]); }
}
template <int N> __device__ __forceinline__ float lxf(float x) { return __int_as_float(lxi<N>(__float_as_int(x))); }
template <int N> __device__ __forceinline__ unsigned lxu(unsigned x) { return (unsigned)lxi<N>((int)x); }
namespace pg8 {
#define PG8_LAS __attribute__((address_space(3)))
typedef unsigned short bf16_t;
typedef short bf16x8 __attribute__((ext_vector_type(8)));
typedef float f32x4 __attribute__((ext_vector_type(4)));
typedef unsigned u32x4 __attribute__((ext_vector_type(4)));
constexpr int BM = 256, BK = 64, HALF = 128, HTB = HALF * BK * 2  , STAGE_BYTES = 8 * HTB, NXCD = 8, WGM = 8;

__host__ __device__ __forceinline__ int lds_byte(int r, int c) { const int st = (r >> 4) * 2 + (c >> 5), rr = r & 15, cc = c & 31, ob = rr * 64 + cc * 2; return st * 1024 + (ob ^ (((ob >> 9) & 1) << 5)); }
__host__ __device__ __forceinline__ void stage_rc(int b, int& R, int& C) { const int st = b / 1024, sb = b % 1024, swz = sb ^ (((sb >> 9) & 1) << 5); R = (st >> 1) * 16 + swz / 64; C = (st & 1) * 32 + (swz % 64) / 2; }
__host__ __device__ __forceinline__ int perm32(int rho) { const int n = rho >> 4, i = rho & 15; return 8 * (i >> 2) + 4 * n + (i & 3); }

struct Unit { int pm, pn; };
struct Gemm { const bf16_t* A; const bf16_t* Bt; int M, N, K; };

struct StaticOrder {
    int nM, nN, nwg, G, c;
    __host__ __device__ void init(int M, int N, int G_, int c_) { nM = M / BM; nN = N / BM; nwg = nM * nN; G = G_; c = c_; }
    __host__ __device__ bool next(int i, Unit& u) const {
        const long L = (long)i * G + c; if (L >= nwg) return false;
        int wgid = (int)L; { const int q = nwg / NXCD, r = nwg % NXCD, xcd = wgid % NXCD, off = wgid / NXCD; wgid = (xcd < r ? xcd * (q + 1) : r * (q + 1) + (xcd - r) * q) + off; }
        const int nig = WGM * nN, gid = wgid / nig, fm = gid * WGM, gsz = (nM - fm) < WGM ? (nM - fm) : WGM;
        u.pm = fm + ((wgid % nig) % gsz); u.pn = (wgid % nig) / gsz; return true;
    }
    __device__ __forceinline__ void a_ready(const Unit&) const {}
    __device__ __forceinline__ void done(const Unit&) const {}
};
__device__ __forceinline__ unsigned cvt_pk_bf16(float lo, float hi) { unsigned r; asm volatile("v_cvt_pk_bf16_f32 %0, %1, %2" : "=v"(r) : "v"(lo), "v"(hi)); return r; }
typedef unsigned u32x2v __attribute__((ext_vector_type(2)));
struct EpiResF32 {
    static constexpr bool PERM = false, AFTER_DRAIN = false;
    const float* R; float* C; int ldc;
    __device__ __forceinline__ void operator()(const f32x4 (&acc)[2][2][4][2], const Unit& u, int wr, int wc, int fr, int fq) const {
        const int row0 = u.pm * BM + wr * 64 + fr, col0 = u.pn * BM + wc * 32 + 4 * fq;
#pragma unroll
        for (int ai = 0; ai < 2; ++ai)
#pragma unroll
            for (int m = 0; m < 4; ++m) { const size_t ro = (size_t)(row0 + ai * HALF + m * 16) * ldc + col0;
#pragma unroll
                for (int bj = 0; bj < 2; ++bj)
#pragma unroll
                    for (int n = 0; n < 2; ++n) { const f32x4 r = *(const f32x4*)(R + ro + bj * HALF + n * 16); *(f32x4*)(C + ro + bj * HALF + n * 16) = acc[ai][bj][m][n] + r; } }
    }
};
struct EpiResNorm {
    static constexpr bool PERM = false, AFTER_DRAIN = false;
    const float* R; float* C; bf16_t* HB; const float* gain; float* RS; int ldc;
    __device__ __forceinline__ void operator()(const f32x4 (&acc)[2][2][4][2], const Unit& u, int wr, int wc, int fr, int fq) const {
        const int row0 = u.pm * BM + wr * 64 + fr, col0 = u.pn * BM + wc * 32 + 4 * fq;
        f32x4 gv[2][2];
#pragma unroll
        for (int bj = 0; bj < 2; ++bj)
#pragma unroll
            for (int n = 0; n < 2; ++n) gv[bj][n] = *(const f32x4*)(gain + col0 + bj * HALF + n * 16);
#pragma unroll
        for (int ai = 0; ai < 2; ++ai)
#pragma unroll
            for (int m = 0; m < 4; ++m) { const int row = row0 + ai * HALF + m * 16; const size_t ro = (size_t)row * ldc + col0; float ss = 0.f;
#pragma unroll
                for (int bj = 0; bj < 2; ++bj)
#pragma unroll
                    for (int n = 0; n < 2; ++n) { const f32x4 r = *(const f32x4*)(R + ro + bj * HALF + n * 16); const f32x4 h = acc[ai][bj][m][n] + r; *(f32x4*)(C + ro + bj * HALF + n * 16) = h;
                        ss += (h[0] * h[0] + h[1] * h[1]) + (h[2] * h[2] + h[3] * h[3]); const f32x4 y = h * gv[bj][n];
                        u32x2v w; w.x = cvt_pk_bf16(y[0], y[1]); w.y = cvt_pk_bf16(y[2], y[3]); *(u32x2v*)(HB + ro + bj * HALF + n * 16) = w; }
                ss += lxf<16>(ss); ss += lxf<32>(ss);
                if (fq == 0) RS[(size_t)row * 16 + u.pn * 4 + wc] = ss; }
    }
};
struct EpiBf16 {
    static constexpr bool PERM = true, AFTER_DRAIN = false;
    bf16_t* O; int ldc; const float* RS;
    __device__ __forceinline__ void operator()(const f32x4 (&acc)[2][2][4][2], const Unit& u, int wr, int wc, int fr, int fq) const {
        const int row0 = u.pm * BM + wr * 64 + fr; const int col0 = u.pn * BM + wc * 32 + 8 * fq;
#pragma unroll
        for (int ai = 0; ai < 2; ++ai)
#pragma unroll
            for (int m = 0; m < 4; ++m) { const int row = row0 + ai * HALF + m * 16; bf16_t* rowp = O + (size_t)row * ldc + col0;
                float sc = 1.0f; if (RS) { const f32x4 a = *(const f32x4*)(RS + (size_t)row * 16), b = *(const f32x4*)(RS + (size_t)row * 16 + 4), c2 = *(const f32x4*)(RS + (size_t)row * 16 + 8), d = *(const f32x4*)(RS + (size_t)row * 16 + 12);
                    sc = rsqrtf(((((a[0] + a[1]) + (a[2] + a[3])) + ((b[0] + b[1]) + (b[2] + b[3]))) + (((c2[0] + c2[1]) + (c2[2] + c2[3])) + ((d[0] + d[1]) + (d[2] + d[3])))) * (1.0f / 1024.0f) + 1e-6f); }
#pragma unroll
                for (int bj = 0; bj < 2; ++bj) { const f32x4 v0 = acc[ai][bj][m][0] * sc, v1 = acc[ai][bj][m][1] * sc;
                    u32x4 w; w.x = cvt_pk_bf16(v0[0], v0[1]); w.y = cvt_pk_bf16(v0[2], v0[3]); w.z = cvt_pk_bf16(v1[0], v1[1]); w.w = cvt_pk_bf16(v1[2], v1[3]);
                    *(u32x4*)(rowp + bj * HALF) = w; } }
    }
};

template <class Epi, class Sched, bool STAMP = false>
__device__ __forceinline__ void gemm_phase(PG8_LAS unsigned char* lds, const Gemm g, const Sched& S, const Epi& E, unsigned long long* stamps) {
    int tid_ = threadIdx.x; asm volatile("" : "+v"(tid_));
    const int tid = tid_, wid = __builtin_amdgcn_readfirstlane(tid >> 6), lane = tid & 63, wr = wid >> 2, wc = wid & 3, fr = lane & 15, fq = lane >> 4;
    const int K = g.K, nt = K / BK;
    int ts_lo = 0, ts_hi = 0, nts = 0; const unsigned long long rt_entry = STAMP ? (unsigned long long)wall_clock64() : 0ull;
#define PG8_STAMP() do { if (STAMP && wid == 0 && nts < 64) { const unsigned long long _c = (unsigned long long)clock64(); \
        ts_lo = (lane == nts) ? (int)(unsigned)_c : ts_lo; ts_hi = (lane == nts) ? (int)(unsigned)(_c >> 32) : ts_hi; ++nts; } } while (0)
    PG8_STAMP();
    unsigned voffA[2], voffB[2];
#pragma unroll
    for (int i = 0; i < 2; ++i) { int R, C; stage_rc(tid * 16 + i * 8192, R, C); const int Rb = Epi::PERM ? ((R & ~31) + perm32(R & 31)) : R;
        voffA[i] = (unsigned)(R * K + C) * 2u; voffB[i] = (unsigned)(Rb * K + C) * 2u; }
    const size_t kstep = (size_t)(BK * 2);
    const size_t hstep = (size_t)HALF * K * 2;
    const size_t tstep = 2 * hstep;
    const unsigned ldsw = (unsigned)wid * 1024u;
    const int aoff = lds_byte(wr * 64 + fr, fq * 8), boff = lds_byte(wc * 32 + fr, fq * 8);
#define PG8_SA(b, h) (((b) * 2 + (h)) * HTB)
#define PG8_SB(b, h) ((4 + (b) * 2 + (h)) * HTB)
#define PG8_STAGE(bufoff, gbase, voff) do { _Pragma("unroll") for (int _i = 0; _i < 2; ++_i) \
        __builtin_amdgcn_global_load_lds((const unsigned*)((const char*)(gbase) + (voff)[_i]), (PG8_LAS unsigned*)(lds + (bufoff) + ldsw + _i * 8192), 16, 0, 0); } while (0)
#define PG8_LDA(dst, b, h) do { _Pragma("unroll") for (int m = 0; m < 4; ++m) _Pragma("unroll") for (int k = 0; k < 2; ++k) dst[m][k] = *(const PG8_LAS bf16x8*)(lds + PG8_SA(b, h) + aoff + m * 2048 + k * 1024); } while (0)
#define PG8_LDB(dst, b, h) do { _Pragma("unroll") for (int n = 0; n < 2; ++n) _Pragma("unroll") for (int k = 0; k < 2; ++k) dst[n][k] = *(const PG8_LAS bf16x8*)(lds + PG8_SB(b, h) + boff + n * 2048 + k * 1024); } while (0)
#define PG8_MMA(ai, bj, At, Bt) do { __builtin_amdgcn_s_setprio(1); _Pragma("unroll") for (int m = 0; m < 4; ++m) _Pragma("unroll") for (int n = 0; n < 2; ++n) _Pragma("unroll") for (int k = 0; k < 2; ++k) \
        acc[ai][bj][m][n] = __builtin_amdgcn_mfma_f32_16x16x32_bf16(Bt[n][k], At[m][k], acc[ai][bj][m][n], 0, 0, 0); __builtin_amdgcn_s_setprio(0); } while (0)
#define PG8_WAIT_V(n) asm volatile("s_waitcnt vmcnt(" #n ")" ::: "memory")
#define PG8_WAIT_L(n) asm volatile("s_waitcnt lgkmcnt(" #n ")" ::: "memory")
#define PG8_BAR __builtin_amdgcn_s_barrier()
#define PG8_SCHED __builtin_amdgcn_sched_barrier(0)
    Unit cur, nxt; int ui = 0;
    if (!S.next(0, cur)) return;
    f32x4 acc[2][2][4][2];
#pragma unroll
    for (int a = 0; a < 2; ++a)
#pragma unroll
        for (int b = 0; b < 2; ++b)
#pragma unroll
            for (int m = 0; m < 4; ++m)
#pragma unroll
                for (int n = 0; n < 2; ++n) acc[a][b][m][n] = (f32x4){0.f, 0.f, 0.f, 0.f};
    bf16x8 At[4][2], B0[2][2], B1[2][2];
    const char* cA = (const char*)g.A + (size_t)cur.pm * tstep; const char* cB = (const char*)g.Bt + (size_t)cur.pn * tstep;
    S.a_ready(cur);
    PG8_STAGE(PG8_SB(0, 0), cB, voffB); PG8_STAGE(PG8_SA(0, 0), cA, voffA); PG8_STAGE(PG8_SB(0, 1), cB + hstep, voffB); PG8_STAGE(PG8_SA(0, 1), cA + hstep, voffA);
    if (wr == 1) PG8_BAR;
    PG8_WAIT_V(4); PG8_BAR;
    PG8_STAGE(PG8_SB(1, 0), cB + kstep, voffB); PG8_STAGE(PG8_SA(1, 0), cA + kstep, voffA); PG8_STAGE(PG8_SB(1, 1), cB + hstep + kstep, voffB);
    PG8_WAIT_V(6); PG8_BAR;
    PG8_STAMP();
    for (;;) {
        const bool has_next = S.next(ui + 1, nxt);
        const char* nA = has_next ? (const char*)g.A + (size_t)nxt.pm * tstep : cA; const char* nB = has_next ? (const char*)g.Bt + (size_t)nxt.pn * tstep : cB;
        for (int t = 0; t < nt; t += 2) {
            const bool last = (t == nt - 2);
            const char* a1 = cA + (size_t)(t + 1) * kstep;
            const char* a2 = last ? nA : cA + (size_t)(t + 2) * kstep; const char* b2 = last ? nB : cB + (size_t)(t + 2) * kstep;
            const char* a3 = a2 + kstep; const char* b3 = b2 + kstep;
            if (last && has_next) S.a_ready(nxt);
            PG8_LDB(B0, 0, 0); PG8_SCHED; PG8_LDA(At, 0, 0); PG8_STAGE(PG8_SA(1, 1), a1 + hstep, voffA);
            PG8_WAIT_L(8); PG8_BAR; PG8_WAIT_L(0); PG8_MMA(0, 0, At, B0); PG8_BAR; PG8_SCHED;
            PG8_LDB(B1, 0, 1); PG8_STAGE(PG8_SB(0, 0), b2, voffB);
            PG8_BAR; PG8_WAIT_L(0); PG8_MMA(0, 1, At, B1); PG8_BAR;
            PG8_LDA(At, 0, 1); PG8_STAGE(PG8_SA(0, 0), a2, voffA);
            PG8_BAR; PG8_WAIT_L(0); PG8_MMA(1, 0, At, B0); PG8_BAR; PG8_SCHED;
            PG8_STAGE(PG8_SB(0, 1), b2 + hstep, voffB);
            PG8_WAIT_V(6); PG8_BAR; PG8_MMA(1, 1, At, B1); PG8_BAR;
            PG8_LDB(B0, 1, 0); PG8_SCHED; PG8_LDA(At, 1, 0); PG8_STAGE(PG8_SA(0, 1), a2 + hstep, voffA);
            PG8_WAIT_L(8); PG8_BAR; PG8_WAIT_L(0); PG8_MMA(0, 0, At, B0); PG8_BAR; PG8_SCHED;
            PG8_LDB(B1, 1, 1); PG8_STAGE(PG8_SB(1, 0), b3, voffB);
            PG8_BAR; PG8_WAIT_L(0); PG8_MMA(0, 1, At, B1); PG8_BAR;
            PG8_LDA(At, 1, 1); PG8_STAGE(PG8_SA(1, 0), a3, voffA);
            PG8_BAR; PG8_WAIT_L(0); PG8_MMA(1, 0, At, B0); PG8_BAR; PG8_SCHED;
            PG8_STAGE(PG8_SB(1, 1), b3 + hstep, voffB);
            PG8_WAIT_V(6); PG8_BAR; PG8_MMA(1, 1, At, B1); PG8_BAR;
        }
        PG8_STAMP();
        if constexpr (!Epi::AFTER_DRAIN) { E(acc, cur, wr, wc, fr, fq); S.done(cur); }
        PG8_STAMP();
        if (!has_next) break;
#pragma unroll
        for (int a = 0; a < 2; ++a)
#pragma unroll
            for (int b = 0; b < 2; ++b)
#pragma unroll
                for (int m = 0; m < 4; ++m)
#pragma unroll
                    for (int n = 0; n < 2; ++n) acc[a][b][m][n] = (f32x4){0.f, 0.f, 0.f, 0.f};
        cur = nxt; cA = nA; cB = nB; ++ui;
    }
    PG8_WAIT_V(0);
    if (wr == 0) PG8_BAR;
    PG8_BAR;
    if constexpr (Epi::AFTER_DRAIN) { E.fused(acc, cur, wr, wc, fr, fq, lds, wid, lane); S.done(cur); }
    PG8_STAMP();
    if (STAMP && wid == 0) { stamps[lane] = lane < nts ? (((unsigned long long)(unsigned)ts_hi << 32) | (unsigned)ts_lo) : 0ull;
        if (lane == 62) stamps[62] = rt_entry; if (lane == 63) stamps[63] = (unsigned long long)wall_clock64(); }
#undef PG8_STAMP
#undef PG8_SA
#undef PG8_SB
#undef PG8_STAGE
#undef PG8_LDA
#undef PG8_LDB
#undef PG8_MMA
#undef PG8_WAIT_V
#undef PG8_WAIT_L
#undef PG8_BAR
#undef PG8_SCHED
}
}

using pg8::bf16_t; using pg8::bf16x8; using pg8::f32x4; using pg8::u32x4;
typedef unsigned u32x2 __attribute__((ext_vector_type(2)));
constexpr int T = 16384, D = 1024, SEQ = 2048, NPROJ = 3584, NINW = 3592, NEXP = 16384;
constexpr int EREC = 1792;
constexpr int C_GQ = 0, C_GK = 512, C_GV = 1024, C_GZ = 1536, C_SB = 2048, C_SC = 2304, C_SH = 2560, C_DQ = 2816, C_DK = 3072, C_DV = 3328;
constexpr size_t MiB = 1u << 20;
constexpr size_t WS_CTL = 0, CTL_BYTES = 1 * MiB, WS_WIN = 2 * MiB, WS_WOUT = 16 * MiB, WS_WQ = 20 * MiB, WS_KEYS = 28 * MiB, WS_WGATE = 29 * MiB, WS_VSC = 30 * MiB, WS_USC = 31 * MiB,
    WS_UT = 32 * MiB, WS_VT = 96 * MiB, WS_NBUF = 160 * MiB, WS_PROJ = 192 * MiB, WS_QP = 192 * MiB, WS_QKVC = 304 * MiB, WS_MIXED = 352 * MiB, WS_GB = 384 * MiB,
    WS_AQ = 385 * MiB, WS_AK = 393 * MiB, WS_OGDN = 401 * MiB, WS_GCH = 433 * MiB, WS_AVT = 160 * MiB  , WS_END = 505 * MiB;
constexpr int CW_BAR = 4096;
constexpr size_t WS_RS = 1 * MiB;
constexpr int LDS_BYTES = 155648;
constexpr int MISC_OFF = 155648 - 256;
constexpr int NPHASE = 21;

__device__ __forceinline__ float bf_lo(unsigned w) { return __uint_as_float(w << 16); }
__device__ __forceinline__ float bf_hi(unsigned w) { return __uint_as_float(w & 0xffff0000u); }
__device__ __forceinline__ unsigned f2bf(float f) { unsigned u = __float_as_uint(f); return (u + 0x7fffu + ((u >> 16) & 1u)) >> 16; }
__device__ __forceinline__ unsigned pk2(float lo, float hi) { return f2bf(lo) | (f2bf(hi) << 16); }
__device__ __forceinline__ float wave_sum(float v) {
    v += lxf<1>(v); v += lxf<2>(v); v += lxf<4>(v); v += lxf<8>(v); v += lxf<16>(v); v += lxf<32>(v);
    return v;
}
__device__ __forceinline__ int kperm(int x) { return (x & ~31) | (((x >> 2) & 3) << 3) | (((x >> 4) & 1) << 2) | (x & 3); }
__device__ __forceinline__ float silu_f(float x) { return x / (1.0f + __expf(-x)); }

#define XB_TMO      128
#define XB_XCNT(j)  (256  + 64 * (j))
#define XB_XSUB(j)  (1280 + 64 * (j))
#define XB_XGEN(j)  (2304 + 64 * (j))
#define XB_TOP      3328
#define XB_TOPGEN   3392
#define XCD_BAR_WORDS 3456
#define XB_SPIN_CAP (1u << 18)
#define LAS __attribute__((address_space(3)))

__device__ __forceinline__ unsigned xb_ld(unsigned* p)              { return __hip_atomic_load(p, __ATOMIC_RELAXED, __HIP_MEMORY_SCOPE_AGENT); }
__device__ __forceinline__ unsigned xb_add(unsigned* p, unsigned v) { return __hip_atomic_fetch_add(p, v, __ATOMIC_RELAXED, __HIP_MEMORY_SCOPE_AGENT); }
__device__ __forceinline__ unsigned xb_xcc_id() { return (unsigned)__builtin_amdgcn_s_getreg((3 << 11) | 20) & 0xFu; }
#define XB_SPIN(cond, bar) do { unsigned _sp = 0; while (cond) { __builtin_amdgcn_s_sleep(1); \
    if ((++_sp & 255u) == 0u) { if (xb_ld(&(bar)[XB_TMO])) break; if (_sp > XB_SPIN_CAP) { atomicAdd(&(bar)[XB_TMO], 1u); break; } } } } while (0)

struct XcdBarrier {
    unsigned* bar; unsigned x;
    volatile LAS unsigned* st;
};

__device__ __forceinline__ XcdBarrier xcd_barrier_post(unsigned* bar, volatile LAS unsigned* st) {
    XcdBarrier b; b.bar = bar; b.x = xb_xcc_id(); b.st = st;
    if (threadIdx.x == 0) (void)xb_add(&bar[XB_XCNT(b.x)], 1u);
    return b;
}
__device__ __forceinline__ void xcd_barrier_complete(unsigned* bar, unsigned x, unsigned& nloc, unsigned& nx) {
    const unsigned G = gridDim.x * gridDim.y * gridDim.z;
    unsigned sum, cnt, mine, sp = 0u;
    for (;;) {
        sum = 0u; cnt = 0u; mine = 0u;
#pragma unroll
        for (unsigned j = 0; j < 16; ++j) { const unsigned c = xb_ld(&bar[XB_XCNT(j)]); sum += c; cnt += (c > 0u) ? 1u : 0u; mine = (j == x) ? c : mine; }
        if (sum == G) break;
        __builtin_amdgcn_s_sleep(1);
        if ((++sp & 255u) == 0u) { if (xb_ld(&bar[XB_TMO])) break; if (sp > XB_SPIN_CAP) { atomicAdd(&bar[XB_TMO], 1u); break; } }
    }
    nloc = mine > 0u ? mine : 1u; nx = cnt > 0u ? cnt : 1u;
}

__device__ __forceinline__ void xcd_barrier(const XcdBarrier& b) {
    asm volatile("s_waitcnt vmcnt(0)" ::: "memory");
    __syncthreads();
    if (threadIdx.x == 0) {
        unsigned* bar = b.bar;
        __builtin_amdgcn_s_waitcnt(0);
        unsigned nloc = b.st[0], nx = b.st[1];
        if (nloc == 0u) { xcd_barrier_complete(bar, b.x, nloc, nx); b.st[0] = nloc; b.st[1] = nx; }
        const unsigned old = xb_add(&bar[XB_XSUB(b.x)], 1u);
        const unsigned gen = old / nloc;
        if (old + 1u == (gen + 1u) * nloc) {
            __builtin_amdgcn_fence(__ATOMIC_RELEASE, "agent");
            asm volatile("s_waitcnt vmcnt(0)" ::: "memory");
            const unsigned og = xb_add(&bar[XB_TOP], 1u);
            const unsigned tg = og / nx;
            if (og + 1u == (tg + 1u) * nx) xb_add(&bar[XB_TOPGEN], 1u);
            else XB_SPIN(xb_ld(&bar[XB_TOPGEN]) == tg, bar);
            __builtin_amdgcn_fence(__ATOMIC_ACQUIRE, "agent");
            xb_add(&bar[XB_XGEN(b.x)], 1u);
            asm volatile("s_waitcnt vmcnt(0)" ::: "memory");
        } else {
            XB_SPIN(xb_ld(&bar[XB_XGEN(b.x)]) == gen, bar);
            __builtin_amdgcn_fence(__ATOMIC_ACQUIRE, "agent");
            asm volatile("s_waitcnt vmcnt(0)" ::: "memory");
        }
    }
    __syncthreads();
}

struct Args { const float* in[19]; float* out; unsigned char* ws; int ph_lo, ph_hi; };
struct Ctx {
    LAS unsigned char* lds; int tid, lane, wave, G, bid;
};

struct __attribute__((packed, aligned(4))) U3 { unsigned x, y, z; };
typedef unsigned u32x6 __attribute__((ext_vector_type(6)));
typedef float f32x32 __attribute__((ext_vector_type(32)));
__device__ __forceinline__ unsigned fp6_e2m3(float x) {
    const float a = fabsf(x); const float cdf = a < 2.f ? rintf(a * 8.f) : (a < 4.f ? rintf(a * 4.f) + 8.f : rintf(a * 2.f) + 16.f);
    return (unsigned)fminf(cdf, 31.f) | ((__float_as_uint(x) >> 31) << 5);
}
__device__ __forceinline__ void cvt_flat8(const float* src, unsigned char* dst, size_t n8, size_t gt, size_t NT) {
    const float4* s = (const float4*)src; u32x4* d = (u32x4*)dst;
    for (size_t i = gt; i < n8; i += NT) { const float4 a = s[2 * i], b = s[2 * i + 1]; u32x4 w; w.x = pk2(a.x, a.y); w.y = pk2(a.z, a.w); w.z = pk2(b.x, b.y); w.w = pk2(b.z, b.w); d[i] = w; }
}
__device__ __forceinline__ void cvt_transpose(const float* w, bf16_t* dst, int N, size_t gt, size_t NT) {
    const size_t items = (size_t)2 * 128 * N;
    for (size_t i = gt; i < items; i += NT) {
        const int cc = (int)(i % N), kb = (int)((i / N) % 128), l = (int)(i / ((size_t)N * 128));
        const float* s = w + ((size_t)l * 1024 + kb * 8) * N + cc; float v[8];
#pragma unroll
        for (int j = 0; j < 8; ++j) v[j] = s[(size_t)j * N];
        u32x4 o; o.x = pk2(v[0], v[1]); o.y = pk2(v[2], v[3]); o.z = pk2(v[4], v[5]); o.w = pk2(v[6], v[7]);
        *(u32x4*)(dst + ((size_t)l * N + cc) * 1024 + kb * 8) = o;
    }
}
__device__ __forceinline__ void p0_prologue(Ctx& c, const Args& A) {
    const size_t gt = (size_t)c.bid * 512 + c.tid, NT = (size_t)c.G * 512;
#pragma unroll 1
    for (int tb = 0; tb < 2; ++tb) {
        const float* src = tb ? A.in[18] : A.in[17]; unsigned char* dst = A.ws + WS_UT + (tb ? 1024 : 0);   float* vs = (float*)(A.ws + (tb ? WS_VSC : WS_USC));
        for (int row = c.bid * 8 + c.wave; row < 2 * NEXP; row += c.G * 8) {
            const float4* sp = (const float4*)(src + (size_t)row * 1024 + 16 * c.lane); float4 f[4]; float am = 0.f;
#pragma unroll
            for (int i = 0; i < 4; ++i) { f[i] = sp[i]; am = fmaxf(fmaxf(am, fmaxf(fabsf(f[i].x), fabsf(f[i].y))), fmaxf(fabsf(f[i].z), fabsf(f[i].w))); }
            am = fmaxf(am, lxf<1>(am)); am = fmaxf(am, lxf<2>(am)); am = fmaxf(am, lxf<4>(am)); am = fmaxf(am, lxf<8>(am)); am = fmaxf(am, lxf<16>(am)); am = fmaxf(am, lxf<32>(am));
            const float sc = am > 0.f ? __uint_as_float(__float_as_uint((tb ? 7.5f : 127.0f) / am) & 0x7f800000u) : 1.0f;
            if (tb) {
                unsigned long long lo = 0ull; unsigned hi = 0u;
#pragma unroll
                for (int i = 0; i < 16; ++i) { const float x = (i & 3) == 0 ? f[i >> 2].x : ((i & 3) == 1 ? f[i >> 2].y : ((i & 3) == 2 ? f[i >> 2].z : f[i >> 2].w)); const unsigned cd = fp6_e2m3(x * sc);
                    if (i < 10) lo |= (unsigned long long)cd << (6 * i); else if (i == 10) { lo |= (unsigned long long)(cd & 15u) << 60; hi |= cd >> 4; } else hi |= cd << (6 * i - 64); }
                U3 w3; w3.x = (unsigned)lo; w3.y = (unsigned)(lo >> 32); w3.z = hi;
                *(U3*)(dst + (size_t)row * EREC + 12 * c.lane) = w3;
            } else {
                u32x4 w; unsigned ww[4];
#pragma unroll
                for (int i = 0; i < 4; ++i) ww[i] = ((unsigned)(int)rintf(f[i].x * sc) & 255u) | (((unsigned)(int)rintf(f[i].y * sc) & 255u) << 8) | (((unsigned)(int)rintf(f[i].z * sc) & 255u) << 16) | (((unsigned)(int)rintf(f[i].w * sc) & 255u) << 24);
                w.x = ww[0]; w.y = ww[1]; w.z = ww[2]; w.w = ww[3];
                *(u32x4*)(dst + (size_t)row * EREC + 16 * c.lane) = w; }
            if (c.lane == 0) vs[row] = 1.0f / sc;
        }
    }
    cvt_flat8(A.in[16], A.ws + WS_KEYS, (size_t)2 * 8 * 2 * 128 * 128 / 8, gt, NT);
    cvt_transpose(A.in[13], (bf16_t*)(A.ws + WS_WOUT), 1024, gt, NT);
    cvt_transpose(A.in[15], (bf16_t*)(A.ws + WS_WQ), 2048, gt, NT);
    {
        const float* w = A.in[3]; const size_t items = (size_t)2 * 128 * NINW;
        for (size_t i = gt; i < items; i += NT) {
            const int cc = (int)(i % NINW), kb = (int)((i / NINW) % 128), l = (int)(i / ((size_t)NINW * 128));
            const float* s = w + ((size_t)l * 1024 + kb * 8) * NINW + cc; float v[8];
#pragma unroll
            for (int j = 0; j < 8; ++j) v[j] = s[(size_t)j * NINW];
            if (cc >= 2048 && cc < 2056) { float* d = (float*)(A.ws + WS_WGATE) + ((size_t)l * 8 + (cc - 2048)) * 1024 + kb * 8;
                *(float4*)d = make_float4(v[0], v[1], v[2], v[3]); *(float4*)(d + 4) = make_float4(v[4], v[5], v[6], v[7]); }
            else { const int c2 = cc < 2048 ? cc : cc - 8; u32x4 o; o.x = pk2(v[0], v[1]); o.y = pk2(v[2], v[3]); o.z = pk2(v[4], v[5]); o.w = pk2(v[6], v[7]);
                *(u32x4*)((bf16_t*)(A.ws + WS_WIN) + ((size_t)l * NPROJ + c2) * 1024 + kb * 8) = o; }
        }
    }
}

__device__ __forceinline__ void phase_norm(Ctx& c, const Args& A, const float* src, const float* gain, bf16_t* dst, const float* wgate, const float* a_log, const float* dt_bias, float* GB) {
    const int gw = c.bid * 8 + c.wave, NGW = c.G * 8, lane = c.lane;
    const bool o1 = lane & 1, o2 = lane & 2, o4 = lane & 4; const int es = ((lane & 1) << 2) | (lane & 2) | ((lane >> 2) & 1);
    float4 g[4];
#pragma unroll
    for (int j = 0; j < 4; ++j) g[j] = ((const float4*)gain)[lane + 64 * j];
    for (int m0 = gw * 2; m0 < T; m0 += NGW * 2) {
        float4 v[2][4];
#pragma unroll
        for (int rr = 0; rr < 2; ++rr)
#pragma unroll
            for (int j = 0; j < 4; ++j) v[rr][j] = ((const float4*)(src + (size_t)(m0 + rr) * D))[lane + 64 * j];
#pragma unroll
        for (int rr = 0; rr < 2; ++rr) {
            const int m = m0 + rr; float ss = 0.f;
#pragma unroll
            for (int j = 0; j < 4; ++j) { ss += (v[rr][j].x * v[rr][j].x + v[rr][j].y * v[rr][j].y) + (v[rr][j].z * v[rr][j].z + v[rr][j].w * v[rr][j].w);
                v[rr][j].x *= g[j].x; v[rr][j].y *= g[j].y; v[rr][j].z *= g[j].z; v[rr][j].w *= g[j].w; }
            float cc = 0.f;
            if (wgate) {
                float d[8];
#pragma unroll
                for (int q = 0; q < 8; ++q) { float a = 0.f;
#pragma unroll
                    for (int j = 0; j < 4; ++j) { const float4 w = ((const float4*)(wgate + q * 1024))[lane + 64 * j]; a += (v[rr][j].x * w.x + v[rr][j].y * w.y) + (v[rr][j].z * w.z + v[rr][j].w * w.w); }
                    d[q] = a; }
                float a0 = o1 ? d[4] : d[0], a1 = o1 ? d[5] : d[1], a2 = o1 ? d[6] : d[2], a3 = o1 ? d[7] : d[3];
                a0 += lxf<1>(o1 ? d[0] : d[4]); a1 += lxf<1>(o1 ? d[1] : d[5]); a2 += lxf<1>(o1 ? d[2] : d[6]); a3 += lxf<1>(o1 ? d[3] : d[7]);
                float b0 = o2 ? a2 : a0, b1 = o2 ? a3 : a1; b0 += lxf<2>(o2 ? a0 : a2); b1 += lxf<2>(o2 ? a1 : a3);
                cc = o4 ? b1 : b0; cc += lxf<4>(o4 ? b0 : b1);
                cc += lxf<8>(cc); cc += lxf<16>(cc); cc += lxf<32>(cc);
            }
            const float rstd = rsqrtf(wave_sum(ss) * (1.0f / D) + 1e-6f);
            u32x2* o8 = (u32x2*)(dst + (size_t)m * D) + lane;
#pragma unroll
            for (int j = 0; j < 4; ++j) { u32x2 w; w.x = pk2(v[rr][j].x * rstd, v[rr][j].y * rstd); w.y = pk2(v[rr][j].z * rstd, v[rr][j].w * rstd); o8[64 * j] = w; }
            if (wgate && lane < 8) { const float r = cc * rstd; float o;
                if (es < 4) o = 1.0f / (1.0f + __expf(-r));
                else { const float z = r + dt_bias[es - 4]; const float sp = z > 20.f ? z : log1pf(__expf(z)); o = -__expf(a_log[es - 4]) * sp; }
                GB[(size_t)m * 8 + es] = o; }
        }
    }
}

__device__ __forceinline__ void unpack8(const u32x4& w, float* f) { f[0] = bf_lo(w.x); f[1] = bf_hi(w.x); f[2] = bf_lo(w.y); f[3] = bf_hi(w.y); f[4] = bf_lo(w.z); f[5] = bf_hi(w.z); f[6] = bf_lo(w.w); f[7] = bf_hi(w.w); }
__device__ __forceinline__ void phase_prep(Ctx& c, const Args& A, int l) {
    const int gw = c.bid * 8 + c.wave, NGW = c.G * 8, lane = c.lane;
    const bf16_t* PROJ = (const bf16_t*)(A.ws + WS_PROJ);
    bf16_t* QKVC = (bf16_t*)(A.ws + WS_QKVC); bf16_t* AQ = (bf16_t*)(A.ws + WS_AQ); bf16_t* AK = (bf16_t*)(A.ws + WS_AK); bf16_t* MIXED = (bf16_t*)(A.ws + WS_MIXED); bf16_t* AVT = (bf16_t*)(A.ws + WS_AVT);
    const float* gconv = A.in[4] + (size_t)l * 4 * 1536; const float* sconv = A.in[8] + (size_t)l * 3 * 256;
    const float* qg = A.in[9] + l * 32; const float* kg = A.in[10] + l * 32;
    const u32x4 zero4 = {0u, 0u, 0u, 0u};
    for (int run = gw; run < T / 8; run += NGW) {
        const int t0 = run * 8, s0 = t0 & (SEQ - 1);
#pragma unroll 1
        for (int it = 0; it < 3; ++it) {
            const int ch = (it * 64 + lane) * 8;
            u32x4 rows[11];
#pragma unroll
            for (int j = 0; j < 11; ++j) rows[j] = (s0 + j - 3 >= 0) ? *(const u32x4*)(PROJ + (size_t)(t0 + j - 3) * NPROJ + ch) : zero4;
            float w[4][8];
#pragma unroll
            for (int j = 0; j < 4; ++j) { const float4 a = *(const float4*)(gconv + j * 1536 + ch), b = *(const float4*)(gconv + j * 1536 + ch + 4);
                w[j][0] = a.x; w[j][1] = a.y; w[j][2] = a.z; w[j][3] = a.w; w[j][4] = b.x; w[j][5] = b.y; w[j][6] = b.z; w[j][7] = b.w; }
#pragma unroll
            for (int i = 0; i < 8; ++i) {
                float acc[8] = {0.f, 0.f, 0.f, 0.f, 0.f, 0.f, 0.f, 0.f};
#pragma unroll
                for (int j = 0; j < 4; ++j) { float x[8]; unpack8(rows[i + j], x);
#pragma unroll
                    for (int e = 0; e < 8; ++e) acc[e] += w[j][e] * x[e]; }
                float ss = 0.f;
#pragma unroll
                for (int e = 0; e < 8; ++e) { acc[e] = silu_f(acc[e]); ss += acc[e] * acc[e]; }
                if (it < 2) {
                    ss += lxf<1>(ss); ss += lxf<2>(ss); ss += lxf<4>(ss); ss += lxf<8>(ss);
                    const float r = rsqrtf(ss + 1e-6f);
#pragma unroll
                    for (int e = 0; e < 8; ++e) acc[e] *= r; }
                u32x4 o4; o4.x = pk2(acc[0], acc[1]); o4.y = pk2(acc[2], acc[3]); o4.z = pk2(acc[4], acc[5]); o4.w = pk2(acc[6], acc[7]);
                *(u32x4*)(QKVC + (size_t)(t0 + i) * 1536 + ch) = o4;
            }
        }
        {
            u32x2 wq[8], wk[8], wv[8];
#pragma unroll
            for (int i = 0; i < 8; ++i) { const bf16_t* r = PROJ + (size_t)(t0 + i) * NPROJ + 4 * lane; wq[i] = *(const u32x2*)(r + C_DQ); wk[i] = *(const u32x2*)(r + C_DK); wv[i] = *(const u32x2*)(r + C_DV); }
            const float4 g4 = *(const float4*)(qg + 4 * (lane & 7)), h4 = *(const float4*)(kg + 4 * (lane & 7));
#pragma unroll
            for (int i = 0; i < 8; ++i) {
                float q[4] = {bf_lo(wq[i].x), bf_hi(wq[i].x), bf_lo(wq[i].y), bf_hi(wq[i].y)}, k[4] = {bf_lo(wk[i].x), bf_hi(wk[i].x), bf_lo(wk[i].y), bf_hi(wk[i].y)};
                float sq = (q[0] * q[0] + q[1] * q[1]) + (q[2] * q[2] + q[3] * q[3]), sk = (k[0] * k[0] + k[1] * k[1]) + (k[2] * k[2] + k[3] * k[3]);
                sq += lxf<1>(sq); sk += lxf<1>(sk); sq += lxf<2>(sq); sk += lxf<2>(sk); sq += lxf<4>(sq); sk += lxf<4>(sk);
                const float rq = rsqrtf(sq * (1.0f / 32.0f) + 1e-6f) * (0.17677669529663687f * 1.4426950408889634f), rk = rsqrtf(sk * (1.0f / 32.0f) + 1e-6f);
                u32x2 oq, ok; oq.x = pk2(q[0] * rq * g4.x, q[1] * rq * g4.y); oq.y = pk2(q[2] * rq * g4.z, q[3] * rq * g4.w);
                ok.x = pk2(k[0] * rk * h4.x, k[1] * rk * h4.y); ok.y = pk2(k[2] * rk * h4.z, k[3] * rk * h4.w);
                *(u32x2*)(AQ + (size_t)(t0 + i) * 256 + 4 * lane) = oq; *(u32x2*)(AK + (size_t)(t0 + i) * 256 + 4 * lane) = ok;
            }
            bf16_t* vt = AVT + ((size_t)((t0 >> 11) * 4 + (lane >> 4)) * 64 + (lane & 15) * 4) * SEQ + kperm(s0);
#pragma unroll
            for (int d = 0; d < 4; ++d) {
                unsigned e[8];
#pragma unroll
                for (int i = 0; i < 8; ++i) { const unsigned w = (d < 2) ? wv[i].x : wv[i].y; e[i] = (d & 1) ? (w >> 16) : (w & 0xffffu); }
                u32x2 lo, hi; lo.x = e[0] | (e[1] << 16); lo.y = e[2] | (e[3] << 16); hi.x = e[4] | (e[5] << 16); hi.y = e[6] | (e[7] << 16);
                *(u32x2*)(vt + (size_t)d * SEQ) = lo; *(u32x2*)(vt + (size_t)d * SEQ + 8) = hi;
            }
        }
        {
            const int ch = 4 * lane; u32x2 wc[10], wh[10], wb[8];
#pragma unroll
            for (int j = 0; j < 10; ++j) { const bool ok = (s0 + j - 2 >= 0); const bf16_t* r = PROJ + (size_t)(t0 + j - 2) * NPROJ + ch;
                wc[j] = ok ? *(const u32x2*)(r + C_SC) : (u32x2){0u, 0u}; wh[j] = ok ? *(const u32x2*)(r + C_SH) : (u32x2){0u, 0u}; }
#pragma unroll
            for (int i = 0; i < 8; ++i) wb[i] = *(const u32x2*)(PROJ + (size_t)(t0 + i) * NPROJ + C_SB + ch);
            float4 cw[3];
#pragma unroll
            for (int j = 0; j < 3; ++j) cw[j] = *(const float4*)(sconv + j * 256 + ch);
            float p[10][4];
#pragma unroll
            for (int j = 0; j < 10; ++j) { p[j][0] = bf_lo(wc[j].x) * bf_lo(wh[j].x); p[j][1] = bf_hi(wc[j].x) * bf_hi(wh[j].x); p[j][2] = bf_lo(wc[j].y) * bf_lo(wh[j].y); p[j][3] = bf_hi(wc[j].y) * bf_hi(wh[j].y); }
#pragma unroll
            for (int i = 0; i < 8; ++i) {
                const float a0 = cw[0].x * p[i][0] + cw[1].x * p[i + 1][0] + cw[2].x * p[i + 2][0], a1 = cw[0].y * p[i][1] + cw[1].y * p[i + 1][1] + cw[2].y * p[i + 2][1];
                const float a2 = cw[0].z * p[i][2] + cw[1].z * p[i + 1][2] + cw[2].z * p[i + 2][2], a3 = cw[0].w * p[i][3] + cw[1].w * p[i + 1][3] + cw[2].w * p[i + 2][3];
                u32x2 o; o.x = pk2(bf_lo(wb[i].x) * a0, bf_hi(wb[i].x) * a1); o.y = pk2(bf_lo(wb[i].y) * a2, bf_hi(wb[i].y) * a3);
                *(u32x2*)(MIXED + (size_t)(t0 + i) * 1024 + 512 + ch) = o;
            }
        }
    }
}

__device__ __forceinline__ void gdn_seq_unit(Ctx& c, const Args& A, int u) {
    const int bh = u >> 1, j0 = (u & 1) * 64, b = bh >> 2, h = bh & 3, tid = c.tid, lane = c.lane;
    const bf16_t* QKVC = (const bf16_t*)(A.ws + WS_QKVC); const float* GB = (const float*)(A.ws + WS_GB); float* OG = (float*)(A.ws + WS_OGDN);
    LAS float* kq = (LAS float*)c.lds;
    LAS float* vv = (LAS float*)(c.lds + 65536);
    LAS float* bg = (LAS float*)(c.lds + 65536 + 16384);
    float S[128];
#pragma unroll
    for (int d = 0; d < 128; ++d) S[d] = 0.f;
    for (int ck = 0; ck < 32; ++ck) {
        const int t0 = b * SEQ + ck * 64;
        __syncthreads();
        for (int e = tid; e < 64 * 128; e += 512) { const int i = e >> 7, p = (e & 127) * 2;
            const int col = p < 128 ? (C_GK + h * 128 + p) : (C_GQ + h * 128 + (p - 128));
            const unsigned w = *(const unsigned*)(QKVC + (size_t)(t0 + i) * 1536 + col); kq[i * 256 + p] = bf_lo(w); kq[i * 256 + p + 1] = bf_hi(w); }
        for (int e = tid; e < 64 * 32; e += 512) { const int i = e >> 5, p = (e & 31) * 2; const unsigned w = *(const unsigned*)(QKVC + (size_t)(t0 + i) * 1536 + C_GV + h * 128 + j0 + p); vv[i * 64 + p] = bf_lo(w); vv[i * 64 + p + 1] = bf_hi(w); }
        if (tid < 64) { bg[tid] = GB[(size_t)(t0 + tid) * 8 + h]; bg[64 + tid] = __expf(GB[(size_t)(t0 + tid) * 8 + 4 + h]); }
        __syncthreads();
        if (c.wave == 0) {
            for (int i = 0; i < 64; ++i) {
                const float beta = bg[i], al = bg[64 + i]; const LAS f32x4* kr = (const LAS f32x4*)(kq + i * 256); const LAS f32x4* qr = kr + 32;
                float ks = 0.f;
#pragma unroll
                for (int dg = 0; dg < 4; ++dg) {
#pragma unroll
                    for (int dd = 0; dd < 8; ++dd) { const int d4 = dg * 8 + dd; const f32x4 k4 = kr[d4]; ks += (k4.x * S[4 * d4] + k4.y * S[4 * d4 + 1]) + (k4.z * S[4 * d4 + 2] + k4.w * S[4 * d4 + 3]); }
                    asm volatile("" ::: "memory"); }
                const float delta = beta * (vv[i * 64 + lane] - al * ks); float o = 0.f;
#pragma unroll
                for (int dg = 0; dg < 8; ++dg) {
#pragma unroll
                    for (int dd = 0; dd < 4; ++dd) { const int d4 = dg * 4 + dd; const f32x4 k4 = kr[d4], q4 = qr[d4];
                        S[4 * d4] = al * S[4 * d4] + k4.x * delta; S[4 * d4 + 1] = al * S[4 * d4 + 1] + k4.y * delta; S[4 * d4 + 2] = al * S[4 * d4 + 2] + k4.z * delta; S[4 * d4 + 3] = al * S[4 * d4 + 3] + k4.w * delta;
                        o += (q4.x * S[4 * d4] + q4.y * S[4 * d4 + 1]) + (q4.z * S[4 * d4 + 2] + q4.w * S[4 * d4 + 3]); }
                    asm volatile("" ::: "memory"); }
                OG[(size_t)(t0 + i) * 512 + h * 128 + j0 + lane] = o * 0.08838834764831845f;
            }
        }
    }
    __syncthreads();
}
constexpr int GCH_BYTES = 73728, GCH_WM = 0, GCH_QM = 16384, GCH_KT = 32768, GCH_AM = 49152, GCH_UT = 57344;
__device__ __forceinline__ bf16x8 pack_frag(const f32x4& a, const f32x4& b) { u32x4 w; w.x = pg8::cvt_pk_bf16(a[0], a[1]); w.y = pg8::cvt_pk_bf16(a[2], a[3]); w.z = pg8::cvt_pk_bf16(b[0], b[1]); w.w = pg8::cvt_pk_bf16(b[2], b[3]); return __builtin_bit_cast(bf16x8, w); }
__device__ __forceinline__ void gdn_chunk_unit(Ctx& c, const Args& A, int unit) {
    const int tid = c.tid, lane = c.lane, wave = c.wave, fr = lane & 15, fq = lane >> 4;
    const int bh = unit >> 5, ck = unit & 31, b = bh >> 2, h = bh & 3, t0 = b * SEQ + ck * 64;
    const bf16_t* QKVC = (const bf16_t*)(A.ws + WS_QKVC); const float* GB = (const float*)(A.ws + WS_GB); float* GL = (float*)(A.ws + WS_GB + 512 * 1024);
    unsigned char* rec = A.ws + WS_GCH + (size_t)unit * GCH_BYTES;
    LAS float* gcs = (LAS float*)c.lds;
    LAS float* bet = gcs + 64;
    LAS float* Lm = (LAS float*)(c.lds + 512);
    LAS bf16_t* Tb = (LAS bf16_t*)(c.lds + 512 + 16384);
    LAS bf16_t* vt = Tb + 64 * 72;
    LAS bf16_t* kt = vt + 128 * 72;
    LAS bf16_t* k2 = kt + 128 * 72;
    __syncthreads();
    if (tid < 64) { float g = GB[(size_t)(t0 + tid) * 8 + 4 + h];
#pragma unroll
        for (int o = 1; o < 64; o <<= 1) { const float n = __shfl_up(g, o); if (lane >= o) g += n; }
        gcs[tid] = g; bet[tid] = GB[(size_t)(t0 + tid) * 8 + h]; }
    __syncthreads();
#pragma unroll 1
    for (int bb = 0; bb < 2; ++bb) {
        const int blk = wave * 2 + bb, ib = blk >> 2, jb = blk & 3;
        f32x4 kk = (f32x4){0.f, 0.f, 0.f, 0.f}, qk = (f32x4){0.f, 0.f, 0.f, 0.f};
        if (jb <= ib) {
            const bf16_t* ki = QKVC + (size_t)(t0 + ib * 16 + fr) * 1536 + C_GK + h * 128 + 8 * fq; const bf16_t* qi = QKVC + (size_t)(t0 + ib * 16 + fr) * 1536 + C_GQ + h * 128 + 8 * fq;
            const bf16_t* kj = QKVC + (size_t)(t0 + jb * 16 + fr) * 1536 + C_GK + h * 128 + 8 * fq;
#pragma unroll
            for (int ks = 0; ks < 4; ++ks) { const bf16x8 a = *(const bf16x8*)(ki + ks * 32), q = *(const bf16x8*)(qi + ks * 32), bj = *(const bf16x8*)(kj + ks * 32);
                kk = __builtin_amdgcn_mfma_f32_16x16x32_bf16(a, bj, kk, 0, 0, 0); qk = __builtin_amdgcn_mfma_f32_16x16x32_bf16(q, bj, qk, 0, 0, 0); }
        }
        const int j = jb * 16 + fr; const float gj = gcs[j]; bf16_t* AM = (bf16_t*)(rec + GCH_AM);
#pragma unroll
        for (int r = 0; r < 4; ++r) { const int i = ib * 16 + 4 * fq + r; const float dec = i >= j ? __expf(gcs[i] - gj) : 0.f;
            Lm[i * 64 + j] = i > j ? bet[i] * kk[r] * dec : 0.f;
            AM[i * 64 + kperm(j)] = (bf16_t)f2bf(qk[r] * dec * 0.08838834764831845f); }
    }
    __syncthreads();
    if (wave == 0) {
        float Tc[64];
#pragma unroll
        for (int i = 0; i < 64; ++i) { float acc = (lane == i) ? 1.f : 0.f;
#pragma unroll
            for (int j4 = 0; j4 < (i + 3) / 4; ++j4) { const f32x4 l4 = *(const LAS f32x4*)(Lm + i * 64 + 4 * j4);
#pragma unroll
                for (int x = 0; x < 4; ++x) if (4 * j4 + x < i) acc -= l4[x] * Tc[4 * j4 + x]; }
            Tc[i] = acc; Tb[i * 72 + lane] = (bf16_t)f2bf(acc); }
    } else {
        const float glast = gcs[63];
        for (int e = tid - 64; e < 64 * 16; e += 448) { const int j = e >> 4, d8 = (e & 15) * 8; const float bj = bet[j], gj = gcs[j]; const float s1 = bj * __expf(gj), s2 = __expf(glast - gj);
            const u32x4 kw = *(const u32x4*)(QKVC + (size_t)(t0 + j) * 1536 + C_GK + h * 128 + d8), vw = *(const u32x4*)(QKVC + (size_t)(t0 + j) * 1536 + C_GV + h * 128 + d8);
            const float kf[8] = {bf_lo(kw.x), bf_hi(kw.x), bf_lo(kw.y), bf_hi(kw.y), bf_lo(kw.z), bf_hi(kw.z), bf_lo(kw.w), bf_hi(kw.w)};
            const float vf[8] = {bf_lo(vw.x), bf_hi(vw.x), bf_lo(vw.y), bf_hi(vw.y), bf_lo(vw.z), bf_hi(vw.z), bf_lo(vw.w), bf_hi(vw.w)};
            const int jp = kperm(j);
#pragma unroll
            for (int x = 0; x < 8; ++x) { vt[(d8 + x) * 72 + j] = (bf16_t)f2bf(vf[x] * bj); kt[(d8 + x) * 72 + j] = (bf16_t)f2bf(kf[x] * s1); k2[(d8 + x) * 72 + jp] = (bf16_t)f2bf(kf[x] * s2); }
        }
        bf16_t* QM = (bf16_t*)(rec + GCH_QM);
        for (int e = tid - 64; e < 64 * 16; e += 448) { const int j = e >> 4, m8 = e & 15, m = m8 & 3; const float s = __expf(gcs[j]) * 0.08838834764831845f;
            const u32x4 qw = *(const u32x4*)(QKVC + (size_t)(t0 + j) * 1536 + C_GQ + h * 128 + m8 * 8);
            const int pos = (m8 >> 2) * 32 + 16 * (m & 1) + 4 * (m >> 1);
            u32x2 w0, w1; w0.x = pk2(bf_lo(qw.x) * s, bf_hi(qw.x) * s); w0.y = pk2(bf_lo(qw.y) * s, bf_hi(qw.y) * s); w1.x = pk2(bf_lo(qw.z) * s, bf_hi(qw.z) * s); w1.y = pk2(bf_lo(qw.w) * s, bf_hi(qw.w) * s);
            *(u32x2*)(QM + j * 128 + pos) = w0; *(u32x2*)(QM + j * 128 + pos + 8) = w1; }
        if (tid == 64) GL[unit] = glast;
    }
    __syncthreads();
    {
        f32x4 ua[4], wa[4];
#pragma unroll
        for (int mb = 0; mb < 4; ++mb) { ua[mb] = (f32x4){0.f, 0.f, 0.f, 0.f}; wa[mb] = (f32x4){0.f, 0.f, 0.f, 0.f}; }
#pragma unroll
        for (int ks = 0; ks < 2; ++ks) {
            const bf16x8 vf = *(const LAS bf16x8*)(vt + (16 * wave + fr) * 72 + ks * 32 + 8 * fq), kf = *(const LAS bf16x8*)(kt + (16 * wave + fr) * 72 + ks * 32 + 8 * fq);
#pragma unroll
            for (int mb = 0; mb < 4; ++mb) { const bf16x8 tf = *(const LAS bf16x8*)(Tb + (16 * mb + fr) * 72 + ks * 32 + 8 * fq);
                ua[mb] = __builtin_amdgcn_mfma_f32_16x16x32_bf16(tf, vf, ua[mb], 0, 0, 0);
                wa[mb] = __builtin_amdgcn_mfma_f32_16x16x32_bf16(kf, tf, wa[mb], 0, 0, 0); }
        }
        bf16_t* UT = (bf16_t*)(rec + GCH_UT); bf16_t* WM = (bf16_t*)(rec + GCH_WM);
#pragma unroll
        for (int mb = 0; mb < 4; ++mb) { u32x2 w; w.x = pk2(ua[mb][0], ua[mb][1]); w.y = pk2(ua[mb][2], ua[mb][3]); *(u32x2*)(UT + (16 * wave + fr) * 64 + 16 * mb + 4 * fq) = w;
            u32x2 v; v.x = pk2(wa[mb][0], wa[mb][1]); v.y = pk2(wa[mb][2], wa[mb][3]); *(u32x2*)(WM + (16 * mb + fr) * 128 + kperm(16 * wave + 4 * fq)) = v; }
        bf16_t* KT = (bf16_t*)(rec + GCH_KT);
#pragma unroll
        for (int k = 0; k < 2; ++k) { const int e = tid + 512 * k, row = e >> 3, cc = e & 7; *(u32x4*)(KT + row * 64 + cc * 8) = *(const LAS u32x4*)(k2 + row * 72 + cc * 8); }
    }
}
struct GaUnit { int t0, h; unsigned char* rec; };
__device__ __forceinline__ GaUnit ga_unit(const Args& A, int unit) { GaUnit u; const int bh = unit >> 5, ck = unit & 31; u.h = bh & 3; u.t0 = (bh >> 2) * SEQ + ck * 64; u.rec = A.ws + WS_GCH + (size_t)unit * GCH_BYTES; return u; }
__device__ __forceinline__ void ga_stage(const GaUnit& u, const bf16_t* QKVC, const LAS float* gcs, const LAS float* bet, LAS bf16_t* vt, LAS bf16_t* kt, LAS bf16_t* k2, int rel, int nth) {
    const float glast = gcs[63];
#pragma unroll 3
    for (int e = rel; e < 64 * 16; e += nth) { const int j = e >> 4, d8 = (e & 15) * 8; const float bj = bet[j], gj = gcs[j]; const float s1 = bj * __expf(gj), s2 = __expf(glast - gj);
        const u32x4 kw = *(const u32x4*)(QKVC + (size_t)(u.t0 + j) * 1536 + C_GK + u.h * 128 + d8), vw = *(const u32x4*)(QKVC + (size_t)(u.t0 + j) * 1536 + C_GV + u.h * 128 + d8);
        const float kf[8] = {bf_lo(kw.x), bf_hi(kw.x), bf_lo(kw.y), bf_hi(kw.y), bf_lo(kw.z), bf_hi(kw.z), bf_lo(kw.w), bf_hi(kw.w)};
        const float vf[8] = {bf_lo(vw.x), bf_hi(vw.x), bf_lo(vw.y), bf_hi(vw.y), bf_lo(vw.z), bf_hi(vw.z), bf_lo(vw.w), bf_hi(vw.w)};
        const int jp = kperm(j);
#pragma unroll
        for (int x = 0; x < 8; ++x) { vt[(d8 + x) * 72 + j] = (bf16_t)f2bf(vf[x] * bj); kt[(d8 + x) * 72 + j] = (bf16_t)f2bf(kf[x] * s1); k2[(d8 + x) * 72 + jp] = (bf16_t)f2bf(kf[x] * s2); }
    }
}
__device__ __forceinline__ void ga_qm(const GaUnit& u, const bf16_t* QKVC, const LAS float* gcs, int rel, int nth) {
    bf16_t* QM = (bf16_t*)(u.rec + GCH_QM);
#pragma unroll 3
    for (int e = rel; e < 64 * 16; e += nth) { const int j = e >> 4, m8 = e & 15, m = m8 & 3; const float s = __expf(gcs[j]) * 0.08838834764831845f;
        const u32x4 qw = *(const u32x4*)(QKVC + (size_t)(u.t0 + j) * 1536 + C_GQ + u.h * 128 + m8 * 8);
        const int pos = (m8 >> 2) * 32 + 16 * (m & 1) + 4 * (m >> 1);
        u32x2 w0, w1; w0.x = pk2(bf_lo(qw.x) * s, bf_hi(qw.x) * s); w0.y = pk2(bf_lo(qw.y) * s, bf_hi(qw.y) * s); w1.x = pk2(bf_lo(qw.z) * s, bf_hi(qw.z) * s); w1.y = pk2(bf_lo(qw.w) * s, bf_hi(qw.w) * s);
        *(u32x2*)(QM + j * 128 + pos) = w0; *(u32x2*)(QM + j * 128 + pos + 8) = w1; }
}
__device__ __forceinline__ void ga_uw(const GaUnit& u, const LAS bf16_t* Tb, const LAS bf16_t* vt, const LAS bf16_t* kt, const LAS bf16_t* k2, int tid, int wave, int fr, int fq) {
    f32x4 ua[4], wa[4];
#pragma unroll
    for (int mb = 0; mb < 4; ++mb) { ua[mb] = (f32x4){0.f, 0.f, 0.f, 0.f}; wa[mb] = (f32x4){0.f, 0.f, 0.f, 0.f}; }
#pragma unroll
    for (int ks = 0; ks < 2; ++ks) {
        const bf16x8 vf = *(const LAS bf16x8*)(vt + (16 * wave + fr) * 72 + ks * 32 + 8 * fq), kf = *(const LAS bf16x8*)(kt + (16 * wave + fr) * 72 + ks * 32 + 8 * fq);
#pragma unroll
        for (int mb = 0; mb < 4; ++mb) { const bf16x8 tf = *(const LAS bf16x8*)(Tb + (16 * mb + fr) * 72 + ks * 32 + 8 * fq);
            ua[mb] = __builtin_amdgcn_mfma_f32_16x16x32_bf16(tf, vf, ua[mb], 0, 0, 0);
            wa[mb] = __builtin_amdgcn_mfma_f32_16x16x32_bf16(kf, tf, wa[mb], 0, 0, 0); }
    }
    bf16_t* UT = (bf16_t*)(u.rec + GCH_UT); bf16_t* WM = (bf16_t*)(u.rec + GCH_WM);
#pragma unroll
    for (int mb = 0; mb < 4; ++mb) { u32x2 w; w.x = pk2(ua[mb][0], ua[mb][1]); w.y = pk2(ua[mb][2], ua[mb][3]); *(u32x2*)(UT + (16 * wave + fr) * 64 + 16 * mb + 4 * fq) = w;
        u32x2 v; v.x = pk2(wa[mb][0], wa[mb][1]); v.y = pk2(wa[mb][2], wa[mb][3]); *(u32x2*)(WM + (16 * mb + fr) * 128 + kperm(16 * wave + 4 * fq)) = v; }
    bf16_t* KT = (bf16_t*)(u.rec + GCH_KT);
#pragma unroll
    for (int k = 0; k < 2; ++k) { const int e = tid + 512 * k, row = e >> 3, cc = e & 7; *(u32x4*)(KT + row * 64 + cc * 8) = *(const LAS u32x4*)(k2 + row * 72 + cc * 8); }
}
__device__ __forceinline__ void gdn_chunk_pair(Ctx& c, const Args& A, int unit0, int unit1) {
    const int tid = c.tid, lane = c.lane, wave = c.wave, fr = lane & 15, fq = lane >> 4;
    const bf16_t* QKVC = (const bf16_t*)(A.ws + WS_QKVC); const float* GB = (const float*)(A.ws + WS_GB); float* GL = (float*)(A.ws + WS_GB + 512 * 1024);
    LAS float* gcs = (LAS float*)c.lds;
    LAS float* bet = gcs + 128;
    LAS float* Lm = (LAS float*)(c.lds + 1024);
    LAS bf16_t* Tb = (LAS bf16_t*)(c.lds + 33792);
    LAS bf16_t* vt = (LAS bf16_t*)(c.lds + 52224);
    LAS bf16_t* kt = vt + 128 * 72; LAS bf16_t* k2 = kt + 128 * 72;
    const GaUnit U0 = ga_unit(A, unit0), U1 = ga_unit(A, unit1);
    __syncthreads();
    if (tid < 128) { const GaUnit& u = wave ? U1 : U0; float g = GB[(size_t)(u.t0 + lane) * 8 + 4 + u.h];
#pragma unroll
        for (int o = 1; o < 64; o <<= 1) { const float n = __shfl_up(g, o); if (lane >= o) g += n; }
        gcs[wave * 64 + lane] = g; bet[wave * 64 + lane] = GB[(size_t)(u.t0 + lane) * 8 + u.h]; }
    __syncthreads();
#pragma unroll 2
    for (int bb = 0; bb < 4; ++bb) {
        const int idx = wave * 4 + bb, p = idx >> 4, blk = idx & 15, ib = blk >> 2, jb = blk & 3; const GaUnit& u = p ? U1 : U0;
        f32x4 kk = (f32x4){0.f, 0.f, 0.f, 0.f}, qk = (f32x4){0.f, 0.f, 0.f, 0.f};
        if (jb <= ib) {
            const bf16_t* ki = QKVC + (size_t)(u.t0 + ib * 16 + fr) * 1536 + C_GK + u.h * 128 + 8 * fq; const bf16_t* qi = QKVC + (size_t)(u.t0 + ib * 16 + fr) * 1536 + C_GQ + u.h * 128 + 8 * fq;
            const bf16_t* kj = QKVC + (size_t)(u.t0 + jb * 16 + fr) * 1536 + C_GK + u.h * 128 + 8 * fq;
#pragma unroll
            for (int ks = 0; ks < 4; ++ks) { const bf16x8 a = *(const bf16x8*)(ki + ks * 32), q = *(const bf16x8*)(qi + ks * 32), bj = *(const bf16x8*)(kj + ks * 32);
                kk = __builtin_amdgcn_mfma_f32_16x16x32_bf16(a, bj, kk, 0, 0, 0); qk = __builtin_amdgcn_mfma_f32_16x16x32_bf16(q, bj, qk, 0, 0, 0); }
        }
        const int j = jb * 16 + fr; const float gj = gcs[p * 64 + j]; bf16_t* AM = (bf16_t*)(u.rec + GCH_AM);
#pragma unroll
        for (int r = 0; r < 4; ++r) { const int i = ib * 16 + 4 * fq + r; const float dec = i >= j ? __expf(gcs[p * 64 + i] - gj) : 0.f;
            Lm[p * 4096 + i * 64 + j] = i > j ? bet[p * 64 + i] * kk[r] * dec : 0.f;
            AM[i * 64 + kperm(j)] = (bf16_t)f2bf(qk[r] * dec * 0.08838834764831845f); }
    }
    __syncthreads();
    if (wave < 2) {
        const LAS float* L = Lm + wave * 4096; LAS bf16_t* Tw = Tb + wave * 64 * 72;
        float Tc[64];
#pragma unroll
        for (int i = 0; i < 64; ++i) { float ac[4] = {(lane == i) ? 1.f : 0.f, 0.f, 0.f, 0.f};
#pragma unroll
            for (int j4 = 0; j4 < (i + 3) / 4; ++j4) { const f32x4 l4 = *(const LAS f32x4*)(L + i * 64 + 4 * j4);
#pragma unroll
                for (int x = 0; x < 4; ++x) if (4 * j4 + x < i) ac[x] -= l4[x] * Tc[4 * j4 + x]; }
            const float acc = (ac[0] + ac[1]) + (ac[2] + ac[3]);
            Tc[i] = acc; Tw[i * 72 + lane] = (bf16_t)f2bf(acc); }
    } else {
        ga_stage(U0, QKVC, gcs, bet, vt, kt, k2, tid - 128, 384);
        ga_qm(U0, QKVC, gcs, tid - 128, 384); ga_qm(U1, QKVC, gcs + 64, tid - 128, 384);
        if (tid == 128) { GL[unit0] = gcs[63]; GL[unit1] = gcs[127]; }
    }
    __syncthreads();
    ga_uw(U0, Tb, vt, kt, k2, tid, wave, fr, fq);
    __syncthreads();
    ga_stage(U1, QKVC, gcs + 64, bet + 64, vt, kt, k2, tid, 512);
    __syncthreads();
    ga_uw(U1, Tb + 64 * 72, vt, kt, k2, tid, wave, fr, fq);
}
__device__ __forceinline__ void gdn_scan(Ctx& c, const Args& A, int unit) {
    const int bh = unit >> 1, dv0 = (unit & 1) * 64 + 16 * (c.wave & 3); const bool active = c.wave < 4;
    const int tid = c.tid, lane = c.lane, fr = lane & 15, fq = lane >> 4, b = bh >> 2, h = bh & 3;
    constexpr int L_WM = 0, L_QM = 17408, L_KT = 34816, L_AM = 53248, L_BUF = 62464;
    const unsigned char* rec0 = A.ws + WS_GCH + (size_t)bh * 32 * GCH_BYTES; const float* GL = (const float*)(A.ws + WS_GB + 512 * 1024) + bh * 32; float* OG = (float*)(A.ws + WS_OGDN);
    f32x4 S[8];
#pragma unroll
    for (int i = 0; i < 8; ++i) S[i] = (f32x4){0.f, 0.f, 0.f, 0.f};
    u32x4 pre[14]; const int t2 = tid - 256;
#define GDN_LOAD(rec) do { _Pragma("unroll") for (int k = 0; k < 14; ++k) pre[k] = *(const u32x4*)((rec) + (size_t)(t2 + 256 * k) * 16); } while (0)
#define GDN_STORE(base) do { \
        _Pragma("unroll") for (int k = 0; k < 4; ++k) { const int q = t2 + 256 * k; *(LAS u32x4*)((base) + L_WM + (q >> 4) * 272 + (q & 15) * 16) = pre[k]; *(LAS u32x4*)((base) + L_QM + (q >> 4) * 272 + (q & 15) * 16) = pre[4 + k]; \
            *(LAS u32x4*)((base) + L_KT + (q >> 3) * 144 + (q & 7) * 16) = pre[8 + k]; } \
        _Pragma("unroll") for (int k = 0; k < 2; ++k) { const int q = t2 + 256 * k; *(LAS u32x4*)((base) + L_AM + (q >> 3) * 144 + (q & 7) * 16) = pre[12 + k]; } } while (0)
    __syncthreads();
    if (!active) { GDN_LOAD(rec0); GDN_STORE(c.lds); }
    u32x2 uwc[4], uwn[4]; float glc = GL[0], gln = 0.f;
#pragma unroll
    for (int mb = 0; mb < 4; ++mb) { uwc[mb] = *(const u32x2*)((const bf16_t*)(rec0 + GCH_UT) + (dv0 + fr) * 64 + 16 * mb + 4 * fq); uwn[mb] = uwc[mb]; }
    __syncthreads();
#pragma unroll 1
    for (int ck = 0; ck < 32; ++ck) {
        const unsigned char* rec = rec0 + (size_t)ck * GCH_BYTES; LAS unsigned char* B0 = c.lds + (ck & 1) * L_BUF; const int t0 = b * SEQ + ck * 64;
        if (ck + 1 < 32) { if (!active) GDN_LOAD(rec + GCH_BYTES); const bf16_t* UTn = (const bf16_t*)(rec + GCH_BYTES + GCH_UT);
#pragma unroll
            for (int mb = 0; mb < 4; ++mb) uwn[mb] = *(const u32x2*)(UTn + (dv0 + fr) * 64 + 16 * mb + 4 * fq); gln = GL[ck + 1]; }
        if (active) {
        bf16x8 sB[4];
#pragma unroll
        for (int ks = 0; ks < 4; ++ks) sB[ks] = pack_frag(S[2 * ks], S[2 * ks + 1]);
        f32x4 vn[4], oa[4];
#pragma unroll
        for (int mb = 0; mb < 4; ++mb) { f32x4 p = (f32x4){0.f, 0.f, 0.f, 0.f}, o = (f32x4){0.f, 0.f, 0.f, 0.f};
#pragma unroll
            for (int ks = 0; ks < 4; ++ks) { const bf16x8 aw = *(const LAS bf16x8*)(B0 + L_WM + (16 * mb + fr) * 272 + ks * 64 + fq * 16), aq = *(const LAS bf16x8*)(B0 + L_QM + (16 * mb + fr) * 272 + ks * 64 + fq * 16);
                p = __builtin_amdgcn_mfma_f32_16x16x32_bf16(aw, sB[ks], p, 0, 0, 0); o = __builtin_amdgcn_mfma_f32_16x16x32_bf16(aq, sB[ks], o, 0, 0, 0); }
            const u32x2 uw = uwc[mb];
            vn[mb] = (f32x4){bf_lo(uw.x) - p[0], bf_hi(uw.x) - p[1], bf_lo(uw.y) - p[2], bf_hi(uw.y) - p[3]}; oa[mb] = o; }
        bf16x8 vB[2];
#pragma unroll
        for (int s = 0; s < 2; ++s) vB[s] = pack_frag(vn[2 * s], vn[2 * s + 1]);
#pragma unroll
        for (int mb = 0; mb < 4; ++mb) {
#pragma unroll
            for (int s = 0; s < 2; ++s) { const bf16x8 aa = *(const LAS bf16x8*)(B0 + L_AM + (16 * mb + fr) * 144 + s * 64 + fq * 16); oa[mb] = __builtin_amdgcn_mfma_f32_16x16x32_bf16(aa, vB[s], oa[mb], 0, 0, 0); }
#pragma unroll
            for (int r = 0; r < 4; ++r) OG[(size_t)(t0 + 16 * mb + 4 * fq + r) * 512 + h * 128 + dv0 + fr] = oa[mb][r]; }
        const float gl = __expf(glc);
#pragma unroll
        for (int m8 = 0; m8 < 8; ++m8) { f32x4 s = S[m8] * gl;
#pragma unroll
            for (int s2 = 0; s2 < 2; ++s2) { const bf16x8 ak = *(const LAS bf16x8*)(B0 + L_KT + (16 * m8 + fr) * 144 + s2 * 64 + fq * 16); s = __builtin_amdgcn_mfma_f32_16x16x32_bf16(ak, vB[s2], s, 0, 0, 0); }
            S[m8] = s; }
        }
        if (ck + 1 < 32 && !active) GDN_STORE(c.lds + ((ck + 1) & 1) * L_BUF);
#pragma unroll
        for (int mb = 0; mb < 4; ++mb) uwc[mb] = uwn[mb];
        glc = gln;
        __syncthreads();
    }
#undef GDN_LOAD
#undef GDN_STORE
}
__device__ __forceinline__ int rel_bucket(int n) {
    if (n < 16) return n;
    const int v = 16 + (int)(__logf((float)n * (1.0f / 16.0f)) / 2.0794415416798357f * 16.0f);
    return v < 31 ? v : 31;
}
__device__ __forceinline__ void attn_mfma(Ctx& c, const Args& A, int l, int first_block, int nblocks) {
    const int tid = c.tid, lane = c.lane, wave = c.wave, fr = lane & 15, fq = lane >> 4;
    const bf16_t* AQ = (const bf16_t*)(A.ws + WS_AQ); const bf16_t* AK = (const bf16_t*)(A.ws + WS_AK); const bf16_t* AVT = (const bf16_t*)(A.ws + WS_AVT); bf16_t* MIXED = (bf16_t*)(A.ws + WS_MIXED);
    LAS float* bt = (LAS float*)c.lds;
    LAS float* cs = bt + 512;
    const float* rel_bias = A.in[1]; const float* lamp = A.in[11] + l * 128; const float* subln = A.in[12] + l * 64;
    const float lambda_init = 0.8f - 0.6f * __expf(-0.3f * (float)l);
    __syncthreads();
    {
        float mq = 0.f, mk = 0.f, mb = 0.f;
        for (int d = 0; d < 32; ++d) { mq = fmaxf(mq, fabsf(A.in[9][l * 32 + d])); mk = fmaxf(mk, fabsf(A.in[10][l * 32 + d])); }
        for (int i = 0; i < 128; ++i) mb = fmaxf(mb, fabsf(rel_bias[i]));
        const float cshift = 5.656854249492381f * mq * mk + mb;
        const int n = tid & 127, hh = tid >> 7; bt[hh * 128 + n] = (rel_bias[rel_bucket(n) * 4 + hh] - cshift) * 1.4426950408889634f;
        if (tid == 0) { float s01 = 0.f, s23 = 0.f; for (int d = 0; d < 32; ++d) { s01 += lamp[d] * lamp[32 + d]; s23 += lamp[64 + d] * lamp[96 + d]; } cs[0] = __expf(s01) - __expf(s23) + lambda_init; }
    }
    __syncthreads();
    const float lam = cs[0];
    bf16x8 ones; { const short o = (fr == 0) ? (short)0x3f80 : (short)0; ones = (bf16x8){o, o, o, o, o, o, o, o}; }
    constexpr int AT_K = 4096, AT_V = 4096 + 4608, AT_BUF = 9728;
    const int wg = c.bid - first_block;
#pragma unroll 1
    for (int rd = 0; rd * nblocks < 256; ++rd) {
        const int it = rd * nblocks + ((rd & 1) ? nblocks - 1 - wg : wg); if (it >= 256) continue;
        const int bh = it & 31, QB = 7 - (it >> 5), b = bh >> 2, h = bh & 3, q0 = QB * 256 + 32 * wave, nsteps = 8 * QB + 8;
        const float bfar = bt[h * 128 + 127];
        bf16x8 qf[2][2];
#pragma unroll
        for (int m = 0; m < 2; ++m)
#pragma unroll
            for (int nq = 0; nq < 2; ++nq) qf[m][nq] = *(const bf16x8*)(AQ + (size_t)(b * SEQ + q0 + nq * 16 + fr) * 256 + h * 64 + m * 32 + 8 * fq);
        f32x4 oacc[2][2][4], lacc[2][2];
#pragma unroll
        for (int m = 0; m < 2; ++m)
#pragma unroll
            for (int nq = 0; nq < 2; ++nq) { lacc[m][nq] = (f32x4){0.f, 0.f, 0.f, 0.f};
#pragma unroll
                for (int nb = 0; nb < 4; ++nb) oacc[m][nq][nb] = (f32x4){0.f, 0.f, 0.f, 0.f}; }
        const int t2 = tid & 255; const bool isK = tid < 256;
        const bf16_t* gsrc = isK ? AK + (size_t)(b * SEQ + (t2 >> 3)) * 256 + h * 64 + (t2 & 7) * 8 : AVT + ((size_t)bh * 64 + (t2 >> 2)) * SEQ + (t2 & 3) * 8;
        const size_t gstep = isK ? (size_t)32 * 256 : (size_t)32;
        const int ldst = isK ? AT_K + (t2 >> 3) * 144 + (t2 & 7) * 16 : AT_V + (t2 >> 2) * 80 + (t2 & 3) * 16;
        __syncthreads();
        u32x4 pre = *(const u32x4*)gsrc; *(LAS u32x4*)(c.lds + ldst) = pre;
        __syncthreads();
#pragma unroll 1
        for (int st = 0; st < nsteps; ++st) {
            const int k0 = st * 32; const LAS unsigned char* B0 = c.lds + (st & 1) * AT_BUF;
            if (st + 1 < nsteps) pre = *(const u32x4*)(gsrc + (size_t)(st + 1) * gstep);
            if (k0 <= q0) {
            bf16x8 kf[2][2], vf[4];
#pragma unroll
            for (int m = 0; m < 2; ++m)
#pragma unroll
                for (int kb = 0; kb < 2; ++kb) kf[m][kb] = *(const LAS bf16x8*)(B0 + AT_K + (kb * 16 + fr) * 144 + m * 64 + fq * 16);
#pragma unroll
            for (int nb = 0; nb < 4; ++nb) vf[nb] = *(const LAS bf16x8*)(B0 + AT_V + (16 * nb + fr) * 80 + fq * 16);
            const bool nearby = (k0 + 144 > q0);
            f32x4 cin[2][2];
            if (nearby) {
#pragma unroll
                for (int nq = 0; nq < 2; ++nq)
#pragma unroll
                    for (int kb = 0; kb < 2; ++kb)
#pragma unroll
                        for (int r = 0; r < 4; ++r) { const int n = (q0 + nq * 16 + fr) - (k0 + kb * 16 + 4 * fq + r); cin[nq][kb][r] = n >= 0 ? bt[h * 128 + (n > 127 ? 127 : n)] : -1.0e30f; }
            } else {
#pragma unroll
                for (int nq = 0; nq < 2; ++nq)
#pragma unroll
                    for (int kb = 0; kb < 2; ++kb) cin[nq][kb] = (f32x4){bfar, bfar, bfar, bfar};
            }
#pragma unroll
            for (int m = 0; m < 2; ++m)
#pragma unroll
                for (int nq = 0; nq < 2; ++nq) {
                    f32x4 p[2];
#pragma unroll
                    for (int kb = 0; kb < 2; ++kb) {
                        f32x4 s = __builtin_amdgcn_mfma_f32_16x16x32_bf16(kf[m][kb], qf[m][nq], cin[nq][kb], 0, 0, 0);
#pragma unroll
                        for (int r = 0; r < 4; ++r) s[r] = __builtin_amdgcn_exp2f(s[r]);
                        p[kb] = s;
                    }
                    const bf16x8 pf = pack_frag(p[0], p[1]);
#pragma unroll
                    for (int nb = 0; nb < 4; ++nb) oacc[m][nq][nb] = __builtin_amdgcn_mfma_f32_16x16x32_bf16(vf[nb], pf, oacc[m][nq][nb], 0, 0, 0);
                    lacc[m][nq] = __builtin_amdgcn_mfma_f32_16x16x32_bf16(ones, pf, lacc[m][nq], 0, 0, 0);
                }
            }
            if (st + 1 < nsteps) *(LAS u32x4*)(c.lds + ((st + 1) & 1) * AT_BUF + ldst) = pre;
            __syncthreads();
        }
#pragma unroll
        for (int nq = 0; nq < 2; ++nq) {
            const float l0 = __shfl(lacc[0][nq][0], fr), l1 = __shfl(lacc[1][nq][0], fr);
            const float i0 = 1.0f / l0, i1 = lam / l1; float ss = 0.f; f32x4 o[4];
#pragma unroll
            for (int nb = 0; nb < 4; ++nb) { o[nb] = oacc[0][nq][nb] * i0 - oacc[1][nq][nb] * i1; ss += (o[nb][0] * o[nb][0] + o[nb][1] * o[nb][1]) + (o[nb][2] * o[nb][2] + o[nb][3] * o[nb][3]); }
            ss += lxf<16>(ss); ss += lxf<32>(ss);
            const float rn = rsqrtf(ss * (1.0f / 64.0f) + 1e-6f) * (1.0f - lambda_init);
            bf16_t* orow = MIXED + (size_t)(b * SEQ + q0 + nq * 16 + fr) * 1024 + 768 + h * 64;
#pragma unroll
            for (int nb = 0; nb < 4; ++nb) { const float4 sg = *(const float4*)(subln + 16 * nb + 4 * fq);
                u32x2 w; w.x = pk2(o[nb][0] * rn * sg.x, o[nb][1] * rn * sg.y); w.y = pk2(o[nb][2] * rn * sg.z, o[nb][3] * rn * sg.w);
                *(u32x2*)(orow + 16 * nb + 4 * fq) = w; }
        }
    }
    __syncthreads();
}
__device__ __forceinline__ void phase_gdn_out(Ctx& c, const Args& A, int l) {
    const int gw = c.bid * 8 + c.wave, NGW = c.G * 8, lane = c.lane;
    const bf16_t* PROJ = (const bf16_t*)(A.ws + WS_PROJ); const float* OG = (const float*)(A.ws + WS_OGDN); bf16_t* MIXED = (bf16_t*)(A.ws + WS_MIXED);
    const float4 g0 = *(const float4*)(A.in[7] + l * 128 + (lane & 15) * 8), g1 = *(const float4*)(A.in[7] + l * 128 + (lane & 15) * 8 + 4);
    for (int run = gw; run < T / 8; run += NGW) {
        const int t0 = run * 8; float4 oa[8], ob[8]; u32x4 zz[8];
#pragma unroll
        for (int i = 0; i < 8; ++i) { const float* op = OG + (size_t)(t0 + i) * 512 + lane * 8; oa[i] = *(const float4*)op; ob[i] = *(const float4*)(op + 4); zz[i] = *(const u32x4*)(PROJ + (size_t)(t0 + i) * NPROJ + C_GZ + lane * 8); }
#pragma unroll
        for (int i = 0; i < 8; ++i) {
            float ss = (oa[i].x * oa[i].x + oa[i].y * oa[i].y) + (oa[i].z * oa[i].z + oa[i].w * oa[i].w) + (ob[i].x * ob[i].x + ob[i].y * ob[i].y) + (ob[i].z * ob[i].z + ob[i].w * ob[i].w);
            ss += lxf<1>(ss); ss += lxf<2>(ss); ss += lxf<4>(ss); ss += lxf<8>(ss);
            const float r = rsqrtf(ss * (1.0f / 128.0f) + 1e-6f);
            u32x4 w; w.x = pk2(oa[i].x * r * g0.x * silu_f(bf_lo(zz[i].x)), oa[i].y * r * g0.y * silu_f(bf_hi(zz[i].x))); w.y = pk2(oa[i].z * r * g0.z * silu_f(bf_lo(zz[i].y)), oa[i].w * r * g0.w * silu_f(bf_hi(zz[i].y)));
            w.z = pk2(ob[i].x * r * g1.x * silu_f(bf_lo(zz[i].z)), ob[i].y * r * g1.y * silu_f(bf_hi(zz[i].z))); w.w = pk2(ob[i].z * r * g1.z * silu_f(bf_lo(zz[i].w)), ob[i].w * r * g1.w * silu_f(bf_hi(zz[i].w)));
            *(u32x4*)(MIXED + (size_t)(t0 + i) * 1024 + lane * 8) = w;
        }
    }
}

__device__ __forceinline__ unsigned ord_key(float f) { const unsigned u = __float_as_uint(f); return (u & 0x80000000u) ? ~u : (u | 0x80000000u); }
__device__ __forceinline__ float ord_val(unsigned o) { return __uint_as_float((o & 0x80000000u) ? (o & 0x7fffffffu) : ~o); }
__device__ __forceinline__ float gelu_erf(float v) {
    const float av = fabsf(v), t = __builtin_amdgcn_rcpf(av * 0.2316418882f + 1.0f);
    float q = t * 0.5307027145f + (-0.7265760135f); q = q * t + 0.7107068705f; q = q * t + (-0.142248368f); q = q * t + 0.127414796f; q = q * t;
    const float e = __builtin_amdgcn_exp2f((v * v) * (-0.72134752044f)); const float m = v * (q * e);
    return v < 0.f ? m : v - m;
}
typedef __bf16 v2bf_t __attribute__((ext_vector_type(2)));
__device__ __forceinline__ float dot2bf(unsigned a, unsigned b, float acc) { return __builtin_amdgcn_fdot2_f32_bf16(__builtin_bit_cast(v2bf_t, a), __builtin_bit_cast(v2bf_t, b), acc, false); }
__device__ __forceinline__ float dot8(const u32x4& x, const u32x4& u, float acc) { acc = dot2bf(x.x, u.x, acc); acc = dot2bf(x.y, u.y, acc); acc = dot2bf(x.z, u.z, acc); return dot2bf(x.w, u.w, acc); }
__device__ __forceinline__ void axpy8(float* o, float cf, const u32x4& v) {
    o[0] += cf * bf_lo(v.x); o[1] += cf * bf_hi(v.x); o[2] += cf * bf_lo(v.y); o[3] += cf * bf_hi(v.y); o[4] += cf * bf_lo(v.z); o[5] += cf * bf_hi(v.z); o[6] += cf * bf_lo(v.w); o[7] += cf * bf_hi(v.w); }
typedef float f32x2_t __attribute__((ext_vector_type(2)));
__device__ __forceinline__ void axpy16_fp8(float* o, float cf, const u32x4& v) {
    const unsigned w[4] = {v.x, v.y, v.z, v.w};
#pragma unroll
    for (int i = 0; i < 4; ++i) { const f32x2_t a = __builtin_amdgcn_cvt_pk_f32_fp8((int)w[i], false), b = __builtin_amdgcn_cvt_pk_f32_fp8((int)w[i], true);
        o[4 * i] += cf * a.x; o[4 * i + 1] += cf * a.y; o[4 * i + 2] += cf * b.x; o[4 * i + 3] += cf * b.y; }
}
typedef _Float16 v2h_t __attribute__((ext_vector_type(2)));
__device__ __forceinline__ unsigned pkh(float a, float b) { const v2h_t h = {(_Float16)a, (_Float16)b}; return __builtin_bit_cast(unsigned, h); }
typedef _Float16 v2h_t __attribute__((ext_vector_type(2)));
__device__ __forceinline__ float dot4_fp8(unsigned uw, unsigned xlo, unsigned xhi, float acc) {
    acc = __builtin_amdgcn_fdot2(__builtin_amdgcn_cvt_scalef32_pk_f16_fp8(uw, 1.0f, false), __builtin_bit_cast(v2h_t, xlo), acc, false);
    return __builtin_amdgcn_fdot2(__builtin_amdgcn_cvt_scalef32_pk_f16_fp8(uw, 1.0f, true), __builtin_bit_cast(v2h_t, xhi), acc, false);
}
__device__ __forceinline__ float dot16_fp8(const u32x4& x0, const u32x4& x1, const u32x4& u) {
    float acc = dot4_fp8(u.x, x0.x, x0.y, 0.f); acc = dot4_fp8(u.y, x0.z, x0.w, acc); acc = dot4_fp8(u.z, x1.x, x1.y, acc); return dot4_fp8(u.w, x1.z, x1.w, acc);
}
__device__ __forceinline__ void cvt16_fp8(float* f, const u32x4& v) {
    const unsigned w[4] = {v.x, v.y, v.z, v.w};
#pragma unroll
    for (int i = 0; i < 4; ++i) { const f32x2_t a = __builtin_amdgcn_cvt_pk_f32_fp8((int)w[i], false), b = __builtin_amdgcn_cvt_pk_f32_fp8((int)w[i], true); f[4 * i] = a.x; f[4 * i + 1] = a.y; f[4 * i + 2] = b.x; f[4 * i + 3] = b.y; }
}
__device__ __forceinline__ void phase_peer(Ctx& c, const Args& A, int l, float* hdst, bool fuse_next, const XcdBarrier& bar, bool align) {
    const int tid = c.tid, lane = c.lane, wave = c.wave, fr = lane & 15, fq = lane >> 4;
    const bf16_t* QP = (const bf16_t*)(A.ws + WS_QP); const bf16_t* KEYS = (const bf16_t*)(A.ws + WS_KEYS) + (size_t)l * 16 * 128 * 128;
    const bf16_t* XF = (const bf16_t*)(A.ws + WS_NBUF); const float* RSl = (const float*)(A.ws + WS_RS); const unsigned char* U8 = A.ws + WS_UT + (size_t)l * NEXP * EREC; const unsigned char* V8 = U8 + 1024; const float* VS = (const float*)(A.ws + WS_VSC) + (size_t)l * NEXP; const float* US = (const float*)(A.ws + WS_USC) + (size_t)l * NEXP;
    LAS int* lidx = (LAS int*)c.lds;
    LAS float* lgate = (LAS float*)(c.lds + 32768);
    LAS unsigned* tkb = (LAS unsigned*)(c.lds + 65536);
    for (int blk = c.bid; blk < T / 64; blk += c.G) {
        const int tb0 = blk * 64;
        __syncthreads();
#pragma unroll 1
        for (int rrep_ = 0; rrep_ < 1 + ((DUP >> 11) & 1); ++rrep_) {
#define PEER_RLOAD(Q, Kf, st) do { const int hh_ = (st) >> 2, ks_ = (st) & 3, hp_ = (hh_ >> 1) * 8 + wave, sp_ = (hh_ & 1) * 2; \
        const bf16_t* qp_ = QP; const bf16_t* kp_ = KEYS; asm volatile("" : "+s"(qp_), "+s"(kp_) : "v"(acc[1][7]));     \
        _Pragma("unroll") for (int sb = 0; sb < 2; ++sb) Q[sb] = *(const bf16x8*)(qp_ + (size_t)(tb0 + (sp_ + sb) * 16 + fr) * 2048 + hp_ * 128 + ks_ * 32 + 8 * fq); \
        _Pragma("unroll") for (int nb = 0; nb < 8; ++nb) Kf[nb] = *(const bf16x8*)(kp_ + ((size_t)hp_ * 128 + nb * 16 + fr) * 128 + ks_ * 32 + 8 * fq); } while (0)
#define PEER_RMMA(Q, Kf) do { _Pragma("unroll") for (int nb = 0; nb < 8; ++nb) _Pragma("unroll") for (int sb = 0; sb < 2; ++sb) acc[sb][nb] = __builtin_amdgcn_mfma_f32_16x16x32_bf16(Kf[nb], Q[sb], acc[sb][nb], 0, 0, 0); } while (0)
            bf16x8 qA[2], kA[8], qB[2], kB[8]; f32x4 acc[2][8]; acc[1][7] = (f32x4){0.f, 0.f, 0.f, 0.f};
            PEER_RLOAD(qA, kA, 0);
#pragma unroll 1
            for (int hh = 0; hh < 4; ++hh) {
                const int hp = (hh >> 1) * 8 + wave, sp = (hh & 1) * 2;
#pragma unroll
                for (int sb = 0; sb < 2; ++sb)
#pragma unroll
                    for (int nb = 0; nb < 8; ++nb) acc[sb][nb] = (f32x4){0.f, 0.f, 0.f, 0.f};
                PEER_RLOAD(qB, kB, 4 * hh + 1); PEER_RMMA(qA, kA);
                PEER_RLOAD(qA, kA, 4 * hh + 2); PEER_RMMA(qB, kB);
                PEER_RLOAD(qB, kB, 4 * hh + 3); PEER_RMMA(qA, kA);
                { const int hn_ = hh < 3 ? hh + 1 : hh; PEER_RLOAD(qA, kA, 4 * hn_); }
                PEER_RMMA(qB, kB);
#define PEER_MERGE(N) do { unsigned p[16]; \
        _Pragma("unroll") for (int i = 0; i < 16; ++i) p[i] = lxu<N>(v[i]); \
        _Pragma("unroll") for (int i = 0; i < 16; ++i) v[i] = v[i] > p[15 - i] ? v[i] : p[15 - i]; \
        _Pragma("unroll") for (int j = 8; j > 0; j >>= 1) _Pragma("unroll") for (int i = 0; i < 16; ++i) { const int q = i ^ j; if (q > i) { const unsigned x = v[i], y = v[q]; v[i] = x > y ? x : y; v[q] = x > y ? y : x; } } } while (0)
#pragma unroll 1
                for (int sb = 0; sb < 2; ++sb) {
                    LAS unsigned* tk = tkb + (sp + sb) * 4096;
                    unsigned v[32];
#pragma unroll
                    for (int nb = 0; nb < 8; ++nb) { const f32x4 a_ = sb == 0 ? acc[0][nb] : acc[1][nb];
#pragma unroll
                        for (int r = 0; r < 4; ++r) v[nb * 4 + r] = (ord_key(a_[r]) & ~127u) | (unsigned)(127 - (nb * 16 + 4 * fq + r)); }
#pragma unroll
                    for (int k = 2; k <= 32; k <<= 1)
#pragma unroll
                        for (int j = k >> 1; j > 0; j >>= 1)
#pragma unroll
                            for (int i = 0; i < 32; ++i) { const int q = i ^ j; if (q > i) { const bool desc = ((i & k) == 0); const unsigned x = v[i], y = v[q]; const unsigned hi = x > y ? x : y, lo = x > y ? y : x; v[i] = desc ? hi : lo; v[q] = desc ? lo : hi; } }
                    PEER_MERGE(16); PEER_MERGE(32);
                    { u32x4 w; w.x = fq == 0 ? v[0] : (fq == 1 ? v[4] : (fq == 2 ? v[8] : v[12])); w.y = fq == 0 ? v[1] : (fq == 1 ? v[5] : (fq == 2 ? v[9] : v[13]));
                      w.z = fq == 0 ? v[2] : (fq == 1 ? v[6] : (fq == 2 ? v[10] : v[14])); w.w = fq == 0 ? v[3] : (fq == 1 ? v[7] : (fq == 2 ? v[11] : v[15]));
                      *(LAS u32x4*)(tk + (fr * 16 + hp) * 16 + 4 * fq) = w; }
                }
#undef PEER_MERGE
            }
#undef PEER_RLOAD
#undef PEER_RMMA
            __syncthreads();
#pragma unroll 1
            for (int sub = 0; sub < 4; ++sub)
            {
                const LAS unsigned* tk = tkb + sub * 4096;
                const int pp = tid >> 2, qd = tid & 3, tok = pp >> 3, h = pp & 7;
                const LAS unsigned* a = tk + (tok * 16 + 2 * h) * 16; const LAS unsigned* b = a + 16;
                unsigned v[16], s5[5];
                {
                    const float sj0 = ord_val(b[qd] & ~127u), sj1 = ord_val(b[qd + 4] & ~127u), sj2 = ord_val(b[qd + 8] & ~127u), sj3 = ord_val(b[qd + 12] & ~127u);
#pragma unroll
                    for (int i = 0; i < 16; ++i) { const float si = ord_val(a[i] & ~127u);
                        v[i] = ((i + 1) * (qd + 1) <= 16) ? ((ord_key(si + sj0) & ~255u) | (unsigned)(255 - (i * 16 + qd))) : 0u;
                        if (i < 3) s5[i] = ((i + 1) * (qd + 5) <= 16) ? ((ord_key(si + sj1) & ~255u) | (unsigned)(255 - (i * 16 + qd + 4))) : 0u;
                        if (i == 0) { s5[3] = ((qd + 9) <= 16) ? ((ord_key(si + sj2) & ~255u) | (unsigned)(255 - (qd + 8))) : 0u; s5[4] = ((qd + 13) <= 16) ? ((ord_key(si + sj3) & ~255u) | (unsigned)(255 - (qd + 12))) : 0u; } }
                }
#define PEER_CE(x, y) do { const unsigned hi_ = x > y ? x : y, lo_ = x > y ? y : x; x = hi_; y = lo_; } while (0)
                PEER_CE(s5[0], s5[1]); PEER_CE(s5[3], s5[4]); PEER_CE(s5[2], s5[4]); PEER_CE(s5[2], s5[3]); PEER_CE(s5[0], s5[3]); PEER_CE(s5[0], s5[2]); PEER_CE(s5[1], s5[4]); PEER_CE(s5[1], s5[3]); PEER_CE(s5[1], s5[2]);
#pragma unroll
                for (int t = 0; t < 5; ++t) v[15 - t] = v[15 - t] > s5[t] ? v[15 - t] : s5[t];
#pragma unroll
                for (int j = 8; j > 0; j >>= 1)
#pragma unroll
                    for (int i = 0; i < 16; ++i) { const int q = i ^ j; if (q > i) PEER_CE(v[i], v[q]); }
#define PEER_MERGE(N) do { unsigned p[16]; \
        _Pragma("unroll") for (int i = 0; i < 16; ++i) p[i] = lxu<N>(v[i]); \
        _Pragma("unroll") for (int i = 0; i < 16; ++i) v[i] = v[i] > p[15 - i] ? v[i] : p[15 - i]; \
        _Pragma("unroll") for (int j = 8; j > 0; j >>= 1) _Pragma("unroll") for (int i = 0; i < 16; ++i) { const int q = i ^ j; if (q > i) PEER_CE(v[i], v[q]); } } while (0)
                PEER_MERGE(1); PEER_MERGE(2);
#undef PEER_MERGE
#undef PEER_CE
                const float mx = ord_val(v[0] & ~255u); const int tl = sub * 16 + tok;
                unsigned m4[4]; float e4[4]; int x4[4];
#pragma unroll
                for (int t = 0; t < 4; ++t) { m4[t] = qd == 0 ? v[t] : (qd == 1 ? v[4 + t] : (qd == 2 ? v[8 + t] : v[12 + t]));
                    const int pos = 255 - (int)(m4[t] & 255u), pi = pos >> 4, pj = pos & 15;
                    e4[t] = __expf(ord_val(m4[t] & ~255u) - mx);
                    x4[t] = (127 - (int)(a[pi] & 127u)) * 128 + (127 - (int)(b[pj] & 127u)); }
                float sum = (e4[0] + e4[1]) + (e4[2] + e4[3]); sum += lxf<1>(sum); sum += lxf<2>(sum);
                const float inv = 1.0f / sum;
                { u32x4 xi; xi.x = (unsigned)x4[0]; xi.y = (unsigned)x4[1]; xi.z = (unsigned)x4[2]; xi.w = (unsigned)x4[3]; *(LAS u32x4*)(lidx + tl * 128 + h * 16 + 4 * qd) = xi;
                  f32x4 gi; gi.x = e4[0] * inv; gi.y = e4[1] * inv; gi.z = e4[2] * inv; gi.w = e4[3] * inv; *(LAS f32x4*)(lgate + tl * 128 + h * 16 + 4 * qd) = gi; }
            }
        }
        __syncthreads();
        constexpr int NS = 6, NB = 86;
        LAS unsigned* slw = (LAS unsigned*)(c.lds + 65536) + wave * 1056; LAS float* sgw = (LAS float*)(c.lds + 65536 + 33792) + wave * 1056;
        const int es = ((lane & 1) << 2) | (lane & 2) | ((lane >> 2) & 1);
#pragma unroll 1
        for (int pass = 0; pass < 2; ++pass) {
            const int tl0 = pass * 32 + wave * 4; LAS unsigned* sl = slw + pass * 528; LAS float* sg = sgw + pass * 528;
            int il[4], ih[4]; float gl[4], gh[4];
#pragma unroll
            for (int k = 0; k < 4; ++k) { const int a0 = lidx[(tl0 + k) * 128 + lane], a1 = lidx[(tl0 + k) * 128 + 64 + lane];
                gl[k] = lgate[(tl0 + k) * 128 + lane] * VS[a0]; gh[k] = lgate[(tl0 + k) * 128 + 64 + lane] * VS[a1];
                il[k] = a0 | (k << 14) | (int)(((__float_as_uint(US[a0]) >> 23) & 255u) << 16); ih[k] = a1 | (k << 14) | (int)(((__float_as_uint(US[a1]) >> 23) & 255u) << 16); }
            LAS int* ct = (LAS int*)(c.lds + 133632) + wave * 256;
#pragma unroll
            for (int i = 0; i < 4; ++i) ct[lane + 64 * i] = 0;
            int rk[8];
#pragma unroll
            for (int g = 0; g < 8; ++g) { const int w = (g & 1) ? ih[g >> 1] : il[g >> 1]; const int r = (w >> 9) & 31; unsigned long long eq = ~0ull;
#pragma unroll
                for (int bt_ = 0; bt_ < 5; ++bt_) { const bool bit = (r >> bt_) & 1; const unsigned long long m = __ballot(bit); eq &= bit ? m : ~m; }
                rk[g] = (int)__builtin_amdgcn_mbcnt_hi((unsigned)(eq >> 32), __builtin_amdgcn_mbcnt_lo((unsigned)eq, 0u));
                ct[r * 8 + g] = __builtin_popcountll(eq); }
            { const int c0 = ct[4 * lane], c1 = ct[4 * lane + 1], c2 = ct[4 * lane + 2], c3 = ct[4 * lane + 3]; int sum = (c0 + c1) + (c2 + c3);
#pragma unroll
              for (int o = 1; o < 64; o <<= 1) { const int n = __shfl_up(sum, o); if (lane >= o) sum += n; }
              const int ex = sum - ((c0 + c1) + (c2 + c3));
              ct[4 * lane] = ex; ct[4 * lane + 1] = ex + c0; ct[4 * lane + 2] = ex + c0 + c1; ct[4 * lane + 3] = ex + c0 + c1 + c2; }
#pragma unroll
            for (int g = 0; g < 8; ++g) { const int w = (g & 1) ? ih[g >> 1] : il[g >> 1]; const int pos = ct[((w >> 9) & 31) * 8 + g] + rk[g]; sl[pos] = (unsigned)w; sg[pos] = (g & 1) ? gh[g >> 1] : gl[g >> 1]; }
            if (lane < NS * NB - 512) { sl[512 + lane] = sl[511] & 0x00ff3fffu; sg[512 + lane] = 0.f; }
        }
        __syncthreads();
        LAS unsigned char* xw = c.lds + wave * 8192;
#pragma unroll 1
        for (int pass = 0; pass < 2; ++pass) {
            if (align && pass == 1) xcd_barrier(bar);
            const int tl0 = pass * 32 + wave * 4; const LAS unsigned* sl = slw + pass * 528; const LAS float* sg = sgw + pass * 528;
            float out[4][16]; float xinv1;
            {
                float f[4][16]; float am = 0.f;
#pragma unroll
                for (int k = 0; k < 4; ++k) { const size_t t = (size_t)(tb0 + tl0 + k);
                    float rs; { const float4 a = *(const float4*)(RSl + t * 16), b = *(const float4*)(RSl + t * 16 + 4), c2 = *(const float4*)(RSl + t * 16 + 8), d = *(const float4*)(RSl + t * 16 + 12);
                        rs = rsqrtf(((((a.x + a.y) + (a.z + a.w)) + ((b.x + b.y) + (b.z + b.w))) + (((c2.x + c2.y) + (c2.z + c2.w)) + ((d.x + d.y) + (d.z + d.w)))) * (1.0f / 1024.0f) + 1e-6f); }
                    const u32x4 w0 = *(const u32x4*)(XF + t * 1024 + 16 * lane), w1 = *(const u32x4*)(XF + t * 1024 + 16 * lane + 8);
                    f[k][0] = bf_lo(w0.x); f[k][1] = bf_hi(w0.x); f[k][2] = bf_lo(w0.y); f[k][3] = bf_hi(w0.y); f[k][4] = bf_lo(w0.z); f[k][5] = bf_hi(w0.z); f[k][6] = bf_lo(w0.w); f[k][7] = bf_hi(w0.w);
                    f[k][8] = bf_lo(w1.x); f[k][9] = bf_hi(w1.x); f[k][10] = bf_lo(w1.y); f[k][11] = bf_hi(w1.y); f[k][12] = bf_lo(w1.z); f[k][13] = bf_hi(w1.z); f[k][14] = bf_lo(w1.w); f[k][15] = bf_hi(w1.w);
#pragma unroll
                    for (int i = 0; i < 16; ++i) { f[k][i] *= rs; am = fmaxf(am, fabsf(f[k][i])); } }
                am = fmaxf(am, lxf<1>(am)); am = fmaxf(am, lxf<2>(am)); am = fmaxf(am, lxf<4>(am)); am = fmaxf(am, lxf<8>(am)); am = fmaxf(am, lxf<16>(am)); am = fmaxf(am, lxf<32>(am));
                const float sx = am > 0.f ? __uint_as_float(__float_as_uint(127.0f / am) & 0x7f800000u) : 1.0f;
                xinv1 = __int_as_float(__builtin_amdgcn_readfirstlane(__float_as_int(1.0f / sx)));
#pragma unroll
                for (int k = 0; k < 4; ++k) { u32x4 xq; unsigned qq[4];
#pragma unroll
                    for (int i = 0; i < 4; ++i) qq[i] = ((unsigned)(int)rintf(f[k][4 * i] * sx) & 255u) | (((unsigned)(int)rintf(f[k][4 * i + 1] * sx) & 255u) << 8) | (((unsigned)(int)rintf(f[k][4 * i + 2] * sx) & 255u) << 16) | (((unsigned)(int)rintf(f[k][4 * i + 3] * sx) & 255u) << 24);
                    xq.x = qq[0]; xq.y = qq[1]; xq.z = qq[2]; xq.w = qq[3];
                    *(LAS u32x4*)(xw + k * 1024 + lane * 16) = xq; }
#pragma unroll
                for (int k = 0; k < 4; ++k)
#pragma unroll
                    for (int i = 0; i < 16; ++i) out[k][i] = 0.f;
            }
            u32x4 uuA[NS], uuB[NS]; U3 vvA[NS], vvB[NS]; unsigned mA[NS], mB[NS];
#define PEER_ISSUE(uu, vv, mm, b) do { \
        _Pragma("unroll") for (int s = 0; s < NS; ++s) { mm[s] = __builtin_amdgcn_readfirstlane(sl[NS * (b) + s]); \
            const size_t ex_ = (size_t)(mm[s] & 16383u); uu[s] = ((const u32x4*)(U8 + ex_ * EREC))[lane]; vv[s] = ((const U3*)(V8 + ex_ * EREC))[lane]; } } while (0)
#define PEER_COMPUTE(uu, vv, mm, b) do { int d_[8]; _Pragma("unroll") for (int s = NS; s < 8; ++s) d_[s] = 0; \
        _Pragma("unroll") for (int s = 0; s < NS; ++s) { const unsigned kx_ = (mm[s] >> 14) & 3u; const u32x4 xq_ = *(const LAS u32x4*)(xw + kx_ * 1024 + lane * 16); \
            int ia_ = __builtin_amdgcn_sdot4((int)uu[s].x, (int)xq_.x, 0, false); ia_ = __builtin_amdgcn_sdot4((int)uu[s].y, (int)xq_.y, ia_, false); ia_ = __builtin_amdgcn_sdot4((int)uu[s].z, (int)xq_.z, ia_, false); ia_ = __builtin_amdgcn_sdot4((int)uu[s].w, (int)xq_.w, ia_, false); \
            d_[s] = ia_; } \
          \
        const bool o1_ = lane & 1, o2_ = lane & 2, o4_ = lane & 4; \
        int a0_ = o1_ ? d_[4] : d_[0], a1_ = o1_ ? d_[5] : d_[1], a2_ = o1_ ? d_[6] : d_[2], a3_ = o1_ ? d_[7] : d_[3]; \
        a0_ += lxi<1>(o1_ ? d_[0] : d_[4]); a1_ += lxi<1>(o1_ ? d_[1] : d_[5]); a2_ += lxi<1>(o1_ ? d_[2] : d_[6]); a3_ += lxi<1>(o1_ ? d_[3] : d_[7]); \
        int b0_ = o2_ ? a2_ : a0_, b1_ = o2_ ? a3_ : a1_; b0_ += lxi<2>(o2_ ? a0_ : a2_); b1_ += lxi<2>(o2_ ? a1_ : a3_); \
        int ci_ = o4_ ? b1_ : b0_; ci_ += lxi<4>(o4_ ? b0_ : b1_); \
        ci_ += lxi<8>(ci_); ci_ += lxi<16>(ci_); ci_ += lxi<32>(ci_); \
        const int esl_ = NS * (b) + (es < NS ? es : 0); \
        const float cc_ = (float)ci_ * (__uint_as_float(((sl[esl_] >> 16) & 255u) << 23) * xinv1);     \
        const int cfl_ = __float_as_int(sg[esl_] * (es < NS ? 1.0f : 0.0f) * gelu_erf(cc_)); \
        const float cf_[8] = {__int_as_float(__builtin_amdgcn_readlane(cfl_, 0)), __int_as_float(__builtin_amdgcn_readlane(cfl_, 4)), __int_as_float(__builtin_amdgcn_readlane(cfl_, 2)), __int_as_float(__builtin_amdgcn_readlane(cfl_, 6)), \
                              __int_as_float(__builtin_amdgcn_readlane(cfl_, 1)), __int_as_float(__builtin_amdgcn_readlane(cfl_, 5)), __int_as_float(__builtin_amdgcn_readlane(cfl_, 3)), __int_as_float(__builtin_amdgcn_readlane(cfl_, 7))}; \
        _Pragma("unroll") for (int sp_ = 0; sp_ < NS; sp_ += 2) {     \
            const u32x6 w6_ = {vv[sp_].x, vv[sp_].y, vv[sp_].z, vv[sp_ + 1].x, vv[sp_ + 1].y, vv[sp_ + 1].z}; const f32x32 vf_ = __builtin_amdgcn_cvt_scalef32_pk32_f32_fp6(w6_, 1.0f); \
            _Pragma("unroll") for (int h_ = 0; h_ < 2; ++h_) { const int s = sp_ + h_; const unsigned kk_ = (mm[s] >> 14) & 3u; \
                _Pragma("unroll") for (int k = 0; k < 4; ++k) { if (kk_ == (unsigned)k) { _Pragma("unroll") for (int i = 0; i < 16; ++i) out[k][i] += cf_[s] * vf_[16 * h_ + i]; asm volatile("" ::: "memory"); } } } } } while (0)
#pragma unroll 1
            for (int grep_ = 0; grep_ < 1 + ((DUP >> 15) & 1); ++grep_) {
            if (grep_) {
#pragma unroll
                for (int k = 0; k < 4; ++k)
#pragma unroll
                    for (int i = 0; i < 16; ++i) out[k][i] = 0.f; }
            PEER_ISSUE(uuA, vvA, mA, 0);
#pragma unroll 1
            for (int bb = 0; bb < NB; bb += 2) {
                PEER_ISSUE(uuB, vvB, mB, bb + 1);
                PEER_COMPUTE(uuA, vvA, mA, bb);
                if (bb + 2 < NB) PEER_ISSUE(uuA, vvA, mA, bb + 2);
                PEER_COMPUTE(uuB, vvB, mB, bb + 1);
            }
            }
#undef PEER_ISSUE
#undef PEER_COMPUTE
#pragma unroll
            for (int k = 0; k < 4; ++k) { const size_t t = (size_t)(tb0 + tl0 + k); const float* hp = A.out + t * 1024 + 16 * lane; float* hq = hdst + t * 1024 + 16 * lane;
#pragma unroll
                for (int i = 0; i < 4; ++i) { float4 h4 = *(const float4*)(hp + 4 * i); h4.x += out[k][4 * i]; h4.y += out[k][4 * i + 1]; h4.z += out[k][4 * i + 2]; h4.w += out[k][4 * i + 3]; *(float4*)(hq + 4 * i) = h4; }
            }
#pragma unroll 1
            for (int k2 = 0; k2 < (fuse_next ? 2 : 0); ++k2) {
                int lo16 = 16 * lane; asm volatile("" : "+v"(lo16));
                const float* nx_gain = A.in[2] + (l + 1) * 1024 + lo16; const float* nx_wgate = (const float*)(A.ws + WS_WGATE) + (l + 1) * 8 * 1024 + lo16; const float* nx_alog = A.in[5] + (l + 1) * 4; const float* nx_dtb = A.in[6] + (l + 1) * 4;
                float hv[2][16], ss[2], d[2][8];
#pragma unroll
                for (int k = 0; k < 2; ++k) { const float* hq = hdst + (size_t)(tb0 + tl0 + 2 * k2 + k) * 1024 + lo16;
#pragma unroll
                    for (int i = 0; i < 4; ++i) { const float4 h4 = *(const float4*)(hq + 4 * i); hv[k][4 * i] = h4.x; hv[k][4 * i + 1] = h4.y; hv[k][4 * i + 2] = h4.z; hv[k][4 * i + 3] = h4.w; }
                    float s2 = 0.f;
#pragma unroll
                    for (int i = 0; i < 16; ++i) s2 += hv[k][i] * hv[k][i];
                    ss[k] = s2; }
#pragma unroll
                for (int i = 0; i < 4; ++i) { const float4 g4 = *(const float4*)(nx_gain + 4 * i);
#pragma unroll
                    for (int k = 0; k < 2; ++k) { hv[k][4 * i] *= g4.x; hv[k][4 * i + 1] *= g4.y; hv[k][4 * i + 2] *= g4.z; hv[k][4 * i + 3] *= g4.w; } }
#pragma unroll
                for (int qh = 0; qh < 2; ++qh) {
                    const float* wg_ = nx_wgate; if (qh) asm volatile("" : "+v"(wg_) : "v"(d[1][3]));
#pragma unroll
                    for (int q = 4 * qh; q < 4 * qh + 4; ++q) { float4 w[4];
#pragma unroll
                        for (int i = 0; i < 4; ++i) w[i] = *(const float4*)(wg_ + q * 1024 + 4 * i);
#pragma unroll
                        for (int k = 0; k < 2; ++k) { float a = 0.f;
#pragma unroll
                            for (int i = 0; i < 4; ++i) a += (hv[k][4 * i] * w[i].x + hv[k][4 * i + 1] * w[i].y) + (hv[k][4 * i + 2] * w[i].z + hv[k][4 * i + 3] * w[i].w);
                            d[k][q] = a; } } }
                const bool o1 = lane & 1, o2 = lane & 2, o4 = lane & 4;
#pragma unroll
                for (int k = 0; k < 2; ++k) { const size_t t = (size_t)(tb0 + tl0 + 2 * k2 + k);
                    float a0 = o1 ? d[k][4] : d[k][0], a1 = o1 ? d[k][5] : d[k][1], a2 = o1 ? d[k][6] : d[k][2], a3 = o1 ? d[k][7] : d[k][3];
                    a0 += lxf<1>(o1 ? d[k][0] : d[k][4]); a1 += lxf<1>(o1 ? d[k][1] : d[k][5]); a2 += lxf<1>(o1 ? d[k][2] : d[k][6]); a3 += lxf<1>(o1 ? d[k][3] : d[k][7]);
                    float b0 = o2 ? a2 : a0, b1 = o2 ? a3 : a1; b0 += lxf<2>(o2 ? a0 : a2); b1 += lxf<2>(o2 ? a1 : a3);
                    float cc = o4 ? b1 : b0; cc += lxf<4>(o4 ? b0 : b1);
                    cc += lxf<8>(cc); cc += lxf<16>(cc); cc += lxf<32>(cc);
                    const float rstd = rsqrtf(wave_sum(ss[k]) * (1.0f / D) + 1e-6f);
                    u32x4 w0, w1; w0.x = pk2(hv[k][0] * rstd, hv[k][1] * rstd); w0.y = pk2(hv[k][2] * rstd, hv[k][3] * rstd); w0.z = pk2(hv[k][4] * rstd, hv[k][5] * rstd); w0.w = pk2(hv[k][6] * rstd, hv[k][7] * rstd);
                    w1.x = pk2(hv[k][8] * rstd, hv[k][9] * rstd); w1.y = pk2(hv[k][10] * rstd, hv[k][11] * rstd); w1.z = pk2(hv[k][12] * rstd, hv[k][13] * rstd); w1.w = pk2(hv[k][14] * rstd, hv[k][15] * rstd);
                    bf16_t* xo = (bf16_t*)(A.ws + WS_NBUF) + t * 1024 + lo16; *(u32x4*)xo = w0; *(u32x4*)(xo + 8) = w1;
                    if (lane < 8) { const float r = cc * rstd; float o;
                        if (es < 4) o = 1.0f / (1.0f + __expf(-r));
                        else { const float z = r + nx_dtb[es - 4]; const float sp = z > 20.f ? z : log1pf(__expf(z)); o = -__expf(nx_alog[es - 4]) * sp; }
                        ((float*)(A.ws + WS_GB))[t * 8 + es] = o; }
                }
            }
        }
    }
    __syncthreads();
}

__device__ __forceinline__ bool relaunder(Ctx& c) { int t = threadIdx.x; asm volatile("" : "+v"(t)); c.tid = t; c.lane = t & 63; c.wave = __builtin_amdgcn_readfirstlane(t >> 6); return true; }
__global__ void __launch_bounds__(512, 2) fwd(Args a) {
    extern __shared__ __attribute__((aligned(16))) unsigned char lds_raw[];
    Ctx c; c.lds = (LAS unsigned char*)lds_raw; c.tid = threadIdx.x; c.lane = c.tid & 63; c.wave = __builtin_amdgcn_readfirstlane(c.tid >> 6); c.G = gridDim.x; c.bid = blockIdx.x;
    const Args& A = a;
    volatile LAS unsigned* MISC = (volatile LAS unsigned*)(c.lds + MISC_OFF);
    if (c.tid < 64) MISC[c.tid] = 0u;
    __syncthreads();
    const int lo = a.ph_lo, hi = a.ph_hi;
    XcdBarrier bar; bar.bar = (unsigned*)(A.ws + WS_CTL) + CW_BAR; bar.x = 0; bar.st = MISC + 8;
    if (hi - lo > 1) bar = xcd_barrier_post((unsigned*)(A.ws + WS_CTL) + CW_BAR, MISC + 8);
#define IN(k) (lo <= (k) && (k) < hi && relaunder(c))
#define INR(k) (lo <= (k) && (k) < hi)
#define SEAM(k) do { if (INR(k) && INR((k) + 1)) { xcd_barrier(bar); if ((DUP >> 14) & 1) xcd_barrier(bar); } } while (0)
    bf16_t* NBUF = (bf16_t*)(A.ws + WS_NBUF); bf16_t* PROJ = (bf16_t*)(A.ws + WS_PROJ); bf16_t* MIXED = (bf16_t*)(A.ws + WS_MIXED); bf16_t* QP = (bf16_t*)(A.ws + WS_QP);
    float* GB = (float*)(A.ws + WS_GB);
    if (IN(0)) REP(10) p0_prologue(c, a);
    SEAM(0);
    auto layer = [&](const int l) __attribute__((always_inline)) {
        const int pb = 1 + 10 * l;
        if (l == 0 && IN(pb + 0) && !(KO & (1 << 0))) REP(0) phase_norm(c, a, l == 0 ? A.in[0] : A.out, A.in[2] + l * 1024, NBUF, (const float*)(A.ws + WS_WGATE) + l * 8 * 1024, A.in[5] + l * 4, A.in[6] + l * 4, GB);
        if (l == 0) SEAM(pb + 0);
        if (IN(pb + 1) && !(KO & (1 << 1))) REP(1) { pg8::Gemm g{NBUF, (const bf16_t*)(A.ws + WS_WIN) + (size_t)l * NPROJ * 1024, T, NPROJ, 1024}; pg8::StaticOrder S; S.init(T, NPROJ, c.G, c.bid); pg8::EpiBf16 E{PROJ, NPROJ, nullptr};
            pg8::gemm_phase<pg8::EpiBf16, pg8::StaticOrder>(c.lds, g, S, E, nullptr); }
        SEAM(pb + 1);
        if (IN(pb + 2) && !(KO & (1 << 2))) REP(2) phase_prep(c, a, l);
        SEAM(pb + 2);
        if (IN(pb + 3)) REP(3) { for (int u = c.bid; u < 1024; u += 2 * c.G) { if (u + c.G < 1024) gdn_chunk_pair(c, a, u, u + c.G); else gdn_chunk_unit(c, a, u); } }
        SEAM(pb + 3);
        if (IN(pb + 4) && !(KO & (1 << 3))) REP(4) { if (c.bid < 64) { for (int rp = 0; rp < 1 + ((DUP >> 12) & 1); ++rp) gdn_scan(c, a, c.bid); } else { for (int rp = 0; rp < 1 + ((DUP >> 13) & 1); ++rp) attn_mfma(c, a, l, 64, c.G - 64); } }
        SEAM(pb + 4);
        if (IN(pb + 5) && !(KO & (1 << 4))) REP(5) phase_gdn_out(c, a, l);
        SEAM(pb + 5);
        if (IN(pb + 6) && !(KO & (1 << 5))) REP(6) { pg8::Gemm g{MIXED, (const bf16_t*)(A.ws + WS_WOUT) + (size_t)l * 1024 * 1024, T, 1024, 1024}; pg8::StaticOrder S; S.init(T, 1024, c.G, c.bid); pg8::EpiResNorm E{l == 0 ? A.in[0] : A.out, A.out, NBUF, A.in[14] + l * 1024, (float*)(A.ws + WS_RS), 1024};
            pg8::gemm_phase<pg8::EpiResNorm, pg8::StaticOrder>(c.lds, g, S, E, nullptr); }
        SEAM(pb + 6);
        if (IN(pb + 8) && !(KO & (1 << 7))) REP(8) { pg8::Gemm g{NBUF, (const bf16_t*)(A.ws + WS_WQ) + (size_t)l * 2048 * 1024, T, 2048, 1024}; pg8::StaticOrder S; S.init(T, 2048, c.G, c.bid); pg8::EpiBf16 E{QP, 2048, (const float*)(A.ws + WS_RS)};
            pg8::gemm_phase<pg8::EpiBf16, pg8::StaticOrder>(c.lds, g, S, E, nullptr); }
        SEAM(pb + 8);
        if (IN(pb + 9) && !(KO & (1 << 8))) REP(9) phase_peer(c, a, l, LASTREP(9) ? A.out : (float*)(A.ws + WS_GCH), l == 0, bar, (hi - lo > 1) && c.G * 64 == T);
        SEAM(pb + 9);
    };
    layer(0); layer(1);
#undef IN
#undef INR
#undef SEAM
}

extern "C" void kernel_launch(void* const* d_in, const int* in_sizes, int n_in, void* d_out, int out_size, void* d_ws, size_t ws_size, hipStream_t stream) {
    static int grid = 0;
    if (grid == 0) {
        if (n_in != 19 || out_size != T * D || ws_size < WS_END) { fprintf(stderr, "kernel_launch: unexpected shapes (n_in %d out %d ws %zu)\n", n_in, out_size, ws_size); grid = -1; return; }
        if (hipFuncSetAttribute((const void*)fwd, hipFuncAttributeMaxDynamicSharedMemorySize, LDS_BYTES) != hipSuccess) { fprintf(stderr, "kernel_launch: hipFuncSetAttribute failed\n"); grid = -1; return; }
        int dev = 0, cus = 0, per_cu = 0;
        (void)hipGetDevice(&dev); (void)hipDeviceGetAttribute(&cus, hipDeviceAttributeMultiprocessorCount, dev);
        (void)hipOccupancyMaxActiveBlocksPerMultiprocessor(&per_cu, (const void*)fwd, 512, LDS_BYTES);
        (void)hipGetLastError();
        if (per_cu < 1) fprintf(stderr, "kernel_launch: occupancy query reports %d blocks per CU\n", per_cu);
        grid = cus > 0 ? cus : 256;
    }
    if (grid < 0) return;
    (void)hipMemsetAsync((char*)d_ws + WS_CTL, 0, CTL_BYTES, stream);
    Args a{};
    for (int i = 0; i < 19; ++i) a.in[i] = (const float*)d_in[i];
    a.out = (float*)d_out; a.ws = (unsigned char*)d_ws;
#if MK_ONE_LAUNCH
    a.ph_lo = 0; a.ph_hi = NPHASE;
    hipLaunchKernelGGL(fwd, dim3(grid), dim3(512), LDS_BYTES, stream, a);
#else
    for (int p = 0; p < NPHASE; ++p) { a.ph_lo = p; a.ph_hi = p + 1; hipLaunchKernelGGL(fwd, dim3(grid), dim3(512), LDS_BYTES, stream, a); }
#endif
}
```

```cpp
#include <hip/hip_runtime.h>
#include <cstdio>
#include <cstdint>
#include <cstring>

#ifndef KO
#define KO 0
#endif
#ifndef DUP
#define DUP 0
#endif
#define ALIGN_V 0
#define REP(k) for (int rep = 0; rep < 1 + ((DUP >> (k)) & 1); ++rep)
#define LASTREP(k) (rep == ((DUP >> (k)) & 1))
#ifndef MK_ONE_LAUNCH
#define MK_ONE_LAUNCH 1
#endif

template <int CTRL> __device__ __forceinline__ int dpp_i(int x) { return __builtin_amdgcn_mov_dpp(x, CTRL, 0xf, 0xf, true); }
template <int N> __device__ __forceinline__ int lxi(int x) {
    if constexpr (N == 1) return dpp_i<0xB1>(x);
    else if constexpr (N == 2) return dpp_i<0x4E>(x);
    else if constexpr (N == 4) return dpp_i<0x1B>(dpp_i<0x141>(x));
    else if constexpr (N == 8) return dpp_i<0x128>(x);
    else if constexpr (N == 16) { const auto r = __builtin_amdgcn_permlane16_swap((unsigned)x, (unsigned)x, false, false); return (int)((threadIdx.x & 16) ? r[0] : r[1]); }
    else { const auto r = __builtin_amdgcn_permlane32_swap((unsigned)x, (unsigned)x, false, false); return (int)((threadIdx.x & 32) ? r[0] : r[1]); }
}
template <int N> __device__ __forceinline__ float lxf(float x) { return __int_as_float(lxi<N>(__float_as_int(x))); }
template <int N> __device__ __forceinline__ unsigned lxu(unsigned x) { return (unsigned)lxi<N>((int)x); }
namespace pg8 {
#define PG8_LAS __attribute__((address_space(3)))
typedef unsigned short bf16_t;
typedef short bf16x8 __attribute__((ext_vector_type(8)));
typedef float f32x4 __attribute__((ext_vector_type(4)));
typedef unsigned u32x4 __attribute__((ext_vector_type(4)));
constexpr int BM = 256, BK = 64, HALF = 128, HTB = HALF * BK * 2  , STAGE_BYTES = 8 * HTB, NXCD = 8, WGM = 8;

__host__ __device__ __forceinline__ int lds_byte(int r, int c) { const int st = (r >> 4) * 2 + (c >> 5), rr = r & 15, cc = c & 31, ob = rr * 64 + cc * 2; return st * 1024 + (ob ^ (((ob >> 9) & 1) << 5)); }
__host__ __device__ __forceinline__ void stage_rc(int b, int& R, int& C) { const int st = b / 1024, sb = b % 1024, swz = sb ^ (((sb >> 9) & 1) << 5); R = (st >> 1) * 16 + swz / 64; C = (st & 1) * 32 + (swz % 64) / 2; }
__host__ __device__ __forceinline__ int perm32(int rho) { const int n = rho >> 4, i = rho & 15; return 8 * (i >> 2) + 4 * n + (i & 3); }

struct Unit { int pm, pn; };
struct Gemm { const bf16_t* A; const bf16_t* Bt; int M, N, K; };

struct StaticOrder {
    int nM, nN, nwg, G, c;
    __host__ __device__ void init(int M, int N, int G_, int c_) { nM = M / BM; nN = N / BM; nwg = nM * nN; G = G_; c = c_; }
    __host__ __device__ bool next(int i, Unit& u) const {
        const long L = (long)i * G + c; if (L >= nwg) return false;
        int wgid = (int)L; { const int q = nwg / NXCD, r = nwg % NXCD, xcd = wgid % NXCD, off = wgid / NXCD; wgid = (xcd < r ? xcd * (q + 1) : r * (q + 1) + (xcd - r) * q) + off; }
        const int nig = WGM * nN, gid = wgid / nig, fm = gid * WGM, gsz = (nM - fm) < WGM ? (nM - fm) : WGM;
        u.pm = fm + ((wgid % nig) % gsz); u.pn = (wgid % nig) / gsz; return true;
    }
    __device__ __forceinline__ void a_ready(const Unit&) const {}
    __device__ __forceinline__ void done(const Unit&) const {}
};
__device__ __forceinline__ unsigned cvt_pk_bf16(float lo, float hi) { unsigned r; asm volatile("v_cvt_pk_bf16_f32 %0, %1, %2" : "=v"(r) : "v"(lo), "v"(hi)); return r; }
typedef unsigned u32x2v __attribute__((ext_vector_type(2)));
struct EpiResF32 {
    static constexpr bool PERM = false, AFTER_DRAIN = false;
    const float* R; float* C; int ldc;
    __device__ __forceinline__ void operator()(const f32x4 (&acc)[2][2][4][2], const Unit& u, int wr, int wc, int fr, int fq) const {
        const int row0 = u.pm * BM + wr * 64 + fr, col0 = u.pn * BM + wc * 32 + 4 * fq;
#pragma unroll
        for (int ai = 0; ai < 2; ++ai)
#pragma unroll
            for (int m = 0; m < 4; ++m) { const size_t ro = (size_t)(row0 + ai * HALF + m * 16) * ldc + col0;
#pragma unroll
                for (int bj = 0; bj < 2; ++bj)
#pragma unroll
                    for (int n = 0; n < 2; ++n) { const f32x4 r = *(const f32x4*)(R + ro + bj * HALF + n * 16); *(f32x4*)(C + ro + bj * HALF + n * 16) = acc[ai][bj][m][n] + r; } }
    }
};
struct EpiResNorm {
    static constexpr bool PERM = false, AFTER_DRAIN = false;
    const float* R; float* C; bf16_t* HB; const float* gain; float* RS; int ldc;
    __device__ __forceinline__ void operator()(const f32x4 (&acc)[2][2][4][2], const Unit& u, int wr, int wc, int fr, int fq) const {
        const int row0 = u.pm * BM + wr * 64 + fr, col0 = u.pn * BM + wc * 32 + 4 * fq;
        f32x4 gv[2][2];
#pragma unroll
        for (int bj = 0; bj < 2; ++bj)
#pragma unroll
            for (int n = 0; n < 2; ++n) gv[bj][n] = *(const f32x4*)(gain + col0 + bj * HALF + n * 16);
#pragma unroll
        for (int ai = 0; ai < 2; ++ai)
#pragma unroll
            for (int m = 0; m < 4; ++m) { const int row = row0 + ai * HALF + m * 16; const size_t ro = (size_t)row * ldc + col0; float ss = 0.f;
#pragma unroll
                for (int bj = 0; bj < 2; ++bj)
#pragma unroll
                    for (int n = 0; n < 2; ++n) { const f32x4 r = *(const f32x4*)(R + ro + bj * HALF + n * 16); const f32x4 h = acc[ai][bj][m][n] + r; *(f32x4*)(C + ro + bj * HALF + n * 16) = h;
                        ss += (h[0] * h[0] + h[1] * h[1]) + (h[2] * h[2] + h[3] * h[3]); const f32x4 y = h * gv[bj][n];
                        u32x2v w; w.x = cvt_pk_bf16(y[0], y[1]); w.y = cvt_pk_bf16(y[2], y[3]); *(u32x2v*)(HB + ro + bj * HALF + n * 16) = w; }
                ss += lxf<16>(ss); ss += lxf<32>(ss);
                if (fq == 0) RS[(size_t)row * 16 + u.pn * 4 + wc] = ss; }
    }
};
struct EpiBf16 {
    static constexpr bool PERM = true, AFTER_DRAIN = false;
    bf16_t* O; int ldc; const float* RS;
    __device__ __forceinline__ void operator()(const f32x4 (&acc)[2][2][4][2], const Unit& u, int wr, int wc, int fr, int fq) const {
        const int row0 = u.pm * BM + wr * 64 + fr; const int col0 = u.pn * BM + wc * 32 + 8 * fq;
#pragma unroll
        for (int ai = 0; ai < 2; ++ai)
#pragma unroll
            for (int m = 0; m < 4; ++m) { const int row = row0 + ai * HALF + m * 16; bf16_t* rowp = O + (size_t)row * ldc + col0;
                float sc = 1.0f; if (RS) { const f32x4 a = *(const f32x4*)(RS + (size_t)row * 16), b = *(const f32x4*)(RS + (size_t)row * 16 + 4), c2 = *(const f32x4*)(RS + (size_t)row * 16 + 8), d = *(const f32x4*)(RS + (size_t)row * 16 + 12);
                    sc = rsqrtf(((((a[0] + a[1]) + (a[2] + a[3])) + ((b[0] + b[1]) + (b[2] + b[3]))) + (((c2[0] + c2[1]) + (c2[2] + c2[3])) + ((d[0] + d[1]) + (d[2] + d[3])))) * (1.0f / 1024.0f) + 1e-6f); }
#pragma unroll
                for (int bj = 0; bj < 2; ++bj) { const f32x4 v0 = acc[ai][bj][m][0] * sc, v1 = acc[ai][bj][m][1] * sc;
                    u32x4 w; w.x = cvt_pk_bf16(v0[0], v0[1]); w.y = cvt_pk_bf16(v0[2], v0[3]); w.z = cvt_pk_bf16(v1[0], v1[1]); w.w = cvt_pk_bf16(v1[2], v1[3]);
                    *(u32x4*)(rowp + bj * HALF) = w; } }
    }
};

template <class Epi, class Sched, bool STAMP = false>
__device__ __forceinline__ void gemm_phase(PG8_LAS unsigned char* lds, const Gemm g, const Sched& S, const Epi& E, unsigned long long* stamps) {
    int tid_ = threadIdx.x; asm volatile("" : "+v"(tid_));
    const int tid = tid_, wid = __builtin_amdgcn_readfirstlane(tid >> 6), lane = tid & 63, wr = wid >> 2, wc = wid & 3, fr = lane & 15, fq = lane >> 4;
    const int K = g.K, nt = K / BK;
    int ts_lo = 0, ts_hi = 0, nts = 0; const unsigned long long rt_entry = STAMP ? (unsigned long long)wall_clock64() : 0ull;
#define PG8_STAMP() do { if (STAMP && wid == 0 && nts < 64) { const unsigned long long _c = (unsigned long long)clock64(); \
        ts_lo = (lane == nts) ? (int)(unsigned)_c : ts_lo; ts_hi = (lane == nts) ? (int)(unsigned)(_c >> 32) : ts_hi; ++nts; } } while (0)
    PG8_STAMP();
    unsigned voffA[2], voffB[2];
#pragma unroll
    for (int i = 0; i < 2; ++i) { int R, C; stage_rc(tid * 16 + i * 8192, R, C); const int Rb = Epi::PERM ? ((R & ~31) + perm32(R & 31)) : R;
        voffA[i] = (unsigned)(R * K + C) * 2u; voffB[i] = (unsigned)(Rb * K + C) * 2u; }
    const size_t kstep = (size_t)(BK * 2);
    const size_t hstep = (size_t)HALF * K * 2;
    const size_t tstep = 2 * hstep;
    const unsigned ldsw = (unsigned)wid * 1024u;
    const int aoff = lds_byte(wr * 64 + fr, fq * 8), boff = lds_byte(wc * 32 + fr, fq * 8);
#define PG8_SA(b, h) (((b) * 2 + (h)) * HTB)
#define PG8_SB(b, h) ((4 + (b) * 2 + (h)) * HTB)
#define PG8_STAGE(bufoff, gbase, voff) do { _Pragma("unroll") for (int _i = 0; _i < 2; ++_i) \
        __builtin_amdgcn_global_load_lds((const unsigned*)((const char*)(gbase) + (voff)[_i]), (PG8_LAS unsigned*)(lds + (bufoff) + ldsw + _i * 8192), 16, 0, 0); } while (0)
#define PG8_LDA(dst, b, h) do { _Pragma("unroll") for (int m = 0; m < 4; ++m) _Pragma("unroll") for (int k = 0; k < 2; ++k) dst[m][k] = *(const PG8_LAS bf16x8*)(lds + PG8_SA(b, h) + aoff + m * 2048 + k * 1024); } while (0)
#define PG8_LDB(dst, b, h) do { _Pragma("unroll") for (int n = 0; n < 2; ++n) _Pragma("unroll") for (int k = 0; k < 2; ++k) dst[n][k] = *(const PG8_LAS bf16x8*)(lds + PG8_SB(b, h) + boff + n * 2048 + k * 1024); } while (0)
#define PG8_MMA(ai, bj, At, Bt) do { __builtin_amdgcn_s_setprio(1); _Pragma("unroll") for (int m = 0; m < 4; ++m) _Pragma("unroll") for (int n = 0; n < 2; ++n) _Pragma("unroll") for (int k = 0; k < 2; ++k) \
        acc[ai][bj][m][n] = __builtin_amdgcn_mfma_f32_16x16x32_bf16(Bt[n][k], At[m][k], acc[ai][bj][m][n], 0, 0, 0); __builtin_amdgcn_s_setprio(0); } while (0)
#define PG8_WAIT_V(n) asm volatile("s_waitcnt vmcnt(" #n ")" ::: "memory")
#define PG8_WAIT_L(n) asm volatile("s_waitcnt lgkmcnt(" #n ")" ::: "memory")
#define PG8_BAR __builtin_amdgcn_s_barrier()
#define PG8_SCHED __builtin_amdgcn_sched_barrier(0)
    Unit cur, nxt; int ui = 0;
    if (!S.next(0, cur)) return;
    f32x4 acc[2][2][4][2];
#pragma unroll
    for (int a = 0; a < 2; ++a)
#pragma unroll
        for (int b = 0; b < 2; ++b)
#pragma unroll
            for (int m = 0; m < 4; ++m)
#pragma unroll
                for (int n = 0; n < 2; ++n) acc[a][b][m][n] = (f32x4){0.f, 0.f, 0.f, 0.f};
    bf16x8 At[4][2], B0[2][2], B1[2][2];
    const char* cA = (const char*)g.A + (size_t)cur.pm * tstep; const char* cB = (const char*)g.Bt + (size_t)cur.pn * tstep;
    S.a_ready(cur);
    PG8_STAGE(PG8_SB(0, 0), cB, voffB); PG8_STAGE(PG8_SA(0, 0), cA, voffA); PG8_STAGE(PG8_SB(0, 1), cB + hstep, voffB); PG8_STAGE(PG8_SA(0, 1), cA + hstep, voffA);
    if (wr == 1) PG8_BAR;
    PG8_WAIT_V(4); PG8_BAR;
    PG8_STAGE(PG8_SB(1, 0), cB + kstep, voffB); PG8_STAGE(PG8_SA(1, 0), cA + kstep, voffA); PG8_STAGE(PG8_SB(1, 1), cB + hstep + kstep, voffB);
    PG8_WAIT_V(6); PG8_BAR;
    PG8_STAMP();
    for (;;) {
        const bool has_next = S.next(ui + 1, nxt);
        const char* nA = has_next ? (const char*)g.A + (size_t)nxt.pm * tstep : cA; const char* nB = has_next ? (const char*)g.Bt + (size_t)nxt.pn * tstep : cB;
        for (int t = 0; t < nt; t += 2) {
            const bool last = (t == nt - 2);
            const char* a1 = cA + (size_t)(t + 1) * kstep;
            const char* a2 = last ? nA : cA + (size_t)(t + 2) * kstep; const char* b2 = last ? nB : cB + (size_t)(t + 2) * kstep;
            const char* a3 = a2 + kstep; const char* b3 = b2 + kstep;
            if (last && has_next) S.a_ready(nxt);
            PG8_LDB(B0, 0, 0); PG8_SCHED; PG8_LDA(At, 0, 0); PG8_STAGE(PG8_SA(1, 1), a1 + hstep, voffA);
            PG8_WAIT_L(8); PG8_BAR; PG8_WAIT_L(0); PG8_MMA(0, 0, At, B0); PG8_BAR; PG8_SCHED;
            PG8_LDB(B1, 0, 1); PG8_STAGE(PG8_SB(0, 0), b2, voffB);
            PG8_BAR; PG8_WAIT_L(0); PG8_MMA(0, 1, At, B1); PG8_BAR;
            PG8_LDA(At, 0, 1); PG8_STAGE(PG8_SA(0, 0), a2, voffA);
            PG8_BAR; PG8_WAIT_L(0); PG8_MMA(1, 0, At, B0); PG8_BAR; PG8_SCHED;
            PG8_STAGE(PG8_SB(0, 1), b2 + hstep, voffB);
            PG8_WAIT_V(6); PG8_BAR; PG8_MMA(1, 1, At, B1); PG8_BAR;
            PG8_LDB(B0, 1, 0); PG8_SCHED; PG8_LDA(At, 1, 0); PG8_STAGE(PG8_SA(0, 1), a2 + hstep, voffA);
            PG8_WAIT_L(8); PG8_BAR; PG8_WAIT_L(0); PG8_MMA(0, 0, At, B0); PG8_BAR; PG8_SCHED;
            PG8_LDB(B1, 1, 1); PG8_STAGE(PG8_SB(1, 0), b3, voffB);
            PG8_BAR; PG8_WAIT_L(0); PG8_MMA(0, 1, At, B1); PG8_BAR;
            PG8_LDA(At, 1, 1); PG8_STAGE(PG8_SA(1, 0), a3, voffA);
            PG8_BAR; PG8_WAIT_L(0); PG8_MMA(1, 0, At, B0); PG8_BAR; PG8_SCHED;
            PG8_STAGE(PG8_SB(1, 1), b3 + hstep, voffB);
            PG8_WAIT_V(6); PG8_BAR; PG8_MMA(1, 1, At, B1); PG8_BAR;
        }
        PG8_STAMP();
        if constexpr (!Epi::AFTER_DRAIN) { E(acc, cur, wr, wc, fr, fq); S.done(cur); }
        PG8_STAMP();
        if (!has_next) break;
#pragma unroll
        for (int a = 0; a < 2; ++a)
#pragma unroll
            for (int b = 0; b < 2; ++b)
#pragma unroll
                for (int m = 0; m < 4; ++m)
#pragma unroll
                    for (int n = 0; n < 2; ++n) acc[a][b][m][n] = (f32x4){0.f, 0.f, 0.f, 0.f};
        cur = nxt; cA = nA; cB = nB; ++ui;
    }
    PG8_WAIT_V(0);
    if (wr == 0) PG8_BAR;
    PG8_BAR;
    if constexpr (Epi::AFTER_DRAIN) { E.fused(acc, cur, wr, wc, fr, fq, lds, wid, lane); S.done(cur); }
    PG8_STAMP();
    if (STAMP && wid == 0) { stamps[lane] = lane < nts ? (((unsigned long long)(unsigned)ts_hi << 32) | (unsigned)ts_lo) : 0ull;
        if (lane == 62) stamps[62] = rt_entry; if (lane == 63) stamps[63] = (unsigned long long)wall_clock64(); }
#undef PG8_STAMP
#undef PG8_SA
#undef PG8_SB
#undef PG8_STAGE
#undef PG8_LDA
#undef PG8_LDB
#undef PG8_MMA
#undef PG8_WAIT_V
#undef PG8_WAIT_L
#undef PG8_BAR
#undef PG8_SCHED
}
}

using pg8::bf16_t; using pg8::bf16x8; using pg8::f32x4; using pg8::u32x4;
typedef unsigned u32x2 __attribute__((ext_vector_type(2)));
constexpr int T = 16384, D = 1024, SEQ = 2048, NPROJ = 3584, NINW = 3592, NEXP = 16384;
constexpr int EREC = 1792;
constexpr int C_GQ = 0, C_GK = 512, C_GV = 1024, C_GZ = 1536, C_SB = 2048, C_SC = 2304, C_SH = 2560, C_DQ = 2816, C_DK = 3072, C_DV = 3328;
constexpr size_t MiB = 1u << 20;
constexpr size_t WS_CTL = 0, CTL_BYTES = 1 * MiB, WS_WIN = 2 * MiB, WS_WOUT = 16 * MiB, WS_WQ = 20 * MiB, WS_KEYS = 28 * MiB, WS_WGATE = 29 * MiB, WS_VSC = 30 * MiB, WS_USC = 31 * MiB,
    WS_UT = 32 * MiB, WS_VT = 96 * MiB, WS_NBUF = 160 * MiB, WS_PROJ = 192 * MiB, WS_QP = 192 * MiB, WS_QKVC = 304 * MiB, WS_MIXED = 352 * MiB, WS_GB = 384 * MiB,
    WS_AQ = 385 * MiB, WS_AK = 393 * MiB, WS_OGDN = 401 * MiB, WS_GCH = 433 * MiB, WS_AVT = 160 * MiB  , WS_END = 505 * MiB;
constexpr int CW_BAR = 4096;
constexpr size_t WS_RS = 1 * MiB;
constexpr int LDS_BYTES = 155648;
constexpr int MISC_OFF = 155648 - 256;
constexpr int NPHASE = 21;

__device__ __forceinline__ float bf_lo(unsigned w) { return __uint_as_float(w << 16); }
__device__ __forceinline__ float bf_hi(unsigned w) { return __uint_as_float(w & 0xffff0000u); }
__device__ __forceinline__ unsigned f2bf(float f) { unsigned u = __float_as_uint(f); return (u + 0x7fffu + ((u >> 16) & 1u)) >> 16; }
__device__ __forceinline__ unsigned pk2(float lo, float hi) { return f2bf(lo) | (f2bf(hi) << 16); }
__device__ __forceinline__ float wave_sum(float v) {
    v += lxf<1>(v); v += lxf<2>(v); v += lxf<4>(v); v += lxf<8>(v); v += lxf<16>(v); v += lxf<32>(v);
    return v;
}
__device__ __forceinline__ int kperm(int x) { return (x & ~31) | (((x >> 2) & 3) << 3) | (((x >> 4) & 1) << 2) | (x & 3); }
__device__ __forceinline__ float silu_f(float x) { return x / (1.0f + __expf(-x)); }

#define XB_TMO      128
#define XB_XCNT(j)  (256  + 64 * (j))
#define XB_XSUB(j)  (1280 + 64 * (j))
#define XB_XGEN(j)  (2304 + 64 * (j))
#define XB_TOP      3328
#define XB_TOPGEN   3392
#define XCD_BAR_WORDS 3456
#define XB_SPIN_CAP (1u << 18)
#define LAS __attribute__((address_space(3)))

__device__ __forceinline__ unsigned xb_ld(unsigned* p)              { return __hip_atomic_load(p, __ATOMIC_RELAXED, __HIP_MEMORY_SCOPE_AGENT); }
__device__ __forceinline__ unsigned xb_add(unsigned* p, unsigned v) { return __hip_atomic_fetch_add(p, v, __ATOMIC_RELAXED, __HIP_MEMORY_SCOPE_AGENT); }
__device__ __forceinline__ unsigned xb_xcc_id() { return (unsigned)__builtin_amdgcn_s_getreg((3 << 11) | 20) & 0xFu; }
#define XB_SPIN(cond, bar) do { unsigned _sp = 0; while (cond) { __builtin_amdgcn_s_sleep(1); \
    if ((++_sp & 255u) == 0u) { if (xb_ld(&(bar)[XB_TMO])) break; if (_sp > XB_SPIN_CAP) { atomicAdd(&(bar)[XB_TMO], 1u); break; } } } } while (0)

struct XcdBarrier {
    unsigned* bar; unsigned x;
    volatile LAS unsigned* st;
};

__device__ __forceinline__ XcdBarrier xcd_barrier_post(unsigned* bar, volatile LAS unsigned* st) {
    XcdBarrier b; b.bar = bar; b.x = xb_xcc_id(); b.st = st;
    if (threadIdx.x == 0) (void)xb_add(&bar[XB_XCNT(b.x)], 1u);
    return b;
}
__device__ __forceinline__ void xcd_barrier_complete(unsigned* bar, unsigned x, unsigned& nloc, unsigned& nx) {
    const unsigned G = gridDim.x * gridDim.y * gridDim.z;
    unsigned sum, cnt, mine, sp = 0u;
    for (;;) {
        sum = 0u; cnt = 0u; mine = 0u;
#pragma unroll
        for (unsigned j = 0; j < 16; ++j) { const unsigned c = xb_ld(&bar[XB_XCNT(j)]); sum += c; cnt += (c > 0u) ? 1u : 0u; mine = (j == x) ? c : mine; }
        if (sum == G) break;
        __builtin_amdgcn_s_sleep(1);
        if ((++sp & 255u) == 0u) { if (xb_ld(&bar[XB_TMO])) break; if (sp > XB_SPIN_CAP) { atomicAdd(&bar[XB_TMO], 1u); break; } }
    }
    nloc = mine > 0u ? mine : 1u; nx = cnt > 0u ? cnt : 1u;
}

__device__ __forceinline__ void xcd_barrier(const XcdBarrier& b) {
    asm volatile("s_waitcnt vmcnt(0)" ::: "memory");
    __syncthreads();
    if (threadIdx.x == 0) {
        unsigned* bar = b.bar;
        __builtin_amdgcn_s_waitcnt(0);
        unsigned nloc = b.st[0], nx = b.st[1];
        if (nloc == 0u) { xcd_barrier_complete(bar, b.x, nloc, nx); b.st[0] = nloc; b.st[1] = nx; }
        const unsigned old = xb_add(&bar[XB_XSUB(b.x)], 1u);
        const unsigned gen = old / nloc;
        if (old + 1u == (gen + 1u) * nloc) {
            __builtin_amdgcn_fence(__ATOMIC_RELEASE, "agent");
            asm volatile("s_waitcnt vmcnt(0)" ::: "memory");
            const unsigned og = xb_add(&bar[XB_TOP], 1u);
            const unsigned tg = og / nx;
            if (og + 1u == (tg + 1u) * nx) xb_add(&bar[XB_TOPGEN], 1u);
            else XB_SPIN(xb_ld(&bar[XB_TOPGEN]) == tg, bar);
            __builtin_amdgcn_fence(__ATOMIC_ACQUIRE, "agent");
            xb_add(&bar[XB_XGEN(b.x)], 1u);
            asm volatile("s_waitcnt vmcnt(0)" ::: "memory");
        } else {
            XB_SPIN(xb_ld(&bar[XB_XGEN(b.x)]) == gen, bar);
            __builtin_amdgcn_fence(__ATOMIC_ACQUIRE, "agent");
            asm volatile("s_waitcnt vmcnt(0)" ::: "memory");
        }
    }
    __syncthreads();
}

struct Args { const float* in[19]; float* out; unsigned char* ws; int ph_lo, ph_hi; };
struct Ctx {
    LAS unsigned char* lds; int tid, lane, wave, G, bid;
};

struct __attribute__((packed, aligned(4))) U3 { unsigned x, y, z; };
typedef unsigned u32x6 __attribute__((ext_vector_type(6)));
typedef float f32x32 __attribute__((ext_vector_type(32)));
__device__ __forceinline__ unsigned fp6_e2m3(float x) {
    const float a = fabsf(x); const float cdf = a < 2.f ? rintf(a * 8.f) : (a < 4.f ? rintf(a * 4.f) + 8.f : rintf(a * 2.f) + 16.f);
    return (unsigned)fminf(cdf, 31.f) | ((__float_as_uint(x) >> 31) << 5);
}
__device__ __forceinline__ void cvt_flat8(const float* src, unsigned char* dst, size_t n8, size_t gt, size_t NT) {
    const float4* s = (const float4*)src; u32x4* d = (u32x4*)dst;
    for (size_t i = gt; i < n8; i += NT) { const float4 a = s[2 * i], b = s[2 * i + 1]; u32x4 w; w.x = pk2(a.x, a.y); w.y = pk2(a.z, a.w); w.z = pk2(b.x, b.y); w.w = pk2(b.z, b.w); d[i] = w; }
}
__device__ __forceinline__ void cvt_transpose(const float* w, bf16_t* dst, int N, size_t gt, size_t NT) {
    const size_t items = (size_t)2 * 128 * N;
    for (size_t i = gt; i < items; i += NT) {
        const int cc = (int)(i % N), kb = (int)((i / N) % 128), l = (int)(i / ((size_t)N * 128));
        const float* s = w + ((size_t)l * 1024 + kb * 8) * N + cc; float v[8];
#pragma unroll
        for (int j = 0; j < 8; ++j) v[j] = s[(size_t)j * N];
        u32x4 o; o.x = pk2(v[0], v[1]); o.y = pk2(v[2], v[3]); o.z = pk2(v[4], v[5]); o.w = pk2(v[6], v[7]);
        *(u32x4*)(dst + ((size_t)l * N + cc) * 1024 + kb * 8) = o;
    }
}
__device__ __forceinline__ void p0_prologue(Ctx& c, const Args& A) {
    const size_t gt = (size_t)c.bid * 512 + c.tid, NT = (size_t)c.G * 512;
#pragma unroll 1
    for (int tb = 0; tb < 2; ++tb) {
        const float* src = tb ? A.in[18] : A.in[17]; unsigned char* dst = A.ws + WS_UT + (tb ? 1024 : 0);   float* vs = (float*)(A.ws + (tb ? WS_VSC : WS_USC));
        for (int row = c.bid * 8 + c.wave; row < 2 * NEXP; row += c.G * 8) {
            const float4* sp = (const float4*)(src + (size_t)row * 1024 + 16 * c.lane); float4 f[4]; float am = 0.f;
#pragma unroll
            for (int i = 0; i < 4; ++i) { f[i] = sp[i]; am = fmaxf(fmaxf(am, fmaxf(fabsf(f[i].x), fabsf(f[i].y))), fmaxf(fabsf(f[i].z), fabsf(f[i].w))); }
            am = fmaxf(am, lxf<1>(am)); am = fmaxf(am, lxf<2>(am)); am = fmaxf(am, lxf<4>(am)); am = fmaxf(am, lxf<8>(am)); am = fmaxf(am, lxf<16>(am)); am = fmaxf(am, lxf<32>(am));
            const float sc = am > 0.f ? __uint_as_float(__float_as_uint((tb ? 7.5f : 127.0f) / am) & 0x7f800000u) : 1.0f;
            if (tb) {
                unsigned long long lo = 0ull; unsigned hi = 0u;
#pragma unroll
                for (int i = 0; i < 16; ++i) { const float x = (i & 3) == 0 ? f[i >> 2].x : ((i & 3) == 1 ? f[i >> 2].y : ((i & 3) == 2 ? f[i >> 2].z : f[i >> 2].w)); const unsigned cd = fp6_e2m3(x * sc);
                    if (i < 10) lo |= (unsigned long long)cd << (6 * i); else if (i == 10) { lo |= (unsigned long long)(cd & 15u) << 60; hi |= cd >> 4; } else hi |= cd << (6 * i - 64); }
                U3 w3; w3.x = (unsigned)lo; w3.y = (unsigned)(lo >> 32); w3.z = hi;
                *(U3*)(dst + (size_t)row * EREC + 12 * c.lane) = w3;
            } else {
                u32x4 w; unsigned ww[4];
#pragma unroll
                for (int i = 0; i < 4; ++i) ww[i] = ((unsigned)(int)rintf(f[i].x * sc) & 255u) | (((unsigned)(int)rintf(f[i].y * sc) & 255u) << 8) | (((unsigned)(int)rintf(f[i].z * sc) & 255u) << 16) | (((unsigned)(int)rintf(f[i].w * sc) & 255u) << 24);
                w.x = ww[0]; w.y = ww[1]; w.z = ww[2]; w.w = ww[3];
                *(u32x4*)(dst + (size_t)row * EREC + 16 * c.lane) = w; }
            if (c.lane == 0) vs[row] = 1.0f / sc;
        }
    }
    cvt_flat8(A.in[16], A.ws + WS_KEYS, (size_t)2 * 8 * 2 * 128 * 128 / 8, gt, NT);
    cvt_transpose(A.in[13], (bf16_t*)(A.ws + WS_WOUT), 1024, gt, NT);
    cvt_transpose(A.in[15], (bf16_t*)(A.ws + WS_WQ), 2048, gt, NT);
    {
        const float* w = A.in[3]; const size_t items = (size_t)2 * 128 * NINW;
        for (size_t i = gt; i < items; i += NT) {
            const int cc = (int)(i % NINW), kb = (int)((i / NINW) % 128), l = (int)(i / ((size_t)NINW * 128));
            const float* s = w + ((size_t)l * 1024 + kb * 8) * NINW + cc; float v[8];
#pragma unroll
            for (int j = 0; j < 8; ++j) v[j] = s[(size_t)j * NINW];
            if (cc >= 2048 && cc < 2056) { float* d = (float*)(A.ws + WS_WGATE) + ((size_t)l * 8 + (cc - 2048)) * 1024 + kb * 8;
                *(float4*)d = make_float4(v[0], v[1], v[2], v[3]); *(float4*)(d + 4) = make_float4(v[4], v[5], v[6], v[7]); }
            else { const int c2 = cc < 2048 ? cc : cc - 8; u32x4 o; o.x = pk2(v[0], v[1]); o.y = pk2(v[2], v[3]); o.z = pk2(v[4], v[5]); o.w = pk2(v[6], v[7]);
                *(u32x4*)((bf16_t*)(A.ws + WS_WIN) + ((size_t)l * NPROJ + c2) * 1024 + kb * 8) = o; }
        }
    }
}

__device__ __forceinline__ void phase_norm(Ctx& c, const Args& A, const float* src, const float* gain, bf16_t* dst, const float* wgate, const float* a_log, const float* dt_bias, float* GB) {
    const int gw = c.bid * 8 + c.wave, NGW = c.G * 8, lane = c.lane;
    const bool o1 = lane & 1, o2 = lane & 2, o4 = lane & 4; const int es = ((lane & 1) << 2) | (lane & 2) | ((lane >> 2) & 1);
    float4 g[4];
#pragma unroll
    for (int j = 0; j < 4; ++j) g[j] = ((const float4*)gain)[lane + 64 * j];
    for (int m0 = gw * 2; m0 < T; m0 += NGW * 2) {
        float4 v[2][4];
#pragma unroll
        for (int rr = 0; rr < 2; ++rr)
#pragma unroll
            for (int j = 0; j < 4; ++j) v[rr][j] = ((const float4*)(src + (size_t)(m0 + rr) * D))[lane + 64 * j];
#pragma unroll
        for (int rr = 0; rr < 2; ++rr) {
            const int m = m0 + rr; float ss = 0.f;
#pragma unroll
            for (int j = 0; j < 4; ++j) { ss += (v[rr][j].x * v[rr][j].x + v[rr][j].y * v[rr][j].y) + (v[rr][j].z * v[rr][j].z + v[rr][j].w * v[rr][j].w);
                v[rr][j].x *= g[j].x; v[rr][j].y *= g[j].y; v[rr][j].z *= g[j].z; v[rr][j].w *= g[j].w; }
            float cc = 0.f;
            if (wgate) {
                float d[8];
#pragma unroll
                for (int q = 0; q < 8; ++q) { float a = 0.f;
#pragma unroll
                    for (int j = 0; j < 4; ++j) { const float4 w = ((const float4*)(wgate + q * 1024))[lane + 64 * j]; a += (v[rr][j].x * w.x + v[rr][j].y * w.y) + (v[rr][j].z * w.z + v[rr][j].w * w.w); }
                    d[q] = a; }
                float a0 = o1 ? d[4] : d[0], a1 = o1 ? d[5] : d[1], a2 = o1 ? d[6] : d[2], a3 = o1 ? d[7] : d[3];
                a0 += lxf<1>(o1 ? d[0] : d[4]); a1 += lxf<1>(o1 ? d[1] : d[5]); a2 += lxf<1>(o1 ? d[2] : d[6]); a3 += lxf<1>(o1 ? d[3] : d[7]);
                float b0 = o2 ? a2 : a0, b1 = o2 ? a3 : a1; b0 += lxf<2>(o2 ? a0 : a2); b1 += lxf<2>(o2 ? a1 : a3);
                cc = o4 ? b1 : b0; cc += lxf<4>(o4 ? b0 : b1);
                cc += lxf<8>(cc); cc += lxf<16>(cc); cc += lxf<32>(cc);
            }
            const float rstd = rsqrtf(wave_sum(ss) * (1.0f / D) + 1e-6f);
            u32x2* o8 = (u32x2*)(dst + (size_t)m * D) + lane;
#pragma unroll
            for (int j = 0; j < 4; ++j) { u32x2 w; w.x = pk2(v[rr][j].x * rstd, v[rr][j].y * rstd); w.y = pk2(v[rr][j].z * rstd, v[rr][j].w * rstd); o8[64 * j] = w; }
            if (wgate && lane < 8) { const float r = cc * rstd; float o;
                if (es < 4) o = 1.0f / (1.0f + __expf(-r));
                else { const float z = r + dt_bias[es - 4]; const float sp = z > 20.f ? z : log1pf(__expf(z)); o = -__expf(a_log[es - 4]) * sp; }
                GB[(size_t)m * 8 + es] = o; }
        }
    }
}

__device__ __forceinline__ void unpack8(const u32x4& w, float* f) { f[0] = bf_lo(w.x); f[1] = bf_hi(w.x); f[2] = bf_lo(w.y); f[3] = bf_hi(w.y); f[4] = bf_lo(w.z); f[5] = bf_hi(w.z); f[6] = bf_lo(w.w); f[7] = bf_hi(w.w); }
__device__ __forceinline__ void phase_prep(Ctx& c, const Args& A, int l) {
    const int gw = c.bid * 8 + c.wave, NGW = c.G * 8, lane = c.lane;
    const bf16_t* PROJ = (const bf16_t*)(A.ws + WS_PROJ);
    bf16_t* QKVC = (bf16_t*)(A.ws + WS_QKVC); bf16_t* AQ = (bf16_t*)(A.ws + WS_AQ); bf16_t* AK = (bf16_t*)(A.ws + WS_AK); bf16_t* MIXED = (bf16_t*)(A.ws + WS_MIXED); bf16_t* AVT = (bf16_t*)(A.ws + WS_AVT);
    const float* gconv = A.in[4] + (size_t)l * 4 * 1536; const float* sconv = A.in[8] + (size_t)l * 3 * 256;
    const float* qg = A.in[9] + l * 32; const float* kg = A.in[10] + l * 32;
    const u32x4 zero4 = {0u, 0u, 0u, 0u};
    for (int run = gw; run < T / 8; run += NGW) {
        const int t0 = run * 8, s0 = t0 & (SEQ - 1);
#pragma unroll 1
        for (int it = 0; it < 3; ++it) {
            const int ch = (it * 64 + lane) * 8;
            u32x4 rows[11];
#pragma unroll
            for (int j = 0; j < 11; ++j) rows[j] = (s0 + j - 3 >= 0) ? *(const u32x4*)(PROJ + (size_t)(t0 + j - 3) * NPROJ + ch) : zero4;
            float w[4][8];
#pragma unroll
            for (int j = 0; j < 4; ++j) { const float4 a = *(const float4*)(gconv + j * 1536 + ch), b = *(const float4*)(gconv + j * 1536 + ch + 4);
                w[j][0] = a.x; w[j][1] = a.y; w[j][2] = a.z; w[j][3] = a.w; w[j][4] = b.x; w[j][5] = b.y; w[j][6] = b.z; w[j][7] = b.w; }
#pragma unroll
            for (int i = 0; i < 8; ++i) {
                float acc[8] = {0.f, 0.f, 0.f, 0.f, 0.f, 0.f, 0.f, 0.f};
#pragma unroll
                for (int j = 0; j < 4; ++j) { float x[8]; unpack8(rows[i + j], x);
#pragma unroll
                    for (int e = 0; e < 8; ++e) acc[e] += w[j][e] * x[e]; }
                float ss = 0.f;
#pragma unroll
                for (int e = 0; e < 8; ++e) { acc[e] = silu_f(acc[e]); ss += acc[e] * acc[e]; }
                if (it < 2) {
                    ss += lxf<1>(ss); ss += lxf<2>(ss); ss += lxf<4>(ss); ss += lxf<8>(ss);
                    const float r = rsqrtf(ss + 1e-6f);
#pragma unroll
                    for (int e = 0; e < 8; ++e) acc[e] *= r; }
                u32x4 o4; o4.x = pk2(acc[0], acc[1]); o4.y = pk2(acc[2], acc[3]); o4.z = pk2(acc[4], acc[5]); o4.w = pk2(acc[6], acc[7]);
                *(u32x4*)(QKVC + (size_t)(t0 + i) * 1536 + ch) = o4;
            }
        }
        {
            u32x2 wq[8], wk[8], wv[8];
#pragma unroll
            for (int i = 0; i < 8; ++i) { const bf16_t* r = PROJ + (size_t)(t0 + i) * NPROJ + 4 * lane; wq[i] = *(const u32x2*)(r + C_DQ); wk[i] = *(const u32x2*)(r + C_DK); wv[i] = *(const u32x2*)(r + C_DV); }
            const float4 g4 = *(const float4*)(qg + 4 * (lane & 7)), h4 = *(const float4*)(kg + 4 * (lane & 7));
#pragma unroll
            for (int i = 0; i < 8; ++i) {
                float q[4] = {bf_lo(wq[i].x), bf_hi(wq[i].x), bf_lo(wq[i].y), bf_hi(wq[i].y)}, k[4] = {bf_lo(wk[i].x), bf_hi(wk[i].x), bf_lo(wk[i].y), bf_hi(wk[i].y)};
                float sq = (q[0] * q[0] + q[1] * q[1]) + (q[2] * q[2] + q[3] * q[3]), sk = (k[0] * k[0] + k[1] * k[1]) + (k[2] * k[2] + k[3] * k[3]);
                sq += lxf<1>(sq); sk += lxf<1>(sk); sq += lxf<2>(sq); sk += lxf<2>(sk); sq += lxf<4>(sq); sk += lxf<4>(sk);
                const float rq = rsqrtf(sq * (1.0f / 32.0f) + 1e-6f) * (0.17677669529663687f * 1.4426950408889634f), rk = rsqrtf(sk * (1.0f / 32.0f) + 1e-6f);
                u32x2 oq, ok; oq.x = pk2(q[0] * rq * g4.x, q[1] * rq * g4.y); oq.y = pk2(q[2] * rq * g4.z, q[3] * rq * g4.w);
                ok.x = pk2(k[0] * rk * h4.x, k[1] * rk * h4.y); ok.y = pk2(k[2] * rk * h4.z, k[3] * rk * h4.w);
                *(u32x2*)(AQ + (size_t)(t0 + i) * 256 + 4 * lane) = oq; *(u32x2*)(AK + (size_t)(t0 + i) * 256 + 4 * lane) = ok;
            }
            bf16_t* vt = AVT + ((size_t)((t0 >> 11) * 4 + (lane >> 4)) * 64 + (lane & 15) * 4) * SEQ + kperm(s0);
#pragma unroll
            for (int d = 0; d < 4; ++d) {
                unsigned e[8];
#pragma unroll
                for (int i = 0; i < 8; ++i) { const unsigned w = (d < 2) ? wv[i].x : wv[i].y; e[i] = (d & 1) ? (w >> 16) : (w & 0xffffu); }
                u32x2 lo, hi; lo.x = e[0] | (e[1] << 16); lo.y = e[2] | (e[3] << 16); hi.x = e[4] | (e[5] << 16); hi.y = e[6] | (e[7] << 16);
                *(u32x2*)(vt + (size_t)d * SEQ) = lo; *(u32x2*)(vt + (size_t)d * SEQ + 8) = hi;
            }
        }
        {
            const int ch = 4 * lane; u32x2 wc[10], wh[10], wb[8];
#pragma unroll
            for (int j = 0; j < 10; ++j) { const bool ok = (s0 + j - 2 >= 0); const bf16_t* r = PROJ + (size_t)(t0 + j - 2) * NPROJ + ch;
                wc[j] = ok ? *(const u32x2*)(r + C_SC) : (u32x2){0u, 0u}; wh[j] = ok ? *(const u32x2*)(r + C_SH) : (u32x2){0u, 0u}; }
#pragma unroll
            for (int i = 0; i < 8; ++i) wb[i] = *(const u32x2*)(PROJ + (size_t)(t0 + i) * NPROJ + C_SB + ch);
            float4 cw[3];
#pragma unroll
            for (int j = 0; j < 3; ++j) cw[j] = *(const float4*)(sconv + j * 256 + ch);
            float p[10][4];
#pragma unroll
            for (int j = 0; j < 10; ++j) { p[j][0] = bf_lo(wc[j].x) * bf_lo(wh[j].x); p[j][1] = bf_hi(wc[j].x) * bf_hi(wh[j].x); p[j][2] = bf_lo(wc[j].y) * bf_lo(wh[j].y); p[j][3] = bf_hi(wc[j].y) * bf_hi(wh[j].y); }
#pragma unroll
            for (int i = 0; i < 8; ++i) {
                const float a0 = cw[0].x * p[i][0] + cw[1].x * p[i + 1][0] + cw[2].x * p[i + 2][0], a1 = cw[0].y * p[i][1] + cw[1].y * p[i + 1][1] + cw[2].y * p[i + 2][1];
                const float a2 = cw[0].z * p[i][2] + cw[1].z * p[i + 1][2] + cw[2].z * p[i + 2][2], a3 = cw[0].w * p[i][3] + cw[1].w * p[i + 1][3] + cw[2].w * p[i + 2][3];
                u32x2 o; o.x = pk2(bf_lo(wb[i].x) * a0, bf_hi(wb[i].x) * a1); o.y = pk2(bf_lo(wb[i].y) * a2, bf_hi(wb[i].y) * a3);
                *(u32x2*)(MIXED + (size_t)(t0 + i) * 1024 + 512 + ch) = o;
            }
        }
    }
}

__device__ __forceinline__ void gdn_seq_unit(Ctx& c, const Args& A, int u) {
    const int bh = u >> 1, j0 = (u & 1) * 64, b = bh >> 2, h = bh & 3, tid = c.tid, lane = c.lane;
    const bf16_t* QKVC = (const bf16_t*)(A.ws + WS_QKVC); const float* GB = (const float*)(A.ws + WS_GB); float* OG = (float*)(A.ws + WS_OGDN);
    LAS float* kq = (LAS float*)c.lds;
    LAS float* vv = (LAS float*)(c.lds + 65536);
    LAS float* bg = (LAS float*)(c.lds + 65536 + 16384);
    float S[128];
#pragma unroll
    for (int d = 0; d < 128; ++d) S[d] = 0.f;
    for (int ck = 0; ck < 32; ++ck) {
        const int t0 = b * SEQ + ck * 64;
        __syncthreads();
        for (int e = tid; e < 64 * 128; e += 512) { const int i = e >> 7, p = (e & 127) * 2;
            const int col = p < 128 ? (C_GK + h * 128 + p) : (C_GQ + h * 128 + (p - 128));
            const unsigned w = *(const unsigned*)(QKVC + (size_t)(t0 + i) * 1536 + col); kq[i * 256 + p] = bf_lo(w); kq[i * 256 + p + 1] = bf_hi(w); }
        for (int e = tid; e < 64 * 32; e += 512) { const int i = e >> 5, p = (e & 31) * 2; const unsigned w = *(const unsigned*)(QKVC + (size_t)(t0 + i) * 1536 + C_GV + h * 128 + j0 + p); vv[i * 64 + p] = bf_lo(w); vv[i * 64 + p + 1] = bf_hi(w); }
        if (tid < 64) { bg[tid] = GB[(size_t)(t0 + tid) * 8 + h]; bg[64 + tid] = __expf(GB[(size_t)(t0 + tid) * 8 + 4 + h]); }
        __syncthreads();
        if (c.wave == 0) {
            for (int i = 0; i < 64; ++i) {
                const float beta = bg[i], al = bg[64 + i]; const LAS f32x4* kr = (const LAS f32x4*)(kq + i * 256); const LAS f32x4* qr = kr + 32;
                float ks = 0.f;
#pragma unroll
                for (int dg = 0; dg < 4; ++dg) {
#pragma unroll
                    for (int dd = 0; dd < 8; ++dd) { const int d4 = dg * 8 + dd; const f32x4 k4 = kr[d4]; ks += (k4.x * S[4 * d4] + k4.y * S[4 * d4 + 1]) + (k4.z * S[4 * d4 + 2] + k4.w * S[4 * d4 + 3]); }
                    asm volatile("" ::: "memory"); }
                const float delta = beta * (vv[i * 64 + lane] - al * ks); float o = 0.f;
#pragma unroll
                for (int dg = 0; dg < 8; ++dg) {
#pragma unroll
                    for (int dd = 0; dd < 4; ++dd) { const int d4 = dg * 4 + dd; const f32x4 k4 = kr[d4], q4 = qr[d4];
                        S[4 * d4] = al * S[4 * d4] + k4.x * delta; S[4 * d4 + 1] = al * S[4 * d4 + 1] + k4.y * delta; S[4 * d4 + 2] = al * S[4 * d4 + 2] + k4.z * delta; S[4 * d4 + 3] = al * S[4 * d4 + 3] + k4.w * delta;
                        o += (q4.x * S[4 * d4] + q4.y * S[4 * d4 + 1]) + (q4.z * S[4 * d4 + 2] + q4.w * S[4 * d4 + 3]); }
                    asm volatile("" ::: "memory"); }
                OG[(size_t)(t0 + i) * 512 + h * 128 + j0 + lane] = o * 0.08838834764831845f;
            }
        }
    }
    __syncthreads();
}
constexpr int GCH_BYTES = 73728, GCH_WM = 0, GCH_QM = 16384, GCH_KT = 32768, GCH_AM = 49152, GCH_UT = 57344;
__device__ __forceinline__ bf16x8 pack_frag(const f32x4& a, const f32x4& b) { u32x4 w; w.x = pg8::cvt_pk_bf16(a[0], a[1]); w.y = pg8::cvt_pk_bf16(a[2], a[3]); w.z = pg8::cvt_pk_bf16(b[0], b[1]); w.w = pg8::cvt_pk_bf16(b[2], b[3]); return __builtin_bit_cast(bf16x8, w); }
__device__ __forceinline__ void gdn_chunk_unit(Ctx& c, const Args& A, int unit) {
    const int tid = c.tid, lane = c.lane, wave = c.wave, fr = lane & 15, fq = lane >> 4;
    const int bh = unit >> 5, ck = unit & 31, b = bh >> 2, h = bh & 3, t0 = b * SEQ + ck * 64;
    const bf16_t* QKVC = (const bf16_t*)(A.ws + WS_QKVC); const float* GB = (const float*)(A.ws + WS_GB); float* GL = (float*)(A.ws + WS_GB + 512 * 1024);
    unsigned char* rec = A.ws + WS_GCH + (size_t)unit * GCH_BYTES;
    LAS float* gcs = (LAS float*)c.lds;
    LAS float* bet = gcs + 64;
    LAS float* Lm = (LAS float*)(c.lds + 512);
    LAS bf16_t* Tb = (LAS bf16_t*)(c.lds + 512 + 16384);
    LAS bf16_t* vt = Tb + 64 * 72;
    LAS bf16_t* kt = vt + 128 * 72;
    LAS bf16_t* k2 = kt + 128 * 72;
    __syncthreads();
    if (tid < 64) { float g = GB[(size_t)(t0 + tid) * 8 + 4 + h];
#pragma unroll
        for (int o = 1; o < 64; o <<= 1) { const float n = __shfl_up(g, o); if (lane >= o) g += n; }
        gcs[tid] = g; bet[tid] = GB[(size_t)(t0 + tid) * 8 + h]; }
    __syncthreads();
#pragma unroll 1
    for (int bb = 0; bb < 2; ++bb) {
        const int blk = wave * 2 + bb, ib = blk >> 2, jb = blk & 3;
        f32x4 kk = (f32x4){0.f, 0.f, 0.f, 0.f}, qk = (f32x4){0.f, 0.f, 0.f, 0.f};
        if (jb <= ib) {
            const bf16_t* ki = QKVC + (size_t)(t0 + ib * 16 + fr) * 1536 + C_GK + h * 128 + 8 * fq; const bf16_t* qi = QKVC + (size_t)(t0 + ib * 16 + fr) * 1536 + C_GQ + h * 128 + 8 * fq;
            const bf16_t* kj = QKVC + (size_t)(t0 + jb * 16 + fr) * 1536 + C_GK + h * 128 + 8 * fq;
#pragma unroll
            for (int ks = 0; ks < 4; ++ks) { const bf16x8 a = *(const bf16x8*)(ki + ks * 32), q = *(const bf16x8*)(qi + ks * 32), bj = *(const bf16x8*)(kj + ks * 32);
                kk = __builtin_amdgcn_mfma_f32_16x16x32_bf16(a, bj, kk, 0, 0, 0); qk = __builtin_amdgcn_mfma_f32_16x16x32_bf16(q, bj, qk, 0, 0, 0); }
        }
        const int j = jb * 16 + fr; const float gj = gcs[j]; bf16_t* AM = (bf16_t*)(rec + GCH_AM);
#pragma unroll
        for (int r = 0; r < 4; ++r) { const int i = ib * 16 + 4 * fq + r; const float dec = i >= j ? __expf(gcs[i] - gj) : 0.f;
            Lm[i * 64 + j] = i > j ? bet[i] * kk[r] * dec : 0.f;
            AM[i * 64 + kperm(j)] = (bf16_t)f2bf(qk[r] * dec * 0.08838834764831845f); }
    }
    __syncthreads();
    if (wave == 0) {
        float Tc[64];
#pragma unroll
        for (int i = 0; i < 64; ++i) { float acc = (lane == i) ? 1.f : 0.f;
#pragma unroll
            for (int j4 = 0; j4 < (i + 3) / 4; ++j4) { const f32x4 l4 = *(const LAS f32x4*)(Lm + i * 64 + 4 * j4);
#pragma unroll
                for (int x = 0; x < 4; ++x) if (4 * j4 + x < i) acc -= l4[x] * Tc[4 * j4 + x]; }
            Tc[i] = acc; Tb[i * 72 + lane] = (bf16_t)f2bf(acc); }
    } else {
        const float glast = gcs[63];
        for (int e = tid - 64; e < 64 * 16; e += 448) { const int j = e >> 4, d8 = (e & 15) * 8; const float bj = bet[j], gj = gcs[j]; const float s1 = bj * __expf(gj), s2 = __expf(glast - gj);
            const u32x4 kw = *(const u32x4*)(QKVC + (size_t)(t0 + j) * 1536 + C_GK + h * 128 + d8), vw = *(const u32x4*)(QKVC + (size_t)(t0 + j) * 1536 + C_GV + h * 128 + d8);
            const float kf[8] = {bf_lo(kw.x), bf_hi(kw.x), bf_lo(kw.y), bf_hi(kw.y), bf_lo(kw.z), bf_hi(kw.z), bf_lo(kw.w), bf_hi(kw.w)};
            const float vf[8] = {bf_lo(vw.x), bf_hi(vw.x), bf_lo(vw.y), bf_hi(vw.y), bf_lo(vw.z), bf_hi(vw.z), bf_lo(vw.w), bf_hi(vw.w)};
            const int jp = kperm(j);
#pragma unroll
            for (int x = 0; x < 8; ++x) { vt[(d8 + x) * 72 + j] = (bf16_t)f2bf(vf[x] * bj); kt[(d8 + x) * 72 + j] = (bf16_t)f2bf(kf[x] * s1); k2[(d8 + x) * 72 + jp] = (bf16_t)f2bf(kf[x] * s2); }
        }
        bf16_t* QM = (bf16_t*)(rec + GCH_QM);
        for (int e = tid - 64; e < 64 * 16; e += 448) { const int j = e >> 4, m8 = e & 15, m = m8 & 3; const float s = __expf(gcs[j]) * 0.08838834764831845f;
            const u32x4 qw = *(const u32x4*)(QKVC + (size_t)(t0 + j) * 1536 + C_GQ + h * 128 + m8 * 8);
            const int pos = (m8 >> 2) * 32 + 16 * (m & 1) + 4 * (m >> 1);
            u32x2 w0, w1; w0.x = pk2(bf_lo(qw.x) * s, bf_hi(qw.x) * s); w0.y = pk2(bf_lo(qw.y) * s, bf_hi(qw.y) * s); w1.x = pk2(bf_lo(qw.z) * s, bf_hi(qw.z) * s); w1.y = pk2(bf_lo(qw.w) * s, bf_hi(qw.w) * s);
            *(u32x2*)(QM + j * 128 + pos) = w0; *(u32x2*)(QM + j * 128 + pos + 8) = w1; }
        if (tid == 64) GL[unit] = glast;
    }
    __syncthreads();
    {
        f32x4 ua[4], wa[4];
#pragma unroll
        for (int mb = 0; mb < 4; ++mb) { ua[mb] = (f32x4){0.f, 0.f, 0.f, 0.f}; wa[mb] = (f32x4){0.f, 0.f, 0.f, 0.f}; }
#pragma unroll
        for (int ks = 0; ks < 2; ++ks) {
            const bf16x8 vf = *(const LAS bf16x8*)(vt + (16 * wave + fr) * 72 + ks * 32 + 8 * fq), kf = *(const LAS bf16x8*)(kt + (16 * wave + fr) * 72 + ks * 32 + 8 * fq);
#pragma unroll
            for (int mb = 0; mb < 4; ++mb) { const bf16x8 tf = *(const LAS bf16x8*)(Tb + (16 * mb + fr) * 72 + ks * 32 + 8 * fq);
                ua[mb] = __builtin_amdgcn_mfma_f32_16x16x32_bf16(tf, vf, ua[mb], 0, 0, 0);
                wa[mb] = __builtin_amdgcn_mfma_f32_16x16x32_bf16(kf, tf, wa[mb], 0, 0, 0); }
        }
        bf16_t* UT = (bf16_t*)(rec + GCH_UT); bf16_t* WM = (bf16_t*)(rec + GCH_WM);
#pragma unroll
        for (int mb = 0; mb < 4; ++mb) { u32x2 w; w.x = pk2(ua[mb][0], ua[mb][1]); w.y = pk2(ua[mb][2], ua[mb][3]); *(u32x2*)(UT + (16 * wave + fr) * 64 + 16 * mb + 4 * fq) = w;
            u32x2 v; v.x = pk2(wa[mb][0], wa[mb][1]); v.y = pk2(wa[mb][2], wa[mb][3]); *(u32x2*)(WM + (16 * mb + fr) * 128 + kperm(16 * wave + 4 * fq)) = v; }
        bf16_t* KT = (bf16_t*)(rec + GCH_KT);
#pragma unroll
        for (int k = 0; k < 2; ++k) { const int e = tid + 512 * k, row = e >> 3, cc = e & 7; *(u32x4*)(KT + row * 64 + cc * 8) = *(const LAS u32x4*)(k2 + row * 72 + cc * 8); }
    }
}
struct GaUnit { int t0, h; unsigned char* rec; };
__device__ __forceinline__ GaUnit ga_unit(const Args& A, int unit) { GaUnit u; const int bh = unit >> 5, ck = unit & 31; u.h = bh & 3; u.t0 = (bh >> 2) * SEQ + ck * 64; u.rec = A.ws + WS_GCH + (size_t)unit * GCH_BYTES; return u; }
__device__ __forceinline__ void ga_stage(const GaUnit& u, const bf16_t* QKVC, const LAS float* gcs, const LAS float* bet, LAS bf16_t* vt, LAS bf16_t* kt, LAS bf16_t* k2, int rel, int nth) {
    const float glast = gcs[63];
#pragma unroll 3
    for (int e = rel; e < 64 * 16; e += nth) { const int j = e >> 4, d8 = (e & 15) * 8; const float bj = bet[j], gj = gcs[j]; const float s1 = bj * __expf(gj), s2 = __expf(glast - gj);
        const u32x4 kw = *(const u32x4*)(QKVC + (size_t)(u.t0 + j) * 1536 + C_GK + u.h * 128 + d8), vw = *(const u32x4*)(QKVC + (size_t)(u.t0 + j) * 1536 + C_GV + u.h * 128 + d8);
        const float kf[8] = {bf_lo(kw.x), bf_hi(kw.x), bf_lo(kw.y), bf_hi(kw.y), bf_lo(kw.z), bf_hi(kw.z), bf_lo(kw.w), bf_hi(kw.w)};
        const float vf[8] = {bf_lo(vw.x), bf_hi(vw.x), bf_lo(vw.y), bf_hi(vw.y), bf_lo(vw.z), bf_hi(vw.z), bf_lo(vw.w), bf_hi(vw.w)};
        const int jp = kperm(j);
#pragma unroll
        for (int x = 0; x < 8; ++x) { vt[(d8 + x) * 72 + j] = (bf16_t)f2bf(vf[x] * bj); kt[(d8 + x) * 72 + j] = (bf16_t)f2bf(kf[x] * s1); k2[(d8 + x) * 72 + jp] = (bf16_t)f2bf(kf[x] * s2); }
    }
}
__device__ __forceinline__ void ga_qm(const GaUnit& u, const bf16_t* QKVC, const LAS float* gcs, int rel, int nth) {
    bf16_t* QM = (bf16_t*)(u.rec + GCH_QM);
#pragma unroll 3
    for (int e = rel; e < 64 * 16; e += nth) { const int j = e >> 4, m8 = e & 15, m = m8 & 3; const float s = __expf(gcs[j]) * 0.08838834764831845f;
        const u32x4 qw = *(const u32x4*)(QKVC + (size_t)(u.t0 + j) * 1536 + C_GQ + u.h * 128 + m8 * 8);
        const int pos = (m8 >> 2) * 32 + 16 * (m & 1) + 4 * (m >> 1);
        u32x2 w0, w1; w0.x = pk2(bf_lo(qw.x) * s, bf_hi(qw.x) * s); w0.y = pk2(bf_lo(qw.y) * s, bf_hi(qw.y) * s); w1.x = pk2(bf_lo(qw.z) * s, bf_hi(qw.z) * s); w1.y = pk2(bf_lo(qw.w) * s, bf_hi(qw.w) * s);
        *(u32x2*)(QM + j * 128 + pos) = w0; *(u32x2*)(QM + j * 128 + pos + 8) = w1; }
}
__device__ __forceinline__ void ga_uw(const GaUnit& u, const LAS bf16_t* Tb, const LAS bf16_t* vt, const LAS bf16_t* kt, const LAS bf16_t* k2, int tid, int wave, int fr, int fq) {
    f32x4 ua[4], wa[4];
#pragma unroll
    for (int mb = 0; mb < 4; ++mb) { ua[mb] = (f32x4){0.f, 0.f, 0.f, 0.f}; wa[mb] = (f32x4){0.f, 0.f, 0.f, 0.f}; }
#pragma unroll
    for (int ks = 0; ks < 2; ++ks) {
        const bf16x8 vf = *(const LAS bf16x8*)(vt + (16 * wave + fr) * 72 + ks * 32 + 8 * fq), kf = *(const LAS bf16x8*)(kt + (16 * wave + fr) * 72 + ks * 32 + 8 * fq);
#pragma unroll
        for (int mb = 0; mb < 4; ++mb) { const bf16x8 tf = *(const LAS bf16x8*)(Tb + (16 * mb + fr) * 72 + ks * 32 + 8 * fq);
            ua[mb] = __builtin_amdgcn_mfma_f32_16x16x32_bf16(tf, vf, ua[mb], 0, 0, 0);
            wa[mb] = __builtin_amdgcn_mfma_f32_16x16x32_bf16(kf, tf, wa[mb], 0, 0, 0); }
    }
    bf16_t* UT = (bf16_t*)(u.rec + GCH_UT); bf16_t* WM = (bf16_t*)(u.rec + GCH_WM);
#pragma unroll
    for (int mb = 0; mb < 4; ++mb) { u32x2 w; w.x = pk2(ua[mb][0], ua[mb][1]); w.y = pk2(ua[mb][2], ua[mb][3]); *(u32x2*)(UT + (16 * wave + fr) * 64 + 16 * mb + 4 * fq) = w;
        u32x2 v; v.x = pk2(wa[mb][0], wa[mb][1]); v.y = pk2(wa[mb][2], wa[mb][3]); *(u32x2*)(WM + (16 * mb + fr) * 128 + kperm(16 * wave + 4 * fq)) = v; }
    bf16_t* KT = (bf16_t*)(u.rec + GCH_KT);
#pragma unroll
    for (int k = 0; k < 2; ++k) { const int e = tid + 512 * k, row = e >> 3, cc = e & 7; *(u32x4*)(KT + row * 64 + cc * 8) = *(const LAS u32x4*)(k2 + row * 72 + cc * 8); }
}
__device__ __forceinline__ void gdn_chunk_pair(Ctx& c, const Args& A, int unit0, int unit1) {
    const int tid = c.tid, lane = c.lane, wave = c.wave, fr = lane & 15, fq = lane >> 4;
    const bf16_t* QKVC = (const bf16_t*)(A.ws + WS_QKVC); const float* GB = (const float*)(A.ws + WS_GB); float* GL = (float*)(A.ws + WS_GB + 512 * 1024);
    LAS float* gcs = (LAS float*)c.lds;
    LAS float* bet = gcs + 128;
    LAS float* Lm = (LAS float*)(c.lds + 1024);
    LAS bf16_t* Tb = (LAS bf16_t*)(c.lds + 33792);
    LAS bf16_t* vt = (LAS bf16_t*)(c.lds + 52224);
    LAS bf16_t* kt = vt + 128 * 72; LAS bf16_t* k2 = kt + 128 * 72;
    const GaUnit U0 = ga_unit(A, unit0), U1 = ga_unit(A, unit1);
    __syncthreads();
    if (tid < 128) { const GaUnit& u = wave ? U1 : U0; float g = GB[(size_t)(u.t0 + lane) * 8 + 4 + u.h];
#pragma unroll
        for (int o = 1; o < 64; o <<= 1) { const float n = __shfl_up(g, o); if (lane >= o) g += n; }
        gcs[wave * 64 + lane] = g; bet[wave * 64 + lane] = GB[(size_t)(u.t0 + lane) * 8 + u.h]; }
    __syncthreads();
#pragma unroll 2
    for (int bb = 0; bb < 4; ++bb) {
        const int idx = wave * 4 + bb, p = idx >> 4, blk = idx & 15, ib = blk >> 2, jb = blk & 3; const GaUnit& u = p ? U1 : U0;
        f32x4 kk = (f32x4){0.f, 0.f, 0.f, 0.f}, qk = (f32x4){0.f, 0.f, 0.f, 0.f};
        if (jb <= ib) {
            const bf16_t* ki = QKVC + (size_t)(u.t0 + ib * 16 + fr) * 1536 + C_GK + u.h * 128 + 8 * fq; const bf16_t* qi = QKVC + (size_t)(u.t0 + ib * 16 + fr) * 1536 + C_GQ + u.h * 128 + 8 * fq;
            const bf16_t* kj = QKVC + (size_t)(u.t0 + jb * 16 + fr) * 1536 + C_GK + u.h * 128 + 8 * fq;
#pragma unroll
            for (int ks = 0; ks < 4; ++ks) { const bf16x8 a = *(const bf16x8*)(ki + ks * 32), q = *(const bf16x8*)(qi + ks * 32), bj = *(const bf16x8*)(kj + ks * 32);
                kk = __builtin_amdgcn_mfma_f32_16x16x32_bf16(a, bj, kk, 0, 0, 0); qk = __builtin_amdgcn_mfma_f32_16x16x32_bf16(q, bj, qk, 0, 0, 0); }
        }
        const int j = jb * 16 + fr; const float gj = gcs[p * 64 + j]; bf16_t* AM = (bf16_t*)(u.rec + GCH_AM);
#pragma unroll
        for (int r = 0; r < 4; ++r) { const int i = ib * 16 + 4 * fq + r; const float dec = i >= j ? __expf(gcs[p * 64 + i] - gj) : 0.f;
            Lm[p * 4096 + i * 64 + j] = i > j ? bet[p * 64 + i] * kk[r] * dec : 0.f;
            AM[i * 64 + kperm(j)] = (bf16_t)f2bf(qk[r] * dec * 0.08838834764831845f); }
    }
    __syncthreads();
    if (wave < 2) {
        const LAS float* L = Lm + wave * 4096; LAS bf16_t* Tw = Tb + wave * 64 * 72;
        float Tc[64];
#pragma unroll
        for (int i = 0; i < 64; ++i) { float ac[4] = {(lane == i) ? 1.f : 0.f, 0.f, 0.f, 0.f};
#pragma unroll
            for (int j4 = 0; j4 < (i + 3) / 4; ++j4) { const f32x4 l4 = *(const LAS f32x4*)(L + i * 64 + 4 * j4);
#pragma unroll
                for (int x = 0; x < 4; ++x) if (4 * j4 + x < i) ac[x] -= l4[x] * Tc[4 * j4 + x]; }
            const float acc = (ac[0] + ac[1]) + (ac[2] + ac[3]);
            Tc[i] = acc; Tw[i * 72 + lane] = (bf16_t)f2bf(acc); }
    } else {
        ga_stage(U0, QKVC, gcs, bet, vt, kt, k2, tid - 128, 384);
        ga_qm(U0, QKVC, gcs, tid - 128, 384); ga_qm(U1, QKVC, gcs + 64, tid - 128, 384);
        if (tid == 128) { GL[unit0] = gcs[63]; GL[unit1] = gcs[127]; }
    }
    __syncthreads();
    ga_uw(U0, Tb, vt, kt, k2, tid, wave, fr, fq);
    __syncthreads();
    ga_stage(U1, QKVC, gcs + 64, bet + 64, vt, kt, k2, tid, 512);
    __syncthreads();
    ga_uw(U1, Tb + 64 * 72, vt, kt, k2, tid, wave, fr, fq);
}
__device__ __forceinline__ void gdn_scan(Ctx& c, const Args& A, int unit) {
    const int bh = unit >> 1, dv0 = (unit & 1) * 64 + 16 * (c.wave & 3); const bool active = c.wave < 4;
    const int tid = c.tid, lane = c.lane, fr = lane & 15, fq = lane >> 4, b = bh >> 2, h = bh & 3;
    constexpr int L_WM = 0, L_QM = 17408, L_KT = 34816, L_AM = 53248, L_BUF = 62464;
    const unsigned char* rec0 = A.ws + WS_GCH + (size_t)bh * 32 * GCH_BYTES; const float* GL = (const float*)(A.ws + WS_GB + 512 * 1024) + bh * 32; float* OG = (float*)(A.ws + WS_OGDN);
    f32x4 S[8];
#pragma unroll
    for (int i = 0; i < 8; ++i) S[i] = (f32x4){0.f, 0.f, 0.f, 0.f};
    u32x4 pre[14]; const int t2 = tid - 256;
#define GDN_LOAD(rec) do { _Pragma("unroll") for (int k = 0; k < 14; ++k) pre[k] = *(const u32x4*)((rec) + (size_t)(t2 + 256 * k) * 16); } while (0)
#define GDN_STORE(base) do { \
        _Pragma("unroll") for (int k = 0; k < 4; ++k) { const int q = t2 + 256 * k; *(LAS u32x4*)((base) + L_WM + (q >> 4) * 272 + (q & 15) * 16) = pre[k]; *(LAS u32x4*)((base) + L_QM + (q >> 4) * 272 + (q & 15) * 16) = pre[4 + k]; \
            *(LAS u32x4*)((base) + L_KT + (q >> 3) * 144 + (q & 7) * 16) = pre[8 + k]; } \
        _Pragma("unroll") for (int k = 0; k < 2; ++k) { const int q = t2 + 256 * k; *(LAS u32x4*)((base) + L_AM + (q >> 3) * 144 + (q & 7) * 16) = pre[12 + k]; } } while (0)
    __syncthreads();
    if (!active) { GDN_LOAD(rec0); GDN_STORE(c.lds); }
    u32x2 uwc[4], uwn[4]; float glc = GL[0], gln = 0.f;
#pragma unroll
    for (int mb = 0; mb < 4; ++mb) { uwc[mb] = *(const u32x2*)((const bf16_t*)(rec0 + GCH_UT) + (dv0 + fr) * 64 + 16 * mb + 4 * fq); uwn[mb] = uwc[mb]; }
    __syncthreads();
#pragma unroll 1
    for (int ck = 0; ck < 32; ++ck) {
        const unsigned char* rec = rec0 + (size_t)ck * GCH_BYTES; LAS unsigned char* B0 = c.lds + (ck & 1) * L_BUF; const int t0 = b * SEQ + ck * 64;
        if (ck + 1 < 32) { if (!active) GDN_LOAD(rec + GCH_BYTES); const bf16_t* UTn = (const bf16_t*)(rec + GCH_BYTES + GCH_UT);
#pragma unroll
            for (int mb = 0; mb < 4; ++mb) uwn[mb] = *(const u32x2*)(UTn + (dv0 + fr) * 64 + 16 * mb + 4 * fq); gln = GL[ck + 1]; }
        if (active) {
        bf16x8 sB[4];
#pragma unroll
        for (int ks = 0; ks < 4; ++ks) sB[ks] = pack_frag(S[2 * ks], S[2 * ks + 1]);
        f32x4 vn[4], oa[4];
#pragma unroll
        for (int mb = 0; mb < 4; ++mb) { f32x4 p = (f32x4){0.f, 0.f, 0.f, 0.f}, o = (f32x4){0.f, 0.f, 0.f, 0.f};
#pragma unroll
            for (int ks = 0; ks < 4; ++ks) { const bf16x8 aw = *(const LAS bf16x8*)(B0 + L_WM + (16 * mb + fr) * 272 + ks * 64 + fq * 16), aq = *(const LAS bf16x8*)(B0 + L_QM + (16 * mb + fr) * 272 + ks * 64 + fq * 16);
                p = __builtin_amdgcn_mfma_f32_16x16x32_bf16(aw, sB[ks], p, 0, 0, 0); o = __builtin_amdgcn_mfma_f32_16x16x32_bf16(aq, sB[ks], o, 0, 0, 0); }
            const u32x2 uw = uwc[mb];
            vn[mb] = (f32x4){bf_lo(uw.x) - p[0], bf_hi(uw.x) - p[1], bf_lo(uw.y) - p[2], bf_hi(uw.y) - p[3]}; oa[mb] = o; }
        bf16x8 vB[2];
#pragma unroll
        for (int s = 0; s < 2; ++s) vB[s] = pack_frag(vn[2 * s], vn[2 * s + 1]);
#pragma unroll
        for (int mb = 0; mb < 4; ++mb) {
#pragma unroll
            for (int s = 0; s < 2; ++s) { const bf16x8 aa = *(const LAS bf16x8*)(B0 + L_AM + (16 * mb + fr) * 144 + s * 64 + fq * 16); oa[mb] = __builtin_amdgcn_mfma_f32_16x16x32_bf16(aa, vB[s], oa[mb], 0, 0, 0); }
#pragma unroll
            for (int r = 0; r < 4; ++r) OG[(size_t)(t0 + 16 * mb + 4 * fq + r) * 512 + h * 128 + dv0 + fr] = oa[mb][r]; }
        const float gl = __expf(glc);
#pragma unroll
        for (int m8 = 0; m8 < 8; ++m8) { f32x4 s = S[m8] * gl;
#pragma unroll
            for (int s2 = 0; s2 < 2; ++s2) { const bf16x8 ak = *(const LAS bf16x8*)(B0 + L_KT + (16 * m8 + fr) * 144 + s2 * 64 + fq * 16); s = __builtin_amdgcn_mfma_f32_16x16x32_bf16(ak, vB[s2], s, 0, 0, 0); }
            S[m8] = s; }
        }
        if (ck + 1 < 32 && !active) GDN_STORE(c.lds + ((ck + 1) & 1) * L_BUF);
#pragma unroll
        for (int mb = 0; mb < 4; ++mb) uwc[mb] = uwn[mb];
        glc = gln;
        __syncthreads();
    }
#undef GDN_LOAD
#undef GDN_STORE
}
__device__ __forceinline__ int rel_bucket(int n) {
    if (n < 16) return n;
    const int v = 16 + (int)(__logf((float)n * (1.0f / 16.0f)) / 2.0794415416798357f * 16.0f);
    return v < 31 ? v : 31;
}
__device__ __forceinline__ void attn_mfma(Ctx& c, const Args& A, int l, int first_block, int nblocks) {
    const int tid = c.tid, lane = c.lane, wave = c.wave, fr = lane & 15, fq = lane >> 4;
    const bf16_t* AQ = (const bf16_t*)(A.ws + WS_AQ); const bf16_t* AK = (const bf16_t*)(A.ws + WS_AK); const bf16_t* AVT = (const bf16_t*)(A.ws + WS_AVT); bf16_t* MIXED = (bf16_t*)(A.ws + WS_MIXED);
    LAS float* bt = (LAS float*)c.lds;
    LAS float* cs = bt + 512;
    const float* rel_bias = A.in[1]; const float* lamp = A.in[11] + l * 128; const float* subln = A.in[12] + l * 64;
    const float lambda_init = 0.8f - 0.6f * __expf(-0.3f * (float)l);
    __syncthreads();
    {
        float mq = 0.f, mk = 0.f, mb = 0.f;
        for (int d = 0; d < 32; ++d) { mq = fmaxf(mq, fabsf(A.in[9][l * 32 + d])); mk = fmaxf(mk, fabsf(A.in[10][l * 32 + d])); }
        for (int i = 0; i < 128; ++i) mb = fmaxf(mb, fabsf(rel_bias[i]));
        const float cshift = 5.656854249492381f * mq * mk + mb;
        const int n = tid & 127, hh = tid >> 7; bt[hh * 128 + n] = (rel_bias[rel_bucket(n) * 4 + hh] - cshift) * 1.4426950408889634f;
        if (tid == 0) { float s01 = 0.f, s23 = 0.f; for (int d = 0; d < 32; ++d) { s01 += lamp[d] * lamp[32 + d]; s23 += lamp[64 + d] * lamp[96 + d]; } cs[0] = __expf(s01) - __expf(s23) + lambda_init; }
    }
    __syncthreads();
    const float lam = cs[0];
    bf16x8 ones; { const short o = (fr == 0) ? (short)0x3f80 : (short)0; ones = (bf16x8){o, o, o, o, o, o, o, o}; }
    constexpr int AT_K = 4096, AT_V = 4096 + 4608, AT_BUF = 9728;
    const int wg = c.bid - first_block;
#pragma unroll 1
    for (int rd = 0; rd * nblocks < 256; ++rd) {
        const int it = rd * nblocks + ((rd & 1) ? nblocks - 1 - wg : wg); if (it >= 256) continue;
        const int bh = it & 31, QB = 7 - (it >> 5), b = bh >> 2, h = bh & 3, q0 = QB * 256 + 32 * wave, nsteps = 8 * QB + 8;
        const float bfar = bt[h * 128 + 127];
        bf16x8 qf[2][2];
#pragma unroll
        for (int m = 0; m < 2; ++m)
#pragma unroll
            for (int nq = 0; nq < 2; ++nq) qf[m][nq] = *(const bf16x8*)(AQ + (size_t)(b * SEQ + q0 + nq * 16 + fr) * 256 + h * 64 + m * 32 + 8 * fq);
        f32x4 oacc[2][2][4], lacc[2][2];
#pragma unroll
        for (int m = 0; m < 2; ++m)
#pragma unroll
            for (int nq = 0; nq < 2; ++nq) { lacc[m][nq] = (f32x4){0.f, 0.f, 0.f, 0.f};
#pragma unroll
                for (int nb = 0; nb < 4; ++nb) oacc[m][nq][nb] = (f32x4){0.f, 0.f, 0.f, 0.f}; }
        const int t2 = tid & 255; const bool isK = tid < 256;
        const bf16_t* gsrc = isK ? AK + (size_t)(b * SEQ + (t2 >> 3)) * 256 + h * 64 + (t2 & 7) * 8 : AVT + ((size_t)bh * 64 + (t2 >> 2)) * SEQ + (t2 & 3) * 8;
        const size_t gstep = isK ? (size_t)32 * 256 : (size_t)32;
        const int ldst = isK ? AT_K + (t2 >> 3) * 144 + (t2 & 7) * 16 : AT_V + (t2 >> 2) * 80 + (t2 & 3) * 16;
        __syncthreads();
        u32x4 pre = *(const u32x4*)gsrc; *(LAS u32x4*)(c.lds + ldst) = pre;
        __syncthreads();
#pragma unroll 1
        for (int st = 0; st < nsteps; ++st) {
            const int k0 = st * 32; const LAS unsigned char* B0 = c.lds + (st & 1) * AT_BUF;
            if (st + 1 < nsteps) pre = *(const u32x4*)(gsrc + (size_t)(st + 1) * gstep);
            if (k0 <= q0) {
            bf16x8 kf[2][2], vf[4];
#pragma unroll
            for (int m = 0; m < 2; ++m)
#pragma unroll
                for (int kb = 0; kb < 2; ++kb) kf[m][kb] = *(const LAS bf16x8*)(B0 + AT_K + (kb * 16 + fr) * 144 + m * 64 + fq * 16);
#pragma unroll
            for (int nb = 0; nb < 4; ++nb) vf[nb] = *(const LAS bf16x8*)(B0 + AT_V + (16 * nb + fr) * 80 + fq * 16);
            const bool nearby = (k0 + 144 > q0);
            f32x4 cin[2][2];
            if (nearby) {
#pragma unroll
                for (int nq = 0; nq < 2; ++nq)
#pragma unroll
                    for (int kb = 0; kb < 2; ++kb)
#pragma unroll
                        for (int r = 0; r < 4; ++r) { const int n = (q0 + nq * 16 + fr) - (k0 + kb * 16 + 4 * fq + r); cin[nq][kb][r] = n >= 0 ? bt[h * 128 + (n > 127 ? 127 : n)] : -1.0e30f; }
            } else {
#pragma unroll
                for (int nq = 0; nq < 2; ++nq)
#pragma unroll
                    for (int kb = 0; kb < 2; ++kb) cin[nq][kb] = (f32x4){bfar, bfar, bfar, bfar};
            }
#pragma unroll
            for (int m = 0; m < 2; ++m)
#pragma unroll
                for (int nq = 0; nq < 2; ++nq) {
                    f32x4 p[2];
#pragma unroll
                    for (int kb = 0; kb < 2; ++kb) {
                        f32x4 s = __builtin_amdgcn_mfma_f32_16x16x32_bf16(kf[m][kb], qf[m][nq], cin[nq][kb], 0, 0, 0);
#pragma unroll
                        for (int r = 0; r < 4; ++r) s[r] = __builtin_amdgcn_exp2f(s[r]);
                        p[kb] = s;
                    }
                    const bf16x8 pf = pack_frag(p[0], p[1]);
#pragma unroll
                    for (int nb = 0; nb < 4; ++nb) oacc[m][nq][nb] = __builtin_amdgcn_mfma_f32_16x16x32_bf16(vf[nb], pf, oacc[m][nq][nb], 0, 0, 0);
                    lacc[m][nq] = __builtin_amdgcn_mfma_f32_16x16x32_bf16(ones, pf, lacc[m][nq], 0, 0, 0);
                }
            }
            if (st + 1 < nsteps) *(LAS u32x4*)(c.lds + ((st + 1) & 1) * AT_BUF + ldst) = pre;
            __syncthreads();
        }
#pragma unroll
        for (int nq = 0; nq < 2; ++nq) {
            const float l0 = __shfl(lacc[0][nq][0], fr), l1 = __shfl(lacc[1][nq][0], fr);
            const float i0 = 1.0f / l0, i1 = lam / l1; float ss = 0.f; f32x4 o[4];
#pragma unroll
            for (int nb = 0; nb < 4; ++nb) { o[nb] = oacc[0][nq][nb] * i0 - oacc[1][nq][nb] * i1; ss += (o[nb][0] * o[nb][0] + o[nb][1] * o[nb][1]) + (o[nb][2] * o[nb][2] + o[nb][3] * o[nb][3]); }
            ss += lxf<16>(ss); ss += lxf<32>(ss);
            const float rn = rsqrtf(ss * (1.0f / 64.0f) + 1e-6f) * (1.0f - lambda_init);
            bf16_t* orow = MIXED + (size_t)(b * SEQ + q0 + nq * 16 + fr) * 1024 + 768 + h * 64;
#pragma unroll
            for (int nb = 0; nb < 4; ++nb) { const float4 sg = *(const float4*)(subln + 16 * nb + 4 * fq);
                u32x2 w; w.x = pk2(o[nb][0] * rn * sg.x, o[nb][1] * rn * sg.y); w.y = pk2(o[nb][2] * rn * sg.z, o[nb][3] * rn * sg.w);
                *(u32x2*)(orow + 16 * nb + 4 * fq) = w; }
        }
    }
    __syncthreads();
}
__device__ __forceinline__ void phase_gdn_out(Ctx& c, const Args& A, int l) {
    const int gw = c.bid * 8 + c.wave, NGW = c.G * 8, lane = c.lane;
    const bf16_t* PROJ = (const bf16_t*)(A.ws + WS_PROJ); const float* OG = (const float*)(A.ws + WS_OGDN); bf16_t* MIXED = (bf16_t*)(A.ws + WS_MIXED);
    const float4 g0 = *(const float4*)(A.in[7] + l * 128 + (lane & 15) * 8), g1 = *(const float4*)(A.in[7] + l * 128 + (lane & 15) * 8 + 4);
    for (int run = gw; run < T / 8; run += NGW) {
        const int t0 = run * 8; float4 oa[8], ob[8]; u32x4 zz[8];
#pragma unroll
        for (int i = 0; i < 8; ++i) { const float* op = OG + (size_t)(t0 + i) * 512 + lane * 8; oa[i] = *(const float4*)op; ob[i] = *(const float4*)(op + 4); zz[i] = *(const u32x4*)(PROJ + (size_t)(t0 + i) * NPROJ + C_GZ + lane * 8); }
#pragma unroll
        for (int i = 0; i < 8; ++i) {
            float ss = (oa[i].x * oa[i].x + oa[i].y * oa[i].y) + (oa[i].z * oa[i].z + oa[i].w * oa[i].w) + (ob[i].x * ob[i].x + ob[i].y * ob[i].y) + (ob[i].z * ob[i].z + ob[i].w * ob[i].w);
            ss += lxf<1>(ss); ss += lxf<2>(ss); ss += lxf<4>(ss); ss += lxf<8>(ss);
            const float r = rsqrtf(ss * (1.0f / 128.0f) + 1e-6f);
            u32x4 w; w.x = pk2(oa[i].x * r * g0.x * silu_f(bf_lo(zz[i].x)), oa[i].y * r * g0.y * silu_f(bf_hi(zz[i].x))); w.y = pk2(oa[i].z * r * g0.z * silu_f(bf_lo(zz[i].y)), oa[i].w * r * g0.w * silu_f(bf_hi(zz[i].y)));
            w.z = pk2(ob[i].x * r * g1.x * silu_f(bf_lo(zz[i].z)), ob[i].y * r * g1.y * silu_f(bf_hi(zz[i].z))); w.w = pk2(ob[i].z * r * g1.z * silu_f(bf_lo(zz[i].w)), ob[i].w * r * g1.w * silu_f(bf_hi(zz[i].w)));
            *(u32x4*)(MIXED + (size_t)(t0 + i) * 1024 + lane * 8) = w;
        }
    }
}

__device__ __forceinline__ unsigned ord_key(float f) { const unsigned u = __float_as_uint(f); return (u & 0x80000000u) ? ~u : (u | 0x80000000u); }
__device__ __forceinline__ float ord_val(unsigned o) { return __uint_as_float((o & 0x80000000u) ? (o & 0x7fffffffu) : ~o); }
__device__ __forceinline__ float gelu_erf(float v) {
    const float av = fabsf(v), t = __builtin_amdgcn_rcpf(av * 0.2316418882f + 1.0f);
    float q = t * 0.5307027145f + (-0.7265760135f); q = q * t + 0.7107068705f; q = q * t + (-0.142248368f); q = q * t + 0.127414796f; q = q * t;
    const float e = __builtin_amdgcn_exp2f((v * v) * (-0.72134752044f)); const float m = v * (q * e);
    return v < 0.f ? m : v - m;
}
typedef __bf16 v2bf_t __attribute__((ext_vector_type(2)));
__device__ __forceinline__ float dot2bf(unsigned a, unsigned b, float acc) { return __builtin_amdgcn_fdot2_f32_bf16(__builtin_bit_cast(v2bf_t, a), __builtin_bit_cast(v2bf_t, b), acc, false); }
__device__ __forceinline__ float dot8(const u32x4& x, const u32x4& u, float acc) { acc = dot2bf(x.x, u.x, acc); acc = dot2bf(x.y, u.y, acc); acc = dot2bf(x.z, u.z, acc); return dot2bf(x.w, u.w, acc); }
__device__ __forceinline__ void axpy8(float* o, float cf, const u32x4& v) {
    o[0] += cf * bf_lo(v.x); o[1] += cf * bf_hi(v.x); o[2] += cf * bf_lo(v.y); o[3] += cf * bf_hi(v.y); o[4] += cf * bf_lo(v.z); o[5] += cf * bf_hi(v.z); o[6] += cf * bf_lo(v.w); o[7] += cf * bf_hi(v.w); }
typedef float f32x2_t __attribute__((ext_vector_type(2)));
__device__ __forceinline__ void axpy16_fp8(float* o, float cf, const u32x4& v) {
    const unsigned w[4] = {v.x, v.y, v.z, v.w};
#pragma unroll
    for (int i = 0; i < 4; ++i) { const f32x2_t a = __builtin_amdgcn_cvt_pk_f32_fp8((int)w[i], false), b = __builtin_amdgcn_cvt_pk_f32_fp8((int)w[i], true);
        o[4 * i] += cf * a.x; o[4 * i + 1] += cf * a.y; o[4 * i + 2] += cf * b.x; o[4 * i + 3] += cf * b.y; }
}
typedef _Float16 v2h_t __attribute__((ext_vector_type(2)));
__device__ __forceinline__ unsigned pkh(float a, float b) { const v2h_t h = {(_Float16)a, (_Float16)b}; return __builtin_bit_cast(unsigned, h); }
typedef _Float16 v2h_t __attribute__((ext_vector_type(2)));
__device__ __forceinline__ float dot4_fp8(unsigned uw, unsigned xlo, unsigned xhi, float acc) {
    acc = __builtin_amdgcn_fdot2(__builtin_amdgcn_cvt_scalef32_pk_f16_fp8(uw, 1.0f, false), __builtin_bit_cast(v2h_t, xlo), acc, false);
    return __builtin_amdgcn_fdot2(__builtin_amdgcn_cvt_scalef32_pk_f16_fp8(uw, 1.0f, true), __builtin_bit_cast(v2h_t, xhi), acc, false);
}
__device__ __forceinline__ float dot16_fp8(const u32x4& x0, const u32x4& x1, const u32x4& u) {
    float acc = dot4_fp8(u.x, x0.x, x0.y, 0.f); acc = dot4_fp8(u.y, x0.z, x0.w, acc); acc = dot4_fp8(u.z, x1.x, x1.y, acc); return dot4_fp8(u.w, x1.z, x1.w, acc);
}
__device__ __forceinline__ void cvt16_fp8(float* f, const u32x4& v) {
    const unsigned w[4] = {v.x, v.y, v.z, v.w};
#pragma unroll
    for (int i = 0; i < 4; ++i) { const f32x2_t a = __builtin_amdgcn_cvt_pk_f32_fp8((int)w[i], false), b = __builtin_amdgcn_cvt_pk_f32_fp8((int)w[i], true); f[4 * i] = a.x; f[4 * i + 1] = a.y; f[4 * i + 2] = b.x; f[4 * i + 3] = b.y; }
}
__device__ __forceinline__ void phase_peer(Ctx& c, const Args& A, int l, float* hdst, bool fuse_next, const XcdBarrier& bar, bool align) {
    const int tid = c.tid, lane = c.lane, wave = c.wave, fr = lane & 15, fq = lane >> 4;
    const bf16_t* QP = (const bf16_t*)(A.ws + WS_QP); const bf16_t* KEYS = (const bf16_t*)(A.ws + WS_KEYS) + (size_t)l * 16 * 128 * 128;
    const bf16_t* XF = (const bf16_t*)(A.ws + WS_NBUF); const float* RSl = (const float*)(A.ws + WS_RS); const unsigned char* U8 = A.ws + WS_UT + (size_t)l * NEXP * EREC; const unsigned char* V8 = U8 + 1024; const float* VS = (const float*)(A.ws + WS_VSC) + (size_t)l * NEXP; const float* US = (const float*)(A.ws + WS_USC) + (size_t)l * NEXP;
    LAS int* lidx = (LAS int*)c.lds;
    LAS float* lgate = (LAS float*)(c.lds + 32768);
    LAS unsigned* tkb = (LAS unsigned*)(c.lds + 65536);
    for (int blk = c.bid; blk < T / 64; blk += c.G) {
        const int tb0 = blk * 64;
        __syncthreads();
#pragma unroll 1
        for (int rrep_ = 0; rrep_ < 1 + ((DUP >> 11) & 1); ++rrep_) {
#define PEER_RLOAD(Q, Kf, st) do { const int hh_ = (st) >> 2, ks_ = (st) & 3, hp_ = (hh_ >> 1) * 8 + wave, sp_ = (hh_ & 1) * 2; \
        const bf16_t* qp_ = QP; const bf16_t* kp_ = KEYS; asm volatile("" : "+s"(qp_), "+s"(kp_) : "v"(acc[1][7]));     \
        _Pragma("unroll") for (int sb = 0; sb < 2; ++sb) Q[sb] = *(const bf16x8*)(qp_ + (size_t)(tb0 + (sp_ + sb) * 16 + fr) * 2048 + hp_ * 128 + ks_ * 32 + 8 * fq); \
        _Pragma("unroll") for (int nb = 0; nb < 8; ++nb) Kf[nb] = *(const bf16x8*)(kp_ + ((size_t)hp_ * 128 + nb * 16 + fr) * 128 + ks_ * 32 + 8 * fq); } while (0)
#define PEER_RMMA(Q, Kf) do { _Pragma("unroll") for (int nb = 0; nb < 8; ++nb) _Pragma("unroll") for (int sb = 0; sb < 2; ++sb) acc[sb][nb] = __builtin_amdgcn_mfma_f32_16x16x32_bf16(Kf[nb], Q[sb], acc[sb][nb], 0, 0, 0); } while (0)
            bf16x8 qA[2], kA[8], qB[2], kB[8]; f32x4 acc[2][8]; acc[1][7] = (f32x4){0.f, 0.f, 0.f, 0.f};
            PEER_RLOAD(qA, kA, 0);
#pragma unroll 1
            for (int hh = 0; hh < 4; ++hh) {
                const int hp = (hh >> 1) * 8 + wave, sp = (hh & 1) * 2;
#pragma unroll
                for (int sb = 0; sb < 2; ++sb)
#pragma unroll
                    for (int nb = 0; nb < 8; ++nb) acc[sb][nb] = (f32x4){0.f, 0.f, 0.f, 0.f};
                PEER_RLOAD(qB, kB, 4 * hh + 1); PEER_RMMA(qA, kA);
                PEER_RLOAD(qA, kA, 4 * hh + 2); PEER_RMMA(qB, kB);
                PEER_RLOAD(qB, kB, 4 * hh + 3); PEER_RMMA(qA, kA);
                { const int hn_ = hh < 3 ? hh + 1 : hh; PEER_RLOAD(qA, kA, 4 * hn_); }
                PEER_RMMA(qB, kB);
#define PEER_MERGE(N) do { unsigned p[16]; \
        _Pragma("unroll") for (int i = 0; i < 16; ++i) p[i] = lxu<N>(v[i]); \
        _Pragma("unroll") for (int i = 0; i < 16; ++i) v[i] = v[i] > p[15 - i] ? v[i] : p[15 - i]; \
        _Pragma("unroll") for (int j = 8; j > 0; j >>= 1) _Pragma("unroll") for (int i = 0; i < 16; ++i) { const int q = i ^ j; if (q > i) { const unsigned x = v[i], y = v[q]; v[i] = x > y ? x : y; v[q] = x > y ? y : x; } } } while (0)
#pragma unroll 1
                for (int sb = 0; sb < 2; ++sb) {
                    LAS unsigned* tk = tkb + (sp + sb) * 4096;
                    unsigned v[32];
#pragma unroll
                    for (int nb = 0; nb < 8; ++nb) { const f32x4 a_ = sb == 0 ? acc[0][nb] : acc[1][nb];
#pragma unroll
                        for (int r = 0; r < 4; ++r) v[nb * 4 + r] = (ord_key(a_[r]) & ~127u) | (unsigned)(127 - (nb * 16 + 4 * fq + r)); }
#pragma unroll
                    for (int k = 2; k <= 32; k <<= 1)
#pragma unroll
                        for (int j = k >> 1; j > 0; j >>= 1)
#pragma unroll
                            for (int i = 0; i < 32; ++i) { const int q = i ^ j; if (q > i) { const bool desc = ((i & k) == 0); const unsigned x = v[i], y = v[q]; const unsigned hi = x > y ? x : y, lo = x > y ? y : x; v[i] = desc ? hi : lo; v[q] = desc ? lo : hi; } }
                    PEER_MERGE(16); PEER_MERGE(32);
                    { u32x4 w; w.x = fq == 0 ? v[0] : (fq == 1 ? v[4] : (fq == 2 ? v[8] : v[12])); w.y = fq == 0 ? v[1] : (fq == 1 ? v[5] : (fq == 2 ? v[9] : v[13]));
                      w.z = fq == 0 ? v[2] : (fq == 1 ? v[6] : (fq == 2 ? v[10] : v[14])); w.w = fq == 0 ? v[3] : (fq == 1 ? v[7] : (fq == 2 ? v[11] : v[15]));
                      *(LAS u32x4*)(tk + (fr * 16 + hp) * 16 + 4 * fq) = w; }
                }
#undef PEER_MERGE
            }
#undef PEER_RLOAD
#undef PEER_RMMA
            __syncthreads();
#pragma unroll 1
            for (int sub = 0; sub < 4; ++sub)
            {
                const LAS unsigned* tk = tkb + sub * 4096;
                const int pp = tid >> 2, qd = tid & 3, tok = pp >> 3, h = pp & 7;
                const LAS unsigned* a = tk + (tok * 16 + 2 * h) * 16; const LAS unsigned* b = a + 16;
                unsigned v[16], s5[5];
                {
                    const float sj0 = ord_val(b[qd] & ~127u), sj1 = ord_val(b[qd + 4] & ~127u), sj2 = ord_val(b[qd + 8] & ~127u), sj3 = ord_val(b[qd + 12] & ~127u);
#pragma unroll
                    for (int i = 0; i < 16; ++i) { const float si = ord_val(a[i] & ~127u);
                        v[i] = ((i + 1) * (qd + 1) <= 16) ? ((ord_key(si + sj0) & ~255u) | (unsigned)(255 - (i * 16 + qd))) : 0u;
                        if (i < 3) s5[i] = ((i + 1) * (qd + 5) <= 16) ? ((ord_key(si + sj1) & ~255u) | (unsigned)(255 - (i * 16 + qd + 4))) : 0u;
                        if (i == 0) { s5[3] = ((qd + 9) <= 16) ? ((ord_key(si + sj2) & ~255u) | (unsigned)(255 - (qd + 8))) : 0u; s5[4] = ((qd + 13) <= 16) ? ((ord_key(si + sj3) & ~255u) | (unsigned)(255 - (qd + 12))) : 0u; } }
                }
#define PEER_CE(x, y) do { const unsigned hi_ = x > y ? x : y, lo_ = x > y ? y : x; x = hi_; y = lo_; } while (0)
                PEER_CE(s5[0], s5[1]); PEER_CE(s5[3], s5[4]); PEER_CE(s5[2], s5[4]); PEER_CE(s5[2], s5[3]); PEER_CE(s5[0], s5[3]); PEER_CE(s5[0], s5[2]); PEER_CE(s5[1], s5[4]); PEER_CE(s5[1], s5[3]); PEER_CE(s5[1], s5[2]);
#pragma unroll
                for (int t = 0; t < 5; ++t) v[15 - t] = v[15 - t] > s5[t] ? v[15 - t] : s5[t];
#pragma unroll
                for (int j = 8; j > 0; j >>= 1)
#pragma unroll
                    for (int i = 0; i < 16; ++i) { const int q = i ^ j; if (q > i) PEER_CE(v[i], v[q]); }
#define PEER_MERGE(N) do { unsigned p[16]; \
        _Pragma("unroll") for (int i = 0; i < 16; ++i) p[i] = lxu<N>(v[i]); \
        _Pragma("unroll") for (int i = 0; i < 16; ++i) v[i] = v[i] > p[15 - i] ? v[i] : p[15 - i]; \
        _Pragma("unroll") for (int j = 8; j > 0; j >>= 1) _Pragma("unroll") for (int i = 0; i < 16; ++i) { const int q = i ^ j; if (q > i) PEER_CE(v[i], v[q]); } } while (0)
                PEER_MERGE(1); PEER_MERGE(2);
#undef PEER_MERGE
#undef PEER_CE
                const float mx = ord_val(v[0] & ~255u); const int tl = sub * 16 + tok;
                unsigned m4[4]; float e4[4]; int x4[4];
#pragma unroll
                for (int t = 0; t < 4; ++t) { m4[t] = qd == 0 ? v[t] : (qd == 1 ? v[4 + t] : (qd == 2 ? v[8 + t] : v[12 + t]));
                    const int pos = 255 - (int)(m4[t] & 255u), pi = pos >> 4, pj = pos & 15;
                    e4[t] = __expf(ord_val(m4[t] & ~255u) - mx);
                    x4[t] = (127 - (int)(a[pi] & 127u)) * 128 + (127 - (int)(b[pj] & 127u)); }
                float sum = (e4[0] + e4[1]) + (e4[2] + e4[3]); sum += lxf<1>(sum); sum += lxf<2>(sum);
                const float inv = 1.0f / sum;
                { u32x4 xi; xi.x = (unsigned)x4[0]; xi.y = (unsigned)x4[1]; xi.z = (unsigned)x4[2]; xi.w = (unsigned)x4[3]; *(LAS u32x4*)(lidx + tl * 128 + h * 16 + 4 * qd) = xi;
                  f32x4 gi; gi.x = e4[0] * inv; gi.y = e4[1] * inv; gi.z = e4[2] * inv; gi.w = e4[3] * inv; *(LAS f32x4*)(lgate + tl * 128 + h * 16 + 4 * qd) = gi; }
            }
        }
        __syncthreads();
        constexpr int NS = 6, NB = 86;
        LAS unsigned* slw = (LAS unsigned*)(c.lds + 65536) + wave * 1056; LAS float* sgw = (LAS float*)(c.lds + 65536 + 33792) + wave * 1056;
        const int es = ((lane & 1) << 2) | (lane & 2) | ((lane >> 2) & 1);
#pragma unroll 1
        for (int pass = 0; pass < 2; ++pass) {
            const int tl0 = pass * 32 + wave * 4; LAS unsigned* sl = slw + pass * 528; LAS float* sg = sgw + pass * 528;
            int il[4], ih[4]; float gl[4], gh[4];
#pragma unroll
            for (int k = 0; k < 4; ++k) { const int a0 = lidx[(tl0 + k) * 128 + lane], a1 = lidx[(tl0 + k) * 128 + 64 + lane];
                gl[k] = lgate[(tl0 + k) * 128 + lane] * VS[a0]; gh[k] = lgate[(tl0 + k) * 128 + 64 + lane] * VS[a1];
                il[k] = a0 | (k << 14) | (int)(((__float_as_uint(US[a0]) >> 23) & 255u) << 16); ih[k] = a1 | (k << 14) | (int)(((__float_as_uint(US[a1]) >> 23) & 255u) << 16); }
            LAS int* ct = (LAS int*)(c.lds + 133632) + wave * 256;
#pragma unroll
            for (int i = 0; i < 4; ++i) ct[lane + 64 * i] = 0;
            int rk[8];
#pragma unroll
            for (int g = 0; g < 8; ++g) { const int w = (g & 1) ? ih[g >> 1] : il[g >> 1]; const int r = (w >> 9) & 31; unsigned long long eq = ~0ull;
#pragma unroll
                for (int bt_ = 0; bt_ < 5; ++bt_) { const bool bit = (r >> bt_) & 1; const unsigned long long m = __ballot(bit); eq &= bit ? m : ~m; }
                rk[g] = (int)__builtin_amdgcn_mbcnt_hi((unsigned)(eq >> 32), __builtin_amdgcn_mbcnt_lo((unsigned)eq, 0u));
                ct[r * 8 + g] = __builtin_popcountll(eq); }
            { const int c0 = ct[4 * lane], c1 = ct[4 * lane + 1], c2 = ct[4 * lane + 2], c3 = ct[4 * lane + 3]; int sum = (c0 + c1) + (c2 + c3);
#pragma unroll
              for (int o = 1; o < 64; o <<= 1) { const int n = __shfl_up(sum, o); if (lane >= o) sum += n; }
              const int ex = sum - ((c0 + c1) + (c2 + c3));
              ct[4 * lane] = ex; ct[4 * lane + 1] = ex + c0; ct[4 * lane + 2] = ex + c0 + c1; ct[4 * lane + 3] = ex + c0 + c1 + c2; }
#pragma unroll
            for (int g = 0; g < 8; ++g) { const int w = (g & 1) ? ih[g >> 1] : il[g >> 1]; const int pos = ct[((w >> 9) & 31) * 8 + g] + rk[g]; sl[pos] = (unsigned)w; sg[pos] = (g & 1) ? gh[g >> 1] : gl[g >> 1]; }
            if (lane < NS * NB - 512) { sl[512 + lane] = sl[511] & 0x00ff3fffu; sg[512 + lane] = 0.f; }
        }
        __syncthreads();
        LAS unsigned char* xw = c.lds + wave * 8192;
#pragma unroll 1
        for (int pass = 0; pass < 2; ++pass) {
            if (align && pass == 1) xcd_barrier(bar);
            const int tl0 = pass * 32 + wave * 4; const LAS unsigned* sl = slw + pass * 528; LAS float* sg = sgw + pass * 528;
            float out[4][16]; float xinv1;
            {
                float f[4][16]; float am = 0.f;
#pragma unroll
                for (int k = 0; k < 4; ++k) { const size_t t = (size_t)(tb0 + tl0 + k);
                    float rs; { const float4 a = *(const float4*)(RSl + t * 16), b = *(const float4*)(RSl + t * 16 + 4), c2 = *(const float4*)(RSl + t * 16 + 8), d = *(const float4*)(RSl + t * 16 + 12);
                        rs = rsqrtf(((((a.x + a.y) + (a.z + a.w)) + ((b.x + b.y) + (b.z + b.w))) + (((c2.x + c2.y) + (c2.z + c2.w)) + ((d.x + d.y) + (d.z + d.w)))) * (1.0f / 1024.0f) + 1e-6f); }
                    const u32x4 w0 = *(const u32x4*)(XF + t * 1024 + 16 * lane), w1 = *(const u32x4*)(XF + t * 1024 + 16 * lane + 8);
                    f[k][0] = bf_lo(w0.x); f[k][1] = bf_hi(w0.x); f[k][2] = bf_lo(w0.y); f[k][3] = bf_hi(w0.y); f[k][4] = bf_lo(w0.z); f[k][5] = bf_hi(w0.z); f[k][6] = bf_lo(w0.w); f[k][7] = bf_hi(w0.w);
                    f[k][8] = bf_lo(w1.x); f[k][9] = bf_hi(w1.x); f[k][10] = bf_lo(w1.y); f[k][11] = bf_hi(w1.y); f[k][12] = bf_lo(w1.z); f[k][13] = bf_hi(w1.z); f[k][14] = bf_lo(w1.w); f[k][15] = bf_hi(w1.w);
#pragma unroll
                    for (int i = 0; i < 16; ++i) { f[k][i] *= rs; am = fmaxf(am, fabsf(f[k][i])); } }
                am = fmaxf(am, lxf<1>(am)); am = fmaxf(am, lxf<2>(am)); am = fmaxf(am, lxf<4>(am)); am = fmaxf(am, lxf<8>(am)); am = fmaxf(am, lxf<16>(am)); am = fmaxf(am, lxf<32>(am));
                const float sx = am > 0.f ? __uint_as_float(__float_as_uint(127.0f / am) & 0x7f800000u) : 1.0f;
                xinv1 = __int_as_float(__builtin_amdgcn_readfirstlane(__float_as_int(1.0f / sx)));
#pragma unroll
                for (int k = 0; k < 4; ++k) { u32x4 xq; unsigned qq[4];
#pragma unroll
                    for (int i = 0; i < 4; ++i) qq[i] = ((unsigned)(int)rintf(f[k][4 * i] * sx) & 255u) | (((unsigned)(int)rintf(f[k][4 * i + 1] * sx) & 255u) << 8) | (((unsigned)(int)rintf(f[k][4 * i + 2] * sx) & 255u) << 16) | (((unsigned)(int)rintf(f[k][4 * i + 3] * sx) & 255u) << 24);
                    xq.x = qq[0]; xq.y = qq[1]; xq.z = qq[2]; xq.w = qq[3];
                    *(LAS u32x4*)(xw + k * 1024 + lane * 16) = xq; }
            }
            constexpr int NW = 8, NBW = 64;
            {
                u32x4 uA[NW], uB[NW], uC[NW], uD[NW]; unsigned mA[NW], mB[NW], mC[NW], mD[NW];
#define PEER_UISSUE(uu, mm, b) do { _Pragma("unroll") for (int s = 0; s < NW; ++s) { mm[s] = __builtin_amdgcn_readfirstlane(sl[NW * (b) + s]); uu[s] = ((const u32x4*)(U8 + (size_t)(mm[s] & 16383u) * EREC))[lane]; } } while (0)
#define PEER_UCOMPUTE(uu, mm, b) do { int d_[8]; \
        _Pragma("unroll") for (int s = 0; s < NW; ++s) { const unsigned kx_ = (mm[s] >> 14) & 3u; const u32x4 xq_ = *(const LAS u32x4*)(xw + kx_ * 1024 + lane * 16); \
            int ia_ = __builtin_amdgcn_sdot4((int)uu[s].x, (int)xq_.x, 0, false); ia_ = __builtin_amdgcn_sdot4((int)uu[s].y, (int)xq_.y, ia_, false); ia_ = __builtin_amdgcn_sdot4((int)uu[s].z, (int)xq_.z, ia_, false); ia_ = __builtin_amdgcn_sdot4((int)uu[s].w, (int)xq_.w, ia_, false); \
            d_[s] = ia_; } \
        const bool o1_ = lane & 1, o2_ = lane & 2, o4_ = lane & 4; \
        int a0_ = o1_ ? d_[4] : d_[0], a1_ = o1_ ? d_[5] : d_[1], a2_ = o1_ ? d_[6] : d_[2], a3_ = o1_ ? d_[7] : d_[3]; \
        a0_ += lxi<1>(o1_ ? d_[0] : d_[4]); a1_ += lxi<1>(o1_ ? d_[1] : d_[5]); a2_ += lxi<1>(o1_ ? d_[2] : d_[6]); a3_ += lxi<1>(o1_ ? d_[3] : d_[7]); \
        int b0_ = o2_ ? a2_ : a0_, b1_ = o2_ ? a3_ : a1_; b0_ += lxi<2>(o2_ ? a0_ : a2_); b1_ += lxi<2>(o2_ ? a1_ : a3_); \
        int ci_ = o4_ ? b1_ : b0_; ci_ += lxi<4>(o4_ ? b0_ : b1_); \
        ci_ += lxi<8>(ci_); ci_ += lxi<16>(ci_); ci_ += lxi<32>(ci_); \
        const int esl_ = NW * (b) + es;     \
        const float cc_ = (float)ci_ * (__uint_as_float(((sl[esl_] >> 16) & 255u) << 23) * xinv1); \
        const float cfv_ = sg[esl_] * gelu_erf(cc_); \
        if (lane < 8) sg[esl_] = cfv_; } while (0)
                PEER_UISSUE(uA, mA, 0); PEER_UISSUE(uB, mB, 1); PEER_UISSUE(uC, mC, 2);
#pragma unroll 1
                for (int bb = 0; bb < NBW; bb += 4) {
                    PEER_UISSUE(uD, mD, bb + 3);
                    PEER_UCOMPUTE(uA, mA, bb);
                    if (bb + 4 < NBW) PEER_UISSUE(uA, mA, bb + 4);
                    PEER_UCOMPUTE(uB, mB, bb + 1);
                    if (bb + 4 < NBW) PEER_UISSUE(uB, mB, bb + 5);
                    PEER_UCOMPUTE(uC, mC, bb + 2);
                    if (bb + 4 < NBW) PEER_UISSUE(uC, mC, bb + 6);
                    PEER_UCOMPUTE(uD, mD, bb + 3);
                }
#undef PEER_UISSUE
#undef PEER_UCOMPUTE
            }
            asm volatile("s_waitcnt lgkmcnt(0)" ::: "memory");
            if (align && ALIGN_V) xcd_barrier(bar);
#pragma unroll
            for (int k = 0; k < 4; ++k)
#pragma unroll
                for (int i = 0; i < 16; ++i) out[k][i] = 0.f;
            {
                U3 vA[NW], vB[NW]; unsigned mA[NW], mB[NW]; float cA[NW], cB[NW];
#define PEER_VISSUE(vv, mm, cc, b) do { _Pragma("unroll") for (int s = 0; s < NW; ++s) { mm[s] = __builtin_amdgcn_readfirstlane(sl[NW * (b) + s]); cc[s] = __int_as_float(__builtin_amdgcn_readfirstlane(__float_as_int(sg[NW * (b) + s]))); \
            vv[s] = ((const U3*)(V8 + (size_t)(mm[s] & 16383u) * EREC))[lane]; } } while (0)
#define PEER_VCOMPUTE(vv, mm, cc) do { \
        _Pragma("unroll") for (int sp_ = 0; sp_ < NW; sp_ += 2) { \
            const u32x6 w6_ = {vv[sp_].x, vv[sp_].y, vv[sp_].z, vv[sp_ + 1].x, vv[sp_ + 1].y, vv[sp_ + 1].z}; const f32x32 vf_ = __builtin_amdgcn_cvt_scalef32_pk32_f32_fp6(w6_, 1.0f); \
            _Pragma("unroll") for (int h_ = 0; h_ < 2; ++h_) { const int s = sp_ + h_; const unsigned kk_ = (mm[s] >> 14) & 3u; \
                _Pragma("unroll") for (int k = 0; k < 4; ++k) { if (kk_ == (unsigned)k) { _Pragma("unroll") for (int i = 0; i < 16; ++i) out[k][i] += cc[s] * vf_[16 * h_ + i]; asm volatile("" ::: "memory"); } } } } } while (0)
                PEER_VISSUE(vA, mA, cA, 0);
#pragma unroll 1
                for (int bb = 0; bb < NBW; bb += 2) {
                    PEER_VISSUE(vB, mB, cB, bb + 1);
                    PEER_VCOMPUTE(vA, mA, cA);
                    if (bb + 2 < NBW) PEER_VISSUE(vA, mA, cA, bb + 2);
                    PEER_VCOMPUTE(vB, mB, cB);
                }
#undef PEER_VISSUE
#undef PEER_VCOMPUTE
            }
#pragma unroll
            for (int k = 0; k < 4; ++k) { const size_t t = (size_t)(tb0 + tl0 + k); const float* hp = A.out + t * 1024 + 16 * lane; float* hq = hdst + t * 1024 + 16 * lane;
#pragma unroll
                for (int i = 0; i < 4; ++i) { float4 h4 = *(const float4*)(hp + 4 * i); h4.x += out[k][4 * i]; h4.y += out[k][4 * i + 1]; h4.z += out[k][4 * i + 2]; h4.w += out[k][4 * i + 3]; *(float4*)(hq + 4 * i) = h4; }
            }
#pragma unroll 1
            for (int k2 = 0; k2 < (fuse_next ? 2 : 0); ++k2) {
                int lo16 = 16 * lane; asm volatile("" : "+v"(lo16));
                const float* nx_gain = A.in[2] + (l + 1) * 1024 + lo16; const float* nx_wgate = (const float*)(A.ws + WS_WGATE) + (l + 1) * 8 * 1024 + lo16; const float* nx_alog = A.in[5] + (l + 1) * 4; const float* nx_dtb = A.in[6] + (l + 1) * 4;
                float hv[2][16], ss[2], d[2][8];
#pragma unroll
                for (int k = 0; k < 2; ++k) { const float* hq = hdst + (size_t)(tb0 + tl0 + 2 * k2 + k) * 1024 + lo16;
#pragma unroll
                    for (int i = 0; i < 4; ++i) { const float4 h4 = *(const float4*)(hq + 4 * i); hv[k][4 * i] = h4.x; hv[k][4 * i + 1] = h4.y; hv[k][4 * i + 2] = h4.z; hv[k][4 * i + 3] = h4.w; }
                    float s2 = 0.f;
#pragma unroll
                    for (int i = 0; i < 16; ++i) s2 += hv[k][i] * hv[k][i];
                    ss[k] = s2; }
#pragma unroll
                for (int i = 0; i < 4; ++i) { const float4 g4 = *(const float4*)(nx_gain + 4 * i);
#pragma unroll
                    for (int k = 0; k < 2; ++k) { hv[k][4 * i] *= g4.x; hv[k][4 * i + 1] *= g4.y; hv[k][4 * i + 2] *= g4.z; hv[k][4 * i + 3] *= g4.w; } }
#pragma unroll
                for (int qh = 0; qh < 2; ++qh) {
                    const float* wg_ = nx_wgate; if (qh) asm volatile("" : "+v"(wg_) : "v"(d[1][3]));
#pragma unroll
                    for (int q = 4 * qh; q < 4 * qh + 4; ++q) { float4 w[4];
#pragma unroll
                        for (int i = 0; i < 4; ++i) w[i] = *(const float4*)(wg_ + q * 1024 + 4 * i);
#pragma unroll
                        for (int k = 0; k < 2; ++k) { float a = 0.f;
#pragma unroll
                            for (int i = 0; i < 4; ++i) a += (hv[k][4 * i] * w[i].x + hv[k][4 * i + 1] * w[i].y) + (hv[k][4 * i + 2] * w[i].z + hv[k][4 * i + 3] * w[i].w);
                            d[k][q] = a; } } }
                const bool o1 = lane & 1, o2 = lane & 2, o4 = lane & 4;
#pragma unroll
                for (int k = 0; k < 2; ++k) { const size_t t = (size_t)(tb0 + tl0 + 2 * k2 + k);
                    float a0 = o1 ? d[k][4] : d[k][0], a1 = o1 ? d[k][5] : d[k][1], a2 = o1 ? d[k][6] : d[k][2], a3 = o1 ? d[k][7] : d[k][3];
                    a0 += lxf<1>(o1 ? d[k][0] : d[k][4]); a1 += lxf<1>(o1 ? d[k][1] : d[k][5]); a2 += lxf<1>(o1 ? d[k][2] : d[k][6]); a3 += lxf<1>(o1 ? d[k][3] : d[k][7]);
                    float b0 = o2 ? a2 : a0, b1 = o2 ? a3 : a1; b0 += lxf<2>(o2 ? a0 : a2); b1 += lxf<2>(o2 ? a1 : a3);
                    float cc = o4 ? b1 : b0; cc += lxf<4>(o4 ? b0 : b1);
                    cc += lxf<8>(cc); cc += lxf<16>(cc); cc += lxf<32>(cc);
                    const float rstd = rsqrtf(wave_sum(ss[k]) * (1.0f / D) + 1e-6f);
                    u32x4 w0, w1; w0.x = pk2(hv[k][0] * rstd, hv[k][1] * rstd); w0.y = pk2(hv[k][2] * rstd, hv[k][3] * rstd); w0.z = pk2(hv[k][4] * rstd, hv[k][5] * rstd); w0.w = pk2(hv[k][6] * rstd, hv[k][7] * rstd);
                    w1.x = pk2(hv[k][8] * rstd, hv[k][9] * rstd); w1.y = pk2(hv[k][10] * rstd, hv[k][11] * rstd); w1.z = pk2(hv[k][12] * rstd, hv[k][13] * rstd); w1.w = pk2(hv[k][14] * rstd, hv[k][15] * rstd);
                    bf16_t* xo = (bf16_t*)(A.ws + WS_NBUF) + t * 1024 + lo16; *(u32x4*)xo = w0; *(u32x4*)(xo + 8) = w1;
                    if (lane < 8) { const float r = cc * rstd; float o;
                        if (es < 4) o = 1.0f / (1.0f + __expf(-r));
                        else { const float z = r + nx_dtb[es - 4]; const float sp = z > 20.f ? z : log1pf(__expf(z)); o = -__expf(nx_alog[es - 4]) * sp; }
                        ((float*)(A.ws + WS_GB))[t * 8 + es] = o; }
                }
            }
        }
    }
    __syncthreads();
}

__device__ __forceinline__ bool relaunder(Ctx& c) { int t = threadIdx.x; asm volatile("" : "+v"(t)); c.tid = t; c.lane = t & 63; c.wave = __builtin_amdgcn_readfirstlane(t >> 6); return true; }
__global__ void __launch_bounds__(512, 2) fwd(Args a) {
    extern __shared__ __attribute__((aligned(16))) unsigned char lds_raw[];
    Ctx c; c.lds = (LAS unsigned char*)lds_raw; c.tid = threadIdx.x; c.lane = c.tid & 63; c.wave = __builtin_amdgcn_readfirstlane(c.tid >> 6); c.G = gridDim.x; c.bid = blockIdx.x;
    const Args& A = a;
    volatile LAS unsigned* MISC = (volatile LAS unsigned*)(c.lds + MISC_OFF);
    if (c.tid < 64) MISC[c.tid] = 0u;
    __syncthreads();
    const int lo = a.ph_lo, hi = a.ph_hi;
    XcdBarrier bar; bar.bar = (unsigned*)(A.ws + WS_CTL) + CW_BAR; bar.x = 0; bar.st = MISC + 8;
    if (hi - lo > 1) bar = xcd_barrier_post((unsigned*)(A.ws + WS_CTL) + CW_BAR, MISC + 8);
#define IN(k) (lo <= (k) && (k) < hi && relaunder(c))
#define INR(k) (lo <= (k) && (k) < hi)
#define SEAM(k) do { if (INR(k) && INR((k) + 1)) { xcd_barrier(bar); if ((DUP >> 14) & 1) xcd_barrier(bar); } } while (0)
    bf16_t* NBUF = (bf16_t*)(A.ws + WS_NBUF); bf16_t* PROJ = (bf16_t*)(A.ws + WS_PROJ); bf16_t* MIXED = (bf16_t*)(A.ws + WS_MIXED); bf16_t* QP = (bf16_t*)(A.ws + WS_QP);
    float* GB = (float*)(A.ws + WS_GB);
    if (IN(0)) REP(10) p0_prologue(c, a);
    SEAM(0);
    auto layer = [&](const int l) __attribute__((always_inline)) {
        const int pb = 1 + 10 * l;
        if (l == 0 && IN(pb + 0) && !(KO & (1 << 0))) REP(0) phase_norm(c, a, l == 0 ? A.in[0] : A.out, A.in[2] + l * 1024, NBUF, (const float*)(A.ws + WS_WGATE) + l * 8 * 1024, A.in[5] + l * 4, A.in[6] + l * 4, GB);
        if (l == 0) SEAM(pb + 0);
        if (IN(pb + 1) && !(KO & (1 << 1))) REP(1) { pg8::Gemm g{NBUF, (const bf16_t*)(A.ws + WS_WIN) + (size_t)l * NPROJ * 1024, T, NPROJ, 1024}; pg8::StaticOrder S; S.init(T, NPROJ, c.G, c.bid); pg8::EpiBf16 E{PROJ, NPROJ, nullptr};
            pg8::gemm_phase<pg8::EpiBf16, pg8::StaticOrder>(c.lds, g, S, E, nullptr); }
        SEAM(pb + 1);
        if (IN(pb + 2) && !(KO & (1 << 2))) REP(2) phase_prep(c, a, l);
        SEAM(pb + 2);
        if (IN(pb + 3)) REP(3) { for (int u = c.bid; u < 1024; u += 2 * c.G) { if (u + c.G < 1024) gdn_chunk_pair(c, a, u, u + c.G); else gdn_chunk_unit(c, a, u); } }
        SEAM(pb + 3);
        if (IN(pb + 4) && !(KO & (1 << 3))) REP(4) { if (c.bid < 64) { for (int rp = 0; rp < 1 + ((DUP >> 12) & 1); ++rp) gdn_scan(c, a, c.bid); } else { for (int rp = 0; rp < 1 + ((DUP >> 13) & 1); ++rp) attn_mfma(c, a, l, 64, c.G - 64); } }
        SEAM(pb + 4);
        if (IN(pb + 5) && !(KO & (1 << 4))) REP(5) phase_gdn_out(c, a, l);
        SEAM(pb + 5);
        if (IN(pb + 6) && !(KO & (1 << 5))) REP(6) { pg8::Gemm g{MIXED, (const bf16_t*)(A.ws + WS_WOUT) + (size_t)l * 1024 * 1024, T, 1024, 1024}; pg8::StaticOrder S; S.init(T, 1024, c.G, c.bid); pg8::EpiResNorm E{l == 0 ? A.in[0] : A.out, A.out, NBUF, A.in[14] + l * 1024, (float*)(A.ws + WS_RS), 1024};
            pg8::gemm_phase<pg8::EpiResNorm, pg8::StaticOrder>(c.lds, g, S, E, nullptr); }
        SEAM(pb + 6);
        if (IN(pb + 8) && !(KO & (1 << 7))) REP(8) { pg8::Gemm g{NBUF, (const bf16_t*)(A.ws + WS_WQ) + (size_t)l * 2048 * 1024, T, 2048, 1024}; pg8::StaticOrder S; S.init(T, 2048, c.G, c.bid); pg8::EpiBf16 E{QP, 2048, (const float*)(A.ws + WS_RS)};
            pg8::gemm_phase<pg8::EpiBf16, pg8::StaticOrder>(c.lds, g, S, E, nullptr); }
        SEAM(pb + 8);
        if (IN(pb + 9) && !(KO & (1 << 8))) REP(9) phase_peer(c, a, l, LASTREP(9) ? A.out : (float*)(A.ws + WS_GCH), l == 0, bar, (hi - lo > 1) && c.G * 64 == T);
        SEAM(pb + 9);
    };
    layer(0); layer(1);
#undef IN
#undef INR
#undef SEAM
}

extern "C" void kernel_launch(void* const* d_in, const int* in_sizes, int n_in, void* d_out, int out_size, void* d_ws, size_t ws_size, hipStream_t stream) {
    static int grid = 0;
    if (grid == 0) {
        if (n_in != 19 || out_size != T * D || ws_size < WS_END) { fprintf(stderr, "kernel_launch: unexpected shapes (n_in %d out %d ws %zu)\n", n_in, out_size, ws_size); grid = -1; return; }
        if (hipFuncSetAttribute((const void*)fwd, hipFuncAttributeMaxDynamicSharedMemorySize, LDS_BYTES) != hipSuccess) { fprintf(stderr, "kernel_launch: hipFuncSetAttribute failed\n"); grid = -1; return; }
        int dev = 0, cus = 0, per_cu = 0;
        (void)hipGetDevice(&dev); (void)hipDeviceGetAttribute(&cus, hipDeviceAttributeMultiprocessorCount, dev);
        (void)hipOccupancyMaxActiveBlocksPerMultiprocessor(&per_cu, (const void*)fwd, 512, LDS_BYTES);
        (void)hipGetLastError();
        if (per_cu < 1) fprintf(stderr, "kernel_launch: occupancy query reports %d blocks per CU\n", per_cu);
        grid = cus > 0 ? cus : 256;
    }
    if (grid < 0) return;
    (void)hipMemsetAsync((char*)d_ws + WS_CTL, 0, CTL_BYTES, stream);
    Args a{};
    for (int i = 0; i < 19; ++i) a.in[i] = (const float*)d_in[i];
    a.out = (float*)d_out; a.ws = (unsigned char*)d_ws;
#if MK_ONE_LAUNCH
    a.ph_lo = 0; a.ph_hi = NPHASE;
    hipLaunchKernelGGL(fwd, dim3(grid), dim3(512), LDS_BYTES, stream, a);
#else
    for (int p = 0; p < NPHASE; ++p) { a.ph_lo = p; a.ph_hi = p + 1; hipLaunchKernelGGL(fwd, dim3(grid), dim3(512), LDS_BYTES, stream, a); }
#endif
}
```

```cpp
#include <hip/hip_runtime.h>
#include <cstdio>
#include <cstdint>
#include <cstring>

#ifndef KO
#define KO 0
#endif
#ifndef DUP
#define DUP 0
#endif
#define ALIGN_V 0
#define REP(k) for (int rep = 0; rep < 1 + ((DUP >> (k)) & 1); ++rep)
#define LASTREP(k) (rep == ((DUP >> (k)) & 1))
#ifndef MK_ONE_LAUNCH
#define MK_ONE_LAUNCH 1
#endif

template <int CTRL> __device__ __forceinline__ int dpp_i(int x) { return __builtin_amdgcn_mov_dpp(x, CTRL, 0xf, 0xf, true); }
template <int N> __device__ __forceinline__ int lxi(int x) {
    if constexpr (N == 1) return dpp_i<0xB1>(x);
    else if constexpr (N == 2) return dpp_i<0x4E>(x);
    else if constexpr (N == 4) return dpp_i<0x1B>(dpp_i<0x141>(x));
    else if constexpr (N == 8) return dpp_i<0x128>(x);
    else if constexpr (N == 16) { const auto r = __builtin_amdgcn_permlane16_swap((unsigned)x, (unsigned)x, false, false); return (int)((threadIdx.x & 16) ? r[0] : r[1]); }
    else { const auto r = __builtin_amdgcn_permlane32_swap((unsigned)x, (unsigned)x, false, false); return (int)((threadIdx.x & 32) ? r[0] : r[1]); }
}
template <int N> __device__ __forceinline__ float lxf(float x) { return __int_as_float(lxi<N>(__float_as_int(x))); }
template <int N> __device__ __forceinline__ unsigned lxu(unsigned x) { return (unsigned)lxi<N>((int)x); }
namespace pg8 {
#define PG8_LAS __attribute__((address_space(3)))
typedef unsigned short bf16_t;
typedef short bf16x8 __attribute__((ext_vector_type(8)));
typedef float f32x4 __attribute__((ext_vector_type(4)));
typedef unsigned u32x4 __attribute__((ext_vector_type(4)));
constexpr int BM = 256, BK = 64, HALF = 128, HTB = HALF * BK * 2  , STAGE_BYTES = 8 * HTB, NXCD = 8, WGM = 8;

__host__ __device__ __forceinline__ int lds_byte(int r, int c) { const int st = (r >> 4) * 2 + (c >> 5), rr = r & 15, cc = c & 31, ob = rr * 64 + cc * 2; return st * 1024 + (ob ^ (((ob >> 9) & 1) << 5)); }
__host__ __device__ __forceinline__ void stage_rc(int b, int& R, int& C) { const int st = b / 1024, sb = b % 1024, swz = sb ^ (((sb >> 9) & 1) << 5); R = (st >> 1) * 16 + swz / 64; C = (st & 1) * 32 + (swz % 64) / 2; }
__host__ __device__ __forceinline__ int perm32(int rho) { const int n = rho >> 4, i = rho & 15; return 8 * (i >> 2) + 4 * n + (i & 3); }

struct Unit { int pm, pn; };
struct Gemm { const bf16_t* A; const bf16_t* Bt; int M, N, K; };

struct StaticOrder {
    int nM, nN, nwg, G, c;
    __host__ __device__ void init(int M, int N, int G_, int c_) { nM = M / BM; nN = N / BM; nwg = nM * nN; G = G_; c = c_; }
    __host__ __device__ bool next(int i, Unit& u) const {
        const long L = (long)i * G + c; if (L >= nwg) return false;
        int wgid = (int)L; { const int q = nwg / NXCD, r = nwg % NXCD, xcd = wgid % NXCD, off = wgid / NXCD; wgid = (xcd < r ? xcd * (q + 1) : r * (q + 1) + (xcd - r) * q) + off; }
        const int nig = WGM * nN, gid = wgid / nig, fm = gid * WGM, gsz = (nM - fm) < WGM ? (nM - fm) : WGM;
        u.pm = fm + ((wgid % nig) % gsz); u.pn = (wgid % nig) / gsz; return true;
    }
    __device__ __forceinline__ void a_ready(const Unit&) const {}
    __device__ __forceinline__ void done(const Unit&) const {}
};
__device__ __forceinline__ unsigned cvt_pk_bf16(float lo, float hi) { unsigned r; asm volatile("v_cvt_pk_bf16_f32 %0, %1, %2" : "=v"(r) : "v"(lo), "v"(hi)); return r; }
typedef unsigned u32x2v __attribute__((ext_vector_type(2)));
struct EpiResF32 {
    static constexpr bool PERM = false, AFTER_DRAIN = false;
    const float* R; float* C; int ldc;
    __device__ __forceinline__ void operator()(const f32x4 (&acc)[2][2][4][2], const Unit& u, int wr, int wc, int fr, int fq) const {
        const int row0 = u.pm * BM + wr * 64 + fr, col0 = u.pn * BM + wc * 32 + 4 * fq;
#pragma unroll
        for (int ai = 0; ai < 2; ++ai)
#pragma unroll
            for (int m = 0; m < 4; ++m) { const size_t ro = (size_t)(row0 + ai * HALF + m * 16) * ldc + col0;
#pragma unroll
                for (int bj = 0; bj < 2; ++bj)
#pragma unroll
                    for (int n = 0; n < 2; ++n) { const f32x4 r = *(const f32x4*)(R + ro + bj * HALF + n * 16); *(f32x4*)(C + ro + bj * HALF + n * 16) = acc[ai][bj][m][n] + r; } }
    }
};
struct EpiResNorm {
    static constexpr bool PERM = false, AFTER_DRAIN = false;
    const float* R; float* C; bf16_t* HB; const float* gain; float* RS; int ldc;
    __device__ __forceinline__ void operator()(const f32x4 (&acc)[2][2][4][2], const Unit& u, int wr, int wc, int fr, int fq) const {
        const int row0 = u.pm * BM + wr * 64 + fr, col0 = u.pn * BM + wc * 32 + 4 * fq;
        f32x4 gv[2][2];
#pragma unroll
        for (int bj = 0; bj < 2; ++bj)
#pragma unroll
            for (int n = 0; n < 2; ++n) gv[bj][n] = *(const f32x4*)(gain + col0 + bj * HALF + n * 16);
#pragma unroll
        for (int ai = 0; ai < 2; ++ai)
#pragma unroll
            for (int m = 0; m < 4; ++m) { const int row = row0 + ai * HALF + m * 16; const size_t ro = (size_t)row * ldc + col0; float ss = 0.f;
#pragma unroll
                for (int bj = 0; bj < 2; ++bj)
#pragma unroll
                    for (int n = 0; n < 2; ++n) { const f32x4 r = *(const f32x4*)(R + ro + bj * HALF + n * 16); const f32x4 h = acc[ai][bj][m][n] + r; *(f32x4*)(C + ro + bj * HALF + n * 16) = h;
                        ss += (h[0] * h[0] + h[1] * h[1]) + (h[2] * h[2] + h[3] * h[3]); const f32x4 y = h * gv[bj][n];
                        u32x2v w; w.x = cvt_pk_bf16(y[0], y[1]); w.y = cvt_pk_bf16(y[2], y[3]); *(u32x2v*)(HB + ro + bj * HALF + n * 16) = w; }
                ss += lxf<16>(ss); ss += lxf<32>(ss);
                if (fq == 0) RS[(size_t)row * 16 + u.pn * 4 + wc] = ss; }
    }
};
struct EpiBf16 {
    static constexpr bool PERM = true, AFTER_DRAIN = false;
    bf16_t* O; int ldc; const float* RS;
    __device__ __forceinline__ void operator()(const f32x4 (&acc)[2][2][4][2], const Unit& u, int wr, int wc, int fr, int fq) const {
        const int row0 = u.pm * BM + wr * 64 + fr; const int col0 = u.pn * BM + wc * 32 + 8 * fq;
#pragma unroll
        for (int ai = 0; ai < 2; ++ai)
#pragma unroll
            for (int m = 0; m < 4; ++m) { const int row = row0 + ai * HALF + m * 16; bf16_t* rowp = O + (size_t)row * ldc + col0;
                float sc = 1.0f; if (RS) { const f32x4 a = *(const f32x4*)(RS + (size_t)row * 16), b = *(const f32x4*)(RS + (size_t)row * 16 + 4), c2 = *(const f32x4*)(RS + (size_t)row * 16 + 8), d = *(const f32x4*)(RS + (size_t)row * 16 + 12);
                    sc = rsqrtf(((((a[0] + a[1]) + (a[2] + a[3])) + ((b[0] + b[1]) + (b[2] + b[3]))) + (((c2[0] + c2[1]) + (c2[2] + c2[3])) + ((d[0] + d[1]) + (d[2] + d[3])))) * (1.0f / 1024.0f) + 1e-6f); }
#pragma unroll
                for (int bj = 0; bj < 2; ++bj) { const f32x4 v0 = acc[ai][bj][m][0] * sc, v1 = acc[ai][bj][m][1] * sc;
                    u32x4 w; w.x = cvt_pk_bf16(v0[0], v0[1]); w.y = cvt_pk_bf16(v0[2], v0[3]); w.z = cvt_pk_bf16(v1[0], v1[1]); w.w = cvt_pk_bf16(v1[2], v1[3]);
                    *(u32x4*)(rowp + bj * HALF) = w; } }
    }
};

template <class Epi, class Sched, bool STAMP = false>
__device__ __forceinline__ void gemm_phase(PG8_LAS unsigned char* lds, const Gemm g, const Sched& S, const Epi& E, unsigned long long* stamps) {
    int tid_ = threadIdx.x; asm volatile("" : "+v"(tid_));
    const int tid = tid_, wid = __builtin_amdgcn_readfirstlane(tid >> 6), lane = tid & 63, wr = wid >> 2, wc = wid & 3, fr = lane & 15, fq = lane >> 4;
    const int K = g.K, nt = K / BK;
    int ts_lo = 0, ts_hi = 0, nts = 0; const unsigned long long rt_entry = STAMP ? (unsigned long long)wall_clock64() : 0ull;
#define PG8_STAMP() do { if (STAMP && wid == 0 && nts < 64) { const unsigned long long _c = (unsigned long long)clock64(); \
        ts_lo = (lane == nts) ? (int)(unsigned)_c : ts_lo; ts_hi = (lane == nts) ? (int)(unsigned)(_c >> 32) : ts_hi; ++nts; } } while (0)
    PG8_STAMP();
    unsigned voffA[2], voffB[2];
#pragma unroll
    for (int i = 0; i < 2; ++i) { int R, C; stage_rc(tid * 16 + i * 8192, R, C); const int Rb = Epi::PERM ? ((R & ~31) + perm32(R & 31)) : R;
        voffA[i] = (unsigned)(R * K + C) * 2u; voffB[i] = (unsigned)(Rb * K + C) * 2u; }
    const size_t kstep = (size_t)(BK * 2);
    const size_t hstep = (size_t)HALF * K * 2;
    const size_t tstep = 2 * hstep;
    const unsigned ldsw = (unsigned)wid * 1024u;
    const int aoff = lds_byte(wr * 64 + fr, fq * 8), boff = lds_byte(wc * 32 + fr, fq * 8);
#define PG8_SA(b, h) (((b) * 2 + (h)) * HTB)
#define PG8_SB(b, h) ((4 + (b) * 2 + (h)) * HTB)
#define PG8_STAGE(bufoff, gbase, voff) do { _Pragma("unroll") for (int _i = 0; _i < 2; ++_i) \
        __builtin_amdgcn_global_load_lds((const unsigned*)((const char*)(gbase) + (voff)[_i]), (PG8_LAS unsigned*)(lds + (bufoff) + ldsw + _i * 8192), 16, 0, 0); } while (0)
#define PG8_LDA(dst, b, h) do { _Pragma("unroll") for (int m = 0; m < 4; ++m) _Pragma("unroll") for (int k = 0; k < 2; ++k) dst[m][k] = *(const PG8_LAS bf16x8*)(lds + PG8_SA(b, h) + aoff + m * 2048 + k * 1024); } while (0)
#define PG8_LDB(dst, b, h) do { _Pragma("unroll") for (int n = 0; n < 2; ++n) _Pragma("unroll") for (int k = 0; k < 2; ++k) dst[n][k] = *(const PG8_LAS bf16x8*)(lds + PG8_SB(b, h) + boff + n * 2048 + k * 1024); } while (0)
#define PG8_MMA(ai, bj, At, Bt) do { __builtin_amdgcn_s_setprio(1); _Pragma("unroll") for (int m = 0; m < 4; ++m) _Pragma("unroll") for (int n = 0; n < 2; ++n) _Pragma("unroll") for (int k = 0; k < 2; ++k) \
        acc[ai][bj][m][n] = __builtin_amdgcn_mfma_f32_16x16x32_bf16(Bt[n][k], At[m][k], acc[ai][bj][m][n], 0, 0, 0); __builtin_amdgcn_s_setprio(0); } while (0)
#define PG8_WAIT_V(n) asm volatile("s_waitcnt vmcnt(" #n ")" ::: "memory")
#define PG8_WAIT_L(n) asm volatile("s_waitcnt lgkmcnt(" #n ")" ::: "memory")
#define PG8_BAR __builtin_amdgcn_s_barrier()
#define PG8_SCHED __builtin_amdgcn_sched_barrier(0)
    Unit cur, nxt; int ui = 0;
    if (!S.next(0, cur)) return;
    f32x4 acc[2][2][4][2];
#pragma unroll
    for (int a = 0; a < 2; ++a)
#pragma unroll
        for (int b = 0; b < 2; ++b)
#pragma unroll
            for (int m = 0; m < 4; ++m)
#pragma unroll
                for (int n = 0; n < 2; ++n) acc[a][b][m][n] = (f32x4){0.f, 0.f, 0.f, 0.f};
    bf16x8 At[4][2], B0[2][2], B1[2][2];
    const char* cA = (const char*)g.A + (size_t)cur.pm * tstep; const char* cB = (const char*)g.Bt + (size_t)cur.pn * tstep;
    S.a_ready(cur);
    PG8_STAGE(PG8_SB(0, 0), cB, voffB); PG8_STAGE(PG8_SA(0, 0), cA, voffA); PG8_STAGE(PG8_SB(0, 1), cB + hstep, voffB); PG8_STAGE(PG8_SA(0, 1), cA + hstep, voffA);
    if (wr == 1) PG8_BAR;
    PG8_WAIT_V(4); PG8_BAR;
    PG8_STAGE(PG8_SB(1, 0), cB + kstep, voffB); PG8_STAGE(PG8_SA(1, 0), cA + kstep, voffA); PG8_STAGE(PG8_SB(1, 1), cB + hstep + kstep, voffB);
    PG8_WAIT_V(6); PG8_BAR;
    PG8_STAMP();
    for (;;) {
        const bool has_next = S.next(ui + 1, nxt);
        const char* nA = has_next ? (const char*)g.A + (size_t)nxt.pm * tstep : cA; const char* nB = has_next ? (const char*)g.Bt + (size_t)nxt.pn * tstep : cB;
        for (int t = 0; t < nt; t += 2) {
            const bool last = (t == nt - 2);
            const char* a1 = cA + (size_t)(t + 1) * kstep;
            const char* a2 = last ? nA : cA + (size_t)(t + 2) * kstep; const char* b2 = last ? nB : cB + (size_t)(t + 2) * kstep;
            const char* a3 = a2 + kstep; const char* b3 = b2 + kstep;
            if (last && has_next) S.a_ready(nxt);
            PG8_LDB(B0, 0, 0); PG8_SCHED; PG8_LDA(At, 0, 0); PG8_STAGE(PG8_SA(1, 1), a1 + hstep, voffA);
            PG8_WAIT_L(8); PG8_BAR; PG8_WAIT_L(0); PG8_MMA(0, 0, At, B0); PG8_BAR; PG8_SCHED;
            PG8_LDB(B1, 0, 1); PG8_STAGE(PG8_SB(0, 0), b2, voffB);
            PG8_BAR; PG8_WAIT_L(0); PG8_MMA(0, 1, At, B1); PG8_BAR;
            PG8_LDA(At, 0, 1); PG8_STAGE(PG8_SA(0, 0), a2, voffA);
            PG8_BAR; PG8_WAIT_L(0); PG8_MMA(1, 0, At, B0); PG8_BAR; PG8_SCHED;
            PG8_STAGE(PG8_SB(0, 1), b2 + hstep, voffB);
            PG8_WAIT_V(6); PG8_BAR; PG8_MMA(1, 1, At, B1); PG8_BAR;
            PG8_LDB(B0, 1, 0); PG8_SCHED; PG8_LDA(At, 1, 0); PG8_STAGE(PG8_SA(0, 1), a2 + hstep, voffA);
            PG8_WAIT_L(8); PG8_BAR; PG8_WAIT_L(0); PG8_MMA(0, 0, At, B0); PG8_BAR; PG8_SCHED;
            PG8_LDB(B1, 1, 1); PG8_STAGE(PG8_SB(1, 0), b3, voffB);
            PG8_BAR; PG8_WAIT_L(0); PG8_MMA(0, 1, At, B1); PG8_BAR;
            PG8_LDA(At, 1, 1); PG8_STAGE(PG8_SA(1, 0), a3, voffA);
            PG8_BAR; PG8_WAIT_L(0); PG8_MMA(1, 0, At, B0); PG8_BAR; PG8_SCHED;
            PG8_STAGE(PG8_SB(1, 1), b3 + hstep, voffB);
            PG8_WAIT_V(6); PG8_BAR; PG8_MMA(1, 1, At, B1); PG8_BAR;
        }
        PG8_STAMP();
        if constexpr (!Epi::AFTER_DRAIN) { E(acc, cur, wr, wc, fr, fq); S.done(cur); }
        PG8_STAMP();
        if (!has_next) break;
#pragma unroll
        for (int a = 0; a < 2; ++a)
#pragma unroll
            for (int b = 0; b < 2; ++b)
#pragma unroll
                for (int m = 0; m < 4; ++m)
#pragma unroll
                    for (int n = 0; n < 2; ++n) acc[a][b][m][n] = (f32x4){0.f, 0.f, 0.f, 0.f};
        cur = nxt; cA = nA; cB = nB; ++ui;
    }
    PG8_WAIT_V(0);
    if (wr == 0) PG8_BAR;
    PG8_BAR;
    if constexpr (Epi::AFTER_DRAIN) { E.fused(acc, cur, wr, wc, fr, fq, lds, wid, lane); S.done(cur); }
    PG8_STAMP();
    if (STAMP && wid == 0) { stamps[lane] = lane < nts ? (((unsigned long long)(unsigned)ts_hi << 32) | (unsigned)ts_lo) : 0ull;
        if (lane == 62) stamps[62] = rt_entry; if (lane == 63) stamps[63] = (unsigned long long)wall_clock64(); }
#undef PG8_STAMP
#undef PG8_SA
#undef PG8_SB
#undef PG8_STAGE
#undef PG8_LDA
#undef PG8_LDB
#undef PG8_MMA
#undef PG8_WAIT_V
#undef PG8_WAIT_L
#undef PG8_BAR
#undef PG8_SCHED
}
}

using pg8::bf16_t; using pg8::bf16x8; using pg8::f32x4; using pg8::u32x4;
typedef unsigned u32x2 __attribute__((ext_vector_type(2)));
constexpr int T = 16384, D = 1024, SEQ = 2048, NPROJ = 3584, NINW = 3592, NEXP = 16384;
constexpr int EREC = 1792;
constexpr int C_GQ = 0, C_GK = 512, C_GV = 1024, C_GZ = 1536, C_SB = 2048, C_SC = 2304, C_SH = 2560, C_DQ = 2816, C_DK = 3072, C_DV = 3328;
constexpr size_t MiB = 1u << 20;
constexpr size_t WS_CTL = 0, CTL_BYTES = 1 * MiB, WS_WIN = 2 * MiB, WS_WOUT = 16 * MiB, WS_WQ = 20 * MiB, WS_KEYS = 28 * MiB, WS_WGATE = 29 * MiB, WS_VSC = 30 * MiB, WS_USC = 31 * MiB,
    WS_UT = 32 * MiB, WS_VT = 96 * MiB, WS_NBUF = 160 * MiB, WS_PROJ = 192 * MiB, WS_QP = 192 * MiB, WS_QKVC = 304 * MiB, WS_MIXED = 352 * MiB, WS_GB = 384 * MiB,
    WS_AQ = 385 * MiB, WS_AK = 393 * MiB, WS_OGDN = 401 * MiB, WS_GCH = 433 * MiB, WS_AVT = 160 * MiB  , WS_END = 505 * MiB;
constexpr int CW_BAR = 4096;
constexpr size_t WS_RS = 1 * MiB;
constexpr int LDS_BYTES = 159744;
constexpr int MISC_OFF = 159744 - 256;
constexpr int NPHASE = 21;

__device__ __forceinline__ float bf_lo(unsigned w) { return __uint_as_float(w << 16); }
__device__ __forceinline__ float bf_hi(unsigned w) { return __uint_as_float(w & 0xffff0000u); }
__device__ __forceinline__ unsigned f2bf(float f) { unsigned u = __float_as_uint(f); return (u + 0x7fffu + ((u >> 16) & 1u)) >> 16; }
__device__ __forceinline__ unsigned pk2(float lo, float hi) { return f2bf(lo) | (f2bf(hi) << 16); }
__device__ __forceinline__ float wave_sum(float v) {
    v += lxf<1>(v); v += lxf<2>(v); v += lxf<4>(v); v += lxf<8>(v); v += lxf<16>(v); v += lxf<32>(v);
    return v;
}
__device__ __forceinline__ int kperm(int x) { return (x & ~31) | (((x >> 2) & 3) << 3) | (((x >> 4) & 1) << 2) | (x & 3); }
__device__ __forceinline__ float silu_f(float x) { return x / (1.0f + __expf(-x)); }

#define XB_TMO      128
#define XB_XCNT(j)  (256  + 64 * (j))
#define XB_XSUB(j)  (1280 + 64 * (j))
#define XB_XGEN(j)  (2304 + 64 * (j))
#define XB_TOP      3328
#define XB_TOPGEN   3392
#define XCD_BAR_WORDS 3456
#define XB_SPIN_CAP (1u << 18)
#define LAS __attribute__((address_space(3)))

__device__ __forceinline__ unsigned xb_ld(unsigned* p)              { return __hip_atomic_load(p, __ATOMIC_RELAXED, __HIP_MEMORY_SCOPE_AGENT); }
__device__ __forceinline__ unsigned xb_add(unsigned* p, unsigned v) { return __hip_atomic_fetch_add(p, v, __ATOMIC_RELAXED, __HIP_MEMORY_SCOPE_AGENT); }
__device__ __forceinline__ unsigned xb_xcc_id() { return (unsigned)__builtin_amdgcn_s_getreg((3 << 11) | 20) & 0xFu; }
#define XB_SPIN(cond, bar) do { unsigned _sp = 0; while (cond) { __builtin_amdgcn_s_sleep(1); \
    if ((++_sp & 255u) == 0u) { if (xb_ld(&(bar)[XB_TMO])) break; if (_sp > XB_SPIN_CAP) { atomicAdd(&(bar)[XB_TMO], 1u); break; } } } } while (0)

struct XcdBarrier {
    unsigned* bar; unsigned x;
    volatile LAS unsigned* st;
};

__device__ __forceinline__ XcdBarrier xcd_barrier_post(unsigned* bar, volatile LAS unsigned* st) {
    XcdBarrier b; b.bar = bar; b.x = xb_xcc_id(); b.st = st;
    if (threadIdx.x == 0) (void)xb_add(&bar[XB_XCNT(b.x)], 1u);
    return b;
}
__device__ __forceinline__ void xcd_barrier_complete(unsigned* bar, unsigned x, unsigned& nloc, unsigned& nx) {
    const unsigned G = gridDim.x * gridDim.y * gridDim.z;
    unsigned sum, cnt, mine, sp = 0u;
    for (;;) {
        sum = 0u; cnt = 0u; mine = 0u;
#pragma unroll
        for (unsigned j = 0; j < 16; ++j) { const unsigned c = xb_ld(&bar[XB_XCNT(j)]); sum += c; cnt += (c > 0u) ? 1u : 0u; mine = (j == x) ? c : mine; }
        if (sum == G) break;
        __builtin_amdgcn_s_sleep(1);
        if ((++sp & 255u) == 0u) { if (xb_ld(&bar[XB_TMO])) break; if (sp > XB_SPIN_CAP) { atomicAdd(&bar[XB_TMO], 1u); break; } }
    }
    nloc = mine > 0u ? mine : 1u; nx = cnt > 0u ? cnt : 1u;
}

__device__ __forceinline__ void xcd_barrier(const XcdBarrier& b) {
    asm volatile("s_waitcnt vmcnt(0)" ::: "memory");
    __syncthreads();
    if (threadIdx.x == 0) {
        unsigned* bar = b.bar;
        __builtin_amdgcn_s_waitcnt(0);
        unsigned nloc = b.st[0], nx = b.st[1];
        if (nloc == 0u) { xcd_barrier_complete(bar, b.x, nloc, nx); b.st[0] = nloc; b.st[1] = nx; }
        const unsigned old = xb_add(&bar[XB_XSUB(b.x)], 1u);
        const unsigned gen = old / nloc;
        if (old + 1u == (gen + 1u) * nloc) {
            __builtin_amdgcn_fence(__ATOMIC_RELEASE, "agent");
            asm volatile("s_waitcnt vmcnt(0)" ::: "memory");
            const unsigned og = xb_add(&bar[XB_TOP], 1u);
            const unsigned tg = og / nx;
            if (og + 1u == (tg + 1u) * nx) xb_add(&bar[XB_TOPGEN], 1u);
            else XB_SPIN(xb_ld(&bar[XB_TOPGEN]) == tg, bar);
            __builtin_amdgcn_fence(__ATOMIC_ACQUIRE, "agent");
            xb_add(&bar[XB_XGEN(b.x)], 1u);
            asm volatile("s_waitcnt vmcnt(0)" ::: "memory");
        } else {
            XB_SPIN(xb_ld(&bar[XB_XGEN(b.x)]) == gen, bar);
            __builtin_amdgcn_fence(__ATOMIC_ACQUIRE, "agent");
            asm volatile("s_waitcnt vmcnt(0)" ::: "memory");
        }
    }
    __syncthreads();
}

struct Args { const float* in[19]; float* out; unsigned char* ws; int ph_lo, ph_hi; };
struct Ctx {
    LAS unsigned char* lds; int tid, lane, wave, G, bid;
};

struct __attribute__((packed, aligned(4))) U3 { unsigned x, y, z; };
typedef unsigned u32x6 __attribute__((ext_vector_type(6)));
typedef float f32x32 __attribute__((ext_vector_type(32)));
__device__ __forceinline__ unsigned fp6_e2m3(float x) {
    const float a = fabsf(x); const float cdf = a < 2.f ? rintf(a * 8.f) : (a < 4.f ? rintf(a * 4.f) + 8.f : rintf(a * 2.f) + 16.f);
    return (unsigned)fminf(cdf, 31.f) | ((__float_as_uint(x) >> 31) << 5);
}
__device__ __forceinline__ void cvt_flat8(const float* src, unsigned char* dst, size_t n8, size_t gt, size_t NT) {
    const float4* s = (const float4*)src; u32x4* d = (u32x4*)dst;
    for (size_t i = gt; i < n8; i += NT) { const float4 a = s[2 * i], b = s[2 * i + 1]; u32x4 w; w.x = pk2(a.x, a.y); w.y = pk2(a.z, a.w); w.z = pk2(b.x, b.y); w.w = pk2(b.z, b.w); d[i] = w; }
}
__device__ __forceinline__ void cvt_transpose(const float* w, bf16_t* dst, int N, size_t gt, size_t NT) {
    const size_t items = (size_t)2 * 128 * N;
    for (size_t i = gt; i < items; i += NT) {
        const int cc = (int)(i % N), kb = (int)((i / N) % 128), l = (int)(i / ((size_t)N * 128));
        const float* s = w + ((size_t)l * 1024 + kb * 8) * N + cc; float v[8];
#pragma unroll
        for (int j = 0; j < 8; ++j) v[j] = s[(size_t)j * N];
        u32x4 o; o.x = pk2(v[0], v[1]); o.y = pk2(v[2], v[3]); o.z = pk2(v[4], v[5]); o.w = pk2(v[6], v[7]);
        *(u32x4*)(dst + ((size_t)l * N + cc) * 1024 + kb * 8) = o;
    }
}
__device__ __forceinline__ void p0_prologue(Ctx& c, const Args& A) {
    const size_t gt = (size_t)c.bid * 512 + c.tid, NT = (size_t)c.G * 512;
#pragma unroll 1
    for (int tb = 0; tb < 2; ++tb) {
        const float* src = tb ? A.in[18] : A.in[17]; unsigned char* dst = A.ws + WS_UT + (tb ? 1024 : 0);   float* vs = (float*)(A.ws + (tb ? WS_VSC : WS_USC));
        for (int row = c.bid * 8 + c.wave; row < 2 * NEXP; row += c.G * 8) {
            const float4* sp = (const float4*)(src + (size_t)row * 1024 + 16 * c.lane); float4 f[4]; float am = 0.f;
#pragma unroll
            for (int i = 0; i < 4; ++i) { f[i] = sp[i]; am = fmaxf(fmaxf(am, fmaxf(fabsf(f[i].x), fabsf(f[i].y))), fmaxf(fabsf(f[i].z), fabsf(f[i].w))); }
            am = fmaxf(am, lxf<1>(am)); am = fmaxf(am, lxf<2>(am)); am = fmaxf(am, lxf<4>(am)); am = fmaxf(am, lxf<8>(am)); am = fmaxf(am, lxf<16>(am)); am = fmaxf(am, lxf<32>(am));
            const float sc = am > 0.f ? __uint_as_float(__float_as_uint((tb ? 7.5f : 127.0f) / am) & 0x7f800000u) : 1.0f;
            if (tb) {
                unsigned long long lo = 0ull; unsigned hi = 0u;
#pragma unroll
                for (int i = 0; i < 16; ++i) { const float x = (i & 3) == 0 ? f[i >> 2].x : ((i & 3) == 1 ? f[i >> 2].y : ((i & 3) == 2 ? f[i >> 2].z : f[i >> 2].w)); const unsigned cd = fp6_e2m3(x * sc);
                    if (i < 10) lo |= (unsigned long long)cd << (6 * i); else if (i == 10) { lo |= (unsigned long long)(cd & 15u) << 60; hi |= cd >> 4; } else hi |= cd << (6 * i - 64); }
                U3 w3; w3.x = (unsigned)lo; w3.y = (unsigned)(lo >> 32); w3.z = hi;
                *(U3*)(dst + (size_t)row * EREC + 12 * c.lane) = w3;
            } else {
                u32x4 w; unsigned ww[4];
#pragma unroll
                for (int i = 0; i < 4; ++i) ww[i] = ((unsigned)(int)rintf(f[i].x * sc) & 255u) | (((unsigned)(int)rintf(f[i].y * sc) & 255u) << 8) | (((unsigned)(int)rintf(f[i].z * sc) & 255u) << 16) | (((unsigned)(int)rintf(f[i].w * sc) & 255u) << 24);
                w.x = ww[0]; w.y = ww[1]; w.z = ww[2]; w.w = ww[3];
                *(u32x4*)(dst + (size_t)row * EREC + 16 * c.lane) = w; }
            if (c.lane == 0) vs[row] = 1.0f / sc;
        }
    }
    cvt_flat8(A.in[16], A.ws + WS_KEYS, (size_t)2 * 8 * 2 * 128 * 128 / 8, gt, NT);
    cvt_transpose(A.in[13], (bf16_t*)(A.ws + WS_WOUT), 1024, gt, NT);
    cvt_transpose(A.in[15], (bf16_t*)(A.ws + WS_WQ), 2048, gt, NT);
    {
        const float* w = A.in[3]; const size_t items = (size_t)2 * 128 * NINW;
        for (size_t i = gt; i < items; i += NT) {
            const int cc = (int)(i % NINW), kb = (int)((i / NINW) % 128), l = (int)(i / ((size_t)NINW * 128));
            const float* s = w + ((size_t)l * 1024 + kb * 8) * NINW + cc; float v[8];
#pragma unroll
            for (int j = 0; j < 8; ++j) v[j] = s[(size_t)j * NINW];
            if (cc >= 2048 && cc < 2056) { float* d = (float*)(A.ws + WS_WGATE) + ((size_t)l * 8 + (cc - 2048)) * 1024 + kb * 8;
                *(float4*)d = make_float4(v[0], v[1], v[2], v[3]); *(float4*)(d + 4) = make_float4(v[4], v[5], v[6], v[7]); }
            else { const int c2 = cc < 2048 ? cc : cc - 8; u32x4 o; o.x = pk2(v[0], v[1]); o.y = pk2(v[2], v[3]); o.z = pk2(v[4], v[5]); o.w = pk2(v[6], v[7]);
                *(u32x4*)((bf16_t*)(A.ws + WS_WIN) + ((size_t)l * NPROJ + c2) * 1024 + kb * 8) = o; }
        }
    }
}

__device__ __forceinline__ void phase_norm(Ctx& c, const Args& A, const float* src, const float* gain, bf16_t* dst, const float* wgate, const float* a_log, const float* dt_bias, float* GB) {
    const int gw = c.bid * 8 + c.wave, NGW = c.G * 8, lane = c.lane;
    const bool o1 = lane & 1, o2 = lane & 2, o4 = lane & 4; const int es = ((lane & 1) << 2) | (lane & 2) | ((lane >> 2) & 1);
    float4 g[4];
#pragma unroll
    for (int j = 0; j < 4; ++j) g[j] = ((const float4*)gain)[lane + 64 * j];
    for (int m0 = gw * 2; m0 < T; m0 += NGW * 2) {
        float4 v[2][4];
#pragma unroll
        for (int rr = 0; rr < 2; ++rr)
#pragma unroll
            for (int j = 0; j < 4; ++j) v[rr][j] = ((const float4*)(src + (size_t)(m0 + rr) * D))[lane + 64 * j];
#pragma unroll
        for (int rr = 0; rr < 2; ++rr) {
            const int m = m0 + rr; float ss = 0.f;
#pragma unroll
            for (int j = 0; j < 4; ++j) { ss += (v[rr][j].x * v[rr][j].x + v[rr][j].y * v[rr][j].y) + (v[rr][j].z * v[rr][j].z + v[rr][j].w * v[rr][j].w);
                v[rr][j].x *= g[j].x; v[rr][j].y *= g[j].y; v[rr][j].z *= g[j].z; v[rr][j].w *= g[j].w; }
            float cc = 0.f;
            if (wgate) {
                float d[8];
#pragma unroll
                for (int q = 0; q < 8; ++q) { float a = 0.f;
#pragma unroll
                    for (int j = 0; j < 4; ++j) { const float4 w = ((const float4*)(wgate + q * 1024))[lane + 64 * j]; a += (v[rr][j].x * w.x + v[rr][j].y * w.y) + (v[rr][j].z * w.z + v[rr][j].w * w.w); }
                    d[q] = a; }
                float a0 = o1 ? d[4] : d[0], a1 = o1 ? d[5] : d[1], a2 = o1 ? d[6] : d[2], a3 = o1 ? d[7] : d[3];
                a0 += lxf<1>(o1 ? d[0] : d[4]); a1 += lxf<1>(o1 ? d[1] : d[5]); a2 += lxf<1>(o1 ? d[2] : d[6]); a3 += lxf<1>(o1 ? d[3] : d[7]);
                float b0 = o2 ? a2 : a0, b1 = o2 ? a3 : a1; b0 += lxf<2>(o2 ? a0 : a2); b1 += lxf<2>(o2 ? a1 : a3);
                cc = o4 ? b1 : b0; cc += lxf<4>(o4 ? b0 : b1);
                cc += lxf<8>(cc); cc += lxf<16>(cc); cc += lxf<32>(cc);
            }
            const float rstd = rsqrtf(wave_sum(ss) * (1.0f / D) + 1e-6f);
            u32x2* o8 = (u32x2*)(dst + (size_t)m * D) + lane;
#pragma unroll
            for (int j = 0; j < 4; ++j) { u32x2 w; w.x = pk2(v[rr][j].x * rstd, v[rr][j].y * rstd); w.y = pk2(v[rr][j].z * rstd, v[rr][j].w * rstd); o8[64 * j] = w; }
            if (wgate && lane < 8) { const float r = cc * rstd; float o;
                if (es < 4) o = 1.0f / (1.0f + __expf(-r));
                else { const float z = r + dt_bias[es - 4]; const float sp = z > 20.f ? z : log1pf(__expf(z)); o = -__expf(a_log[es - 4]) * sp; }
                GB[(size_t)m * 8 + es] = o; }
        }
    }
}

__device__ __forceinline__ void unpack8(const u32x4& w, float* f) { f[0] = bf_lo(w.x); f[1] = bf_hi(w.x); f[2] = bf_lo(w.y); f[3] = bf_hi(w.y); f[4] = bf_lo(w.z); f[5] = bf_hi(w.z); f[6] = bf_lo(w.w); f[7] = bf_hi(w.w); }
__device__ __forceinline__ void phase_prep(Ctx& c, const Args& A, int l) {
    const int gw = c.bid * 8 + c.wave, NGW = c.G * 8, lane = c.lane;
    const bf16_t* PROJ = (const bf16_t*)(A.ws + WS_PROJ);
    bf16_t* QKVC = (bf16_t*)(A.ws + WS_QKVC); bf16_t* AQ = (bf16_t*)(A.ws + WS_AQ); bf16_t* AK = (bf16_t*)(A.ws + WS_AK); bf16_t* MIXED = (bf16_t*)(A.ws + WS_MIXED); bf16_t* AVT = (bf16_t*)(A.ws + WS_AVT);
    const float* gconv = A.in[4] + (size_t)l * 4 * 1536; const float* sconv = A.in[8] + (size_t)l * 3 * 256;
    const float* qg = A.in[9] + l * 32; const float* kg = A.in[10] + l * 32;
    const u32x4 zero4 = {0u, 0u, 0u, 0u};
    for (int run = gw; run < T / 8; run += NGW) {
        const int t0 = run * 8, s0 = t0 & (SEQ - 1);
#pragma unroll 1
        for (int it = 0; it < 3; ++it) {
            const int ch = (it * 64 + lane) * 8;
            u32x4 rows[11];
#pragma unroll
            for (int j = 0; j < 11; ++j) rows[j] = (s0 + j - 3 >= 0) ? *(const u32x4*)(PROJ + (size_t)(t0 + j - 3) * NPROJ + ch) : zero4;
            float w[4][8];
#pragma unroll
            for (int j = 0; j < 4; ++j) { const float4 a = *(const float4*)(gconv + j * 1536 + ch), b = *(const float4*)(gconv + j * 1536 + ch + 4);
                w[j][0] = a.x; w[j][1] = a.y; w[j][2] = a.z; w[j][3] = a.w; w[j][4] = b.x; w[j][5] = b.y; w[j][6] = b.z; w[j][7] = b.w; }
#pragma unroll
            for (int i = 0; i < 8; ++i) {
                float acc[8] = {0.f, 0.f, 0.f, 0.f, 0.f, 0.f, 0.f, 0.f};
#pragma unroll
                for (int j = 0; j < 4; ++j) { float x[8]; unpack8(rows[i + j], x);
#pragma unroll
                    for (int e = 0; e < 8; ++e) acc[e] += w[j][e] * x[e]; }
                float ss = 0.f;
#pragma unroll
                for (int e = 0; e < 8; ++e) { acc[e] = silu_f(acc[e]); ss += acc[e] * acc[e]; }
                if (it < 2) {
                    ss += lxf<1>(ss); ss += lxf<2>(ss); ss += lxf<4>(ss); ss += lxf<8>(ss);
                    const float r = rsqrtf(ss + 1e-6f);
#pragma unroll
                    for (int e = 0; e < 8; ++e) acc[e] *= r; }
                u32x4 o4; o4.x = pk2(acc[0], acc[1]); o4.y = pk2(acc[2], acc[3]); o4.z = pk2(acc[4], acc[5]); o4.w = pk2(acc[6], acc[7]);
                *(u32x4*)(QKVC + (size_t)(t0 + i) * 1536 + ch) = o4;
            }
        }
        {
            u32x2 wq[8], wk[8], wv[8];
#pragma unroll
            for (int i = 0; i < 8; ++i) { const bf16_t* r = PROJ + (size_t)(t0 + i) * NPROJ + 4 * lane; wq[i] = *(const u32x2*)(r + C_DQ); wk[i] = *(const u32x2*)(r + C_DK); wv[i] = *(const u32x2*)(r + C_DV); }
            const float4 g4 = *(const float4*)(qg + 4 * (lane & 7)), h4 = *(const float4*)(kg + 4 * (lane & 7));
#pragma unroll
            for (int i = 0; i < 8; ++i) {
                float q[4] = {bf_lo(wq[i].x), bf_hi(wq[i].x), bf_lo(wq[i].y), bf_hi(wq[i].y)}, k[4] = {bf_lo(wk[i].x), bf_hi(wk[i].x), bf_lo(wk[i].y), bf_hi(wk[i].y)};
                float sq = (q[0] * q[0] + q[1] * q[1]) + (q[2] * q[2] + q[3] * q[3]), sk = (k[0] * k[0] + k[1] * k[1]) + (k[2] * k[2] + k[3] * k[3]);
                sq += lxf<1>(sq); sk += lxf<1>(sk); sq += lxf<2>(sq); sk += lxf<2>(sk); sq += lxf<4>(sq); sk += lxf<4>(sk);
                const float rq = rsqrtf(sq * (1.0f / 32.0f) + 1e-6f) * (0.17677669529663687f * 1.4426950408889634f), rk = rsqrtf(sk * (1.0f / 32.0f) + 1e-6f);
                u32x2 oq, ok; oq.x = pk2(q[0] * rq * g4.x, q[1] * rq * g4.y); oq.y = pk2(q[2] * rq * g4.z, q[3] * rq * g4.w);
                ok.x = pk2(k[0] * rk * h4.x, k[1] * rk * h4.y); ok.y = pk2(k[2] * rk * h4.z, k[3] * rk * h4.w);
                *(u32x2*)(AQ + (size_t)(t0 + i) * 256 + 4 * lane) = oq; *(u32x2*)(AK + (size_t)(t0 + i) * 256 + 4 * lane) = ok;
            }
            bf16_t* vt = AVT + ((size_t)((t0 >> 11) * 4 + (lane >> 4)) * 64 + (lane & 15) * 4) * SEQ + kperm(s0);
#pragma unroll
            for (int d = 0; d < 4; ++d) {
                unsigned e[8];
#pragma unroll
                for (int i = 0; i < 8; ++i) { const unsigned w = (d < 2) ? wv[i].x : wv[i].y; e[i] = (d & 1) ? (w >> 16) : (w & 0xffffu); }
                u32x2 lo, hi; lo.x = e[0] | (e[1] << 16); lo.y = e[2] | (e[3] << 16); hi.x = e[4] | (e[5] << 16); hi.y = e[6] | (e[7] << 16);
                *(u32x2*)(vt + (size_t)d * SEQ) = lo; *(u32x2*)(vt + (size_t)d * SEQ + 8) = hi;
            }
        }
        {
            const int ch = 4 * lane; u32x2 wc[10], wh[10], wb[8];
#pragma unroll
            for (int j = 0; j < 10; ++j) { const bool ok = (s0 + j - 2 >= 0); const bf16_t* r = PROJ + (size_t)(t0 + j - 2) * NPROJ + ch;
                wc[j] = ok ? *(const u32x2*)(r + C_SC) : (u32x2){0u, 0u}; wh[j] = ok ? *(const u32x2*)(r + C_SH) : (u32x2){0u, 0u}; }
#pragma unroll
            for (int i = 0; i < 8; ++i) wb[i] = *(const u32x2*)(PROJ + (size_t)(t0 + i) * NPROJ + C_SB + ch);
            float4 cw[3];
#pragma unroll
            for (int j = 0; j < 3; ++j) cw[j] = *(const float4*)(sconv + j * 256 + ch);
            float p[10][4];
#pragma unroll
            for (int j = 0; j < 10; ++j) { p[j][0] = bf_lo(wc[j].x) * bf_lo(wh[j].x); p[j][1] = bf_hi(wc[j].x) * bf_hi(wh[j].x); p[j][2] = bf_lo(wc[j].y) * bf_lo(wh[j].y); p[j][3] = bf_hi(wc[j].y) * bf_hi(wh[j].y); }
#pragma unroll
            for (int i = 0; i < 8; ++i) {
                const float a0 = cw[0].x * p[i][0] + cw[1].x * p[i + 1][0] + cw[2].x * p[i + 2][0], a1 = cw[0].y * p[i][1] + cw[1].y * p[i + 1][1] + cw[2].y * p[i + 2][1];
                const float a2 = cw[0].z * p[i][2] + cw[1].z * p[i + 1][2] + cw[2].z * p[i + 2][2], a3 = cw[0].w * p[i][3] + cw[1].w * p[i + 1][3] + cw[2].w * p[i + 2][3];
                u32x2 o; o.x = pk2(bf_lo(wb[i].x) * a0, bf_hi(wb[i].x) * a1); o.y = pk2(bf_lo(wb[i].y) * a2, bf_hi(wb[i].y) * a3);
                *(u32x2*)(MIXED + (size_t)(t0 + i) * 1024 + 512 + ch) = o;
            }
        }
    }
}

__device__ __forceinline__ void gdn_seq_unit(Ctx& c, const Args& A, int u) {
    const int bh = u >> 1, j0 = (u & 1) * 64, b = bh >> 2, h = bh & 3, tid = c.tid, lane = c.lane;
    const bf16_t* QKVC = (const bf16_t*)(A.ws + WS_QKVC); const float* GB = (const float*)(A.ws + WS_GB); float* OG = (float*)(A.ws + WS_OGDN);
    LAS float* kq = (LAS float*)c.lds;
    LAS float* vv = (LAS float*)(c.lds + 65536);
    LAS float* bg = (LAS float*)(c.lds + 65536 + 16384);
    float S[128];
#pragma unroll
    for (int d = 0; d < 128; ++d) S[d] = 0.f;
    for (int ck = 0; ck < 32; ++ck) {
        const int t0 = b * SEQ + ck * 64;
        __syncthreads();
        for (int e = tid; e < 64 * 128; e += 512) { const int i = e >> 7, p = (e & 127) * 2;
            const int col = p < 128 ? (C_GK + h * 128 + p) : (C_GQ + h * 128 + (p - 128));
            const unsigned w = *(const unsigned*)(QKVC + (size_t)(t0 + i) * 1536 + col); kq[i * 256 + p] = bf_lo(w); kq[i * 256 + p + 1] = bf_hi(w); }
        for (int e = tid; e < 64 * 32; e += 512) { const int i = e >> 5, p = (e & 31) * 2; const unsigned w = *(const unsigned*)(QKVC + (size_t)(t0 + i) * 1536 + C_GV + h * 128 + j0 + p); vv[i * 64 + p] = bf_lo(w); vv[i * 64 + p + 1] = bf_hi(w); }
        if (tid < 64) { bg[tid] = GB[(size_t)(t0 + tid) * 8 + h]; bg[64 + tid] = __expf(GB[(size_t)(t0 + tid) * 8 + 4 + h]); }
        __syncthreads();
        if (c.wave == 0) {
            for (int i = 0; i < 64; ++i) {
                const float beta = bg[i], al = bg[64 + i]; const LAS f32x4* kr = (const LAS f32x4*)(kq + i * 256); const LAS f32x4* qr = kr + 32;
                float ks = 0.f;
#pragma unroll
                for (int dg = 0; dg < 4; ++dg) {
#pragma unroll
                    for (int dd = 0; dd < 8; ++dd) { const int d4 = dg * 8 + dd; const f32x4 k4 = kr[d4]; ks += (k4.x * S[4 * d4] + k4.y * S[4 * d4 + 1]) + (k4.z * S[4 * d4 + 2] + k4.w * S[4 * d4 + 3]); }
                    asm volatile("" ::: "memory"); }
                const float delta = beta * (vv[i * 64 + lane] - al * ks); float o = 0.f;
#pragma unroll
                for (int dg = 0; dg < 8; ++dg) {
#pragma unroll
                    for (int dd = 0; dd < 4; ++dd) { const int d4 = dg * 4 + dd; const f32x4 k4 = kr[d4], q4 = qr[d4];
                        S[4 * d4] = al * S[4 * d4] + k4.x * delta; S[4 * d4 + 1] = al * S[4 * d4 + 1] + k4.y * delta; S[4 * d4 + 2] = al * S[4 * d4 + 2] + k4.z * delta; S[4 * d4 + 3] = al * S[4 * d4 + 3] + k4.w * delta;
                        o += (q4.x * S[4 * d4] + q4.y * S[4 * d4 + 1]) + (q4.z * S[4 * d4 + 2] + q4.w * S[4 * d4 + 3]); }
                    asm volatile("" ::: "memory"); }
                OG[(size_t)(t0 + i) * 512 + h * 128 + j0 + lane] = o * 0.08838834764831845f;
            }
        }
    }
    __syncthreads();
}
constexpr int GCH_BYTES = 73728, GCH_WM = 0, GCH_QM = 16384, GCH_KT = 32768, GCH_AM = 49152, GCH_UT = 57344;
__device__ __forceinline__ bf16x8 pack_frag(const f32x4& a, const f32x4& b) { u32x4 w; w.x = pg8::cvt_pk_bf16(a[0], a[1]); w.y = pg8::cvt_pk_bf16(a[2], a[3]); w.z = pg8::cvt_pk_bf16(b[0], b[1]); w.w = pg8::cvt_pk_bf16(b[2], b[3]); return __builtin_bit_cast(bf16x8, w); }
__device__ __forceinline__ void gdn_chunk_unit(Ctx& c, const Args& A, int unit) {
    const int tid = c.tid, lane = c.lane, wave = c.wave, fr = lane & 15, fq = lane >> 4;
    const int bh = unit >> 5, ck = unit & 31, b = bh >> 2, h = bh & 3, t0 = b * SEQ + ck * 64;
    const bf16_t* QKVC = (const bf16_t*)(A.ws + WS_QKVC); const float* GB = (const float*)(A.ws + WS_GB); float* GL = (float*)(A.ws + WS_GB + 512 * 1024);
    unsigned char* rec = A.ws + WS_GCH + (size_t)unit * GCH_BYTES;
    LAS float* gcs = (LAS float*)c.lds;
    LAS float* bet = gcs + 64;
    LAS float* Lm = (LAS float*)(c.lds + 512);
    LAS bf16_t* Tb = (LAS bf16_t*)(c.lds + 512 + 16384);
    LAS bf16_t* vt = Tb + 64 * 72;
    LAS bf16_t* kt = vt + 128 * 72;
    LAS bf16_t* k2 = kt + 128 * 72;
    __syncthreads();
    if (tid < 64) { float g = GB[(size_t)(t0 + tid) * 8 + 4 + h];
#pragma unroll
        for (int o = 1; o < 64; o <<= 1) { const float n = __shfl_up(g, o); if (lane >= o) g += n; }
        gcs[tid] = g; bet[tid] = GB[(size_t)(t0 + tid) * 8 + h]; }
    __syncthreads();
#pragma unroll 1
    for (int bb = 0; bb < 2; ++bb) {
        const int blk = wave * 2 + bb, ib = blk >> 2, jb = blk & 3;
        f32x4 kk = (f32x4){0.f, 0.f, 0.f, 0.f}, qk = (f32x4){0.f, 0.f, 0.f, 0.f};
        if (jb <= ib) {
            const bf16_t* ki = QKVC + (size_t)(t0 + ib * 16 + fr) * 1536 + C_GK + h * 128 + 8 * fq; const bf16_t* qi = QKVC + (size_t)(t0 + ib * 16 + fr) * 1536 + C_GQ + h * 128 + 8 * fq;
            const bf16_t* kj = QKVC + (size_t)(t0 + jb * 16 + fr) * 1536 + C_GK + h * 128 + 8 * fq;
#pragma unroll
            for (int ks = 0; ks < 4; ++ks) { const bf16x8 a = *(const bf16x8*)(ki + ks * 32), q = *(const bf16x8*)(qi + ks * 32), bj = *(const bf16x8*)(kj + ks * 32);
                kk = __builtin_amdgcn_mfma_f32_16x16x32_bf16(a, bj, kk, 0, 0, 0); qk = __builtin_amdgcn_mfma_f32_16x16x32_bf16(q, bj, qk, 0, 0, 0); }
        }
        const int j = jb * 16 + fr; const float gj = gcs[j]; bf16_t* AM = (bf16_t*)(rec + GCH_AM);
#pragma unroll
        for (int r = 0; r < 4; ++r) { const int i = ib * 16 + 4 * fq + r; const float dec = i >= j ? __expf(gcs[i] - gj) : 0.f;
            Lm[i * 64 + j] = i > j ? bet[i] * kk[r] * dec : 0.f;
            AM[i * 64 + kperm(j)] = (bf16_t)f2bf(qk[r] * dec * 0.08838834764831845f); }
    }
    __syncthreads();
    if (wave == 0) {
        float Tc[64];
#pragma unroll
        for (int i = 0; i < 64; ++i) { float acc = (lane == i) ? 1.f : 0.f;
#pragma unroll
            for (int j4 = 0; j4 < (i + 3) / 4; ++j4) { const f32x4 l4 = *(const LAS f32x4*)(Lm + i * 64 + 4 * j4);
#pragma unroll
                for (int x = 0; x < 4; ++x) if (4 * j4 + x < i) acc -= l4[x] * Tc[4 * j4 + x]; }
            Tc[i] = acc; Tb[i * 72 + lane] = (bf16_t)f2bf(acc); }
    } else {
        const float glast = gcs[63];
        for (int e = tid - 64; e < 64 * 16; e += 448) { const int j = e >> 4, d8 = (e & 15) * 8; const float bj = bet[j], gj = gcs[j]; const float s1 = bj * __expf(gj), s2 = __expf(glast - gj);
            const u32x4 kw = *(const u32x4*)(QKVC + (size_t)(t0 + j) * 1536 + C_GK + h * 128 + d8), vw = *(const u32x4*)(QKVC + (size_t)(t0 + j) * 1536 + C_GV + h * 128 + d8);
            const float kf[8] = {bf_lo(kw.x), bf_hi(kw.x), bf_lo(kw.y), bf_hi(kw.y), bf_lo(kw.z), bf_hi(kw.z), bf_lo(kw.w), bf_hi(kw.w)};
            const float vf[8] = {bf_lo(vw.x), bf_hi(vw.x), bf_lo(vw.y), bf_hi(vw.y), bf_lo(vw.z), bf_hi(vw.z), bf_lo(vw.w), bf_hi(vw.w)};
            const int jp = kperm(j);
#pragma unroll
            for (int x = 0; x < 8; ++x) { vt[(d8 + x) * 72 + j] = (bf16_t)f2bf(vf[x] * bj); kt[(d8 + x) * 72 + j] = (bf16_t)f2bf(kf[x] * s1); k2[(d8 + x) * 72 + jp] = (bf16_t)f2bf(kf[x] * s2); }
        }
        bf16_t* QM = (bf16_t*)(rec + GCH_QM);
        for (int e = tid - 64; e < 64 * 16; e += 448) { const int j = e >> 4, m8 = e & 15, m = m8 & 3; const float s = __expf(gcs[j]) * 0.08838834764831845f;
            const u32x4 qw = *(const u32x4*)(QKVC + (size_t)(t0 + j) * 1536 + C_GQ + h * 128 + m8 * 8);
            const int pos = (m8 >> 2) * 32 + 16 * (m & 1) + 4 * (m >> 1);
            u32x2 w0, w1; w0.x = pk2(bf_lo(qw.x) * s, bf_hi(qw.x) * s); w0.y = pk2(bf_lo(qw.y) * s, bf_hi(qw.y) * s); w1.x = pk2(bf_lo(qw.z) * s, bf_hi(qw.z) * s); w1.y = pk2(bf_lo(qw.w) * s, bf_hi(qw.w) * s);
            *(u32x2*)(QM + j * 128 + pos) = w0; *(u32x2*)(QM + j * 128 + pos + 8) = w1; }
        if (tid == 64) GL[unit] = glast;
    }
    __syncthreads();
    {
        f32x4 ua[4], wa[4];
#pragma unroll
        for (int mb = 0; mb < 4; ++mb) { ua[mb] = (f32x4){0.f, 0.f, 0.f, 0.f}; wa[mb] = (f32x4){0.f, 0.f, 0.f, 0.f}; }
#pragma unroll
        for (int ks = 0; ks < 2; ++ks) {
            const bf16x8 vf = *(const LAS bf16x8*)(vt + (16 * wave + fr) * 72 + ks * 32 + 8 * fq), kf = *(const LAS bf16x8*)(kt + (16 * wave + fr) * 72 + ks * 32 + 8 * fq);
#pragma unroll
            for (int mb = 0; mb < 4; ++mb) { const bf16x8 tf = *(const LAS bf16x8*)(Tb + (16 * mb + fr) * 72 + ks * 32 + 8 * fq);
                ua[mb] = __builtin_amdgcn_mfma_f32_16x16x32_bf16(tf, vf, ua[mb], 0, 0, 0);
                wa[mb] = __builtin_amdgcn_mfma_f32_16x16x32_bf16(kf, tf, wa[mb], 0, 0, 0); }
        }
        bf16_t* UT = (bf16_t*)(rec + GCH_UT); bf16_t* WM = (bf16_t*)(rec + GCH_WM);
#pragma unroll
        for (int mb = 0; mb < 4; ++mb) { u32x2 w; w.x = pk2(ua[mb][0], ua[mb][1]); w.y = pk2(ua[mb][2], ua[mb][3]); *(u32x2*)(UT + (16 * wave + fr) * 64 + 16 * mb + 4 * fq) = w;
            u32x2 v; v.x = pk2(wa[mb][0], wa[mb][1]); v.y = pk2(wa[mb][2], wa[mb][3]); *(u32x2*)(WM + (16 * mb + fr) * 128 + kperm(16 * wave + 4 * fq)) = v; }
        bf16_t* KT = (bf16_t*)(rec + GCH_KT);
#pragma unroll
        for (int k = 0; k < 2; ++k) { const int e = tid + 512 * k, row = e >> 3, cc = e & 7; *(u32x4*)(KT + row * 64 + cc * 8) = *(const LAS u32x4*)(k2 + row * 72 + cc * 8); }
    }
}
struct GaUnit { int t0, h; unsigned char* rec; };
__device__ __forceinline__ GaUnit ga_unit(const Args& A, int unit) { GaUnit u; const int bh = unit >> 5, ck = unit & 31; u.h = bh & 3; u.t0 = (bh >> 2) * SEQ + ck * 64; u.rec = A.ws + WS_GCH + (size_t)unit * GCH_BYTES; return u; }
__device__ __forceinline__ void ga_stage(const GaUnit& u, const bf16_t* QKVC, const LAS float* gcs, const LAS float* bet, LAS bf16_t* vt, LAS bf16_t* kt, LAS bf16_t* k2, int rel, int nth) {
    const float glast = gcs[63];
#pragma unroll 3
    for (int e = rel; e < 64 * 16; e += nth) { const int j = e >> 4, d8 = (e & 15) * 8; const float bj = bet[j], gj = gcs[j]; const float s1 = bj * __expf(gj), s2 = __expf(glast - gj);
        const u32x4 kw = *(const u32x4*)(QKVC + (size_t)(u.t0 + j) * 1536 + C_GK + u.h * 128 + d8), vw = *(const u32x4*)(QKVC + (size_t)(u.t0 + j) * 1536 + C_GV + u.h * 128 + d8);
        const float kf[8] = {bf_lo(kw.x), bf_hi(kw.x), bf_lo(kw.y), bf_hi(kw.y), bf_lo(kw.z), bf_hi(kw.z), bf_lo(kw.w), bf_hi(kw.w)};
        const float vf[8] = {bf_lo(vw.x), bf_hi(vw.x), bf_lo(vw.y), bf_hi(vw.y), bf_lo(vw.z), bf_hi(vw.z), bf_lo(vw.w), bf_hi(vw.w)};
        const int jp = kperm(j);
#pragma unroll
        for (int x = 0; x < 8; ++x) { vt[(d8 + x) * 72 + j] = (bf16_t)f2bf(vf[x] * bj); kt[(d8 + x) * 72 + j] = (bf16_t)f2bf(kf[x] * s1); k2[(d8 + x) * 72 + jp] = (bf16_t)f2bf(kf[x] * s2); }
    }
}
__device__ __forceinline__ void ga_qm(const GaUnit& u, const bf16_t* QKVC, const LAS float* gcs, int rel, int nth) {
    bf16_t* QM = (bf16_t*)(u.rec + GCH_QM);
#pragma unroll 3
    for (int e = rel; e < 64 * 16; e += nth) { const int j = e >> 4, m8 = e & 15, m = m8 & 3; const float s = __expf(gcs[j]) * 0.08838834764831845f;
        const u32x4 qw = *(const u32x4*)(QKVC + (size_t)(u.t0 + j) * 1536 + C_GQ + u.h * 128 + m8 * 8);
        const int pos = (m8 >> 2) * 32 + 16 * (m & 1) + 4 * (m >> 1);
        u32x2 w0, w1; w0.x = pk2(bf_lo(qw.x) * s, bf_hi(qw.x) * s); w0.y = pk2(bf_lo(qw.y) * s, bf_hi(qw.y) * s); w1.x = pk2(bf_lo(qw.z) * s, bf_hi(qw.z) * s); w1.y = pk2(bf_lo(qw.w) * s, bf_hi(qw.w) * s);
        *(u32x2*)(QM + j * 128 + pos) = w0; *(u32x2*)(QM + j * 128 + pos + 8) = w1; }
}
__device__ __forceinline__ void ga_uw(const GaUnit& u, const LAS bf16_t* Tb, const LAS bf16_t* vt, const LAS bf16_t* kt, const LAS bf16_t* k2, int tid, int wave, int fr, int fq) {
    f32x4 ua[4], wa[4];
#pragma unroll
    for (int mb = 0; mb < 4; ++mb) { ua[mb] = (f32x4){0.f, 0.f, 0.f, 0.f}; wa[mb] = (f32x4){0.f, 0.f, 0.f, 0.f}; }
#pragma unroll
    for (int ks = 0; ks < 2; ++ks) {
        const bf16x8 vf = *(const LAS bf16x8*)(vt + (16 * wave + fr) * 72 + ks * 32 + 8 * fq), kf = *(const LAS bf16x8*)(kt + (16 * wave + fr) * 72 + ks * 32 + 8 * fq);
#pragma unroll
        for (int mb = 0; mb < 4; ++mb) { const bf16x8 tf = *(const LAS bf16x8*)(Tb + (16 * mb + fr) * 72 + ks * 32 + 8 * fq);
            ua[mb] = __builtin_amdgcn_mfma_f32_16x16x32_bf16(tf, vf, ua[mb], 0, 0, 0);
            wa[mb] = __builtin_amdgcn_mfma_f32_16x16x32_bf16(kf, tf, wa[mb], 0, 0, 0); }
    }
    bf16_t* UT = (bf16_t*)(u.rec + GCH_UT); bf16_t* WM = (bf16_t*)(u.rec + GCH_WM);
#pragma unroll
    for (int mb = 0; mb < 4; ++mb) { u32x2 w; w.x = pk2(ua[mb][0], ua[mb][1]); w.y = pk2(ua[mb][2], ua[mb][3]); *(u32x2*)(UT + (16 * wave + fr) * 64 + 16 * mb + 4 * fq) = w;
        u32x2 v; v.x = pk2(wa[mb][0], wa[mb][1]); v.y = pk2(wa[mb][2], wa[mb][3]); *(u32x2*)(WM + (16 * mb + fr) * 128 + kperm(16 * wave + 4 * fq)) = v; }
    bf16_t* KT = (bf16_t*)(u.rec + GCH_KT);
#pragma unroll
    for (int k = 0; k < 2; ++k) { const int e = tid + 512 * k, row = e >> 3, cc = e & 7; *(u32x4*)(KT + row * 64 + cc * 8) = *(const LAS u32x4*)(k2 + row * 72 + cc * 8); }
}
__device__ __forceinline__ void gdn_chunk_pair(Ctx& c, const Args& A, int unit0, int unit1) {
    const int tid = c.tid, lane = c.lane, wave = c.wave, fr = lane & 15, fq = lane >> 4;
    const bf16_t* QKVC = (const bf16_t*)(A.ws + WS_QKVC); const float* GB = (const float*)(A.ws + WS_GB); float* GL = (float*)(A.ws + WS_GB + 512 * 1024);
    LAS float* gcs = (LAS float*)c.lds;
    LAS float* bet = gcs + 128;
    LAS float* Lm = (LAS float*)(c.lds + 1024);
    LAS bf16_t* Tb = (LAS bf16_t*)(c.lds + 33792);
    LAS bf16_t* vt = (LAS bf16_t*)(c.lds + 52224);
    LAS bf16_t* kt = vt + 128 * 72; LAS bf16_t* k2 = kt + 128 * 72;
    const GaUnit U0 = ga_unit(A, unit0), U1 = ga_unit(A, unit1);
    __syncthreads();
    if (tid < 128) { const GaUnit& u = wave ? U1 : U0; float g = GB[(size_t)(u.t0 + lane) * 8 + 4 + u.h];
#pragma unroll
        for (int o = 1; o < 64; o <<= 1) { const float n = __shfl_up(g, o); if (lane >= o) g += n; }
        gcs[wave * 64 + lane] = g; bet[wave * 64 + lane] = GB[(size_t)(u.t0 + lane) * 8 + u.h]; }
    __syncthreads();
#pragma unroll 2
    for (int bb = 0; bb < 4; ++bb) {
        const int idx = wave * 4 + bb, p = idx >> 4, blk = idx & 15, ib = blk >> 2, jb = blk & 3; const GaUnit& u = p ? U1 : U0;
        f32x4 kk = (f32x4){0.f, 0.f, 0.f, 0.f}, qk = (f32x4){0.f, 0.f, 0.f, 0.f};
        if (jb <= ib) {
            const bf16_t* ki = QKVC + (size_t)(u.t0 + ib * 16 + fr) * 1536 + C_GK + u.h * 128 + 8 * fq; const bf16_t* qi = QKVC + (size_t)(u.t0 + ib * 16 + fr) * 1536 + C_GQ + u.h * 128 + 8 * fq;
            const bf16_t* kj = QKVC + (size_t)(u.t0 + jb * 16 + fr) * 1536 + C_GK + u.h * 128 + 8 * fq;
#pragma unroll
            for (int ks = 0; ks < 4; ++ks) { const bf16x8 a = *(const bf16x8*)(ki + ks * 32), q = *(const bf16x8*)(qi + ks * 32), bj = *(const bf16x8*)(kj + ks * 32);
                kk = __builtin_amdgcn_mfma_f32_16x16x32_bf16(a, bj, kk, 0, 0, 0); qk = __builtin_amdgcn_mfma_f32_16x16x32_bf16(q, bj, qk, 0, 0, 0); }
        }
        const int j = jb * 16 + fr; const float gj = gcs[p * 64 + j]; bf16_t* AM = (bf16_t*)(u.rec + GCH_AM);
#pragma unroll
        for (int r = 0; r < 4; ++r) { const int i = ib * 16 + 4 * fq + r; const float dec = i >= j ? __expf(gcs[p * 64 + i] - gj) : 0.f;
            Lm[p * 4096 + i * 64 + j] = i > j ? bet[p * 64 + i] * kk[r] * dec : 0.f;
            AM[i * 64 + kperm(j)] = (bf16_t)f2bf(qk[r] * dec * 0.08838834764831845f); }
    }
    __syncthreads();
    if (wave < 2) {
        const LAS float* L = Lm + wave * 4096; LAS bf16_t* Tw = Tb + wave * 64 * 72;
        float Tc[64];
#pragma unroll
        for (int i = 0; i < 64; ++i) { float ac[4] = {(lane == i) ? 1.f : 0.f, 0.f, 0.f, 0.f};
#pragma unroll
            for (int j4 = 0; j4 < (i + 3) / 4; ++j4) { const f32x4 l4 = *(const LAS f32x4*)(L + i * 64 + 4 * j4);
#pragma unroll
                for (int x = 0; x < 4; ++x) if (4 * j4 + x < i) ac[x] -= l4[x] * Tc[4 * j4 + x]; }
            const float acc = (ac[0] + ac[1]) + (ac[2] + ac[3]);
            Tc[i] = acc; Tw[i * 72 + lane] = (bf16_t)f2bf(acc); }
    } else {
        ga_stage(U0, QKVC, gcs, bet, vt, kt, k2, tid - 128, 384);
        ga_qm(U0, QKVC, gcs, tid - 128, 384); ga_qm(U1, QKVC, gcs + 64, tid - 128, 384);
        if (tid == 128) { GL[unit0] = gcs[63]; GL[unit1] = gcs[127]; }
    }
    __syncthreads();
    ga_uw(U0, Tb, vt, kt, k2, tid, wave, fr, fq);
    __syncthreads();
    ga_stage(U1, QKVC, gcs + 64, bet + 64, vt, kt, k2, tid, 512);
    __syncthreads();
    ga_uw(U1, Tb + 64 * 72, vt, kt, k2, tid, wave, fr, fq);
}
__device__ __forceinline__ void gdn_scan(Ctx& c, const Args& A, int unit) {
    const int bh = unit >> 1, dv0 = (unit & 1) * 64 + 16 * (c.wave & 3); const bool active = c.wave < 4;
    const int tid = c.tid, lane = c.lane, fr = lane & 15, fq = lane >> 4, b = bh >> 2, h = bh & 3;
    constexpr int L_WM = 0, L_QM = 17408, L_KT = 34816, L_AM = 53248, L_BUF = 62464;
    const unsigned char* rec0 = A.ws + WS_GCH + (size_t)bh * 32 * GCH_BYTES; const float* GL = (const float*)(A.ws + WS_GB + 512 * 1024) + bh * 32; float* OG = (float*)(A.ws + WS_OGDN);
    f32x4 S[8];
#pragma unroll
    for (int i = 0; i < 8; ++i) S[i] = (f32x4){0.f, 0.f, 0.f, 0.f};
    u32x4 pre[14]; const int t2 = tid - 256;
#define GDN_LOAD(rec) do { _Pragma("unroll") for (int k = 0; k < 14; ++k) pre[k] = *(const u32x4*)((rec) + (size_t)(t2 + 256 * k) * 16); } while (0)
#define GDN_STORE(base) do { \
        _Pragma("unroll") for (int k = 0; k < 4; ++k) { const int q = t2 + 256 * k; *(LAS u32x4*)((base) + L_WM + (q >> 4) * 272 + (q & 15) * 16) = pre[k]; *(LAS u32x4*)((base) + L_QM + (q >> 4) * 272 + (q & 15) * 16) = pre[4 + k]; \
            *(LAS u32x4*)((base) + L_KT + (q >> 3) * 144 + (q & 7) * 16) = pre[8 + k]; } \
        _Pragma("unroll") for (int k = 0; k < 2; ++k) { const int q = t2 + 256 * k; *(LAS u32x4*)((base) + L_AM + (q >> 3) * 144 + (q & 7) * 16) = pre[12 + k]; } } while (0)
    __syncthreads();
    if (!active) { GDN_LOAD(rec0); GDN_STORE(c.lds); }
    u32x2 uwc[4], uwn[4]; float glc = GL[0], gln = 0.f;
#pragma unroll
    for (int mb = 0; mb < 4; ++mb) { uwc[mb] = *(const u32x2*)((const bf16_t*)(rec0 + GCH_UT) + (dv0 + fr) * 64 + 16 * mb + 4 * fq); uwn[mb] = uwc[mb]; }
    __syncthreads();
#pragma unroll 1
    for (int ck = 0; ck < 32; ++ck) {
        const unsigned char* rec = rec0 + (size_t)ck * GCH_BYTES; LAS unsigned char* B0 = c.lds + (ck & 1) * L_BUF; const int t0 = b * SEQ + ck * 64;
        if (ck + 1 < 32) { if (!active) GDN_LOAD(rec + GCH_BYTES); const bf16_t* UTn = (const bf16_t*)(rec + GCH_BYTES + GCH_UT);
#pragma unroll
            for (int mb = 0; mb < 4; ++mb) uwn[mb] = *(const u32x2*)(UTn + (dv0 + fr) * 64 + 16 * mb + 4 * fq); gln = GL[ck + 1]; }
        if (active) {
        bf16x8 sB[4];
#pragma unroll
        for (int ks = 0; ks < 4; ++ks) sB[ks] = pack_frag(S[2 * ks], S[2 * ks + 1]);
        f32x4 vn[4], oa[4];
#pragma unroll
        for (int mb = 0; mb < 4; ++mb) { f32x4 p = (f32x4){0.f, 0.f, 0.f, 0.f}, o = (f32x4){0.f, 0.f, 0.f, 0.f};
#pragma unroll
            for (int ks = 0; ks < 4; ++ks) { const bf16x8 aw = *(const LAS bf16x8*)(B0 + L_WM + (16 * mb + fr) * 272 + ks * 64 + fq * 16), aq = *(const LAS bf16x8*)(B0 + L_QM + (16 * mb + fr) * 272 + ks * 64 + fq * 16);
                p = __builtin_amdgcn_mfma_f32_16x16x32_bf16(aw, sB[ks], p, 0, 0, 0); o = __builtin_amdgcn_mfma_f32_16x16x32_bf16(aq, sB[ks], o, 0, 0, 0); }
            const u32x2 uw = uwc[mb];
            vn[mb] = (f32x4){bf_lo(uw.x) - p[0], bf_hi(uw.x) - p[1], bf_lo(uw.y) - p[2], bf_hi(uw.y) - p[3]}; oa[mb] = o; }
        bf16x8 vB[2];
#pragma unroll
        for (int s = 0; s < 2; ++s) vB[s] = pack_frag(vn[2 * s], vn[2 * s + 1]);
#pragma unroll
        for (int mb = 0; mb < 4; ++mb) {
#pragma unroll
            for (int s = 0; s < 2; ++s) { const bf16x8 aa = *(const LAS bf16x8*)(B0 + L_AM + (16 * mb + fr) * 144 + s * 64 + fq * 16); oa[mb] = __builtin_amdgcn_mfma_f32_16x16x32_bf16(aa, vB[s], oa[mb], 0, 0, 0); }
#pragma unroll
            for (int r = 0; r < 4; ++r) OG[(size_t)(t0 + 16 * mb + 4 * fq + r) * 512 + h * 128 + dv0 + fr] = oa[mb][r]; }
        const float gl = __expf(glc);
#pragma unroll
        for (int m8 = 0; m8 < 8; ++m8) { f32x4 s = S[m8] * gl;
#pragma unroll
            for (int s2 = 0; s2 < 2; ++s2) { const bf16x8 ak = *(const LAS bf16x8*)(B0 + L_KT + (16 * m8 + fr) * 144 + s2 * 64 + fq * 16); s = __builtin_amdgcn_mfma_f32_16x16x32_bf16(ak, vB[s2], s, 0, 0, 0); }
            S[m8] = s; }
        }
        if (ck + 1 < 32 && !active) GDN_STORE(c.lds + ((ck + 1) & 1) * L_BUF);
#pragma unroll
        for (int mb = 0; mb < 4; ++mb) uwc[mb] = uwn[mb];
        glc = gln;
        __syncthreads();
    }
#undef GDN_LOAD
#undef GDN_STORE
}
__device__ __forceinline__ int rel_bucket(int n) {
    if (n < 16) return n;
    const int v = 16 + (int)(__logf((float)n * (1.0f / 16.0f)) / 2.0794415416798357f * 16.0f);
    return v < 31 ? v : 31;
}
__device__ __forceinline__ void attn_mfma(Ctx& c, const Args& A, int l, int first_block, int nblocks) {
    const int tid = c.tid, lane = c.lane, wave = c.wave, fr = lane & 15, fq = lane >> 4;
    const bf16_t* AQ = (const bf16_t*)(A.ws + WS_AQ); const bf16_t* AK = (const bf16_t*)(A.ws + WS_AK); const bf16_t* AVT = (const bf16_t*)(A.ws + WS_AVT); bf16_t* MIXED = (bf16_t*)(A.ws + WS_MIXED);
    LAS float* bt = (LAS float*)c.lds;
    LAS float* cs = bt + 512;
    const float* rel_bias = A.in[1]; const float* lamp = A.in[11] + l * 128; const float* subln = A.in[12] + l * 64;
    const float lambda_init = 0.8f - 0.6f * __expf(-0.3f * (float)l);
    __syncthreads();
    {
        float mq = 0.f, mk = 0.f, mb = 0.f;
        for (int d = 0; d < 32; ++d) { mq = fmaxf(mq, fabsf(A.in[9][l * 32 + d])); mk = fmaxf(mk, fabsf(A.in[10][l * 32 + d])); }
        for (int i = 0; i < 128; ++i) mb = fmaxf(mb, fabsf(rel_bias[i]));
        const float cshift = 5.656854249492381f * mq * mk + mb;
        const int n = tid & 127, hh = tid >> 7; bt[hh * 128 + n] = (rel_bias[rel_bucket(n) * 4 + hh] - cshift) * 1.4426950408889634f;
        if (tid == 0) { float s01 = 0.f, s23 = 0.f; for (int d = 0; d < 32; ++d) { s01 += lamp[d] * lamp[32 + d]; s23 += lamp[64 + d] * lamp[96 + d]; } cs[0] = __expf(s01) - __expf(s23) + lambda_init; }
    }
    __syncthreads();
    const float lam = cs[0];
    bf16x8 ones; { const short o = (fr == 0) ? (short)0x3f80 : (short)0; ones = (bf16x8){o, o, o, o, o, o, o, o}; }
    constexpr int AT_K = 4096, AT_V = 4096 + 4608, AT_BUF = 9728;
    const int wg = c.bid - first_block;
#pragma unroll 1
    for (int rd = 0; rd * nblocks < 256; ++rd) {
        const int it = rd * nblocks + ((rd & 1) ? nblocks - 1 - wg : wg); if (it >= 256) continue;
        const int bh = it & 31, QB = 7 - (it >> 5), b = bh >> 2, h = bh & 3, q0 = QB * 256 + 32 * wave, nsteps = 8 * QB + 8;
        const float bfar = bt[h * 128 + 127];
        bf16x8 qf[2][2];
#pragma unroll
        for (int m = 0; m < 2; ++m)
#pragma unroll
            for (int nq = 0; nq < 2; ++nq) qf[m][nq] = *(const bf16x8*)(AQ + (size_t)(b * SEQ + q0 + nq * 16 + fr) * 256 + h * 64 + m * 32 + 8 * fq);
        f32x4 oacc[2][2][4], lacc[2][2];
#pragma unroll
        for (int m = 0; m < 2; ++m)
#pragma unroll
            for (int nq = 0; nq < 2; ++nq) { lacc[m][nq] = (f32x4){0.f, 0.f, 0.f, 0.f};
#pragma unroll
                for (int nb = 0; nb < 4; ++nb) oacc[m][nq][nb] = (f32x4){0.f, 0.f, 0.f, 0.f}; }
        const int t2 = tid & 255; const bool isK = tid < 256;
        const bf16_t* gsrc = isK ? AK + (size_t)(b * SEQ + (t2 >> 3)) * 256 + h * 64 + (t2 & 7) * 8 : AVT + ((size_t)bh * 64 + (t2 >> 2)) * SEQ + (t2 & 3) * 8;
        const size_t gstep = isK ? (size_t)32 * 256 : (size_t)32;
        const int ldst = isK ? AT_K + (t2 >> 3) * 144 + (t2 & 7) * 16 : AT_V + (t2 >> 2) * 80 + (t2 & 3) * 16;
        __syncthreads();
        u32x4 pre = *(const u32x4*)gsrc; *(LAS u32x4*)(c.lds + ldst) = pre;
        __syncthreads();
#pragma unroll 1
        for (int st = 0; st < nsteps; ++st) {
            const int k0 = st * 32; const LAS unsigned char* B0 = c.lds + (st & 1) * AT_BUF;
            if (st + 1 < nsteps) pre = *(const u32x4*)(gsrc + (size_t)(st + 1) * gstep);
            if (k0 <= q0) {
            bf16x8 kf[2][2], vf[4];
#pragma unroll
            for (int m = 0; m < 2; ++m)
#pragma unroll
                for (int kb = 0; kb < 2; ++kb) kf[m][kb] = *(const LAS bf16x8*)(B0 + AT_K + (kb * 16 + fr) * 144 + m * 64 + fq * 16);
#pragma unroll
            for (int nb = 0; nb < 4; ++nb) vf[nb] = *(const LAS bf16x8*)(B0 + AT_V + (16 * nb + fr) * 80 + fq * 16);
            const bool nearby = (k0 + 144 > q0);
            f32x4 cin[2][2];
            if (nearby) {
#pragma unroll
                for (int nq = 0; nq < 2; ++nq)
#pragma unroll
                    for (int kb = 0; kb < 2; ++kb)
#pragma unroll
                        for (int r = 0; r < 4; ++r) { const int n = (q0 + nq * 16 + fr) - (k0 + kb * 16 + 4 * fq + r); cin[nq][kb][r] = n >= 0 ? bt[h * 128 + (n > 127 ? 127 : n)] : -1.0e30f; }
            } else {
#pragma unroll
                for (int nq = 0; nq < 2; ++nq)
#pragma unroll
                    for (int kb = 0; kb < 2; ++kb) cin[nq][kb] = (f32x4){bfar, bfar, bfar, bfar};
            }
#pragma unroll
            for (int m = 0; m < 2; ++m)
#pragma unroll
                for (int nq = 0; nq < 2; ++nq) {
                    f32x4 p[2];
#pragma unroll
                    for (int kb = 0; kb < 2; ++kb) {
                        f32x4 s = __builtin_amdgcn_mfma_f32_16x16x32_bf16(kf[m][kb], qf[m][nq], cin[nq][kb], 0, 0, 0);
#pragma unroll
                        for (int r = 0; r < 4; ++r) s[r] = __builtin_amdgcn_exp2f(s[r]);
                        p[kb] = s;
                    }
                    const bf16x8 pf = pack_frag(p[0], p[1]);
#pragma unroll
                    for (int nb = 0; nb < 4; ++nb) oacc[m][nq][nb] = __builtin_amdgcn_mfma_f32_16x16x32_bf16(vf[nb], pf, oacc[m][nq][nb], 0, 0, 0);
                    lacc[m][nq] = __builtin_amdgcn_mfma_f32_16x16x32_bf16(ones, pf, lacc[m][nq], 0, 0, 0);
                }
            }
            if (st + 1 < nsteps) *(LAS u32x4*)(c.lds + ((st + 1) & 1) * AT_BUF + ldst) = pre;
            __syncthreads();
        }
#pragma unroll
        for (int nq = 0; nq < 2; ++nq) {
            const float l0 = __shfl(lacc[0][nq][0], fr), l1 = __shfl(lacc[1][nq][0], fr);
            const float i0 = 1.0f / l0, i1 = lam / l1; float ss = 0.f; f32x4 o[4];
#pragma unroll
            for (int nb = 0; nb < 4; ++nb) { o[nb] = oacc[0][nq][nb] * i0 - oacc[1][nq][nb] * i1; ss += (o[nb][0] * o[nb][0] + o[nb][1] * o[nb][1]) + (o[nb][2] * o[nb][2] + o[nb][3] * o[nb][3]); }
            ss += lxf<16>(ss); ss += lxf<32>(ss);
            const float rn = rsqrtf(ss * (1.0f / 64.0f) + 1e-6f) * (1.0f - lambda_init);
            bf16_t* orow = MIXED + (size_t)(b * SEQ + q0 + nq * 16 + fr) * 1024 + 768 + h * 64;
#pragma unroll
            for (int nb = 0; nb < 4; ++nb) { const float4 sg = *(const float4*)(subln + 16 * nb + 4 * fq);
                u32x2 w; w.x = pk2(o[nb][0] * rn * sg.x, o[nb][1] * rn * sg.y); w.y = pk2(o[nb][2] * rn * sg.z, o[nb][3] * rn * sg.w);
                *(u32x2*)(orow + 16 * nb + 4 * fq) = w; }
        }
    }
    __syncthreads();
}
__device__ __forceinline__ void phase_gdn_out(Ctx& c, const Args& A, int l) {
    const int gw = c.bid * 8 + c.wave, NGW = c.G * 8, lane = c.lane;
    const bf16_t* PROJ = (const bf16_t*)(A.ws + WS_PROJ); const float* OG = (const float*)(A.ws + WS_OGDN); bf16_t* MIXED = (bf16_t*)(A.ws + WS_MIXED);
    const float4 g0 = *(const float4*)(A.in[7] + l * 128 + (lane & 15) * 8), g1 = *(const float4*)(A.in[7] + l * 128 + (lane & 15) * 8 + 4);
    for (int run = gw; run < T / 8; run += NGW) {
        const int t0 = run * 8; float4 oa[8], ob[8]; u32x4 zz[8];
#pragma unroll
        for (int i = 0; i < 8; ++i) { const float* op = OG + (size_t)(t0 + i) * 512 + lane * 8; oa[i] = *(const float4*)op; ob[i] = *(const float4*)(op + 4); zz[i] = *(const u32x4*)(PROJ + (size_t)(t0 + i) * NPROJ + C_GZ + lane * 8); }
#pragma unroll
        for (int i = 0; i < 8; ++i) {
            float ss = (oa[i].x * oa[i].x + oa[i].y * oa[i].y) + (oa[i].z * oa[i].z + oa[i].w * oa[i].w) + (ob[i].x * ob[i].x + ob[i].y * ob[i].y) + (ob[i].z * ob[i].z + ob[i].w * ob[i].w);
            ss += lxf<1>(ss); ss += lxf<2>(ss); ss += lxf<4>(ss); ss += lxf<8>(ss);
            const float r = rsqrtf(ss * (1.0f / 128.0f) + 1e-6f);
            u32x4 w; w.x = pk2(oa[i].x * r * g0.x * silu_f(bf_lo(zz[i].x)), oa[i].y * r * g0.y * silu_f(bf_hi(zz[i].x))); w.y = pk2(oa[i].z * r * g0.z * silu_f(bf_lo(zz[i].y)), oa[i].w * r * g0.w * silu_f(bf_hi(zz[i].y)));
            w.z = pk2(ob[i].x * r * g1.x * silu_f(bf_lo(zz[i].z)), ob[i].y * r * g1.y * silu_f(bf_hi(zz[i].z))); w.w = pk2(ob[i].z * r * g1.z * silu_f(bf_lo(zz[i].w)), ob[i].w * r * g1.w * silu_f(bf_hi(zz[i].w)));
            *(u32x4*)(MIXED + (size_t)(t0 + i) * 1024 + lane * 8) = w;
        }
    }
}

__device__ __forceinline__ unsigned ord_key(float f) { const unsigned u = __float_as_uint(f); return (u & 0x80000000u) ? ~u : (u | 0x80000000u); }
__device__ __forceinline__ float ord_val(unsigned o) { return __uint_as_float((o & 0x80000000u) ? (o & 0x7fffffffu) : ~o); }
__device__ __forceinline__ float gelu_erf(float v) {
    const float av = fabsf(v), t = __builtin_amdgcn_rcpf(av * 0.2316418882f + 1.0f);
    float q = t * 0.5307027145f + (-0.7265760135f); q = q * t + 0.7107068705f; q = q * t + (-0.142248368f); q = q * t + 0.127414796f; q = q * t;
    const float e = __builtin_amdgcn_exp2f((v * v) * (-0.72134752044f)); const float m = v * (q * e);
    return v < 0.f ? m : v - m;
}
typedef __bf16 v2bf_t __attribute__((ext_vector_type(2)));
__device__ __forceinline__ float dot2bf(unsigned a, unsigned b, float acc) { return __builtin_amdgcn_fdot2_f32_bf16(__builtin_bit_cast(v2bf_t, a), __builtin_bit_cast(v2bf_t, b), acc, false); }
__device__ __forceinline__ float dot8(const u32x4& x, const u32x4& u, float acc) { acc = dot2bf(x.x, u.x, acc); acc = dot2bf(x.y, u.y, acc); acc = dot2bf(x.z, u.z, acc); return dot2bf(x.w, u.w, acc); }
__device__ __forceinline__ void axpy8(float* o, float cf, const u32x4& v) {
    o[0] += cf * bf_lo(v.x); o[1] += cf * bf_hi(v.x); o[2] += cf * bf_lo(v.y); o[3] += cf * bf_hi(v.y); o[4] += cf * bf_lo(v.z); o[5] += cf * bf_hi(v.z); o[6] += cf * bf_lo(v.w); o[7] += cf * bf_hi(v.w); }
typedef float f32x2_t __attribute__((ext_vector_type(2)));
__device__ __forceinline__ void axpy16_fp8(float* o, float cf, const u32x4& v) {
    const unsigned w[4] = {v.x, v.y, v.z, v.w};
#pragma unroll
    for (int i = 0; i < 4; ++i) { const f32x2_t a = __builtin_amdgcn_cvt_pk_f32_fp8((int)w[i], false), b = __builtin_amdgcn_cvt_pk_f32_fp8((int)w[i], true);
        o[4 * i] += cf * a.x; o[4 * i + 1] += cf * a.y; o[4 * i + 2] += cf * b.x; o[4 * i + 3] += cf * b.y; }
}
typedef _Float16 v2h_t __attribute__((ext_vector_type(2)));
__device__ __forceinline__ unsigned pkh(float a, float b) { const v2h_t h = {(_Float16)a, (_Float16)b}; return __builtin_bit_cast(unsigned, h); }
typedef _Float16 v2h_t __attribute__((ext_vector_type(2)));
__device__ __forceinline__ float dot4_fp8(unsigned uw, unsigned xlo, unsigned xhi, float acc) {
    acc = __builtin_amdgcn_fdot2(__builtin_amdgcn_cvt_scalef32_pk_f16_fp8(uw, 1.0f, false), __builtin_bit_cast(v2h_t, xlo), acc, false);
    return __builtin_amdgcn_fdot2(__builtin_amdgcn_cvt_scalef32_pk_f16_fp8(uw, 1.0f, true), __builtin_bit_cast(v2h_t, xhi), acc, false);
}
__device__ __forceinline__ float dot16_fp8(const u32x4& x0, const u32x4& x1, const u32x4& u) {
    float acc = dot4_fp8(u.x, x0.x, x0.y, 0.f); acc = dot4_fp8(u.y, x0.z, x0.w, acc); acc = dot4_fp8(u.z, x1.x, x1.y, acc); return dot4_fp8(u.w, x1.z, x1.w, acc);
}
__device__ __forceinline__ void cvt16_fp8(float* f, const u32x4& v) {
    const unsigned w[4] = {v.x, v.y, v.z, v.w};
#pragma unroll
    for (int i = 0; i < 4; ++i) { const f32x2_t a = __builtin_amdgcn_cvt_pk_f32_fp8((int)w[i], false), b = __builtin_amdgcn_cvt_pk_f32_fp8((int)w[i], true); f[4 * i] = a.x; f[4 * i + 1] = a.y; f[4 * i + 2] = b.x; f[4 * i + 3] = b.y; }
}
__device__ __forceinline__ void phase_peer(Ctx& c, const Args& A, int l, float* hdst, bool fuse_next, const XcdBarrier& bar, bool align) {
    const int tid = c.tid, lane = c.lane, wave = c.wave, fr = lane & 15, fq = lane >> 4;
    const bf16_t* QP = (const bf16_t*)(A.ws + WS_QP); const bf16_t* KEYS = (const bf16_t*)(A.ws + WS_KEYS) + (size_t)l * 16 * 128 * 128;
    const bf16_t* XF = (const bf16_t*)(A.ws + WS_NBUF); const float* RSl = (const float*)(A.ws + WS_RS); const unsigned char* U8 = A.ws + WS_UT + (size_t)l * NEXP * EREC; const unsigned char* V8 = U8 + 1024; const float* VS = (const float*)(A.ws + WS_VSC) + (size_t)l * NEXP; const float* US = (const float*)(A.ws + WS_USC) + (size_t)l * NEXP;
    LAS int* lidx = (LAS int*)c.lds;
    LAS float* lgate = (LAS float*)(c.lds + 32768);
    LAS unsigned* tkb = (LAS unsigned*)(c.lds + 65536);
    for (int blk = c.bid; blk < T / 64; blk += c.G) {
        const int tb0 = blk * 64;
        __syncthreads();
#pragma unroll 1
        for (int rrep_ = 0; rrep_ < 1 + ((DUP >> 11) & 1); ++rrep_) {
#define PEER_RLOAD(Q, Kf, st) do { const int hh_ = (st) >> 2, ks_ = (st) & 3, hp_ = (hh_ >> 1) * 8 + wave, sp_ = (hh_ & 1) * 2; \
        const bf16_t* qp_ = QP; const bf16_t* kp_ = KEYS; asm volatile("" : "+s"(qp_), "+s"(kp_) : "v"(acc[1][7]));     \
        _Pragma("unroll") for (int sb = 0; sb < 2; ++sb) Q[sb] = *(const bf16x8*)(qp_ + (size_t)(tb0 + (sp_ + sb) * 16 + fr) * 2048 + hp_ * 128 + ks_ * 32 + 8 * fq); \
        _Pragma("unroll") for (int nb = 0; nb < 8; ++nb) Kf[nb] = *(const bf16x8*)(kp_ + ((size_t)hp_ * 128 + nb * 16 + fr) * 128 + ks_ * 32 + 8 * fq); } while (0)
#define PEER_RMMA(Q, Kf) do { _Pragma("unroll") for (int nb = 0; nb < 8; ++nb) _Pragma("unroll") for (int sb = 0; sb < 2; ++sb) acc[sb][nb] = __builtin_amdgcn_mfma_f32_16x16x32_bf16(Kf[nb], Q[sb], acc[sb][nb], 0, 0, 0); } while (0)
            bf16x8 qA[2], kA[8], qB[2], kB[8]; f32x4 acc[2][8]; acc[1][7] = (f32x4){0.f, 0.f, 0.f, 0.f};
            PEER_RLOAD(qA, kA, 0);
#pragma unroll 1
            for (int hh = 0; hh < 4; ++hh) {
                const int hp = (hh >> 1) * 8 + wave, sp = (hh & 1) * 2;
#pragma unroll
                for (int sb = 0; sb < 2; ++sb)
#pragma unroll
                    for (int nb = 0; nb < 8; ++nb) acc[sb][nb] = (f32x4){0.f, 0.f, 0.f, 0.f};
                PEER_RLOAD(qB, kB, 4 * hh + 1); PEER_RMMA(qA, kA);
                PEER_RLOAD(qA, kA, 4 * hh + 2); PEER_RMMA(qB, kB);
                PEER_RLOAD(qB, kB, 4 * hh + 3); PEER_RMMA(qA, kA);
                { const int hn_ = hh < 3 ? hh + 1 : hh; PEER_RLOAD(qA, kA, 4 * hn_); }
                PEER_RMMA(qB, kB);
#define PEER_MERGE(N) do { unsigned p[16]; \
        _Pragma("unroll") for (int i = 0; i < 16; ++i) p[i] = lxu<N>(v[i]); \
        _Pragma("unroll") for (int i = 0; i < 16; ++i) v[i] = v[i] > p[15 - i] ? v[i] : p[15 - i]; \
        _Pragma("unroll") for (int j = 8; j > 0; j >>= 1) _Pragma("unroll") for (int i = 0; i < 16; ++i) { const int q = i ^ j; if (q > i) { const unsigned x = v[i], y = v[q]; v[i] = x > y ? x : y; v[q] = x > y ? y : x; } } } while (0)
#pragma unroll 1
                for (int sb = 0; sb < 2; ++sb) {
                    LAS unsigned* tk = tkb + (sp + sb) * 4096;
                    unsigned v[32];
#pragma unroll
                    for (int nb = 0; nb < 8; ++nb) { const f32x4 a_ = sb == 0 ? acc[0][nb] : acc[1][nb];
#pragma unroll
                        for (int r = 0; r < 4; ++r) v[nb * 4 + r] = (ord_key(a_[r]) & ~127u) | (unsigned)(127 - (nb * 16 + 4 * fq + r)); }
#pragma unroll
                    for (int k = 2; k <= 32; k <<= 1)
#pragma unroll
                        for (int j = k >> 1; j > 0; j >>= 1)
#pragma unroll
                            for (int i = 0; i < 32; ++i) { const int q = i ^ j; if (q > i) { const bool desc = ((i & k) == 0); const unsigned x = v[i], y = v[q]; const unsigned hi = x > y ? x : y, lo = x > y ? y : x; v[i] = desc ? hi : lo; v[q] = desc ? lo : hi; } }
                    PEER_MERGE(16); PEER_MERGE(32);
                    { u32x4 w; w.x = fq == 0 ? v[0] : (fq == 1 ? v[4] : (fq == 2 ? v[8] : v[12])); w.y = fq == 0 ? v[1] : (fq == 1 ? v[5] : (fq == 2 ? v[9] : v[13]));
                      w.z = fq == 0 ? v[2] : (fq == 1 ? v[6] : (fq == 2 ? v[10] : v[14])); w.w = fq == 0 ? v[3] : (fq == 1 ? v[7] : (fq == 2 ? v[11] : v[15]));
                      *(LAS u32x4*)(tk + (fr * 16 + hp) * 16 + 4 * fq) = w; }
                }
#undef PEER_MERGE
            }
#undef PEER_RLOAD
#undef PEER_RMMA
            __syncthreads();
#pragma unroll 1
            for (int sub = 0; sub < 4; ++sub)
            {
                const LAS unsigned* tk = tkb + sub * 4096;
                const int pp = tid >> 2, qd = tid & 3, tok = pp >> 3, h = pp & 7;
                const LAS unsigned* a = tk + (tok * 16 + 2 * h) * 16; const LAS unsigned* b = a + 16;
                unsigned v[16], s5[5];
                {
                    const float sj0 = ord_val(b[qd] & ~127u), sj1 = ord_val(b[qd + 4] & ~127u), sj2 = ord_val(b[qd + 8] & ~127u), sj3 = ord_val(b[qd + 12] & ~127u);
#pragma unroll
                    for (int i = 0; i < 16; ++i) { const float si = ord_val(a[i] & ~127u);
                        v[i] = ((i + 1) * (qd + 1) <= 16) ? ((ord_key(si + sj0) & ~255u) | (unsigned)(255 - (i * 16 + qd))) : 0u;
                        if (i < 3) s5[i] = ((i + 1) * (qd + 5) <= 16) ? ((ord_key(si + sj1) & ~255u) | (unsigned)(255 - (i * 16 + qd + 4))) : 0u;
                        if (i == 0) { s5[3] = ((qd + 9) <= 16) ? ((ord_key(si + sj2) & ~255u) | (unsigned)(255 - (qd + 8))) : 0u; s5[4] = ((qd + 13) <= 16) ? ((ord_key(si + sj3) & ~255u) | (unsigned)(255 - (qd + 12))) : 0u; } }
                }
#define PEER_CE(x, y) do { const unsigned hi_ = x > y ? x : y, lo_ = x > y ? y : x; x = hi_; y = lo_; } while (0)
                PEER_CE(s5[0], s5[1]); PEER_CE(s5[3], s5[4]); PEER_CE(s5[2], s5[4]); PEER_CE(s5[2], s5[3]); PEER_CE(s5[0], s5[3]); PEER_CE(s5[0], s5[2]); PEER_CE(s5[1], s5[4]); PEER_CE(s5[1], s5[3]); PEER_CE(s5[1], s5[2]);
#pragma unroll
                for (int t = 0; t < 5; ++t) v[15 - t] = v[15 - t] > s5[t] ? v[15 - t] : s5[t];
#pragma unroll
                for (int j = 8; j > 0; j >>= 1)
#pragma unroll
                    for (int i = 0; i < 16; ++i) { const int q = i ^ j; if (q > i) PEER_CE(v[i], v[q]); }
#define PEER_MERGE(N) do { unsigned p[16]; \
        _Pragma("unroll") for (int i = 0; i < 16; ++i) p[i] = lxu<N>(v[i]); \
        _Pragma("unroll") for (int i = 0; i < 16; ++i) v[i] = v[i] > p[15 - i] ? v[i] : p[15 - i]; \
        _Pragma("unroll") for (int j = 8; j > 0; j >>= 1) _Pragma("unroll") for (int i = 0; i < 16; ++i) { const int q = i ^ j; if (q > i) PEER_CE(v[i], v[q]); } } while (0)
                PEER_MERGE(1); PEER_MERGE(2);
#undef PEER_MERGE
#undef PEER_CE
                const float mx = ord_val(v[0] & ~255u); const int tl = sub * 16 + tok;
                unsigned m4[4]; float e4[4]; int x4[4];
#pragma unroll
                for (int t = 0; t < 4; ++t) { m4[t] = qd == 0 ? v[t] : (qd == 1 ? v[4 + t] : (qd == 2 ? v[8 + t] : v[12 + t]));
                    const int pos = 255 - (int)(m4[t] & 255u), pi = pos >> 4, pj = pos & 15;
                    e4[t] = __expf(ord_val(m4[t] & ~255u) - mx);
                    x4[t] = (127 - (int)(a[pi] & 127u)) * 128 + (127 - (int)(b[pj] & 127u)); }
                float sum = (e4[0] + e4[1]) + (e4[2] + e4[3]); sum += lxf<1>(sum); sum += lxf<2>(sum);
                const float inv = 1.0f / sum;
                { u32x4 xi; xi.x = (unsigned)x4[0]; xi.y = (unsigned)x4[1]; xi.z = (unsigned)x4[2]; xi.w = (unsigned)x4[3]; *(LAS u32x4*)(lidx + tl * 128 + h * 16 + 4 * qd) = xi;
                  f32x4 gi; gi.x = e4[0] * inv; gi.y = e4[1] * inv; gi.z = e4[2] * inv; gi.w = e4[3] * inv; *(LAS f32x4*)(lgate + tl * 128 + h * 16 + 4 * qd) = gi; }
            }
        }
        __syncthreads();
        LAS unsigned char* lbase = c.lds + 65536 + wave * 10240;
        const int es = ((lane & 1) << 2) | (lane & 2) | ((lane >> 2) & 1);
#pragma unroll 1
        for (int pass = 0; pass < 2; ++pass) {
            const int tl0 = pass * 32 + wave * 4; LAS unsigned* sl = (LAS unsigned*)lbase + pass * 512; LAS float* sg = (LAS float*)(lbase + 4096) + pass * 512; LAS unsigned short* sv = (LAS unsigned short*)(lbase + 8192) + pass * 512;
            int il[4], ih[4]; float gl[4], gh[4];
#pragma unroll
            for (int k = 0; k < 4; ++k) { const int a0 = lidx[(tl0 + k) * 128 + lane], a1 = lidx[(tl0 + k) * 128 + 64 + lane];
                gl[k] = lgate[(tl0 + k) * 128 + lane] * VS[a0]; gh[k] = lgate[(tl0 + k) * 128 + 64 + lane] * VS[a1];
                il[k] = a0 | (k << 14) | (int)(((__float_as_uint(US[a0]) >> 23) & 255u) << 16); ih[k] = a1 | (k << 14) | (int)(((__float_as_uint(US[a1]) >> 23) & 255u) << 16); }
            LAS int* ct = (LAS int*)(c.lds + 147456) + wave * 256;
            int rk[8], cn[8], pu[8];
#pragma unroll
            for (int g = 0; g < 8; ++g) { const int w = (g & 1) ? ih[g >> 1] : il[g >> 1]; const int r = (w >> 9) & 31; unsigned long long eq = ~0ull;
#pragma unroll
                for (int bt_ = 0; bt_ < 5; ++bt_) { const bool bit = (r >> bt_) & 1; const unsigned long long m = __ballot(bit); eq &= bit ? m : ~m; }
                rk[g] = (int)__builtin_amdgcn_mbcnt_hi((unsigned)(eq >> 32), __builtin_amdgcn_mbcnt_lo((unsigned)eq, 0u)); cn[g] = __builtin_popcountll(eq); }
#pragma unroll
            for (int ord = 0; ord < 2; ++ord) {
#pragma unroll
                for (int i = 0; i < 4; ++i) ct[lane + 64 * i] = 0;
#pragma unroll
                for (int g = 0; g < 8; ++g) { const int w = (g & 1) ? ih[g >> 1] : il[g >> 1]; const int r = (w >> 9) & 31; ct[ord ? (g >> 1) * 64 + r * 2 + (g & 1) : r * 8 + g] = cn[g]; }
                { const int c0 = ct[4 * lane], c1 = ct[4 * lane + 1], c2 = ct[4 * lane + 2], c3 = ct[4 * lane + 3]; int sum = (c0 + c1) + (c2 + c3);
#pragma unroll
                  for (int o = 1; o < 64; o <<= 1) { const int n = __shfl_up(sum, o); if (lane >= o) sum += n; }
                  const int ex = sum - ((c0 + c1) + (c2 + c3));
                  ct[4 * lane] = ex; ct[4 * lane + 1] = ex + c0; ct[4 * lane + 2] = ex + c0 + c1; ct[4 * lane + 3] = ex + c0 + c1 + c2; }
#pragma unroll
                for (int g = 0; g < 8; ++g) { const int w = (g & 1) ? ih[g >> 1] : il[g >> 1]; const int r = (w >> 9) & 31;
                    if (ord == 0) pu[g] = ct[r * 8 + g] + rk[g];
                    else { const int k = g >> 1, p = ct[k * 64 + r * 2 + (g & 1)] + rk[g] - 128 * k;
                        const int vp = 8 * (p >> 1) + 2 * k + (p & 1);
                        sl[pu[g]] = (unsigned)w | ((unsigned)p << 24); sg[vp] = (g & 1) ? gh[k] : gl[k]; sv[vp] = (unsigned short)(w & 16383); } }
            }
        }
        __syncthreads();
        LAS unsigned char* xw = c.lds + wave * 8192;
#pragma unroll 1
        for (int pass = 0; pass < 2; ++pass) {
            if (align && pass == 1) xcd_barrier(bar);
            const int tl0 = pass * 32 + wave * 4; const LAS unsigned* sl = (const LAS unsigned*)lbase + pass * 512; LAS float* sg = (LAS float*)(lbase + 4096) + pass * 512; const LAS unsigned short* sv = (const LAS unsigned short*)(lbase + 8192) + pass * 512;
            float out[4][16]; float xinv1;
            {
                float f[4][16]; float am = 0.f;
#pragma unroll
                for (int k = 0; k < 4; ++k) { const size_t t = (size_t)(tb0 + tl0 + k);
                    float rs; { const float4 a = *(const float4*)(RSl + t * 16), b = *(const float4*)(RSl + t * 16 + 4), c2 = *(const float4*)(RSl + t * 16 + 8), d = *(const float4*)(RSl + t * 16 + 12);
                        rs = rsqrtf(((((a.x + a.y) + (a.z + a.w)) + ((b.x + b.y) + (b.z + b.w))) + (((c2.x + c2.y) + (c2.z + c2.w)) + ((d.x + d.y) + (d.z + d.w)))) * (1.0f / 1024.0f) + 1e-6f); }
                    const u32x4 w0 = *(const u32x4*)(XF + t * 1024 + 16 * lane), w1 = *(const u32x4*)(XF + t * 1024 + 16 * lane + 8);
                    f[k][0] = bf_lo(w0.x); f[k][1] = bf_hi(w0.x); f[k][2] = bf_lo(w0.y); f[k][3] = bf_hi(w0.y); f[k][4] = bf_lo(w0.z); f[k][5] = bf_hi(w0.z); f[k][6] = bf_lo(w0.w); f[k][7] = bf_hi(w0.w);
                    f[k][8] = bf_lo(w1.x); f[k][9] = bf_hi(w1.x); f[k][10] = bf_lo(w1.y); f[k][11] = bf_hi(w1.y); f[k][12] = bf_lo(w1.z); f[k][13] = bf_hi(w1.z); f[k][14] = bf_lo(w1.w); f[k][15] = bf_hi(w1.w);
#pragma unroll
                    for (int i = 0; i < 16; ++i) { f[k][i] *= rs; am = fmaxf(am, fabsf(f[k][i])); } }
                am = fmaxf(am, lxf<1>(am)); am = fmaxf(am, lxf<2>(am)); am = fmaxf(am, lxf<4>(am)); am = fmaxf(am, lxf<8>(am)); am = fmaxf(am, lxf<16>(am)); am = fmaxf(am, lxf<32>(am));
                const float sx = am > 0.f ? __uint_as_float(__float_as_uint(127.0f / am) & 0x7f800000u) : 1.0f;
                xinv1 = __int_as_float(__builtin_amdgcn_readfirstlane(__float_as_int(1.0f / sx)));
#pragma unroll
                for (int k = 0; k < 4; ++k) { u32x4 xq; unsigned qq[4];
#pragma unroll
                    for (int i = 0; i < 4; ++i) qq[i] = ((unsigned)(int)rintf(f[k][4 * i] * sx) & 255u) | (((unsigned)(int)rintf(f[k][4 * i + 1] * sx) & 255u) << 8) | (((unsigned)(int)rintf(f[k][4 * i + 2] * sx) & 255u) << 16) | (((unsigned)(int)rintf(f[k][4 * i + 3] * sx) & 255u) << 24);
                    xq.x = qq[0]; xq.y = qq[1]; xq.z = qq[2]; xq.w = qq[3];
                    *(LAS u32x4*)(xw + k * 1024 + lane * 16) = xq; }
            }
            constexpr int NW = 8, NBW = 64;
            {
                u32x4 uA[NW], uB[NW], uC[NW], uD[NW]; unsigned mA[NW], mB[NW], mC[NW], mD[NW];
#define PEER_UISSUE(uu, mm, b) do { _Pragma("unroll") for (int s = 0; s < NW; ++s) { mm[s] = __builtin_amdgcn_readfirstlane(sl[NW * (b) + s]); uu[s] = ((const u32x4*)(U8 + (size_t)(mm[s] & 16383u) * EREC))[lane]; } } while (0)
#define PEER_UCOMPUTE(uu, mm, b) do { int d_[8]; \
        _Pragma("unroll") for (int s = 0; s < NW; ++s) { const unsigned kx_ = (mm[s] >> 14) & 3u; const u32x4 xq_ = *(const LAS u32x4*)(xw + kx_ * 1024 + lane * 16); \
            int ia_ = __builtin_amdgcn_sdot4((int)uu[s].x, (int)xq_.x, 0, false); ia_ = __builtin_amdgcn_sdot4((int)uu[s].y, (int)xq_.y, ia_, false); ia_ = __builtin_amdgcn_sdot4((int)uu[s].z, (int)xq_.z, ia_, false); ia_ = __builtin_amdgcn_sdot4((int)uu[s].w, (int)xq_.w, ia_, false); \
            d_[s] = ia_; } \
        const bool o1_ = lane & 1, o2_ = lane & 2, o4_ = lane & 4; \
        int a0_ = o1_ ? d_[4] : d_[0], a1_ = o1_ ? d_[5] : d_[1], a2_ = o1_ ? d_[6] : d_[2], a3_ = o1_ ? d_[7] : d_[3]; \
        a0_ += lxi<1>(o1_ ? d_[0] : d_[4]); a1_ += lxi<1>(o1_ ? d_[1] : d_[5]); a2_ += lxi<1>(o1_ ? d_[2] : d_[6]); a3_ += lxi<1>(o1_ ? d_[3] : d_[7]); \
        int b0_ = o2_ ? a2_ : a0_, b1_ = o2_ ? a3_ : a1_; b0_ += lxi<2>(o2_ ? a0_ : a2_); b1_ += lxi<2>(o2_ ? a1_ : a3_); \
        int ci_ = o4_ ? b1_ : b0_; ci_ += lxi<4>(o4_ ? b0_ : b1_); \
        ci_ += lxi<8>(ci_); ci_ += lxi<16>(ci_); ci_ += lxi<32>(ci_); \
        const unsigned wes_ = sl[NW * (b) + es];     \
        const int pv_ = (int)(wes_ >> 24), vp_ = 8 * (pv_ >> 1) + 2 * (int)((wes_ >> 14) & 3u) + (pv_ & 1); \
        const float cc_ = (float)ci_ * (__uint_as_float(((wes_ >> 16) & 255u) << 23) * xinv1); \
        const float cfv_ = sg[vp_] * gelu_erf(cc_); \
        if (lane < 8) sg[vp_] = cfv_; } while (0)
                PEER_UISSUE(uA, mA, 0); PEER_UISSUE(uB, mB, 1); PEER_UISSUE(uC, mC, 2);
#pragma unroll 1
                for (int bb = 0; bb < NBW; bb += 4) {
                    PEER_UISSUE(uD, mD, bb + 3);
                    PEER_UCOMPUTE(uA, mA, bb);
                    if (bb + 4 < NBW) PEER_UISSUE(uA, mA, bb + 4);
                    PEER_UCOMPUTE(uB, mB, bb + 1);
                    if (bb + 4 < NBW) PEER_UISSUE(uB, mB, bb + 5);
                    PEER_UCOMPUTE(uC, mC, bb + 2);
                    if (bb + 4 < NBW) PEER_UISSUE(uC, mC, bb + 6);
                    PEER_UCOMPUTE(uD, mD, bb + 3);
                }
#undef PEER_UISSUE
#undef PEER_UCOMPUTE
            }
            asm volatile("s_waitcnt lgkmcnt(0)" ::: "memory");
            if (align && ALIGN_V) xcd_barrier(bar);
#pragma unroll
            for (int k = 0; k < 4; ++k)
#pragma unroll
                for (int i = 0; i < 16; ++i) out[k][i] = 0.f;
            {
                U3 vA[NW], vB[NW]; float cA[NW], cB[NW];
#define PEER_VISSUE(vv, cc, b) do { _Pragma("unroll") for (int s = 0; s < NW; ++s) { const unsigned e_ = (unsigned)__builtin_amdgcn_readfirstlane((int)sv[NW * (b) + s]); cc[s] = __int_as_float(__builtin_amdgcn_readfirstlane(__float_as_int(sg[NW * (b) + s]))); \
            vv[s] = ((const U3*)(V8 + (size_t)e_ * EREC))[lane]; } } while (0)
#define PEER_VCOMPUTE(vv, cc) do { \
        _Pragma("unroll") for (int k = 0; k < 4; ++k) { \
            const u32x6 w6_ = {vv[2 * k].x, vv[2 * k].y, vv[2 * k].z, vv[2 * k + 1].x, vv[2 * k + 1].y, vv[2 * k + 1].z}; const f32x32 vf_ = __builtin_amdgcn_cvt_scalef32_pk32_f32_fp6(w6_, 1.0f); \
            _Pragma("unroll") for (int i = 0; i < 16; ++i) out[k][i] += cc[2 * k] * vf_[i]; \
            _Pragma("unroll") for (int i = 0; i < 16; ++i) out[k][i] += cc[2 * k + 1] * vf_[16 + i]; } } while (0)
                PEER_VISSUE(vA, cA, 0);
#pragma unroll 1
                for (int bb = 0; bb < NBW; bb += 2) {
                    PEER_VISSUE(vB, cB, bb + 1);
                    PEER_VCOMPUTE(vA, cA);
                    if (bb + 2 < NBW) PEER_VISSUE(vA, cA, bb + 2);
                    PEER_VCOMPUTE(vB, cB);
                }
#undef PEER_VISSUE
#undef PEER_VCOMPUTE
            }
#pragma unroll
            for (int k = 0; k < 4; ++k) { const size_t t = (size_t)(tb0 + tl0 + k); const float* hp = A.out + t * 1024 + 16 * lane; float* hq = hdst + t * 1024 + 16 * lane;
#pragma unroll
                for (int i = 0; i < 4; ++i) { float4 h4 = *(const float4*)(hp + 4 * i); h4.x += out[k][4 * i]; h4.y += out[k][4 * i + 1]; h4.z += out[k][4 * i + 2]; h4.w += out[k][4 * i + 3]; *(float4*)(hq + 4 * i) = h4; }
            }
#pragma unroll 1
            for (int k2 = 0; k2 < (fuse_next ? 2 : 0); ++k2) {
                int lo16 = 16 * lane; asm volatile("" : "+v"(lo16));
                const float* nx_gain = A.in[2] + (l + 1) * 1024 + lo16; const float* nx_wgate = (const float*)(A.ws + WS_WGATE) + (l + 1) * 8 * 1024 + lo16; const float* nx_alog = A.in[5] + (l + 1) * 4; const float* nx_dtb = A.in[6] + (l + 1) * 4;
                float hv[2][16], ss[2], d[2][8];
#pragma unroll
                for (int k = 0; k < 2; ++k) { const float* hq = hdst + (size_t)(tb0 + tl0 + 2 * k2 + k) * 1024 + lo16;
#pragma unroll
                    for (int i = 0; i < 4; ++i) { const float4 h4 = *(const float4*)(hq + 4 * i); hv[k][4 * i] = h4.x; hv[k][4 * i + 1] = h4.y; hv[k][4 * i + 2] = h4.z; hv[k][4 * i + 3] = h4.w; }
                    float s2 = 0.f;
#pragma unroll
                    for (int i = 0; i < 16; ++i) s2 += hv[k][i] * hv[k][i];
                    ss[k] = s2; }
#pragma unroll
                for (int i = 0; i < 4; ++i) { const float4 g4 = *(const float4*)(nx_gain + 4 * i);
#pragma unroll
                    for (int k = 0; k < 2; ++k) { hv[k][4 * i] *= g4.x; hv[k][4 * i + 1] *= g4.y; hv[k][4 * i + 2] *= g4.z; hv[k][4 * i + 3] *= g4.w; } }
#pragma unroll
                for (int qh = 0; qh < 2; ++qh) {
                    const float* wg_ = nx_wgate; if (qh) asm volatile("" : "+v"(wg_) : "v"(d[1][3]));
#pragma unroll
                    for (int q = 4 * qh; q < 4 * qh + 4; ++q) { float4 w[4];
#pragma unroll
                        for (int i = 0; i < 4; ++i) w[i] = *(const float4*)(wg_ + q * 1024 + 4 * i);
#pragma unroll
                        for (int k = 0; k < 2; ++k) { float a = 0.f;
#pragma unroll
                            for (int i = 0; i < 4; ++i) a += (hv[k][4 * i] * w[i].x + hv[k][4 * i + 1] * w[i].y) + (hv[k][4 * i + 2] * w[i].z + hv[k][4 * i + 3] * w[i].w);
                            d[k][q] = a; } } }
                const bool o1 = lane & 1, o2 = lane & 2, o4 = lane & 4;
#pragma unroll
                for (int k = 0; k < 2; ++k) { const size_t t = (size_t)(tb0 + tl0 + 2 * k2 + k);
                    float a0 = o1 ? d[k][4] : d[k][0], a1 = o1 ? d[k][5] : d[k][1], a2 = o1 ? d[k][6] : d[k][2], a3 = o1 ? d[k][7] : d[k][3];
                    a0 += lxf<1>(o1 ? d[k][0] : d[k][4]); a1 += lxf<1>(o1 ? d[k][1] : d[k][5]); a2 += lxf<1>(o1 ? d[k][2] : d[k][6]); a3 += lxf<1>(o1 ? d[k][3] : d[k][7]);
                    float b0 = o2 ? a2 : a0, b1 = o2 ? a3 : a1; b0 += lxf<2>(o2 ? a0 : a2); b1 += lxf<2>(o2 ? a1 : a3);
                    float cc = o4 ? b1 : b0; cc += lxf<4>(o4 ? b0 : b1);
                    cc += lxf<8>(cc); cc += lxf<16>(cc); cc += lxf<32>(cc);
                    const float rstd = rsqrtf(wave_sum(ss[k]) * (1.0f / D) + 1e-6f);
                    u32x4 w0, w1; w0.x = pk2(hv[k][0] * rstd, hv[k][1] * rstd); w0.y = pk2(hv[k][2] * rstd, hv[k][3] * rstd); w0.z = pk2(hv[k][4] * rstd, hv[k][5] * rstd); w0.w = pk2(hv[k][6] * rstd, hv[k][7] * rstd);
                    w1.x = pk2(hv[k][8] * rstd, hv[k][9] * rstd); w1.y = pk2(hv[k][10] * rstd, hv[k][11] * rstd); w1.z = pk2(hv[k][12] * rstd, hv[k][13] * rstd); w1.w = pk2(hv[k][14] * rstd, hv[k][15] * rstd);
                    bf16_t* xo = (bf16_t*)(A.ws + WS_NBUF) + t * 1024 + lo16; *(u32x4*)xo = w0; *(u32x4*)(xo + 8) = w1;
                    if (lane < 8) { const float r = cc * rstd; float o;
                        if (es < 4) o = 1.0f / (1.0f + __expf(-r));
                        else { const float z = r + nx_dtb[es - 4]; const float sp = z > 20.f ? z : log1pf(__expf(z)); o = -__expf(nx_alog[es - 4]) * sp; }
                        ((float*)(A.ws + WS_GB))[t * 8 + es] = o; }
                }
            }
        }
    }
    __syncthreads();
}

__device__ __forceinline__ bool relaunder(Ctx& c) { int t = threadIdx.x; asm volatile("" : "+v"(t)); c.tid = t; c.lane = t & 63; c.wave = __builtin_amdgcn_readfirstlane(t >> 6); return true; }
__global__ void __launch_bounds__(512, 2) fwd(Args a) {
    extern __shared__ __attribute__((aligned(16))) unsigned char lds_raw[];
    Ctx c; c.lds = (LAS unsigned char*)lds_raw; c.tid = threadIdx.x; c.lane = c.tid & 63; c.wave = __builtin_amdgcn_readfirstlane(c.tid >> 6); c.G = gridDim.x; c.bid = blockIdx.x;
    const Args& A = a;
    volatile LAS unsigned* MISC = (volatile LAS unsigned*)(c.lds + MISC_OFF);
    if (c.tid < 64) MISC[c.tid] = 0u;
    __syncthreads();
    const int lo = a.ph_lo, hi = a.ph_hi;
    XcdBarrier bar; bar.bar = (unsigned*)(A.ws + WS_CTL) + CW_BAR; bar.x = 0; bar.st = MISC + 8;
    if (hi - lo > 1) bar = xcd_barrier_post((unsigned*)(A.ws + WS_CTL) + CW_BAR, MISC + 8);
#define IN(k) (lo <= (k) && (k) < hi && relaunder(c))
#define INR(k) (lo <= (k) && (k) < hi)
#define SEAM(k) do { if (INR(k) && INR((k) + 1)) { xcd_barrier(bar); if ((DUP >> 14) & 1) xcd_barrier(bar); } } while (0)
    bf16_t* NBUF = (bf16_t*)(A.ws + WS_NBUF); bf16_t* PROJ = (bf16_t*)(A.ws + WS_PROJ); bf16_t* MIXED = (bf16_t*)(A.ws + WS_MIXED); bf16_t* QP = (bf16_t*)(A.ws + WS_QP);
    float* GB = (float*)(A.ws + WS_GB);
    if (IN(0)) REP(10) p0_prologue(c, a);
    SEAM(0);
    auto layer = [&](const int l) __attribute__((always_inline)) {
        const int pb = 1 + 10 * l;
        if (l == 0 && IN(pb + 0) && !(KO & (1 << 0))) REP(0) phase_norm(c, a, l == 0 ? A.in[0] : A.out, A.in[2] + l * 1024, NBUF, (const float*)(A.ws + WS_WGATE) + l * 8 * 1024, A.in[5] + l * 4, A.in[6] + l * 4, GB);
        if (l == 0) SEAM(pb + 0);
        if (IN(pb + 1) && !(KO & (1 << 1))) REP(1) { pg8::Gemm g{NBUF, (const bf16_t*)(A.ws + WS_WIN) + (size_t)l * NPROJ * 1024, T, NPROJ, 1024}; pg8::StaticOrder S; S.init(T, NPROJ, c.G, c.bid); pg8::EpiBf16 E{PROJ, NPROJ, nullptr};
            pg8::gemm_phase<pg8::EpiBf16, pg8::StaticOrder>(c.lds, g, S, E, nullptr); }
        SEAM(pb + 1);
        if (IN(pb + 2) && !(KO & (1 << 2))) REP(2) phase_prep(c, a, l);
        SEAM(pb + 2);
        if (IN(pb + 3)) REP(3) { for (int u = c.bid; u < 1024; u += 2 * c.G) { if (u + c.G < 1024) gdn_chunk_pair(c, a, u, u + c.G); else gdn_chunk_unit(c, a, u); } }
        SEAM(pb + 3);
        if (IN(pb + 4) && !(KO & (1 << 3))) REP(4) { if (c.bid < 64) { for (int rp = 0; rp < 1 + ((DUP >> 12) & 1); ++rp) gdn_scan(c, a, c.bid); } else { for (int rp = 0; rp < 1 + ((DUP >> 13) & 1); ++rp) attn_mfma(c, a, l, 64, c.G - 64); } }
        SEAM(pb + 4);
        if (IN(pb + 5) && !(KO & (1 << 4))) REP(5) phase_gdn_out(c, a, l);
        SEAM(pb + 5);
        if (IN(pb + 6) && !(KO & (1 << 5))) REP(6) { pg8::Gemm g{MIXED, (const bf16_t*)(A.ws + WS_WOUT) + (size_t)l * 1024 * 1024, T, 1024, 1024}; pg8::StaticOrder S; S.init(T, 1024, c.G, c.bid); pg8::EpiResNorm E{l == 0 ? A.in[0] : A.out, A.out, NBUF, A.in[14] + l * 1024, (float*)(A.ws + WS_RS), 1024};
            pg8::gemm_phase<pg8::EpiResNorm, pg8::StaticOrder>(c.lds, g, S, E, nullptr); }
        SEAM(pb + 6);
        if (IN(pb + 8) && !(KO & (1 << 7))) REP(8) { pg8::Gemm g{NBUF, (const bf16_t*)(A.ws + WS_WQ) + (size_t)l * 2048 * 1024, T, 2048, 1024}; pg8::StaticOrder S; S.init(T, 2048, c.G, c.bid); pg8::EpiBf16 E{QP, 2048, (const float*)(A.ws + WS_RS)};
            pg8::gemm_phase<pg8::EpiBf16, pg8::StaticOrder>(c.lds, g, S, E, nullptr); }
        SEAM(pb + 8);
        if (IN(pb + 9) && !(KO & (1 << 8))) REP(9) phase_peer(c, a, l, LASTREP(9) ? A.out : (float*)(A.ws + WS_GCH), l == 0, bar, (hi - lo > 1) && c.G * 64 == T);
        SEAM(pb + 9);
    };
    layer(0); layer(1);
#undef IN
#undef INR
#undef SEAM
}

extern "C" void kernel_launch(void* const* d_in, const int* in_sizes, int n_in, void* d_out, int out_size, void* d_ws, size_t ws_size, hipStream_t stream) {
    static int grid = 0;
    if (grid == 0) {
        if (n_in != 19 || out_size != T * D || ws_size < WS_END) { fprintf(stderr, "kernel_launch: unexpected shapes (n_in %d out %d ws %zu)\n", n_in, out_size, ws_size); grid = -1; return; }
        if (hipFuncSetAttribute((const void*)fwd, hipFuncAttributeMaxDynamicSharedMemorySize, LDS_BYTES) != hipSuccess) { fprintf(stderr, "kernel_launch: hipFuncSetAttribute failed\n"); grid = -1; return; }
        int dev = 0, cus = 0, per_cu = 0;
        (void)hipGetDevice(&dev); (void)hipDeviceGetAttribute(&cus, hipDeviceAttributeMultiprocessorCount, dev);
        (void)hipOccupancyMaxActiveBlocksPerMultiprocessor(&per_cu, (const void*)fwd, 512, LDS_BYTES);
        (void)hipGetLastError();
        if (per_cu < 1) fprintf(stderr, "kernel_launch: occupancy query reports %d blocks per CU\n", per_cu);
        grid = cus > 0 ? cus : 256;
    }
    if (grid < 0) return;
    (void)hipMemsetAsync((char*)d_ws + WS_CTL, 0, CTL_BYTES, stream);
    Args a{};
    for (int i = 0; i < 19; ++i) a.in[i] = (const float*)d_in[i];
    a.out = (float*)d_out; a.ws = (unsigned char*)d_ws;
#if MK_ONE_LAUNCH
    a.ph_lo = 0; a.ph_hi = NPHASE;
    hipLaunchKernelGGL(fwd, dim3(grid), dim3(512), LDS_BYTES, stream, a);
#else
    for (int p = 0; p < NPHASE; ++p) { a.ph_lo = p; a.ph_hi = p + 1; hipLaunchKernelGGL(fwd, dim3(grid), dim3(512), LDS_BYTES, stream, a); }
#endif
}
```

```cpp
#include <hip/hip_runtime.h>
#include <cstdio>
#include <cstdint>
#include <cstring>

#ifndef KO
#define KO 0
#endif
#ifndef DUP
#define DUP 0
#endif
#define ALIGN_V 0
#define REP(k) for (int rep = 0; rep < 1 + ((DUP >> (k)) & 1); ++rep)
#define LASTREP(k) (rep == ((DUP >> (k)) & 1))
#ifndef MK_ONE_LAUNCH
#define MK_ONE_LAUNCH 1
#endif

template <int CTRL> __device__ __forceinline__ int dpp_i(int x) { return __builtin_amdgcn_mov_dpp(x, CTRL, 0xf, 0xf, true); }
template <int N> __device__ __forceinline__ int lxi(int x) {
    if constexpr (N == 1) return dpp_i<0xB1>(x);
    else if constexpr (N == 2) return dpp_i<0x4E>(x);
    else if constexpr (N == 4) return dpp_i<0x1B>(dpp_i<0x141>(x));
    else if constexpr (N == 8) return dpp_i<0x128>(x);
    else if constexpr (N == 16) { const auto r = __builtin_amdgcn_permlane16_swap((unsigned)x, (unsigned)x, false, false); return (int)((threadIdx.x & 16) ? r[0] : r[1]); }
    else { const auto r = __builtin_amdgcn_permlane32_swap((unsigned)x, (unsigned)x, false, false); return (int)((threadIdx.x & 32) ? r[0] : r[1]); }
}
template <int N> __device__ __forceinline__ float lxf(float x) { return __int_as_float(lxi<N>(__float_as_int(x))); }
template <int N> __device__ __forceinline__ unsigned lxu(unsigned x) { return (unsigned)lxi<N>((int)x); }
namespace pg8 {
#define PG8_LAS __attribute__((address_space(3)))
typedef unsigned short bf16_t;
typedef short bf16x8 __attribute__((ext_vector_type(8)));
typedef float f32x4 __attribute__((ext_vector_type(4)));
typedef unsigned u32x4 __attribute__((ext_vector_type(4)));
constexpr int BM = 256, BK = 64, HALF = 128, HTB = HALF * BK * 2  , STAGE_BYTES = 8 * HTB, NXCD = 8, WGM = 8;

__host__ __device__ __forceinline__ int lds_byte(int r, int c) { const int st = (r >> 4) * 2 + (c >> 5), rr = r & 15, cc = c & 31, ob = rr * 64 + cc * 2; return st * 1024 + (ob ^ (((ob >> 9) & 1) << 5)); }
__host__ __device__ __forceinline__ void stage_rc(int b, int& R, int& C) { const int st = b / 1024, sb = b % 1024, swz = sb ^ (((sb >> 9) & 1) << 5); R = (st >> 1) * 16 + swz / 64; C = (st & 1) * 32 + (swz % 64) / 2; }
__host__ __device__ __forceinline__ int perm32(int rho) { const int n = rho >> 4, i = rho & 15; return 8 * (i >> 2) + 4 * n + (i & 3); }

struct Unit { int pm, pn; };
struct Gemm { const bf16_t* A; const bf16_t* Bt; int M, N, K; };

struct StaticOrder {
    int nM, nN, nwg, G, c;
    __host__ __device__ void init(int M, int N, int G_, int c_) { nM = M / BM; nN = N / BM; nwg = nM * nN; G = G_; c = c_; }
    __host__ __device__ bool next(int i, Unit& u) const {
        const long L = (long)i * G + c; if (L >= nwg) return false;
        int wgid = (int)L; { const int q = nwg / NXCD, r = nwg % NXCD, xcd = wgid % NXCD, off = wgid / NXCD; wgid = (xcd < r ? xcd * (q + 1) : r * (q + 1) + (xcd - r) * q) + off; }
        const int nig = WGM * nN, gid = wgid / nig, fm = gid * WGM, gsz = (nM - fm) < WGM ? (nM - fm) : WGM;
        u.pm = fm + ((wgid % nig) % gsz); u.pn = (wgid % nig) / gsz; return true;
    }
    __device__ __forceinline__ void a_ready(const Unit&) const {}
    __device__ __forceinline__ void done(const Unit&) const {}
};
__device__ __forceinline__ unsigned cvt_pk_bf16(float lo, float hi) { unsigned r; asm volatile("v_cvt_pk_bf16_f32 %0, %1, %2" : "=v"(r) : "v"(lo), "v"(hi)); return r; }
typedef unsigned u32x2v __attribute__((ext_vector_type(2)));
struct EpiResF32 {
    static constexpr bool PERM = false, AFTER_DRAIN = false;
    const float* R; float* C; int ldc;
    __device__ __forceinline__ void operator()(const f32x4 (&acc)[2][2][4][2], const Unit& u, int wr, int wc, int fr, int fq) const {
        const int row0 = u.pm * BM + wr * 64 + fr, col0 = u.pn * BM + wc * 32 + 4 * fq;
#pragma unroll
        for (int ai = 0; ai < 2; ++ai)
#pragma unroll
            for (int m = 0; m < 4; ++m) { const size_t ro = (size_t)(row0 + ai * HALF + m * 16) * ldc + col0;
#pragma unroll
                for (int bj = 0; bj < 2; ++bj)
#pragma unroll
                    for (int n = 0; n < 2; ++n) { const f32x4 r = *(const f32x4*)(R + ro + bj * HALF + n * 16); *(f32x4*)(C + ro + bj * HALF + n * 16) = acc[ai][bj][m][n] + r; } }
    }
};
struct EpiResNorm {
    static constexpr bool PERM = false, AFTER_DRAIN = false;
    const float* R; float* C; bf16_t* HB; const float* gain; float* RS; int ldc;
    __device__ __forceinline__ void operator()(const f32x4 (&acc)[2][2][4][2], const Unit& u, int wr, int wc, int fr, int fq) const {
        const int row0 = u.pm * BM + wr * 64 + fr, col0 = u.pn * BM + wc * 32 + 4 * fq;
        f32x4 gv[2][2];
#pragma unroll
        for (int bj = 0; bj < 2; ++bj)
#pragma unroll
            for (int n = 0; n < 2; ++n) gv[bj][n] = *(const f32x4*)(gain + col0 + bj * HALF + n * 16);
#pragma unroll
        for (int ai = 0; ai < 2; ++ai)
#pragma unroll
            for (int m = 0; m < 4; ++m) { const int row = row0 + ai * HALF + m * 16; const size_t ro = (size_t)row * ldc + col0; float ss = 0.f;
#pragma unroll
                for (int bj = 0; bj < 2; ++bj)
#pragma unroll
                    for (int n = 0; n < 2; ++n) { const f32x4 r = *(const f32x4*)(R + ro + bj * HALF + n * 16); const f32x4 h = acc[ai][bj][m][n] + r; *(f32x4*)(C + ro + bj * HALF + n * 16) = h;
                        ss += (h[0] * h[0] + h[1] * h[1]) + (h[2] * h[2] + h[3] * h[3]); const f32x4 y = h * gv[bj][n];
                        u32x2v w; w.x = cvt_pk_bf16(y[0], y[1]); w.y = cvt_pk_bf16(y[2], y[3]); *(u32x2v*)(HB + ro + bj * HALF + n * 16) = w; }
                ss += lxf<16>(ss); ss += lxf<32>(ss);
                if (fq == 0) RS[(size_t)row * 16 + u.pn * 4 + wc] = ss; }
    }
};
struct EpiBf16 {
    static constexpr bool PERM = true, AFTER_DRAIN = false;
    bf16_t* O; int ldc; const float* RS;
    __device__ __forceinline__ void operator()(const f32x4 (&acc)[2][2][4][2], const Unit& u, int wr, int wc, int fr, int fq) const {
        const int row0 = u.pm * BM + wr * 64 + fr; const int col0 = u.pn * BM + wc * 32 + 8 * fq;
#pragma unroll
        for (int ai = 0; ai < 2; ++ai)
#pragma unroll
            for (int m = 0; m < 4; ++m) { const int row = row0 + ai * HALF + m * 16; bf16_t* rowp = O + (size_t)row * ldc + col0;
                float sc = 1.0f; if (RS) { const f32x4 a = *(const f32x4*)(RS + (size_t)row * 16), b = *(const f32x4*)(RS + (size_t)row * 16 + 4), c2 = *(const f32x4*)(RS + (size_t)row * 16 + 8), d = *(const f32x4*)(RS + (size_t)row * 16 + 12);
                    sc = rsqrtf(((((a[0] + a[1]) + (a[2] + a[3])) + ((b[0] + b[1]) + (b[2] + b[3]))) + (((c2[0] + c2[1]) + (c2[2] + c2[3])) + ((d[0] + d[1]) + (d[2] + d[3])))) * (1.0f / 1024.0f) + 1e-6f); }
#pragma unroll
                for (int bj = 0; bj < 2; ++bj) { const f32x4 v0 = acc[ai][bj][m][0] * sc, v1 = acc[ai][bj][m][1] * sc;
                    u32x4 w; w.x = cvt_pk_bf16(v0[0], v0[1]); w.y = cvt_pk_bf16(v0[2], v0[3]); w.z = cvt_pk_bf16(v1[0], v1[1]); w.w = cvt_pk_bf16(v1[2], v1[3]);
                    *(u32x4*)(rowp + bj * HALF) = w; } }
    }
};

template <class Epi, class Sched, bool STAMP = false>
__device__ __forceinline__ void gemm_phase(PG8_LAS unsigned char* lds, const Gemm g, const Sched& S, const Epi& E, unsigned long long* stamps) {
    int tid_ = threadIdx.x; asm volatile("" : "+v"(tid_));
    const int tid = tid_, wid = __builtin_amdgcn_readfirstlane(tid >> 6), lane = tid & 63, wr = wid >> 2, wc = wid & 3, fr = lane & 15, fq = lane >> 4;
    const int K = g.K, nt = K / BK;
    int ts_lo = 0, ts_hi = 0, nts = 0; const unsigned long long rt_entry = STAMP ? (unsigned long long)wall_clock64() : 0ull;
#define PG8_STAMP() do { if (STAMP && wid == 0 && nts < 64) { const unsigned long long _c = (unsigned long long)clock64(); \
        ts_lo = (lane == nts) ? (int)(unsigned)_c : ts_lo; ts_hi = (lane == nts) ? (int)(unsigned)(_c >> 32) : ts_hi; ++nts; } } while (0)
    PG8_STAMP();
    unsigned voffA[2], voffB[2];
#pragma unroll
    for (int i = 0; i < 2; ++i) { int R, C; stage_rc(tid * 16 + i * 8192, R, C); const int Rb = Epi::PERM ? ((R & ~31) + perm32(R & 31)) : R;
        voffA[i] = (unsigned)(R * K + C) * 2u; voffB[i] = (unsigned)(Rb * K + C) * 2u; }
    const size_t kstep = (size_t)(BK * 2);
    const size_t hstep = (size_t)HALF * K * 2;
    const size_t tstep = 2 * hstep;
    const unsigned ldsw = (unsigned)wid * 1024u;
    const int aoff = lds_byte(wr * 64 + fr, fq * 8), boff = lds_byte(wc * 32 + fr, fq * 8);
#define PG8_SA(b, h) (((b) * 2 + (h)) * HTB)
#define PG8_SB(b, h) ((4 + (b) * 2 + (h)) * HTB)
#define PG8_STAGE(bufoff, gbase, voff) do { _Pragma("unroll") for (int _i = 0; _i < 2; ++_i) \
        __builtin_amdgcn_global_load_lds((const unsigned*)((const char*)(gbase) + (voff)[_i]), (PG8_LAS unsigned*)(lds + (bufoff) + ldsw + _i * 8192), 16, 0, 0); } while (0)
#define PG8_LDA(dst, b, h) do { _Pragma("unroll") for (int m = 0; m < 4; ++m) _Pragma("unroll") for (int k = 0; k < 2; ++k) dst[m][k] = *(const PG8_LAS bf16x8*)(lds + PG8_SA(b, h) + aoff + m * 2048 + k * 1024); } while (0)
#define PG8_LDB(dst, b, h) do { _Pragma("unroll") for (int n = 0; n < 2; ++n) _Pragma("unroll") for (int k = 0; k < 2; ++k) dst[n][k] = *(const PG8_LAS bf16x8*)(lds + PG8_SB(b, h) + boff + n * 2048 + k * 1024); } while (0)
#define PG8_MMA(ai, bj, At, Bt) do { __builtin_amdgcn_s_setprio(1); _Pragma("unroll") for (int m = 0; m < 4; ++m) _Pragma("unroll") for (int n = 0; n < 2; ++n) _Pragma("unroll") for (int k = 0; k < 2; ++k) \
        acc[ai][bj][m][n] = __builtin_amdgcn_mfma_f32_16x16x32_bf16(Bt[n][k], At[m][k], acc[ai][bj][m][n], 0, 0, 0); __builtin_amdgcn_s_setprio(0); } while (0)
#define PG8_WAIT_V(n) asm volatile("s_waitcnt vmcnt(" #n ")" ::: "memory")
#define PG8_WAIT_L(n) asm volatile("s_waitcnt lgkmcnt(" #n ")" ::: "memory")
#define PG8_BAR __builtin_amdgcn_s_barrier()
#define PG8_SCHED __builtin_amdgcn_sched_barrier(0)
    Unit cur, nxt; int ui = 0;
    if (!S.next(0, cur)) return;
    f32x4 acc[2][2][4][2];
#pragma unroll
    for (int a = 0; a < 2; ++a)
#pragma unroll
        for (int b = 0; b < 2; ++b)
#pragma unroll
            for (int m = 0; m < 4; ++m)
#pragma unroll
                for (int n = 0; n < 2; ++n) acc[a][b][m][n] = (f32x4){0.f, 0.f, 0.f, 0.f};
    bf16x8 At[4][2], B0[2][2], B1[2][2];
    const char* cA = (const char*)g.A + (size_t)cur.pm * tstep; const char* cB = (const char*)g.Bt + (size_t)cur.pn * tstep;
    S.a_ready(cur);
    PG8_STAGE(PG8_SB(0, 0), cB, voffB); PG8_STAGE(PG8_SA(0, 0), cA, voffA); PG8_STAGE(PG8_SB(0, 1), cB + hstep, voffB); PG8_STAGE(PG8_SA(0, 1), cA + hstep, voffA);
    if (wr == 1) PG8_BAR;
    PG8_WAIT_V(4); PG8_BAR;
    PG8_STAGE(PG8_SB(1, 0), cB + kstep, voffB); PG8_STAGE(PG8_SA(1, 0), cA + kstep, voffA); PG8_STAGE(PG8_SB(1, 1), cB + hstep + kstep, voffB);
    PG8_WAIT_V(6); PG8_BAR;
    PG8_STAMP();
    for (;;) {
        const bool has_next = S.next(ui + 1, nxt);
        const char* nA = has_next ? (const char*)g.A + (size_t)nxt.pm * tstep : cA; const char* nB = has_next ? (const char*)g.Bt + (size_t)nxt.pn * tstep : cB;
        for (int t = 0; t < nt; t += 2) {
            const bool last = (t == nt - 2);
            const char* a1 = cA + (size_t)(t + 1) * kstep;
            const char* a2 = last ? nA : cA + (size_t)(t + 2) * kstep; const char* b2 = last ? nB : cB + (size_t)(t + 2) * kstep;
            const char* a3 = a2 + kstep; const char* b3 = b2 + kstep;
            if (last && has_next) S.a_ready(nxt);
            PG8_LDB(B0, 0, 0); PG8_SCHED; PG8_LDA(At, 0, 0); PG8_STAGE(PG8_SA(1, 1), a1 + hstep, voffA);
            PG8_WAIT_L(8); PG8_BAR; PG8_WAIT_L(0); PG8_MMA(0, 0, At, B0); PG8_BAR; PG8_SCHED;
            PG8_LDB(B1, 0, 1); PG8_STAGE(PG8_SB(0, 0), b2, voffB);
            PG8_BAR; PG8_WAIT_L(0); PG8_MMA(0, 1, At, B1); PG8_BAR;
            PG8_LDA(At, 0, 1); PG8_STAGE(PG8_SA(0, 0), a2, voffA);
            PG8_BAR; PG8_WAIT_L(0); PG8_MMA(1, 0, At, B0); PG8_BAR; PG8_SCHED;
            PG8_STAGE(PG8_SB(0, 1), b2 + hstep, voffB);
            PG8_WAIT_V(6); PG8_BAR; PG8_MMA(1, 1, At, B1); PG8_BAR;
            PG8_LDB(B0, 1, 0); PG8_SCHED; PG8_LDA(At, 1, 0); PG8_STAGE(PG8_SA(0, 1), a2 + hstep, voffA);
            PG8_WAIT_L(8); PG8_BAR; PG8_WAIT_L(0); PG8_MMA(0, 0, At, B0); PG8_BAR; PG8_SCHED;
            PG8_LDB(B1, 1, 1); PG8_STAGE(PG8_SB(1, 0), b3, voffB);
            PG8_BAR; PG8_WAIT_L(0); PG8_MMA(0, 1, At, B1); PG8_BAR;
            PG8_LDA(At, 1, 1); PG8_STAGE(PG8_SA(1, 0), a3, voffA);
            PG8_BAR; PG8_WAIT_L(0); PG8_MMA(1, 0, At, B0); PG8_BAR; PG8_SCHED;
            PG8_STAGE(PG8_SB(1, 1), b3 + hstep, voffB);
            PG8_WAIT_V(6); PG8_BAR; PG8_MMA(1, 1, At, B1); PG8_BAR;
        }
        PG8_STAMP();
        if constexpr (!Epi::AFTER_DRAIN) { E(acc, cur, wr, wc, fr, fq); S.done(cur); }
        PG8_STAMP();
        if (!has_next) break;
#pragma unroll
        for (int a = 0; a < 2; ++a)
#pragma unroll
            for (int b = 0; b < 2; ++b)
#pragma unroll
                for (int m = 0; m < 4; ++m)
#pragma unroll
                    for (int n = 0; n < 2; ++n) acc[a][b][m][n] = (f32x4){0.f, 0.f, 0.f, 0.f};
        cur = nxt; cA = nA; cB = nB; ++ui;
    }
    PG8_WAIT_V(0);
    if (wr == 0) PG8_BAR;
    PG8_BAR;
    if constexpr (Epi::AFTER_DRAIN) { E.fused(acc, cur, wr, wc, fr, fq, lds, wid, lane); S.done(cur); }
    PG8_STAMP();
    if (STAMP && wid == 0) { stamps[lane] = lane < nts ? (((unsigned long long)(unsigned)ts_hi << 32) | (unsigned)ts_lo) : 0ull;
        if (lane == 62) stamps[62] = rt_entry; if (lane == 63) stamps[63] = (unsigned long long)wall_clock64(); }
#undef PG8_STAMP
#undef PG8_SA
#undef PG8_SB
#undef PG8_STAGE
#undef PG8_LDA
#undef PG8_LDB
#undef PG8_MMA
#undef PG8_WAIT_V
#undef PG8_WAIT_L
#undef PG8_BAR
#undef PG8_SCHED
}
}

using pg8::bf16_t; using pg8::bf16x8; using pg8::f32x4; using pg8::u32x4;
typedef unsigned u32x2 __attribute__((ext_vector_type(2)));
constexpr int T = 16384, D = 1024, SEQ = 2048, NPROJ = 3584, NINW = 3592, NEXP = 16384;
constexpr int EREC = 1792;
constexpr int C_GQ = 0, C_GK = 512, C_GV = 1024, C_GZ = 1536, C_SB = 2048, C_SC = 2304, C_SH = 2560, C_DQ = 2816, C_DK = 3072, C_DV = 3328;
constexpr size_t MiB = 1u << 20;
constexpr size_t WS_CTL = 0, CTL_BYTES = 1 * MiB, WS_WIN = 2 * MiB, WS_WOUT = 16 * MiB, WS_WQ = 20 * MiB, WS_KEYS = 28 * MiB, WS_WGATE = 29 * MiB, WS_VSC = 30 * MiB, WS_USC = 31 * MiB,
    WS_UT = 32 * MiB, WS_VT = 96 * MiB, WS_NBUF = 160 * MiB, WS_PROJ = 192 * MiB, WS_QP = 192 * MiB, WS_QKVC = 304 * MiB, WS_MIXED = 352 * MiB, WS_GB = 384 * MiB,
    WS_AQ = 385 * MiB, WS_AK = 393 * MiB, WS_OGDN = 401 * MiB, WS_GCH = 433 * MiB, WS_AVT = 160 * MiB  , WS_END = 505 * MiB;
constexpr int CW_BAR = 4096;
constexpr size_t WS_RS = 1 * MiB;
constexpr int LDS_BYTES = 159744;
constexpr int MISC_OFF = 159744 - 256;
constexpr int NPHASE = 21;

__device__ __forceinline__ float bf_lo(unsigned w) { return __uint_as_float(w << 16); }
__device__ __forceinline__ float bf_hi(unsigned w) { return __uint_as_float(w & 0xffff0000u); }
__device__ __forceinline__ unsigned f2bf(float f) { unsigned u = __float_as_uint(f); return (u + 0x7fffu + ((u >> 16) & 1u)) >> 16; }
__device__ __forceinline__ unsigned pk2(float lo, float hi) { return f2bf(lo) | (f2bf(hi) << 16); }
__device__ __forceinline__ float wave_sum(float v) {
    v += lxf<1>(v); v += lxf<2>(v); v += lxf<4>(v); v += lxf<8>(v); v += lxf<16>(v); v += lxf<32>(v);
    return v;
}
__device__ __forceinline__ int kperm(int x) { return (x & ~31) | (((x >> 2) & 3) << 3) | (((x >> 4) & 1) << 2) | (x & 3); }
__device__ __forceinline__ float silu_f(float x) { return x / (1.0f + __expf(-x)); }

#define XB_TMO      128
#define XB_XCNT(j)  (256  + 64 * (j))
#define XB_XSUB(j)  (1280 + 64 * (j))
#define XB_XGEN(j)  (2304 + 64 * (j))
#define XB_TOP      3328
#define XB_TOPGEN   3392
#define XCD_BAR_WORDS 3456
#define XB_SPIN_CAP (1u << 18)
#define LAS __attribute__((address_space(3)))

__device__ __forceinline__ unsigned xb_ld(unsigned* p)              { return __hip_atomic_load(p, __ATOMIC_RELAXED, __HIP_MEMORY_SCOPE_AGENT); }
__device__ __forceinline__ unsigned xb_add(unsigned* p, unsigned v) { return __hip_atomic_fetch_add(p, v, __ATOMIC_RELAXED, __HIP_MEMORY_SCOPE_AGENT); }
__device__ __forceinline__ unsigned xb_xcc_id() { return (unsigned)__builtin_amdgcn_s_getreg((3 << 11) | 20) & 0xFu; }
#define XB_SPIN(cond, bar) do { unsigned _sp = 0; while (cond) { __builtin_amdgcn_s_sleep(1); \
    if ((++_sp & 255u) == 0u) { if (xb_ld(&(bar)[XB_TMO])) break; if (_sp > XB_SPIN_CAP) { atomicAdd(&(bar)[XB_TMO], 1u); break; } } } } while (0)

struct XcdBarrier {
    unsigned* bar; unsigned x;
    volatile LAS unsigned* st;
};

__device__ __forceinline__ XcdBarrier xcd_barrier_post(unsigned* bar, volatile LAS unsigned* st) {
    XcdBarrier b; b.bar = bar; b.x = xb_xcc_id(); b.st = st;
    if (threadIdx.x == 0) (void)xb_add(&bar[XB_XCNT(b.x)], 1u);
    return b;
}
__device__ __forceinline__ void xcd_barrier_complete(unsigned* bar, unsigned x, unsigned& nloc, unsigned& nx) {
    const unsigned G = gridDim.x * gridDim.y * gridDim.z;
    unsigned sum, cnt, mine, sp = 0u;
    for (;;) {
        sum = 0u; cnt = 0u; mine = 0u;
#pragma unroll
        for (unsigned j = 0; j < 16; ++j) { const unsigned c = xb_ld(&bar[XB_XCNT(j)]); sum += c; cnt += (c > 0u) ? 1u : 0u; mine = (j == x) ? c : mine; }
        if (sum == G) break;
        __builtin_amdgcn_s_sleep(1);
        if ((++sp & 255u) == 0u) { if (xb_ld(&bar[XB_TMO])) break; if (sp > XB_SPIN_CAP) { atomicAdd(&bar[XB_TMO], 1u); break; } }
    }
    nloc = mine > 0u ? mine : 1u; nx = cnt > 0u ? cnt : 1u;
}

__device__ __forceinline__ void xcd_barrier(const XcdBarrier& b) {
    asm volatile("s_waitcnt vmcnt(0)" ::: "memory");
    __syncthreads();
    if (threadIdx.x == 0) {
        unsigned* bar = b.bar;
        __builtin_amdgcn_s_waitcnt(0);
        unsigned nloc = b.st[0], nx = b.st[1];
        if (nloc == 0u) { xcd_barrier_complete(bar, b.x, nloc, nx); b.st[0] = nloc; b.st[1] = nx; }
        const unsigned old = xb_add(&bar[XB_XSUB(b.x)], 1u);
        const unsigned gen = old / nloc;
        if (old + 1u == (gen + 1u) * nloc) {
            __builtin_amdgcn_fence(__ATOMIC_RELEASE, "agent");
            asm volatile("s_waitcnt vmcnt(0)" ::: "memory");
            const unsigned og = xb_add(&bar[XB_TOP], 1u);
            const unsigned tg = og / nx;
            if (og + 1u == (tg + 1u) * nx) xb_add(&bar[XB_TOPGEN], 1u);
            else XB_SPIN(xb_ld(&bar[XB_TOPGEN]) == tg, bar);
            __builtin_amdgcn_fence(__ATOMIC_ACQUIRE, "agent");
            xb_add(&bar[XB_XGEN(b.x)], 1u);
            asm volatile("s_waitcnt vmcnt(0)" ::: "memory");
        } else {
            XB_SPIN(xb_ld(&bar[XB_XGEN(b.x)]) == gen, bar);
            __builtin_amdgcn_fence(__ATOMIC_ACQUIRE, "agent");
            asm volatile("s_waitcnt vmcnt(0)" ::: "memory");
        }
    }
    __syncthreads();
}

struct Args { const float* in[19]; float* out; unsigned char* ws; int ph_lo, ph_hi; };
struct Ctx {
    LAS unsigned char* lds; int tid, lane, wave, G, bid;
};

struct __attribute__((packed, aligned(4))) U3 { unsigned x, y, z; };
typedef unsigned u32x6 __attribute__((ext_vector_type(6)));
typedef float f32x32 __attribute__((ext_vector_type(32)));
typedef _Float16 f16x32 __attribute__((ext_vector_type(32)));
__device__ __forceinline__ unsigned fp6_e2m3(float x) {
    const float a = fabsf(x); const float cdf = a < 2.f ? rintf(a * 8.f) : (a < 4.f ? rintf(a * 4.f) + 8.f : rintf(a * 2.f) + 16.f);
    return (unsigned)fminf(cdf, 31.f) | ((__float_as_uint(x) >> 31) << 5);
}
__device__ __forceinline__ void cvt_flat8(const float* src, unsigned char* dst, size_t n8, size_t gt, size_t NT) {
    const float4* s = (const float4*)src; u32x4* d = (u32x4*)dst;
    for (size_t i = gt; i < n8; i += NT) { const float4 a = s[2 * i], b = s[2 * i + 1]; u32x4 w; w.x = pk2(a.x, a.y); w.y = pk2(a.z, a.w); w.z = pk2(b.x, b.y); w.w = pk2(b.z, b.w); d[i] = w; }
}
__device__ __forceinline__ void cvt_transpose(const float* w, bf16_t* dst, int N, size_t gt, size_t NT) {
    const size_t items = (size_t)2 * 128 * N;
    for (size_t i = gt; i < items; i += NT) {
        const int cc = (int)(i % N), kb = (int)((i / N) % 128), l = (int)(i / ((size_t)N * 128));
        const float* s = w + ((size_t)l * 1024 + kb * 8) * N + cc; float v[8];
#pragma unroll
        for (int j = 0; j < 8; ++j) v[j] = s[(size_t)j * N];
        u32x4 o; o.x = pk2(v[0], v[1]); o.y = pk2(v[2], v[3]); o.z = pk2(v[4], v[5]); o.w = pk2(v[6], v[7]);
        *(u32x4*)(dst + ((size_t)l * N + cc) * 1024 + kb * 8) = o;
    }
}
__device__ __forceinline__ void p0_prologue(Ctx& c, const Args& A) {
    const size_t gt = (size_t)c.bid * 512 + c.tid, NT = (size_t)c.G * 512;
#pragma unroll 1
    for (int tb = 0; tb < 2; ++tb) {
        const float* src = tb ? A.in[18] : A.in[17]; unsigned char* dst = A.ws + WS_UT + (tb ? 1024 : 0);   float* vs = (float*)(A.ws + (tb ? WS_VSC : WS_USC));
        for (int row = c.bid * 8 + c.wave; row < 2 * NEXP; row += c.G * 8) {
            const float4* sp = (const float4*)(src + (size_t)row * 1024 + 16 * c.lane); float4 f[4]; float am = 0.f;
#pragma unroll
            for (int i = 0; i < 4; ++i) { f[i] = sp[i]; am = fmaxf(fmaxf(am, fmaxf(fabsf(f[i].x), fabsf(f[i].y))), fmaxf(fabsf(f[i].z), fabsf(f[i].w))); }
            am = fmaxf(am, lxf<1>(am)); am = fmaxf(am, lxf<2>(am)); am = fmaxf(am, lxf<4>(am)); am = fmaxf(am, lxf<8>(am)); am = fmaxf(am, lxf<16>(am)); am = fmaxf(am, lxf<32>(am));
            const float sc = am > 0.f ? __uint_as_float(__float_as_uint((tb ? 7.5f : 127.0f) / am) & 0x7f800000u) : 1.0f;
            if (tb) {
                unsigned long long lo = 0ull; unsigned hi = 0u;
#pragma unroll
                for (int i = 0; i < 16; ++i) { const float x = (i & 3) == 0 ? f[i >> 2].x : ((i & 3) == 1 ? f[i >> 2].y : ((i & 3) == 2 ? f[i >> 2].z : f[i >> 2].w)); const unsigned cd = fp6_e2m3(x * sc);
                    if (i < 10) lo |= (unsigned long long)cd << (6 * i); else if (i == 10) { lo |= (unsigned long long)(cd & 15u) << 60; hi |= cd >> 4; } else hi |= cd << (6 * i - 64); }
                U3 w3; w3.x = (unsigned)lo; w3.y = (unsigned)(lo >> 32); w3.z = hi;
                *(U3*)(dst + (size_t)row * EREC + 12 * c.lane) = w3;
            } else {
                u32x4 w; unsigned ww[4];
#pragma unroll
                for (int i = 0; i < 4; ++i) ww[i] = ((unsigned)(int)rintf(f[i].x * sc) & 255u) | (((unsigned)(int)rintf(f[i].y * sc) & 255u) << 8) | (((unsigned)(int)rintf(f[i].z * sc) & 255u) << 16) | (((unsigned)(int)rintf(f[i].w * sc) & 255u) << 24);
                w.x = ww[0]; w.y = ww[1]; w.z = ww[2]; w.w = ww[3];
                *(u32x4*)(dst + (size_t)row * EREC + 16 * c.lane) = w; }
            if (c.lane == 0) vs[row] = 1.0f / sc;
        }
    }
    cvt_flat8(A.in[16], A.ws + WS_KEYS, (size_t)2 * 8 * 2 * 128 * 128 / 8, gt, NT);
    cvt_transpose(A.in[13], (bf16_t*)(A.ws + WS_WOUT), 1024, gt, NT);
    cvt_transpose(A.in[15], (bf16_t*)(A.ws + WS_WQ), 2048, gt, NT);
    {
        const float* w = A.in[3]; const size_t items = (size_t)2 * 128 * NINW;
        for (size_t i = gt; i < items; i += NT) {
            const int cc = (int)(i % NINW), kb = (int)((i / NINW) % 128), l = (int)(i / ((size_t)NINW * 128));
            const float* s = w + ((size_t)l * 1024 + kb * 8) * NINW + cc; float v[8];
#pragma unroll
            for (int j = 0; j < 8; ++j) v[j] = s[(size_t)j * NINW];
            if (cc >= 2048 && cc < 2056) { float* d = (float*)(A.ws + WS_WGATE) + ((size_t)l * 8 + (cc - 2048)) * 1024 + kb * 8;
                *(float4*)d = make_float4(v[0], v[1], v[2], v[3]); *(float4*)(d + 4) = make_float4(v[4], v[5], v[6], v[7]); }
            else { const int c2 = cc < 2048 ? cc : cc - 8; u32x4 o; o.x = pk2(v[0], v[1]); o.y = pk2(v[2], v[3]); o.z = pk2(v[4], v[5]); o.w = pk2(v[6], v[7]);
                *(u32x4*)((bf16_t*)(A.ws + WS_WIN) + ((size_t)l * NPROJ + c2) * 1024 + kb * 8) = o; }
        }
    }
}

__device__ __forceinline__ void phase_norm(Ctx& c, const Args& A, const float* src, const float* gain, bf16_t* dst, const float* wgate, const float* a_log, const float* dt_bias, float* GB) {
    const int gw = c.bid * 8 + c.wave, NGW = c.G * 8, lane = c.lane;
    const bool o1 = lane & 1, o2 = lane & 2, o4 = lane & 4; const int es = ((lane & 1) << 2) | (lane & 2) | ((lane >> 2) & 1);
    float4 g[4];
#pragma unroll
    for (int j = 0; j < 4; ++j) g[j] = ((const float4*)gain)[lane + 64 * j];
    for (int m0 = gw * 2; m0 < T; m0 += NGW * 2) {
        float4 v[2][4];
#pragma unroll
        for (int rr = 0; rr < 2; ++rr)
#pragma unroll
            for (int j = 0; j < 4; ++j) v[rr][j] = ((const float4*)(src + (size_t)(m0 + rr) * D))[lane + 64 * j];
#pragma unroll
        for (int rr = 0; rr < 2; ++rr) {
            const int m = m0 + rr; float ss = 0.f;
#pragma unroll
            for (int j = 0; j < 4; ++j) { ss += (v[rr][j].x * v[rr][j].x + v[rr][j].y * v[rr][j].y) + (v[rr][j].z * v[rr][j].z + v[rr][j].w * v[rr][j].w);
                v[rr][j].x *= g[j].x; v[rr][j].y *= g[j].y; v[rr][j].z *= g[j].z; v[rr][j].w *= g[j].w; }
            float cc = 0.f;
            if (wgate) {
                float d[8];
#pragma unroll
                for (int q = 0; q < 8; ++q) { float a = 0.f;
#pragma unroll
                    for (int j = 0; j < 4; ++j) { const float4 w = ((const float4*)(wgate + q * 1024))[lane + 64 * j]; a += (v[rr][j].x * w.x + v[rr][j].y * w.y) + (v[rr][j].z * w.z + v[rr][j].w * w.w); }
                    d[q] = a; }
                float a0 = o1 ? d[4] : d[0], a1 = o1 ? d[5] : d[1], a2 = o1 ? d[6] : d[2], a3 = o1 ? d[7] : d[3];
                a0 += lxf<1>(o1 ? d[0] : d[4]); a1 += lxf<1>(o1 ? d[1] : d[5]); a2 += lxf<1>(o1 ? d[2] : d[6]); a3 += lxf<1>(o1 ? d[3] : d[7]);
                float b0 = o2 ? a2 : a0, b1 = o2 ? a3 : a1; b0 += lxf<2>(o2 ? a0 : a2); b1 += lxf<2>(o2 ? a1 : a3);
                cc = o4 ? b1 : b0; cc += lxf<4>(o4 ? b0 : b1);
                cc += lxf<8>(cc); cc += lxf<16>(cc); cc += lxf<32>(cc);
            }
            const float rstd = rsqrtf(wave_sum(ss) * (1.0f / D) + 1e-6f);
            u32x2* o8 = (u32x2*)(dst + (size_t)m * D) + lane;
#pragma unroll
            for (int j = 0; j < 4; ++j) { u32x2 w; w.x = pk2(v[rr][j].x * rstd, v[rr][j].y * rstd); w.y = pk2(v[rr][j].z * rstd, v[rr][j].w * rstd); o8[64 * j] = w; }
            if (wgate && lane < 8) { const float r = cc * rstd; float o;
                if (es < 4) o = 1.0f / (1.0f + __expf(-r));
                else { const float z = r + dt_bias[es - 4]; const float sp = z > 20.f ? z : log1pf(__expf(z)); o = -__expf(a_log[es - 4]) * sp; }
                GB[(size_t)m * 8 + es] = o; }
        }
    }
}

__device__ __forceinline__ void unpack8(const u32x4& w, float* f) { f[0] = bf_lo(w.x); f[1] = bf_hi(w.x); f[2] = bf_lo(w.y); f[3] = bf_hi(w.y); f[4] = bf_lo(w.z); f[5] = bf_hi(w.z); f[6] = bf_lo(w.w); f[7] = bf_hi(w.w); }
__device__ __forceinline__ void phase_prep(Ctx& c, const Args& A, int l) {
    const int gw = c.bid * 8 + c.wave, NGW = c.G * 8, lane = c.lane;
    const bf16_t* PROJ = (const bf16_t*)(A.ws + WS_PROJ);
    bf16_t* QKVC = (bf16_t*)(A.ws + WS_QKVC); bf16_t* AQ = (bf16_t*)(A.ws + WS_AQ); bf16_t* AK = (bf16_t*)(A.ws + WS_AK); bf16_t* MIXED = (bf16_t*)(A.ws + WS_MIXED); bf16_t* AVT = (bf16_t*)(A.ws + WS_AVT);
    const float* gconv = A.in[4] + (size_t)l * 4 * 1536; const float* sconv = A.in[8] + (size_t)l * 3 * 256;
    const float* qg = A.in[9] + l * 32; const float* kg = A.in[10] + l * 32;
    const u32x4 zero4 = {0u, 0u, 0u, 0u};
    for (int run = gw; run < T / 8; run += NGW) {
        const int t0 = run * 8, s0 = t0 & (SEQ - 1);
#pragma unroll 1
        for (int it = 0; it < 3; ++it) {
            const int ch = (it * 64 + lane) * 8;
            u32x4 rows[11];
#pragma unroll
            for (int j = 0; j < 11; ++j) rows[j] = (s0 + j - 3 >= 0) ? *(const u32x4*)(PROJ + (size_t)(t0 + j - 3) * NPROJ + ch) : zero4;
            float w[4][8];
#pragma unroll
            for (int j = 0; j < 4; ++j) { const float4 a = *(const float4*)(gconv + j * 1536 + ch), b = *(const float4*)(gconv + j * 1536 + ch + 4);
                w[j][0] = a.x; w[j][1] = a.y; w[j][2] = a.z; w[j][3] = a.w; w[j][4] = b.x; w[j][5] = b.y; w[j][6] = b.z; w[j][7] = b.w; }
#pragma unroll
            for (int i = 0; i < 8; ++i) {
                float acc[8] = {0.f, 0.f, 0.f, 0.f, 0.f, 0.f, 0.f, 0.f};
#pragma unroll
                for (int j = 0; j < 4; ++j) { float x[8]; unpack8(rows[i + j], x);
#pragma unroll
                    for (int e = 0; e < 8; ++e) acc[e] += w[j][e] * x[e]; }
                float ss = 0.f;
#pragma unroll
                for (int e = 0; e < 8; ++e) { acc[e] = silu_f(acc[e]); ss += acc[e] * acc[e]; }
                if (it < 2) {
                    ss += lxf<1>(ss); ss += lxf<2>(ss); ss += lxf<4>(ss); ss += lxf<8>(ss);
                    const float r = rsqrtf(ss + 1e-6f);
#pragma unroll
                    for (int e = 0; e < 8; ++e) acc[e] *= r; }
                u32x4 o4; o4.x = pk2(acc[0], acc[1]); o4.y = pk2(acc[2], acc[3]); o4.z = pk2(acc[4], acc[5]); o4.w = pk2(acc[6], acc[7]);
                *(u32x4*)(QKVC + (size_t)(t0 + i) * 1536 + ch) = o4;
            }
        }
        {
            u32x2 wq[8], wk[8], wv[8];
#pragma unroll
            for (int i = 0; i < 8; ++i) { const bf16_t* r = PROJ + (size_t)(t0 + i) * NPROJ + 4 * lane; wq[i] = *(const u32x2*)(r + C_DQ); wk[i] = *(const u32x2*)(r + C_DK); wv[i] = *(const u32x2*)(r + C_DV); }
            const float4 g4 = *(const float4*)(qg + 4 * (lane & 7)), h4 = *(const float4*)(kg + 4 * (lane & 7));
#pragma unroll
            for (int i = 0; i < 8; ++i) {
                float q[4] = {bf_lo(wq[i].x), bf_hi(wq[i].x), bf_lo(wq[i].y), bf_hi(wq[i].y)}, k[4] = {bf_lo(wk[i].x), bf_hi(wk[i].x), bf_lo(wk[i].y), bf_hi(wk[i].y)};
                float sq = (q[0] * q[0] + q[1] * q[1]) + (q[2] * q[2] + q[3] * q[3]), sk = (k[0] * k[0] + k[1] * k[1]) + (k[2] * k[2] + k[3] * k[3]);
                sq += lxf<1>(sq); sk += lxf<1>(sk); sq += lxf<2>(sq); sk += lxf<2>(sk); sq += lxf<4>(sq); sk += lxf<4>(sk);
                const float rq = rsqrtf(sq * (1.0f / 32.0f) + 1e-6f) * (0.17677669529663687f * 1.4426950408889634f), rk = rsqrtf(sk * (1.0f / 32.0f) + 1e-6f);
                u32x2 oq, ok; oq.x = pk2(q[0] * rq * g4.x, q[1] * rq * g4.y); oq.y = pk2(q[2] * rq * g4.z, q[3] * rq * g4.w);
                ok.x = pk2(k[0] * rk * h4.x, k[1] * rk * h4.y); ok.y = pk2(k[2] * rk * h4.z, k[3] * rk * h4.w);
                *(u32x2*)(AQ + (size_t)(t0 + i) * 256 + 4 * lane) = oq; *(u32x2*)(AK + (size_t)(t0 + i) * 256 + 4 * lane) = ok;
            }
            bf16_t* vt = AVT + ((size_t)((t0 >> 11) * 4 + (lane >> 4)) * 64 + (lane & 15) * 4) * SEQ + kperm(s0);
#pragma unroll
            for (int d = 0; d < 4; ++d) {
                unsigned e[8];
#pragma unroll
                for (int i = 0; i < 8; ++i) { const unsigned w = (d < 2) ? wv[i].x : wv[i].y; e[i] = (d & 1) ? (w >> 16) : (w & 0xffffu); }
                u32x2 lo, hi; lo.x = e[0] | (e[1] << 16); lo.y = e[2] | (e[3] << 16); hi.x = e[4] | (e[5] << 16); hi.y = e[6] | (e[7] << 16);
                *(u32x2*)(vt + (size_t)d * SEQ) = lo; *(u32x2*)(vt + (size_t)d * SEQ + 8) = hi;
            }
        }
        {
            const int ch = 4 * lane; u32x2 wc[10], wh[10], wb[8];
#pragma unroll
            for (int j = 0; j < 10; ++j) { const bool ok = (s0 + j - 2 >= 0); const bf16_t* r = PROJ + (size_t)(t0 + j - 2) * NPROJ + ch;
                wc[j] = ok ? *(const u32x2*)(r + C_SC) : (u32x2){0u, 0u}; wh[j] = ok ? *(const u32x2*)(r + C_SH) : (u32x2){0u, 0u}; }
#pragma unroll
            for (int i = 0; i < 8; ++i) wb[i] = *(const u32x2*)(PROJ + (size_t)(t0 + i) * NPROJ + C_SB + ch);
            float4 cw[3];
#pragma unroll
            for (int j = 0; j < 3; ++j) cw[j] = *(const float4*)(sconv + j * 256 + ch);
            float p[10][4];
#pragma unroll
            for (int j = 0; j < 10; ++j) { p[j][0] = bf_lo(wc[j].x) * bf_lo(wh[j].x); p[j][1] = bf_hi(wc[j].x) * bf_hi(wh[j].x); p[j][2] = bf_lo(wc[j].y) * bf_lo(wh[j].y); p[j][3] = bf_hi(wc[j].y) * bf_hi(wh[j].y); }
#pragma unroll
            for (int i = 0; i < 8; ++i) {
                const float a0 = cw[0].x * p[i][0] + cw[1].x * p[i + 1][0] + cw[2].x * p[i + 2][0], a1 = cw[0].y * p[i][1] + cw[1].y * p[i + 1][1] + cw[2].y * p[i + 2][1];
                const float a2 = cw[0].z * p[i][2] + cw[1].z * p[i + 1][2] + cw[2].z * p[i + 2][2], a3 = cw[0].w * p[i][3] + cw[1].w * p[i + 1][3] + cw[2].w * p[i + 2][3];
                u32x2 o; o.x = pk2(bf_lo(wb[i].x) * a0, bf_hi(wb[i].x) * a1); o.y = pk2(bf_lo(wb[i].y) * a2, bf_hi(wb[i].y) * a3);
                *(u32x2*)(MIXED + (size_t)(t0 + i) * 1024 + 512 + ch) = o;
            }
        }
    }
}

__device__ __forceinline__ void gdn_seq_unit(Ctx& c, const Args& A, int u) {
    const int bh = u >> 1, j0 = (u & 1) * 64, b = bh >> 2, h = bh & 3, tid = c.tid, lane = c.lane;
    const bf16_t* QKVC = (const bf16_t*)(A.ws + WS_QKVC); const float* GB = (const float*)(A.ws + WS_GB); float* OG = (float*)(A.ws + WS_OGDN);
    LAS float* kq = (LAS float*)c.lds;
    LAS float* vv = (LAS float*)(c.lds + 65536);
    LAS float* bg = (LAS float*)(c.lds + 65536 + 16384);
    float S[128];
#pragma unroll
    for (int d = 0; d < 128; ++d) S[d] = 0.f;
    for (int ck = 0; ck < 32; ++ck) {
        const int t0 = b * SEQ + ck * 64;
        __syncthreads();
        for (int e = tid; e < 64 * 128; e += 512) { const int i = e >> 7, p = (e & 127) * 2;
            const int col = p < 128 ? (C_GK + h * 128 + p) : (C_GQ + h * 128 + (p - 128));
            const unsigned w = *(const unsigned*)(QKVC + (size_t)(t0 + i) * 1536 + col); kq[i * 256 + p] = bf_lo(w); kq[i * 256 + p + 1] = bf_hi(w); }
        for (int e = tid; e < 64 * 32; e += 512) { const int i = e >> 5, p = (e & 31) * 2; const unsigned w = *(const unsigned*)(QKVC + (size_t)(t0 + i) * 1536 + C_GV + h * 128 + j0 + p); vv[i * 64 + p] = bf_lo(w); vv[i * 64 + p + 1] = bf_hi(w); }
        if (tid < 64) { bg[tid] = GB[(size_t)(t0 + tid) * 8 + h]; bg[64 + tid] = __expf(GB[(size_t)(t0 + tid) * 8 + 4 + h]); }
        __syncthreads();
        if (c.wave == 0) {
            for (int i = 0; i < 64; ++i) {
                const float beta = bg[i], al = bg[64 + i]; const LAS f32x4* kr = (const LAS f32x4*)(kq + i * 256); const LAS f32x4* qr = kr + 32;
                float ks = 0.f;
#pragma unroll
                for (int dg = 0; dg < 4; ++dg) {
#pragma unroll
                    for (int dd = 0; dd < 8; ++dd) { const int d4 = dg * 8 + dd; const f32x4 k4 = kr[d4]; ks += (k4.x * S[4 * d4] + k4.y * S[4 * d4 + 1]) + (k4.z * S[4 * d4 + 2] + k4.w * S[4 * d4 + 3]); }
                    asm volatile("" ::: "memory"); }
                const float delta = beta * (vv[i * 64 + lane] - al * ks); float o = 0.f;
#pragma unroll
                for (int dg = 0; dg < 8; ++dg) {
#pragma unroll
                    for (int dd = 0; dd < 4; ++dd) { const int d4 = dg * 4 + dd; const f32x4 k4 = kr[d4], q4 = qr[d4];
                        S[4 * d4] = al * S[4 * d4] + k4.x * delta; S[4 * d4 + 1] = al * S[4 * d4 + 1] + k4.y * delta; S[4 * d4 + 2] = al * S[4 * d4 + 2] + k4.z * delta; S[4 * d4 + 3] = al * S[4 * d4 + 3] + k4.w * delta;
                        o += (q4.x * S[4 * d4] + q4.y * S[4 * d4 + 1]) + (q4.z * S[4 * d4 + 2] + q4.w * S[4 * d4 + 3]); }
                    asm volatile("" ::: "memory"); }
                OG[(size_t)(t0 + i) * 512 + h * 128 + j0 + lane] = o * 0.08838834764831845f;
            }
        }
    }
    __syncthreads();
}
constexpr int GCH_BYTES = 73728, GCH_WM = 0, GCH_QM = 16384, GCH_KT = 32768, GCH_AM = 49152, GCH_UT = 57344;
__device__ __forceinline__ bf16x8 pack_frag(const f32x4& a, const f32x4& b) { u32x4 w; w.x = pg8::cvt_pk_bf16(a[0], a[1]); w.y = pg8::cvt_pk_bf16(a[2], a[3]); w.z = pg8::cvt_pk_bf16(b[0], b[1]); w.w = pg8::cvt_pk_bf16(b[2], b[3]); return __builtin_bit_cast(bf16x8, w); }
__device__ __forceinline__ void gdn_chunk_unit(Ctx& c, const Args& A, int unit) {
    const int tid = c.tid, lane = c.lane, wave = c.wave, fr = lane & 15, fq = lane >> 4;
    const int bh = unit >> 5, ck = unit & 31, b = bh >> 2, h = bh & 3, t0 = b * SEQ + ck * 64;
    const bf16_t* QKVC = (const bf16_t*)(A.ws + WS_QKVC); const float* GB = (const float*)(A.ws + WS_GB); float* GL = (float*)(A.ws + WS_GB + 512 * 1024);
    unsigned char* rec = A.ws + WS_GCH + (size_t)unit * GCH_BYTES;
    LAS float* gcs = (LAS float*)c.lds;
    LAS float* bet = gcs + 64;
    LAS float* Lm = (LAS float*)(c.lds + 512);
    LAS bf16_t* Tb = (LAS bf16_t*)(c.lds + 512 + 16384);
    LAS bf16_t* vt = Tb + 64 * 72;
    LAS bf16_t* kt = vt + 128 * 72;
    LAS bf16_t* k2 = kt + 128 * 72;
    __syncthreads();
    if (tid < 64) { float g = GB[(size_t)(t0 + tid) * 8 + 4 + h];
#pragma unroll
        for (int o = 1; o < 64; o <<= 1) { const float n = __shfl_up(g, o); if (lane >= o) g += n; }
        gcs[tid] = g; bet[tid] = GB[(size_t)(t0 + tid) * 8 + h]; }
    __syncthreads();
#pragma unroll 1
    for (int bb = 0; bb < 2; ++bb) {
        const int blk = wave * 2 + bb, ib = blk >> 2, jb = blk & 3;
        f32x4 kk = (f32x4){0.f, 0.f, 0.f, 0.f}, qk = (f32x4){0.f, 0.f, 0.f, 0.f};
        if (jb <= ib) {
            const bf16_t* ki = QKVC + (size_t)(t0 + ib * 16 + fr) * 1536 + C_GK + h * 128 + 8 * fq; const bf16_t* qi = QKVC + (size_t)(t0 + ib * 16 + fr) * 1536 + C_GQ + h * 128 + 8 * fq;
            const bf16_t* kj = QKVC + (size_t)(t0 + jb * 16 + fr) * 1536 + C_GK + h * 128 + 8 * fq;
#pragma unroll
            for (int ks = 0; ks < 4; ++ks) { const bf16x8 a = *(const bf16x8*)(ki + ks * 32), q = *(const bf16x8*)(qi + ks * 32), bj = *(const bf16x8*)(kj + ks * 32);
                kk = __builtin_amdgcn_mfma_f32_16x16x32_bf16(a, bj, kk, 0, 0, 0); qk = __builtin_amdgcn_mfma_f32_16x16x32_bf16(q, bj, qk, 0, 0, 0); }
        }
        const int j = jb * 16 + fr; const float gj = gcs[j]; bf16_t* AM = (bf16_t*)(rec + GCH_AM);
#pragma unroll
        for (int r = 0; r < 4; ++r) { const int i = ib * 16 + 4 * fq + r; const float dec = i >= j ? __expf(gcs[i] - gj) : 0.f;
            Lm[i * 64 + j] = i > j ? bet[i] * kk[r] * dec : 0.f;
            AM[i * 64 + kperm(j)] = (bf16_t)f2bf(qk[r] * dec * 0.08838834764831845f); }
    }
    __syncthreads();
    if (wave == 0) {
        float Tc[64];
#pragma unroll
        for (int i = 0; i < 64; ++i) { float acc = (lane == i) ? 1.f : 0.f;
#pragma unroll
            for (int j4 = 0; j4 < (i + 3) / 4; ++j4) { const f32x4 l4 = *(const LAS f32x4*)(Lm + i * 64 + 4 * j4);
#pragma unroll
                for (int x = 0; x < 4; ++x) if (4 * j4 + x < i) acc -= l4[x] * Tc[4 * j4 + x]; }
            Tc[i] = acc; Tb[i * 72 + lane] = (bf16_t)f2bf(acc); }
    } else {
        const float glast = gcs[63];
        for (int e = tid - 64; e < 64 * 16; e += 448) { const int j = e >> 4, d8 = (e & 15) * 8; const float bj = bet[j], gj = gcs[j]; const float s1 = bj * __expf(gj), s2 = __expf(glast - gj);
            const u32x4 kw = *(const u32x4*)(QKVC + (size_t)(t0 + j) * 1536 + C_GK + h * 128 + d8), vw = *(const u32x4*)(QKVC + (size_t)(t0 + j) * 1536 + C_GV + h * 128 + d8);
            const float kf[8] = {bf_lo(kw.x), bf_hi(kw.x), bf_lo(kw.y), bf_hi(kw.y), bf_lo(kw.z), bf_hi(kw.z), bf_lo(kw.w), bf_hi(kw.w)};
            const float vf[8] = {bf_lo(vw.x), bf_hi(vw.x), bf_lo(vw.y), bf_hi(vw.y), bf_lo(vw.z), bf_hi(vw.z), bf_lo(vw.w), bf_hi(vw.w)};
            const int jp = kperm(j);
#pragma unroll
            for (int x = 0; x < 8; ++x) { vt[(d8 + x) * 72 + j] = (bf16_t)f2bf(vf[x] * bj); kt[(d8 + x) * 72 + j] = (bf16_t)f2bf(kf[x] * s1); k2[(d8 + x) * 72 + jp] = (bf16_t)f2bf(kf[x] * s2); }
        }
        bf16_t* QM = (bf16_t*)(rec + GCH_QM);
        for (int e = tid - 64; e < 64 * 16; e += 448) { const int j = e >> 4, m8 = e & 15, m = m8 & 3; const float s = __expf(gcs[j]) * 0.08838834764831845f;
            const u32x4 qw = *(const u32x4*)(QKVC + (size_t)(t0 + j) * 1536 + C_GQ + h * 128 + m8 * 8);
            const int pos = (m8 >> 2) * 32 + 16 * (m & 1) + 4 * (m >> 1);
            u32x2 w0, w1; w0.x = pk2(bf_lo(qw.x) * s, bf_hi(qw.x) * s); w0.y = pk2(bf_lo(qw.y) * s, bf_hi(qw.y) * s); w1.x = pk2(bf_lo(qw.z) * s, bf_hi(qw.z) * s); w1.y = pk2(bf_lo(qw.w) * s, bf_hi(qw.w) * s);
            *(u32x2*)(QM + j * 128 + pos) = w0; *(u32x2*)(QM + j * 128 + pos + 8) = w1; }
        if (tid == 64) GL[unit] = glast;
    }
    __syncthreads();
    {
        f32x4 ua[4], wa[4];
#pragma unroll
        for (int mb = 0; mb < 4; ++mb) { ua[mb] = (f32x4){0.f, 0.f, 0.f, 0.f}; wa[mb] = (f32x4){0.f, 0.f, 0.f, 0.f}; }
#pragma unroll
        for (int ks = 0; ks < 2; ++ks) {
            const bf16x8 vf = *(const LAS bf16x8*)(vt + (16 * wave + fr) * 72 + ks * 32 + 8 * fq), kf = *(const LAS bf16x8*)(kt + (16 * wave + fr) * 72 + ks * 32 + 8 * fq);
#pragma unroll
            for (int mb = 0; mb < 4; ++mb) { const bf16x8 tf = *(const LAS bf16x8*)(Tb + (16 * mb + fr) * 72 + ks * 32 + 8 * fq);
                ua[mb] = __builtin_amdgcn_mfma_f32_16x16x32_bf16(tf, vf, ua[mb], 0, 0, 0);
                wa[mb] = __builtin_amdgcn_mfma_f32_16x16x32_bf16(kf, tf, wa[mb], 0, 0, 0); }
        }
        bf16_t* UT = (bf16_t*)(rec + GCH_UT); bf16_t* WM = (bf16_t*)(rec + GCH_WM);
#pragma unroll
        for (int mb = 0; mb < 4; ++mb) { u32x2 w; w.x = pk2(ua[mb][0], ua[mb][1]); w.y = pk2(ua[mb][2], ua[mb][3]); *(u32x2*)(UT + (16 * wave + fr) * 64 + 16 * mb + 4 * fq) = w;
            u32x2 v; v.x = pk2(wa[mb][0], wa[mb][1]); v.y = pk2(wa[mb][2], wa[mb][3]); *(u32x2*)(WM + (16 * mb + fr) * 128 + kperm(16 * wave + 4 * fq)) = v; }
        bf16_t* KT = (bf16_t*)(rec + GCH_KT);
#pragma unroll
        for (int k = 0; k < 2; ++k) { const int e = tid + 512 * k, row = e >> 3, cc = e & 7; *(u32x4*)(KT + row * 64 + cc * 8) = *(const LAS u32x4*)(k2 + row * 72 + cc * 8); }
    }
}
struct GaUnit { int t0, h; unsigned char* rec; };
__device__ __forceinline__ GaUnit ga_unit(const Args& A, int unit) { GaUnit u; const int bh = unit >> 5, ck = unit & 31; u.h = bh & 3; u.t0 = (bh >> 2) * SEQ + ck * 64; u.rec = A.ws + WS_GCH + (size_t)unit * GCH_BYTES; return u; }
__device__ __forceinline__ void ga_stage(const GaUnit& u, const bf16_t* QKVC, const LAS float* gcs, const LAS float* bet, LAS bf16_t* vt, LAS bf16_t* kt, LAS bf16_t* k2, int rel, int nth) {
    const float glast = gcs[63];
#pragma unroll 3
    for (int e = rel; e < 64 * 16; e += nth) { const int j = e >> 4, d8 = (e & 15) * 8; const float bj = bet[j], gj = gcs[j]; const float s1 = bj * __expf(gj), s2 = __expf(glast - gj);
        const u32x4 kw = *(const u32x4*)(QKVC + (size_t)(u.t0 + j) * 1536 + C_GK + u.h * 128 + d8), vw = *(const u32x4*)(QKVC + (size_t)(u.t0 + j) * 1536 + C_GV + u.h * 128 + d8);
        const float kf[8] = {bf_lo(kw.x), bf_hi(kw.x), bf_lo(kw.y), bf_hi(kw.y), bf_lo(kw.z), bf_hi(kw.z), bf_lo(kw.w), bf_hi(kw.w)};
        const float vf[8] = {bf_lo(vw.x), bf_hi(vw.x), bf_lo(vw.y), bf_hi(vw.y), bf_lo(vw.z), bf_hi(vw.z), bf_lo(vw.w), bf_hi(vw.w)};
        const int jp = kperm(j);
#pragma unroll
        for (int x = 0; x < 8; ++x) { vt[(d8 + x) * 72 + j] = (bf16_t)f2bf(vf[x] * bj); kt[(d8 + x) * 72 + j] = (bf16_t)f2bf(kf[x] * s1); k2[(d8 + x) * 72 + jp] = (bf16_t)f2bf(kf[x] * s2); }
    }
}
__device__ __forceinline__ void ga_qm(const GaUnit& u, const bf16_t* QKVC, const LAS float* gcs, int rel, int nth) {
    bf16_t* QM = (bf16_t*)(u.rec + GCH_QM);
#pragma unroll 3
    for (int e = rel; e < 64 * 16; e += nth) { const int j = e >> 4, m8 = e & 15, m = m8 & 3; const float s = __expf(gcs[j]) * 0.08838834764831845f;
        const u32x4 qw = *(const u32x4*)(QKVC + (size_t)(u.t0 + j) * 1536 + C_GQ + u.h * 128 + m8 * 8);
        const int pos = (m8 >> 2) * 32 + 16 * (m & 1) + 4 * (m >> 1);
        u32x2 w0, w1; w0.x = pk2(bf_lo(qw.x) * s, bf_hi(qw.x) * s); w0.y = pk2(bf_lo(qw.y) * s, bf_hi(qw.y) * s); w1.x = pk2(bf_lo(qw.z) * s, bf_hi(qw.z) * s); w1.y = pk2(bf_lo(qw.w) * s, bf_hi(qw.w) * s);
        *(u32x2*)(QM + j * 128 + pos) = w0; *(u32x2*)(QM + j * 128 + pos + 8) = w1; }
}
__device__ __forceinline__ void ga_uw(const GaUnit& u, const LAS bf16_t* Tb, const LAS bf16_t* vt, const LAS bf16_t* kt, const LAS bf16_t* k2, int tid, int wave, int fr, int fq) {
    f32x4 ua[4], wa[4];
#pragma unroll
    for (int mb = 0; mb < 4; ++mb) { ua[mb] = (f32x4){0.f, 0.f, 0.f, 0.f}; wa[mb] = (f32x4){0.f, 0.f, 0.f, 0.f}; }
#pragma unroll
    for (int ks = 0; ks < 2; ++ks) {
        const bf16x8 vf = *(const LAS bf16x8*)(vt + (16 * wave + fr) * 72 + ks * 32 + 8 * fq), kf = *(const LAS bf16x8*)(kt + (16 * wave + fr) * 72 + ks * 32 + 8 * fq);
#pragma unroll
        for (int mb = 0; mb < 4; ++mb) { const bf16x8 tf = *(const LAS bf16x8*)(Tb + (16 * mb + fr) * 72 + ks * 32 + 8 * fq);
            ua[mb] = __builtin_amdgcn_mfma_f32_16x16x32_bf16(tf, vf, ua[mb], 0, 0, 0);
            wa[mb] = __builtin_amdgcn_mfma_f32_16x16x32_bf16(kf, tf, wa[mb], 0, 0, 0); }
    }
    bf16_t* UT = (bf16_t*)(u.rec + GCH_UT); bf16_t* WM = (bf16_t*)(u.rec + GCH_WM);
#pragma unroll
    for (int mb = 0; mb < 4; ++mb) { u32x2 w; w.x = pk2(ua[mb][0], ua[mb][1]); w.y = pk2(ua[mb][2], ua[mb][3]); *(u32x2*)(UT + (16 * wave + fr) * 64 + 16 * mb + 4 * fq) = w;
        u32x2 v; v.x = pk2(wa[mb][0], wa[mb][1]); v.y = pk2(wa[mb][2], wa[mb][3]); *(u32x2*)(WM + (16 * mb + fr) * 128 + kperm(16 * wave + 4 * fq)) = v; }
    bf16_t* KT = (bf16_t*)(u.rec + GCH_KT);
#pragma unroll
    for (int k = 0; k < 2; ++k) { const int e = tid + 512 * k, row = e >> 3, cc = e & 7; *(u32x4*)(KT + row * 64 + cc * 8) = *(const LAS u32x4*)(k2 + row * 72 + cc * 8); }
}
__device__ __forceinline__ void gdn_chunk_pair(Ctx& c, const Args& A, int unit0, int unit1) {
    const int tid = c.tid, lane = c.lane, wave = c.wave, fr = lane & 15, fq = lane >> 4;
    const bf16_t* QKVC = (const bf16_t*)(A.ws + WS_QKVC); const float* GB = (const float*)(A.ws + WS_GB); float* GL = (float*)(A.ws + WS_GB + 512 * 1024);
    LAS float* gcs = (LAS float*)c.lds;
    LAS float* bet = gcs + 128;
    LAS float* Lm = (LAS float*)(c.lds + 1024);
    LAS bf16_t* Tb = (LAS bf16_t*)(c.lds + 33792);
    LAS bf16_t* vt = (LAS bf16_t*)(c.lds + 52224);
    LAS bf16_t* kt = vt + 128 * 72; LAS bf16_t* k2 = kt + 128 * 72;
    const GaUnit U0 = ga_unit(A, unit0), U1 = ga_unit(A, unit1);
    __syncthreads();
    if (tid < 128) { const GaUnit& u = wave ? U1 : U0; float g = GB[(size_t)(u.t0 + lane) * 8 + 4 + u.h];
#pragma unroll
        for (int o = 1; o < 64; o <<= 1) { const float n = __shfl_up(g, o); if (lane >= o) g += n; }
        gcs[wave * 64 + lane] = g; bet[wave * 64 + lane] = GB[(size_t)(u.t0 + lane) * 8 + u.h]; }
    __syncthreads();
#pragma unroll 2
    for (int bb = 0; bb < 4; ++bb) {
        const int idx = wave * 4 + bb, p = idx >> 4, blk = idx & 15, ib = blk >> 2, jb = blk & 3; const GaUnit& u = p ? U1 : U0;
        f32x4 kk = (f32x4){0.f, 0.f, 0.f, 0.f}, qk = (f32x4){0.f, 0.f, 0.f, 0.f};
        if (jb <= ib) {
            const bf16_t* ki = QKVC + (size_t)(u.t0 + ib * 16 + fr) * 1536 + C_GK + u.h * 128 + 8 * fq; const bf16_t* qi = QKVC + (size_t)(u.t0 + ib * 16 + fr) * 1536 + C_GQ + u.h * 128 + 8 * fq;
            const bf16_t* kj = QKVC + (size_t)(u.t0 + jb * 16 + fr) * 1536 + C_GK + u.h * 128 + 8 * fq;
#pragma unroll
            for (int ks = 0; ks < 4; ++ks) { const bf16x8 a = *(const bf16x8*)(ki + ks * 32), q = *(const bf16x8*)(qi + ks * 32), bj = *(const bf16x8*)(kj + ks * 32);
                kk = __builtin_amdgcn_mfma_f32_16x16x32_bf16(a, bj, kk, 0, 0, 0); qk = __builtin_amdgcn_mfma_f32_16x16x32_bf16(q, bj, qk, 0, 0, 0); }
        }
        const int j = jb * 16 + fr; const float gj = gcs[p * 64 + j]; bf16_t* AM = (bf16_t*)(u.rec + GCH_AM);
#pragma unroll
        for (int r = 0; r < 4; ++r) { const int i = ib * 16 + 4 * fq + r; const float dec = i >= j ? __expf(gcs[p * 64 + i] - gj) : 0.f;
            Lm[p * 4096 + i * 64 + j] = i > j ? bet[p * 64 + i] * kk[r] * dec : 0.f;
            AM[i * 64 + kperm(j)] = (bf16_t)f2bf(qk[r] * dec * 0.08838834764831845f); }
    }
    __syncthreads();
    if (wave < 2) {
        const LAS float* L = Lm + wave * 4096; LAS bf16_t* Tw = Tb + wave * 64 * 72;
        float Tc[64];
#pragma unroll
        for (int i = 0; i < 64; ++i) { float ac[4] = {(lane == i) ? 1.f : 0.f, 0.f, 0.f, 0.f};
#pragma unroll
            for (int j4 = 0; j4 < (i + 3) / 4; ++j4) { const f32x4 l4 = *(const LAS f32x4*)(L + i * 64 + 4 * j4);
#pragma unroll
                for (int x = 0; x < 4; ++x) if (4 * j4 + x < i) ac[x] -= l4[x] * Tc[4 * j4 + x]; }
            const float acc = (ac[0] + ac[1]) + (ac[2] + ac[3]);
            Tc[i] = acc; Tw[i * 72 + lane] = (bf16_t)f2bf(acc); }
    } else {
        ga_stage(U0, QKVC, gcs, bet, vt, kt, k2, tid - 128, 384);
        ga_qm(U0, QKVC, gcs, tid - 128, 384); ga_qm(U1, QKVC, gcs + 64, tid - 128, 384);
        if (tid == 128) { GL[unit0] = gcs[63]; GL[unit1] = gcs[127]; }
    }
    __syncthreads();
    ga_uw(U0, Tb, vt, kt, k2, tid, wave, fr, fq);
    __syncthreads();
    ga_stage(U1, QKVC, gcs + 64, bet + 64, vt, kt, k2, tid, 512);
    __syncthreads();
    ga_uw(U1, Tb + 64 * 72, vt, kt, k2, tid, wave, fr, fq);
}
__device__ __forceinline__ void gdn_scan(Ctx& c, const Args& A, int unit) {
    const int bh = unit >> 1, dv0 = (unit & 1) * 64 + 16 * (c.wave & 3); const bool active = c.wave < 4;
    const int tid = c.tid, lane = c.lane, fr = lane & 15, fq = lane >> 4, b = bh >> 2, h = bh & 3;
    constexpr int L_WM = 0, L_QM = 17408, L_KT = 34816, L_AM = 53248, L_BUF = 62464;
    const unsigned char* rec0 = A.ws + WS_GCH + (size_t)bh * 32 * GCH_BYTES; const float* GL = (const float*)(A.ws + WS_GB + 512 * 1024) + bh * 32; float* OG = (float*)(A.ws + WS_OGDN);
    f32x4 S[8];
#pragma unroll
    for (int i = 0; i < 8; ++i) S[i] = (f32x4){0.f, 0.f, 0.f, 0.f};
    u32x4 pre[14]; const int t2 = tid - 256;
#define GDN_LOAD(rec) do { _Pragma("unroll") for (int k = 0; k < 14; ++k) pre[k] = *(const u32x4*)((rec) + (size_t)(t2 + 256 * k) * 16); } while (0)
#define GDN_STORE(base) do { \
        _Pragma("unroll") for (int k = 0; k < 4; ++k) { const int q = t2 + 256 * k; *(LAS u32x4*)((base) + L_WM + (q >> 4) * 272 + (q & 15) * 16) = pre[k]; *(LAS u32x4*)((base) + L_QM + (q >> 4) * 272 + (q & 15) * 16) = pre[4 + k]; \
            *(LAS u32x4*)((base) + L_KT + (q >> 3) * 144 + (q & 7) * 16) = pre[8 + k]; } \
        _Pragma("unroll") for (int k = 0; k < 2; ++k) { const int q = t2 + 256 * k; *(LAS u32x4*)((base) + L_AM + (q >> 3) * 144 + (q & 7) * 16) = pre[12 + k]; } } while (0)
    __syncthreads();
    if (!active) { GDN_LOAD(rec0); GDN_STORE(c.lds); }
    u32x2 uwc[4], uwn[4]; float glc = GL[0], gln = 0.f;
#pragma unroll
    for (int mb = 0; mb < 4; ++mb) { uwc[mb] = *(const u32x2*)((const bf16_t*)(rec0 + GCH_UT) + (dv0 + fr) * 64 + 16 * mb + 4 * fq); uwn[mb] = uwc[mb]; }
    __syncthreads();
#pragma unroll 1
    for (int ck = 0; ck < 32; ++ck) {
        const unsigned char* rec = rec0 + (size_t)ck * GCH_BYTES; LAS unsigned char* B0 = c.lds + (ck & 1) * L_BUF; const int t0 = b * SEQ + ck * 64;
        if (ck + 1 < 32) { if (!active) GDN_LOAD(rec + GCH_BYTES); const bf16_t* UTn = (const bf16_t*)(rec + GCH_BYTES + GCH_UT);
#pragma unroll
            for (int mb = 0; mb < 4; ++mb) uwn[mb] = *(const u32x2*)(UTn + (dv0 + fr) * 64 + 16 * mb + 4 * fq); gln = GL[ck + 1]; }
        if (active) {
        bf16x8 sB[4];
#pragma unroll
        for (int ks = 0; ks < 4; ++ks) sB[ks] = pack_frag(S[2 * ks], S[2 * ks + 1]);
        f32x4 vn[4], oa[4];
#pragma unroll
        for (int mb = 0; mb < 4; ++mb) { f32x4 p = (f32x4){0.f, 0.f, 0.f, 0.f}, o = (f32x4){0.f, 0.f, 0.f, 0.f};
#pragma unroll
            for (int ks = 0; ks < 4; ++ks) { const bf16x8 aw = *(const LAS bf16x8*)(B0 + L_WM + (16 * mb + fr) * 272 + ks * 64 + fq * 16), aq = *(const LAS bf16x8*)(B0 + L_QM + (16 * mb + fr) * 272 + ks * 64 + fq * 16);
                p = __builtin_amdgcn_mfma_f32_16x16x32_bf16(aw, sB[ks], p, 0, 0, 0); o = __builtin_amdgcn_mfma_f32_16x16x32_bf16(aq, sB[ks], o, 0, 0, 0); }
            const u32x2 uw = uwc[mb];
            vn[mb] = (f32x4){bf_lo(uw.x) - p[0], bf_hi(uw.x) - p[1], bf_lo(uw.y) - p[2], bf_hi(uw.y) - p[3]}; oa[mb] = o; }
        bf16x8 vB[2];
#pragma unroll
        for (int s = 0; s < 2; ++s) vB[s] = pack_frag(vn[2 * s], vn[2 * s + 1]);
#pragma unroll
        for (int mb = 0; mb < 4; ++mb) {
#pragma unroll
            for (int s = 0; s < 2; ++s) { const bf16x8 aa = *(const LAS bf16x8*)(B0 + L_AM + (16 * mb + fr) * 144 + s * 64 + fq * 16); oa[mb] = __builtin_amdgcn_mfma_f32_16x16x32_bf16(aa, vB[s], oa[mb], 0, 0, 0); }
#pragma unroll
            for (int r = 0; r < 4; ++r) OG[(size_t)(t0 + 16 * mb + 4 * fq + r) * 512 + h * 128 + dv0 + fr] = oa[mb][r]; }
        const float gl = __expf(glc);
#pragma unroll
        for (int m8 = 0; m8 < 8; ++m8) { f32x4 s = S[m8] * gl;
#pragma unroll
            for (int s2 = 0; s2 < 2; ++s2) { const bf16x8 ak = *(const LAS bf16x8*)(B0 + L_KT + (16 * m8 + fr) * 144 + s2 * 64 + fq * 16); s = __builtin_amdgcn_mfma_f32_16x16x32_bf16(ak, vB[s2], s, 0, 0, 0); }
            S[m8] = s; }
        }
        if (ck + 1 < 32 && !active) GDN_STORE(c.lds + ((ck + 1) & 1) * L_BUF);
#pragma unroll
        for (int mb = 0; mb < 4; ++mb) uwc[mb] = uwn[mb];
        glc = gln;
        __syncthreads();
    }
#undef GDN_LOAD
#undef GDN_STORE
}
__device__ __forceinline__ int rel_bucket(int n) {
    if (n < 16) return n;
    const int v = 16 + (int)(__logf((float)n * (1.0f / 16.0f)) / 2.0794415416798357f * 16.0f);
    return v < 31 ? v : 31;
}
__device__ __forceinline__ void attn_mfma(Ctx& c, const Args& A, int l, int first_block, int nblocks) {
    const int tid = c.tid, lane = c.lane, wave = c.wave, fr = lane & 15, fq = lane >> 4;
    const bf16_t* AQ = (const bf16_t*)(A.ws + WS_AQ); const bf16_t* AK = (const bf16_t*)(A.ws + WS_AK); const bf16_t* AVT = (const bf16_t*)(A.ws + WS_AVT); bf16_t* MIXED = (bf16_t*)(A.ws + WS_MIXED);
    LAS float* bt = (LAS float*)c.lds;
    LAS float* cs = bt + 512;
    const float* rel_bias = A.in[1]; const float* lamp = A.in[11] + l * 128; const float* subln = A.in[12] + l * 64;
    const float lambda_init = 0.8f - 0.6f * __expf(-0.3f * (float)l);
    __syncthreads();
    {
        float mq = 0.f, mk = 0.f, mb = 0.f;
        for (int d = 0; d < 32; ++d) { mq = fmaxf(mq, fabsf(A.in[9][l * 32 + d])); mk = fmaxf(mk, fabsf(A.in[10][l * 32 + d])); }
        for (int i = 0; i < 128; ++i) mb = fmaxf(mb, fabsf(rel_bias[i]));
        const float cshift = 5.656854249492381f * mq * mk + mb;
        const int n = tid & 127, hh = tid >> 7; bt[hh * 128 + n] = (rel_bias[rel_bucket(n) * 4 + hh] - cshift) * 1.4426950408889634f;
        if (tid == 0) { float s01 = 0.f, s23 = 0.f; for (int d = 0; d < 32; ++d) { s01 += lamp[d] * lamp[32 + d]; s23 += lamp[64 + d] * lamp[96 + d]; } cs[0] = __expf(s01) - __expf(s23) + lambda_init; }
    }
    __syncthreads();
    const float lam = cs[0];
    bf16x8 ones; { const short o = (fr == 0) ? (short)0x3f80 : (short)0; ones = (bf16x8){o, o, o, o, o, o, o, o}; }
    constexpr int AT_K = 4096, AT_V = 4096 + 4608, AT_BUF = 9728;
    const int wg = c.bid - first_block;
#pragma unroll 1
    for (int rd = 0; rd * nblocks < 256; ++rd) {
        const int it = rd * nblocks + ((rd & 1) ? nblocks - 1 - wg : wg); if (it >= 256) continue;
        const int bh = it & 31, QB = 7 - (it >> 5), b = bh >> 2, h = bh & 3, q0 = QB * 256 + 32 * wave, nsteps = 8 * QB + 8;
        const float bfar = bt[h * 128 + 127];
        bf16x8 qf[2][2];
#pragma unroll
        for (int m = 0; m < 2; ++m)
#pragma unroll
            for (int nq = 0; nq < 2; ++nq) qf[m][nq] = *(const bf16x8*)(AQ + (size_t)(b * SEQ + q0 + nq * 16 + fr) * 256 + h * 64 + m * 32 + 8 * fq);
        f32x4 oacc[2][2][4], lacc[2][2];
#pragma unroll
        for (int m = 0; m < 2; ++m)
#pragma unroll
            for (int nq = 0; nq < 2; ++nq) { lacc[m][nq] = (f32x4){0.f, 0.f, 0.f, 0.f};
#pragma unroll
                for (int nb = 0; nb < 4; ++nb) oacc[m][nq][nb] = (f32x4){0.f, 0.f, 0.f, 0.f}; }
        const int t2 = tid & 255; const bool isK = tid < 256;
        const bf16_t* gsrc = isK ? AK + (size_t)(b * SEQ + (t2 >> 3)) * 256 + h * 64 + (t2 & 7) * 8 : AVT + ((size_t)bh * 64 + (t2 >> 2)) * SEQ + (t2 & 3) * 8;
        const size_t gstep = isK ? (size_t)32 * 256 : (size_t)32;
        const int ldst = isK ? AT_K + (t2 >> 3) * 144 + (t2 & 7) * 16 : AT_V + (t2 >> 2) * 80 + (t2 & 3) * 16;
        __syncthreads();
        u32x4 pre = *(const u32x4*)gsrc; *(LAS u32x4*)(c.lds + ldst) = pre;
        __syncthreads();
#pragma unroll 1
        for (int st = 0; st < nsteps; ++st) {
            const int k0 = st * 32; const LAS unsigned char* B0 = c.lds + (st & 1) * AT_BUF;
            if (st + 1 < nsteps) pre = *(const u32x4*)(gsrc + (size_t)(st + 1) * gstep);
            if (k0 <= q0) {
            bf16x8 kf[2][2], vf[4];
#pragma unroll
            for (int m = 0; m < 2; ++m)
#pragma unroll
                for (int kb = 0; kb < 2; ++kb) kf[m][kb] = *(const LAS bf16x8*)(B0 + AT_K + (kb * 16 + fr) * 144 + m * 64 + fq * 16);
#pragma unroll
            for (int nb = 0; nb < 4; ++nb) vf[nb] = *(const LAS bf16x8*)(B0 + AT_V + (16 * nb + fr) * 80 + fq * 16);
            const bool nearby = (k0 + 144 > q0);
            f32x4 cin[2][2];
            if (nearby) {
#pragma unroll
                for (int nq = 0; nq < 2; ++nq)
#pragma unroll
                    for (int kb = 0; kb < 2; ++kb)
#pragma unroll
                        for (int r = 0; r < 4; ++r) { const int n = (q0 + nq * 16 + fr) - (k0 + kb * 16 + 4 * fq + r); cin[nq][kb][r] = n >= 0 ? bt[h * 128 + (n > 127 ? 127 : n)] : -1.0e30f; }
            } else {
#pragma unroll
                for (int nq = 0; nq < 2; ++nq)
#pragma unroll
                    for (int kb = 0; kb < 2; ++kb) cin[nq][kb] = (f32x4){bfar, bfar, bfar, bfar};
            }
#pragma unroll
            for (int m = 0; m < 2; ++m)
#pragma unroll
                for (int nq = 0; nq < 2; ++nq) {
                    f32x4 p[2];
#pragma unroll
                    for (int kb = 0; kb < 2; ++kb) {
                        f32x4 s = __builtin_amdgcn_mfma_f32_16x16x32_bf16(kf[m][kb], qf[m][nq], cin[nq][kb], 0, 0, 0);
#pragma unroll
                        for (int r = 0; r < 4; ++r) s[r] = __builtin_amdgcn_exp2f(s[r]);
                        p[kb] = s;
                    }
                    const bf16x8 pf = pack_frag(p[0], p[1]);
#pragma unroll
                    for (int nb = 0; nb < 4; ++nb) oacc[m][nq][nb] = __builtin_amdgcn_mfma_f32_16x16x32_bf16(vf[nb], pf, oacc[m][nq][nb], 0, 0, 0);
                    lacc[m][nq] = __builtin_amdgcn_mfma_f32_16x16x32_bf16(ones, pf, lacc[m][nq], 0, 0, 0);
                }
            }
            if (st + 1 < nsteps) *(LAS u32x4*)(c.lds + ((st + 1) & 1) * AT_BUF + ldst) = pre;
            __syncthreads();
        }
#pragma unroll
        for (int nq = 0; nq < 2; ++nq) {
            const float l0 = __shfl(lacc[0][nq][0], fr), l1 = __shfl(lacc[1][nq][0], fr);
            const float i0 = 1.0f / l0, i1 = lam / l1; float ss = 0.f; f32x4 o[4];
#pragma unroll
            for (int nb = 0; nb < 4; ++nb) { o[nb] = oacc[0][nq][nb] * i0 - oacc[1][nq][nb] * i1; ss += (o[nb][0] * o[nb][0] + o[nb][1] * o[nb][1]) + (o[nb][2] * o[nb][2] + o[nb][3] * o[nb][3]); }
            ss += lxf<16>(ss); ss += lxf<32>(ss);
            const float rn = rsqrtf(ss * (1.0f / 64.0f) + 1e-6f) * (1.0f - lambda_init);
            bf16_t* orow = MIXED + (size_t)(b * SEQ + q0 + nq * 16 + fr) * 1024 + 768 + h * 64;
#pragma unroll
            for (int nb = 0; nb < 4; ++nb) { const float4 sg = *(const float4*)(subln + 16 * nb + 4 * fq);
                u32x2 w; w.x = pk2(o[nb][0] * rn * sg.x, o[nb][1] * rn * sg.y); w.y = pk2(o[nb][2] * rn * sg.z, o[nb][3] * rn * sg.w);
                *(u32x2*)(orow + 16 * nb + 4 * fq) = w; }
        }
    }
    __syncthreads();
}
__device__ __forceinline__ void phase_gdn_out(Ctx& c, const Args& A, int l) {
    const int gw = c.bid * 8 + c.wave, NGW = c.G * 8, lane = c.lane;
    const bf16_t* PROJ = (const bf16_t*)(A.ws + WS_PROJ); const float* OG = (const float*)(A.ws + WS_OGDN); bf16_t* MIXED = (bf16_t*)(A.ws + WS_MIXED);
    const float4 g0 = *(const float4*)(A.in[7] + l * 128 + (lane & 15) * 8), g1 = *(const float4*)(A.in[7] + l * 128 + (lane & 15) * 8 + 4);
    for (int run = gw; run < T / 8; run += NGW) {
        const int t0 = run * 8; float4 oa[8], ob[8]; u32x4 zz[8];
#pragma unroll
        for (int i = 0; i < 8; ++i) { const float* op = OG + (size_t)(t0 + i) * 512 + lane * 8; oa[i] = *(const float4*)op; ob[i] = *(const float4*)(op + 4); zz[i] = *(const u32x4*)(PROJ + (size_t)(t0 + i) * NPROJ + C_GZ + lane * 8); }
#pragma unroll
        for (int i = 0; i < 8; ++i) {
            float ss = (oa[i].x * oa[i].x + oa[i].y * oa[i].y) + (oa[i].z * oa[i].z + oa[i].w * oa[i].w) + (ob[i].x * ob[i].x + ob[i].y * ob[i].y) + (ob[i].z * ob[i].z + ob[i].w * ob[i].w);
            ss += lxf<1>(ss); ss += lxf<2>(ss); ss += lxf<4>(ss); ss += lxf<8>(ss);
            const float r = rsqrtf(ss * (1.0f / 128.0f) + 1e-6f);
            u32x4 w; w.x = pk2(oa[i].x * r * g0.x * silu_f(bf_lo(zz[i].x)), oa[i].y * r * g0.y * silu_f(bf_hi(zz[i].x))); w.y = pk2(oa[i].z * r * g0.z * silu_f(bf_lo(zz[i].y)), oa[i].w * r * g0.w * silu_f(bf_hi(zz[i].y)));
            w.z = pk2(ob[i].x * r * g1.x * silu_f(bf_lo(zz[i].z)), ob[i].y * r * g1.y * silu_f(bf_hi(zz[i].z))); w.w = pk2(ob[i].z * r * g1.z * silu_f(bf_lo(zz[i].w)), ob[i].w * r * g1.w * silu_f(bf_hi(zz[i].w)));
            *(u32x4*)(MIXED + (size_t)(t0 + i) * 1024 + lane * 8) = w;
        }
    }
}

__device__ __forceinline__ unsigned ord_key(float f) { const unsigned u = __float_as_uint(f); return (u & 0x80000000u) ? ~u : (u | 0x80000000u); }
__device__ __forceinline__ float ord_val(unsigned o) { return __uint_as_float((o & 0x80000000u) ? (o & 0x7fffffffu) : ~o); }
__device__ __forceinline__ float gelu_erf(float v) {
    const float av = fabsf(v), t = __builtin_amdgcn_rcpf(av * 0.2316418882f + 1.0f);
    float q = t * 0.5307027145f + (-0.7265760135f); q = q * t + 0.7107068705f; q = q * t + (-0.142248368f); q = q * t + 0.127414796f; q = q * t;
    const float e = __builtin_amdgcn_exp2f((v * v) * (-0.72134752044f)); const float m = v * (q * e);
    return v < 0.f ? m : v - m;
}
typedef __bf16 v2bf_t __attribute__((ext_vector_type(2)));
__device__ __forceinline__ float dot2bf(unsigned a, unsigned b, float acc) { return __builtin_amdgcn_fdot2_f32_bf16(__builtin_bit_cast(v2bf_t, a), __builtin_bit_cast(v2bf_t, b), acc, false); }
__device__ __forceinline__ float dot8(const u32x4& x, const u32x4& u, float acc) { acc = dot2bf(x.x, u.x, acc); acc = dot2bf(x.y, u.y, acc); acc = dot2bf(x.z, u.z, acc); return dot2bf(x.w, u.w, acc); }
__device__ __forceinline__ void axpy8(float* o, float cf, const u32x4& v) {
    o[0] += cf * bf_lo(v.x); o[1] += cf * bf_hi(v.x); o[2] += cf * bf_lo(v.y); o[3] += cf * bf_hi(v.y); o[4] += cf * bf_lo(v.z); o[5] += cf * bf_hi(v.z); o[6] += cf * bf_lo(v.w); o[7] += cf * bf_hi(v.w); }
typedef float f32x2_t __attribute__((ext_vector_type(2)));
__device__ __forceinline__ void axpy16_fp8(float* o, float cf, const u32x4& v) {
    const unsigned w[4] = {v.x, v.y, v.z, v.w};
#pragma unroll
    for (int i = 0; i < 4; ++i) { const f32x2_t a = __builtin_amdgcn_cvt_pk_f32_fp8((int)w[i], false), b = __builtin_amdgcn_cvt_pk_f32_fp8((int)w[i], true);
        o[4 * i] += cf * a.x; o[4 * i + 1] += cf * a.y; o[4 * i + 2] += cf * b.x; o[4 * i + 3] += cf * b.y; }
}
typedef _Float16 v2h_t __attribute__((ext_vector_type(2)));
__device__ __forceinline__ unsigned pkh(float a, float b) { const v2h_t h = {(_Float16)a, (_Float16)b}; return __builtin_bit_cast(unsigned, h); }
typedef _Float16 v2h_t __attribute__((ext_vector_type(2)));
__device__ __forceinline__ float dot4_fp8(unsigned uw, unsigned xlo, unsigned xhi, float acc) {
    acc = __builtin_amdgcn_fdot2(__builtin_amdgcn_cvt_scalef32_pk_f16_fp8(uw, 1.0f, false), __builtin_bit_cast(v2h_t, xlo), acc, false);
    return __builtin_amdgcn_fdot2(__builtin_amdgcn_cvt_scalef32_pk_f16_fp8(uw, 1.0f, true), __builtin_bit_cast(v2h_t, xhi), acc, false);
}
__device__ __forceinline__ float dot16_fp8(const u32x4& x0, const u32x4& x1, const u32x4& u) {
    float acc = dot4_fp8(u.x, x0.x, x0.y, 0.f); acc = dot4_fp8(u.y, x0.z, x0.w, acc); acc = dot4_fp8(u.z, x1.x, x1.y, acc); return dot4_fp8(u.w, x1.z, x1.w, acc);
}
__device__ __forceinline__ void cvt16_fp8(float* f, const u32x4& v) {
    const unsigned w[4] = {v.x, v.y, v.z, v.w};
#pragma unroll
    for (int i = 0; i < 4; ++i) { const f32x2_t a = __builtin_amdgcn_cvt_pk_f32_fp8((int)w[i], false), b = __builtin_amdgcn_cvt_pk_f32_fp8((int)w[i], true); f[4 * i] = a.x; f[4 * i + 1] = a.y; f[4 * i + 2] = b.x; f[4 * i + 3] = b.y; }
}
__device__ __forceinline__ void phase_peer(Ctx& c, const Args& A, int l, float* hdst, bool fuse_next, const XcdBarrier& bar, bool align) {
    const int tid = c.tid, lane = c.lane, wave = c.wave, fr = lane & 15, fq = lane >> 4;
    const bf16_t* QP = (const bf16_t*)(A.ws + WS_QP); const bf16_t* KEYS = (const bf16_t*)(A.ws + WS_KEYS) + (size_t)l * 16 * 128 * 128;
    const bf16_t* XF = (const bf16_t*)(A.ws + WS_NBUF); const float* RSl = (const float*)(A.ws + WS_RS); const unsigned char* U8 = A.ws + WS_UT + (size_t)l * NEXP * EREC; const unsigned char* V8 = U8 + 1024; const float* VS = (const float*)(A.ws + WS_VSC) + (size_t)l * NEXP; const float* US = (const float*)(A.ws + WS_USC) + (size_t)l * NEXP;
    LAS int* lidx = (LAS int*)c.lds;
    LAS float* lgate = (LAS float*)(c.lds + 32768);
    LAS unsigned* tkb = (LAS unsigned*)(c.lds + 65536);
    for (int blk = c.bid; blk < T / 64; blk += c.G) {
        const int tb0 = blk * 64;
        __syncthreads();
#pragma unroll 1
        for (int rrep_ = 0; rrep_ < 1 + ((DUP >> 11) & 1); ++rrep_) {
#define PEER_RLOAD(Q, Kf, st) do { const int hh_ = (st) >> 2, ks_ = (st) & 3, hp_ = (hh_ >> 1) * 8 + wave, sp_ = (hh_ & 1) * 2; \
        const bf16_t* qp_ = QP; const bf16_t* kp_ = KEYS; asm volatile("" : "+s"(qp_), "+s"(kp_) : "v"(acc[1][7]));     \
        _Pragma("unroll") for (int sb = 0; sb < 2; ++sb) Q[sb] = *(const bf16x8*)(qp_ + (size_t)(tb0 + (sp_ + sb) * 16 + fr) * 2048 + hp_ * 128 + ks_ * 32 + 8 * fq); \
        _Pragma("unroll") for (int nb = 0; nb < 8; ++nb) Kf[nb] = *(const bf16x8*)(kp_ + ((size_t)hp_ * 128 + nb * 16 + fr) * 128 + ks_ * 32 + 8 * fq); } while (0)
#define PEER_RMMA(Q, Kf) do { _Pragma("unroll") for (int nb = 0; nb < 8; ++nb) _Pragma("unroll") for (int sb = 0; sb < 2; ++sb) acc[sb][nb] = __builtin_amdgcn_mfma_f32_16x16x32_bf16(Kf[nb], Q[sb], acc[sb][nb], 0, 0, 0); } while (0)
            bf16x8 qA[2], kA[8], qB[2], kB[8]; f32x4 acc[2][8]; acc[1][7] = (f32x4){0.f, 0.f, 0.f, 0.f};
            PEER_RLOAD(qA, kA, 0);
#pragma unroll 1
            for (int hh = 0; hh < 4; ++hh) {
                const int hp = (hh >> 1) * 8 + wave, sp = (hh & 1) * 2;
#pragma unroll
                for (int sb = 0; sb < 2; ++sb)
#pragma unroll
                    for (int nb = 0; nb < 8; ++nb) acc[sb][nb] = (f32x4){0.f, 0.f, 0.f, 0.f};
                PEER_RLOAD(qB, kB, 4 * hh + 1); PEER_RMMA(qA, kA);
                PEER_RLOAD(qA, kA, 4 * hh + 2); PEER_RMMA(qB, kB);
                PEER_RLOAD(qB, kB, 4 * hh + 3); PEER_RMMA(qA, kA);
                { const int hn_ = hh < 3 ? hh + 1 : hh; PEER_RLOAD(qA, kA, 4 * hn_); }
                PEER_RMMA(qB, kB);
#define PEER_MERGE(N) do { unsigned p[16]; \
        _Pragma("unroll") for (int i = 0; i < 16; ++i) p[i] = lxu<N>(v[i]); \
        _Pragma("unroll") for (int i = 0; i < 16; ++i) v[i] = v[i] > p[15 - i] ? v[i] : p[15 - i]; \
        _Pragma("unroll") for (int j = 8; j > 0; j >>= 1) _Pragma("unroll") for (int i = 0; i < 16; ++i) { const int q = i ^ j; if (q > i) { const unsigned x = v[i], y = v[q]; v[i] = x > y ? x : y; v[q] = x > y ? y : x; } } } while (0)
#pragma unroll 1
                for (int sb = 0; sb < 2; ++sb) {
                    LAS unsigned* tk = tkb + (sp + sb) * 4096;
                    unsigned v[32];
#pragma unroll
                    for (int nb = 0; nb < 8; ++nb) { const f32x4 a_ = sb == 0 ? acc[0][nb] : acc[1][nb];
#pragma unroll
                        for (int r = 0; r < 4; ++r) v[nb * 4 + r] = (ord_key(a_[r]) & ~127u) | (unsigned)(127 - (nb * 16 + 4 * fq + r)); }
#pragma unroll
                    for (int k = 2; k <= 32; k <<= 1)
#pragma unroll
                        for (int j = k >> 1; j > 0; j >>= 1)
#pragma unroll
                            for (int i = 0; i < 32; ++i) { const int q = i ^ j; if (q > i) { const bool desc = ((i & k) == 0); const unsigned x = v[i], y = v[q]; const unsigned hi = x > y ? x : y, lo = x > y ? y : x; v[i] = desc ? hi : lo; v[q] = desc ? lo : hi; } }
                    PEER_MERGE(16); PEER_MERGE(32);
                    { u32x4 w; w.x = fq == 0 ? v[0] : (fq == 1 ? v[4] : (fq == 2 ? v[8] : v[12])); w.y = fq == 0 ? v[1] : (fq == 1 ? v[5] : (fq == 2 ? v[9] : v[13]));
                      w.z = fq == 0 ? v[2] : (fq == 1 ? v[6] : (fq == 2 ? v[10] : v[14])); w.w = fq == 0 ? v[3] : (fq == 1 ? v[7] : (fq == 2 ? v[11] : v[15]));
                      *(LAS u32x4*)(tk + (fr * 16 + hp) * 16 + 4 * fq) = w; }
                }
#undef PEER_MERGE
            }
#undef PEER_RLOAD
#undef PEER_RMMA
            __syncthreads();
#pragma unroll 1
            for (int sub = 0; sub < 4; ++sub)
            {
                const LAS unsigned* tk = tkb + sub * 4096;
                const int pp = tid >> 2, qd = tid & 3, tok = pp >> 3, h = pp & 7;
                const LAS unsigned* a = tk + (tok * 16 + 2 * h) * 16; const LAS unsigned* b = a + 16;
                unsigned v[16], s5[5];
                {
                    const float sj0 = ord_val(b[qd] & ~127u), sj1 = ord_val(b[qd + 4] & ~127u), sj2 = ord_val(b[qd + 8] & ~127u), sj3 = ord_val(b[qd + 12] & ~127u);
#pragma unroll
                    for (int i = 0; i < 16; ++i) { const float si = ord_val(a[i] & ~127u);
                        v[i] = ((i + 1) * (qd + 1) <= 16) ? ((ord_key(si + sj0) & ~255u) | (unsigned)(255 - (i * 16 + qd))) : 0u;
                        if (i < 3) s5[i] = ((i + 1) * (qd + 5) <= 16) ? ((ord_key(si + sj1) & ~255u) | (unsigned)(255 - (i * 16 + qd + 4))) : 0u;
                        if (i == 0) { s5[3] = ((qd + 9) <= 16) ? ((ord_key(si + sj2) & ~255u) | (unsigned)(255 - (qd + 8))) : 0u; s5[4] = ((qd + 13) <= 16) ? ((ord_key(si + sj3) & ~255u) | (unsigned)(255 - (qd + 12))) : 0u; } }
                }
#define PEER_CE(x, y) do { const unsigned hi_ = x > y ? x : y, lo_ = x > y ? y : x; x = hi_; y = lo_; } while (0)
                PEER_CE(s5[0], s5[1]); PEER_CE(s5[3], s5[4]); PEER_CE(s5[2], s5[4]); PEER_CE(s5[2], s5[3]); PEER_CE(s5[0], s5[3]); PEER_CE(s5[0], s5[2]); PEER_CE(s5[1], s5[4]); PEER_CE(s5[1], s5[3]); PEER_CE(s5[1], s5[2]);
#pragma unroll
                for (int t = 0; t < 5; ++t) v[15 - t] = v[15 - t] > s5[t] ? v[15 - t] : s5[t];
#pragma unroll
                for (int j = 8; j > 0; j >>= 1)
#pragma unroll
                    for (int i = 0; i < 16; ++i) { const int q = i ^ j; if (q > i) PEER_CE(v[i], v[q]); }
#define PEER_MERGE(N) do { unsigned p[16]; \
        _Pragma("unroll") for (int i = 0; i < 16; ++i) p[i] = lxu<N>(v[i]); \
        _Pragma("unroll") for (int i = 0; i < 16; ++i) v[i] = v[i] > p[15 - i] ? v[i] : p[15 - i]; \
        _Pragma("unroll") for (int j = 8; j > 0; j >>= 1) _Pragma("unroll") for (int i = 0; i < 16; ++i) { const int q = i ^ j; if (q > i) PEER_CE(v[i], v[q]); } } while (0)
                PEER_MERGE(1); PEER_MERGE(2);
#undef PEER_MERGE
#undef PEER_CE
                const float mx = ord_val(v[0] & ~255u); const int tl = sub * 16 + tok;
                unsigned m4[4]; float e4[4]; int x4[4];
#pragma unroll
                for (int t = 0; t < 4; ++t) { m4[t] = qd == 0 ? v[t] : (qd == 1 ? v[4 + t] : (qd == 2 ? v[8 + t] : v[12 + t]));
                    const int pos = 255 - (int)(m4[t] & 255u), pi = pos >> 4, pj = pos & 15;
                    e4[t] = __expf(ord_val(m4[t] & ~255u) - mx);
                    x4[t] = (127 - (int)(a[pi] & 127u)) * 128 + (127 - (int)(b[pj] & 127u)); }
                float sum = (e4[0] + e4[1]) + (e4[2] + e4[3]); sum += lxf<1>(sum); sum += lxf<2>(sum);
                const float inv = 1.0f / sum;
                { u32x4 xi; xi.x = (unsigned)x4[0]; xi.y = (unsigned)x4[1]; xi.z = (unsigned)x4[2]; xi.w = (unsigned)x4[3]; *(LAS u32x4*)(lidx + tl * 128 + h * 16 + 4 * qd) = xi;
                  f32x4 gi; gi.x = e4[0] * inv; gi.y = e4[1] * inv; gi.z = e4[2] * inv; gi.w = e4[3] * inv; *(LAS f32x4*)(lgate + tl * 128 + h * 16 + 4 * qd) = gi; }
            }
        }
        __syncthreads();
        LAS unsigned char* lbase = c.lds + 65536 + wave * 10240;
        const int es = ((lane & 1) << 2) | (lane & 2) | ((lane >> 2) & 1);
#pragma unroll 1
        for (int pass = 0; pass < 2; ++pass) {
            const int tl0 = pass * 32 + wave * 4; LAS unsigned* sl = (LAS unsigned*)lbase + pass * 512; LAS float* sg = (LAS float*)(lbase + 4096) + pass * 512; LAS unsigned short* sv = (LAS unsigned short*)(lbase + 8192) + pass * 512;
            int il[4], ih[4]; float gl[4], gh[4];
#pragma unroll
            for (int k = 0; k < 4; ++k) { const int a0 = lidx[(tl0 + k) * 128 + lane], a1 = lidx[(tl0 + k) * 128 + 64 + lane];
                gl[k] = lgate[(tl0 + k) * 128 + lane] * VS[a0]; gh[k] = lgate[(tl0 + k) * 128 + 64 + lane] * VS[a1];
                il[k] = a0 | (k << 14) | (int)(((__float_as_uint(US[a0]) >> 23) & 255u) << 16); ih[k] = a1 | (k << 14) | (int)(((__float_as_uint(US[a1]) >> 23) & 255u) << 16); }
            LAS int* ct = (LAS int*)(c.lds + 147456) + wave * 256;
            int rk[8], cn[8], pu[8];
#pragma unroll
            for (int g = 0; g < 8; ++g) { const int w = (g & 1) ? ih[g >> 1] : il[g >> 1]; const int r = (w >> 9) & 31; unsigned long long eq = ~0ull;
#pragma unroll
                for (int bt_ = 0; bt_ < 5; ++bt_) { const bool bit = (r >> bt_) & 1; const unsigned long long m = __ballot(bit); eq &= bit ? m : ~m; }
                rk[g] = (int)__builtin_amdgcn_mbcnt_hi((unsigned)(eq >> 32), __builtin_amdgcn_mbcnt_lo((unsigned)eq, 0u)); cn[g] = __builtin_popcountll(eq); }
#pragma unroll
            for (int ord = 0; ord < 2; ++ord) {
#pragma unroll
                for (int i = 0; i < 4; ++i) ct[lane + 64 * i] = 0;
#pragma unroll
                for (int g = 0; g < 8; ++g) { const int w = (g & 1) ? ih[g >> 1] : il[g >> 1]; const int r = (w >> 9) & 31; ct[ord ? (g >> 1) * 64 + r * 2 + (g & 1) : r * 8 + g] = cn[g]; }
                { const int c0 = ct[4 * lane], c1 = ct[4 * lane + 1], c2 = ct[4 * lane + 2], c3 = ct[4 * lane + 3]; int sum = (c0 + c1) + (c2 + c3);
#pragma unroll
                  for (int o = 1; o < 64; o <<= 1) { const int n = __shfl_up(sum, o); if (lane >= o) sum += n; }
                  const int ex = sum - ((c0 + c1) + (c2 + c3));
                  ct[4 * lane] = ex; ct[4 * lane + 1] = ex + c0; ct[4 * lane + 2] = ex + c0 + c1; ct[4 * lane + 3] = ex + c0 + c1 + c2; }
#pragma unroll
                for (int g = 0; g < 8; ++g) { const int w = (g & 1) ? ih[g >> 1] : il[g >> 1]; const int r = (w >> 9) & 31;
                    if (ord == 0) pu[g] = ct[r * 8 + g] + rk[g];
                    else { const int k = g >> 1, p = ct[k * 64 + r * 2 + (g & 1)] + rk[g] - 128 * k;
                        const int vp = 8 * (p >> 1) + 2 * k + (p & 1);
                        sl[pu[g]] = (unsigned)w | ((unsigned)p << 24); sg[vp] = (g & 1) ? gh[k] : gl[k]; sv[vp] = (unsigned short)(w & 16383); } }
            }
        }
        __syncthreads();
        LAS unsigned char* xw = c.lds + wave * 8192;
#pragma unroll 1
        for (int pass = 0; pass < 2; ++pass) {
            if (align && pass == 1) xcd_barrier(bar);
            const int tl0 = pass * 32 + wave * 4; const LAS unsigned* sl = (const LAS unsigned*)lbase + pass * 512; LAS float* sg = (LAS float*)(lbase + 4096) + pass * 512; const LAS unsigned short* sv = (const LAS unsigned short*)(lbase + 8192) + pass * 512;
            v2h_t out[4][8]; float xinv1;
            {
                float f[4][16]; float am = 0.f;
#pragma unroll
                for (int k = 0; k < 4; ++k) { const size_t t = (size_t)(tb0 + tl0 + k);
                    float rs; { const float4 a = *(const float4*)(RSl + t * 16), b = *(const float4*)(RSl + t * 16 + 4), c2 = *(const float4*)(RSl + t * 16 + 8), d = *(const float4*)(RSl + t * 16 + 12);
                        rs = rsqrtf(((((a.x + a.y) + (a.z + a.w)) + ((b.x + b.y) + (b.z + b.w))) + (((c2.x + c2.y) + (c2.z + c2.w)) + ((d.x + d.y) + (d.z + d.w)))) * (1.0f / 1024.0f) + 1e-6f); }
                    const u32x4 w0 = *(const u32x4*)(XF + t * 1024 + 16 * lane), w1 = *(const u32x4*)(XF + t * 1024 + 16 * lane + 8);
                    f[k][0] = bf_lo(w0.x); f[k][1] = bf_hi(w0.x); f[k][2] = bf_lo(w0.y); f[k][3] = bf_hi(w0.y); f[k][4] = bf_lo(w0.z); f[k][5] = bf_hi(w0.z); f[k][6] = bf_lo(w0.w); f[k][7] = bf_hi(w0.w);
                    f[k][8] = bf_lo(w1.x); f[k][9] = bf_hi(w1.x); f[k][10] = bf_lo(w1.y); f[k][11] = bf_hi(w1.y); f[k][12] = bf_lo(w1.z); f[k][13] = bf_hi(w1.z); f[k][14] = bf_lo(w1.w); f[k][15] = bf_hi(w1.w);
#pragma unroll
                    for (int i = 0; i < 16; ++i) { f[k][i] *= rs; am = fmaxf(am, fabsf(f[k][i])); } }
                am = fmaxf(am, lxf<1>(am)); am = fmaxf(am, lxf<2>(am)); am = fmaxf(am, lxf<4>(am)); am = fmaxf(am, lxf<8>(am)); am = fmaxf(am, lxf<16>(am)); am = fmaxf(am, lxf<32>(am));
                const float sx = am > 0.f ? __uint_as_float(__float_as_uint(127.0f / am) & 0x7f800000u) : 1.0f;
                xinv1 = __int_as_float(__builtin_amdgcn_readfirstlane(__float_as_int(1.0f / sx)));
#pragma unroll
                for (int k = 0; k < 4; ++k) { u32x4 xq; unsigned qq[4];
#pragma unroll
                    for (int i = 0; i < 4; ++i) qq[i] = ((unsigned)(int)rintf(f[k][4 * i] * sx) & 255u) | (((unsigned)(int)rintf(f[k][4 * i + 1] * sx) & 255u) << 8) | (((unsigned)(int)rintf(f[k][4 * i + 2] * sx) & 255u) << 16) | (((unsigned)(int)rintf(f[k][4 * i + 3] * sx) & 255u) << 24);
                    xq.x = qq[0]; xq.y = qq[1]; xq.z = qq[2]; xq.w = qq[3];
                    *(LAS u32x4*)(xw + k * 1024 + lane * 16) = xq; }
            }
            constexpr int NW = 8, NBW = 64;
            {
                u32x4 uA[NW], uB[NW], uC[NW], uD[NW]; unsigned mA[NW], mB[NW], mC[NW], mD[NW];
#define PEER_UISSUE(uu, mm, b) do { _Pragma("unroll") for (int s = 0; s < NW; ++s) { mm[s] = __builtin_amdgcn_readfirstlane(sl[NW * (b) + s]); uu[s] = ((const u32x4*)(U8 + (size_t)(mm[s] & 16383u) * EREC))[lane]; } } while (0)
#define PEER_UCOMPUTE(uu, mm, b) do { int d_[8]; \
        _Pragma("unroll") for (int s = 0; s < NW; ++s) { const unsigned kx_ = (mm[s] >> 14) & 3u; const u32x4 xq_ = *(const LAS u32x4*)(xw + kx_ * 1024 + lane * 16); \
            int ia_ = __builtin_amdgcn_sdot4((int)uu[s].x, (int)xq_.x, 0, false); ia_ = __builtin_amdgcn_sdot4((int)uu[s].y, (int)xq_.y, ia_, false); ia_ = __builtin_amdgcn_sdot4((int)uu[s].z, (int)xq_.z, ia_, false); ia_ = __builtin_amdgcn_sdot4((int)uu[s].w, (int)xq_.w, ia_, false); \
            d_[s] = ia_; } \
        const bool o1_ = lane & 1, o2_ = lane & 2, o4_ = lane & 4; \
        int a0_ = o1_ ? d_[4] : d_[0], a1_ = o1_ ? d_[5] : d_[1], a2_ = o1_ ? d_[6] : d_[2], a3_ = o1_ ? d_[7] : d_[3]; \
        a0_ += lxi<1>(o1_ ? d_[0] : d_[4]); a1_ += lxi<1>(o1_ ? d_[1] : d_[5]); a2_ += lxi<1>(o1_ ? d_[2] : d_[6]); a3_ += lxi<1>(o1_ ? d_[3] : d_[7]); \
        int b0_ = o2_ ? a2_ : a0_, b1_ = o2_ ? a3_ : a1_; b0_ += lxi<2>(o2_ ? a0_ : a2_); b1_ += lxi<2>(o2_ ? a1_ : a3_); \
        int ci_ = o4_ ? b1_ : b0_; ci_ += lxi<4>(o4_ ? b0_ : b1_); \
        ci_ += lxi<8>(ci_); ci_ += lxi<16>(ci_); ci_ += lxi<32>(ci_); \
        const unsigned wes_ = sl[NW * (b) + es];     \
        const int pv_ = (int)(wes_ >> 24), vp_ = 8 * (pv_ >> 1) + 2 * (int)((wes_ >> 14) & 3u) + (pv_ & 1); \
        const float cc_ = (float)ci_ * (__uint_as_float(((wes_ >> 16) & 255u) << 23) * xinv1); \
        const float cfv_ = sg[vp_] * gelu_erf(cc_); \
        if (lane < 8) sg[vp_] = __uint_as_float(pkh(cfv_, cfv_)); } while (0)
                PEER_UISSUE(uA, mA, 0); PEER_UISSUE(uB, mB, 1); PEER_UISSUE(uC, mC, 2);
#pragma unroll 1
                for (int bb = 0; bb < NBW; bb += 4) {
                    PEER_UISSUE(uD, mD, bb + 3);
                    PEER_UCOMPUTE(uA, mA, bb);
                    if (bb + 4 < NBW) PEER_UISSUE(uA, mA, bb + 4);
                    PEER_UCOMPUTE(uB, mB, bb + 1);
                    if (bb + 4 < NBW) PEER_UISSUE(uB, mB, bb + 5);
                    PEER_UCOMPUTE(uC, mC, bb + 2);
                    if (bb + 4 < NBW) PEER_UISSUE(uC, mC, bb + 6);
                    PEER_UCOMPUTE(uD, mD, bb + 3);
                }
#undef PEER_UISSUE
#undef PEER_UCOMPUTE
            }
            asm volatile("s_waitcnt lgkmcnt(0)" ::: "memory");
            if (align && ALIGN_V) xcd_barrier(bar);
#pragma unroll
            for (int k = 0; k < 4; ++k)
#pragma unroll
                for (int i = 0; i < 8; ++i) out[k][i] = (v2h_t){(_Float16)0.f, (_Float16)0.f};
            {
                U3 vA[NW], vB[NW]; float cA[NW], cB[NW];
#define PEER_VISSUE(vv, cc, b) do { _Pragma("unroll") for (int s = 0; s < NW; ++s) { const unsigned e_ = (unsigned)__builtin_amdgcn_readfirstlane((int)sv[NW * (b) + s]); cc[s] = __int_as_float(__builtin_amdgcn_readfirstlane(__float_as_int(sg[NW * (b) + s]))); \
            vv[s] = ((const U3*)(V8 + (size_t)e_ * EREC))[lane]; } } while (0)
#define PEER_VCOMPUTE(vv, cc) do { \
        _Pragma("unroll") for (int k = 0; k < 4; ++k) { \
            const u32x6 w6_ = {vv[2 * k].x, vv[2 * k].y, vv[2 * k].z, vv[2 * k + 1].x, vv[2 * k + 1].y, vv[2 * k + 1].z}; const f16x32 vf_ = __builtin_amdgcn_cvt_scalef32_pk32_f16_fp6(w6_, 1.0f); \
            const v2h_t c0_ = __builtin_bit_cast(v2h_t, __float_as_uint(cc[2 * k])), c1_ = __builtin_bit_cast(v2h_t, __float_as_uint(cc[2 * k + 1])); \
            _Pragma("unroll") for (int j = 0; j < 8; ++j) { const v2h_t a_ = {vf_[2 * j], vf_[2 * j + 1]}; out[k][j] = __builtin_elementwise_fma(a_, c0_, out[k][j]); } \
            _Pragma("unroll") for (int j = 0; j < 8; ++j) { const v2h_t b_ = {vf_[16 + 2 * j], vf_[16 + 2 * j + 1]}; out[k][j] = __builtin_elementwise_fma(b_, c1_, out[k][j]); } } } while (0)
                PEER_VISSUE(vA, cA, 0);
#pragma unroll 1
                for (int bb = 0; bb < NBW; bb += 2) {
                    PEER_VISSUE(vB, cB, bb + 1);
                    PEER_VCOMPUTE(vA, cA);
                    if (bb + 2 < NBW) PEER_VISSUE(vA, cA, bb + 2);
                    PEER_VCOMPUTE(vB, cB);
                }
#undef PEER_VISSUE
#undef PEER_VCOMPUTE
            }
#pragma unroll
            for (int k = 0; k < 4; ++k) { const size_t t = (size_t)(tb0 + tl0 + k); const float* hp = A.out + t * 1024 + 16 * lane; float* hq = hdst + t * 1024 + 16 * lane;
#pragma unroll
                for (int i = 0; i < 4; ++i) { float4 h4 = *(const float4*)(hp + 4 * i); h4.x += (float)out[k][2 * i].x; h4.y += (float)out[k][2 * i].y; h4.z += (float)out[k][2 * i + 1].x; h4.w += (float)out[k][2 * i + 1].y; *(float4*)(hq + 4 * i) = h4; }
            }
#pragma unroll 1
            for (int k2 = 0; k2 < (fuse_next ? 2 : 0); ++k2) {
                int lo16 = 16 * lane; asm volatile("" : "+v"(lo16));
                const float* nx_gain = A.in[2] + (l + 1) * 1024 + lo16; const float* nx_wgate = (const float*)(A.ws + WS_WGATE) + (l + 1) * 8 * 1024 + lo16; const float* nx_alog = A.in[5] + (l + 1) * 4; const float* nx_dtb = A.in[6] + (l + 1) * 4;
                float hv[2][16], ss[2], d[2][8];
#pragma unroll
                for (int k = 0; k < 2; ++k) { const float* hq = hdst + (size_t)(tb0 + tl0 + 2 * k2 + k) * 1024 + lo16;
#pragma unroll
                    for (int i = 0; i < 4; ++i) { const float4 h4 = *(const float4*)(hq + 4 * i); hv[k][4 * i] = h4.x; hv[k][4 * i + 1] = h4.y; hv[k][4 * i + 2] = h4.z; hv[k][4 * i + 3] = h4.w; }
                    float s2 = 0.f;
#pragma unroll
                    for (int i = 0; i < 16; ++i) s2 += hv[k][i] * hv[k][i];
                    ss[k] = s2; }
#pragma unroll
                for (int i = 0; i < 4; ++i) { const float4 g4 = *(const float4*)(nx_gain + 4 * i);
#pragma unroll
                    for (int k = 0; k < 2; ++k) { hv[k][4 * i] *= g4.x; hv[k][4 * i + 1] *= g4.y; hv[k][4 * i + 2] *= g4.z; hv[k][4 * i + 3] *= g4.w; } }
#pragma unroll
                for (int qh = 0; qh < 2; ++qh) {
                    const float* wg_ = nx_wgate; if (qh) asm volatile("" : "+v"(wg_) : "v"(d[1][3]));
#pragma unroll
                    for (int q = 4 * qh; q < 4 * qh + 4; ++q) { float4 w[4];
#pragma unroll
                        for (int i = 0; i < 4; ++i) w[i] = *(const float4*)(wg_ + q * 1024 + 4 * i);
#pragma unroll
                        for (int k = 0; k < 2; ++k) { float a = 0.f;
#pragma unroll
                            for (int i = 0; i < 4; ++i) a += (hv[k][4 * i] * w[i].x + hv[k][4 * i + 1] * w[i].y) + (hv[k][4 * i + 2] * w[i].z + hv[k][4 * i + 3] * w[i].w);
                            d[k][q] = a; } } }
                const bool o1 = lane & 1, o2 = lane & 2, o4 = lane & 4;
#pragma unroll
                for (int k = 0; k < 2; ++k) { const size_t t = (size_t)(tb0 + tl0 + 2 * k2 + k);
                    float a0 = o1 ? d[k][4] : d[k][0], a1 = o1 ? d[k][5] : d[k][1], a2 = o1 ? d[k][6] : d[k][2], a3 = o1 ? d[k][7] : d[k][3];
                    a0 += lxf<1>(o1 ? d[k][0] : d[k][4]); a1 += lxf<1>(o1 ? d[k][1] : d[k][5]); a2 += lxf<1>(o1 ? d[k][2] : d[k][6]); a3 += lxf<1>(o1 ? d[k][3] : d[k][7]);
                    float b0 = o2 ? a2 : a0, b1 = o2 ? a3 : a1; b0 += lxf<2>(o2 ? a0 : a2); b1 += lxf<2>(o2 ? a1 : a3);
                    float cc = o4 ? b1 : b0; cc += lxf<4>(o4 ? b0 : b1);
                    cc += lxf<8>(cc); cc += lxf<16>(cc); cc += lxf<32>(cc);
                    const float rstd = rsqrtf(wave_sum(ss[k]) * (1.0f / D) + 1e-6f);
                    u32x4 w0, w1; w0.x = pk2(hv[k][0] * rstd, hv[k][1] * rstd); w0.y = pk2(hv[k][2] * rstd, hv[k][3] * rstd); w0.z = pk2(hv[k][4] * rstd, hv[k][5] * rstd); w0.w = pk2(hv[k][6] * rstd, hv[k][7] * rstd);
                    w1.x = pk2(hv[k][8] * rstd, hv[k][9] * rstd); w1.y = pk2(hv[k][10] * rstd, hv[k][11] * rstd); w1.z = pk2(hv[k][12] * rstd, hv[k][13] * rstd); w1.w = pk2(hv[k][14] * rstd, hv[k][15] * rstd);
                    bf16_t* xo = (bf16_t*)(A.ws + WS_NBUF) + t * 1024 + lo16; *(u32x4*)xo = w0; *(u32x4*)(xo + 8) = w1;
                    if (lane < 8) { const float r = cc * rstd; float o;
                        if (es < 4) o = 1.0f / (1.0f + __expf(-r));
                        else { const float z = r + nx_dtb[es - 4]; const float sp = z > 20.f ? z : log1pf(__expf(z)); o = -__expf(nx_alog[es - 4]) * sp; }
                        ((float*)(A.ws + WS_GB))[t * 8 + es] = o; }
                }
            }
        }
    }
    __syncthreads();
}

__device__ __forceinline__ bool relaunder(Ctx& c) { int t = threadIdx.x; asm volatile("" : "+v"(t)); c.tid = t; c.lane = t & 63; c.wave = __builtin_amdgcn_readfirstlane(t >> 6); return true; }
__global__ void __launch_bounds__(512, 2) fwd(Args a) {
    extern __shared__ __attribute__((aligned(16))) unsigned char lds_raw[];
    Ctx c; c.lds = (LAS unsigned char*)lds_raw; c.tid = threadIdx.x; c.lane = c.tid & 63; c.wave = __builtin_amdgcn_readfirstlane(c.tid >> 6); c.G = gridDim.x; c.bid = blockIdx.x;
    const Args& A = a;
    volatile LAS unsigned* MISC = (volatile LAS unsigned*)(c.lds + MISC_OFF);
    if (c.tid < 64) MISC[c.tid] = 0u;
    __syncthreads();
    const int lo = a.ph_lo, hi = a.ph_hi;
    XcdBarrier bar; bar.bar = (unsigned*)(A.ws + WS_CTL) + CW_BAR; bar.x = 0; bar.st = MISC + 8;
    if (hi - lo > 1) bar = xcd_barrier_post((unsigned*)(A.ws + WS_CTL) + CW_BAR, MISC + 8);
#define IN(k) (lo <= (k) && (k) < hi && relaunder(c))
#define INR(k) (lo <= (k) && (k) < hi)
#define SEAM(k) do { if (INR(k) && INR((k) + 1)) { xcd_barrier(bar); if ((DUP >> 14) & 1) xcd_barrier(bar); } } while (0)
    bf16_t* NBUF = (bf16_t*)(A.ws + WS_NBUF); bf16_t* PROJ = (bf16_t*)(A.ws + WS_PROJ); bf16_t* MIXED = (bf16_t*)(A.ws + WS_MIXED); bf16_t* QP = (bf16_t*)(A.ws + WS_QP);
    float* GB = (float*)(A.ws + WS_GB);
    if (IN(0)) REP(10) p0_prologue(c, a);
    SEAM(0);
    auto layer = [&](const int l) __attribute__((always_inline)) {
        const int pb = 1 + 10 * l;
        if (l == 0 && IN(pb + 0) && !(KO & (1 << 0))) REP(0) phase_norm(c, a, l == 0 ? A.in[0] : A.out, A.in[2] + l * 1024, NBUF, (const float*)(A.ws + WS_WGATE) + l * 8 * 1024, A.in[5] + l * 4, A.in[6] + l * 4, GB);
        if (l == 0) SEAM(pb + 0);
        if (IN(pb + 1) && !(KO & (1 << 1))) REP(1) { pg8::Gemm g{NBUF, (const bf16_t*)(A.ws + WS_WIN) + (size_t)l * NPROJ * 1024, T, NPROJ, 1024}; pg8::StaticOrder S; S.init(T, NPROJ, c.G, c.bid); pg8::EpiBf16 E{PROJ, NPROJ, nullptr};
            pg8::gemm_phase<pg8::EpiBf16, pg8::StaticOrder>(c.lds, g, S, E, nullptr); }
        SEAM(pb + 1);
        if (IN(pb + 2) && !(KO & (1 << 2))) REP(2) phase_prep(c, a, l);
        SEAM(pb + 2);
        if (IN(pb + 3)) REP(3) { for (int u = c.bid; u < 1024; u += 2 * c.G) { if (u + c.G < 1024) gdn_chunk_pair(c, a, u, u + c.G); else gdn_chunk_unit(c, a, u); } }
        SEAM(pb + 3);
        if (IN(pb + 4) && !(KO & (1 << 3))) REP(4) { if (c.bid < 64) { for (int rp = 0; rp < 1 + ((DUP >> 12) & 1); ++rp) gdn_scan(c, a, c.bid); } else { for (int rp = 0; rp < 1 + ((DUP >> 13) & 1); ++rp) attn_mfma(c, a, l, 64, c.G - 64); } }
        SEAM(pb + 4);
        if (IN(pb + 5) && !(KO & (1 << 4))) REP(5) phase_gdn_out(c, a, l);
        SEAM(pb + 5);
        if (IN(pb + 6) && !(KO & (1 << 5))) REP(6) { pg8::Gemm g{MIXED, (const bf16_t*)(A.ws + WS_WOUT) + (size_t)l * 1024 * 1024, T, 1024, 1024}; pg8::StaticOrder S; S.init(T, 1024, c.G, c.bid); pg8::EpiResNorm E{l == 0 ? A.in[0] : A.out, A.out, NBUF, A.in[14] + l * 1024, (float*)(A.ws + WS_RS), 1024};
            pg8::gemm_phase<pg8::EpiResNorm, pg8::StaticOrder>(c.lds, g, S, E, nullptr); }
        SEAM(pb + 6);
        if (IN(pb + 8) && !(KO & (1 << 7))) REP(8) { pg8::Gemm g{NBUF, (const bf16_t*)(A.ws + WS_WQ) + (size_t)l * 2048 * 1024, T, 2048, 1024}; pg8::StaticOrder S; S.init(T, 2048, c.G, c.bid); pg8::EpiBf16 E{QP, 2048, (const float*)(A.ws + WS_RS)};
            pg8::gemm_phase<pg8::EpiBf16, pg8::StaticOrder>(c.lds, g, S, E, nullptr); }
        SEAM(pb + 8);
        if (IN(pb + 9) && !(KO & (1 << 8))) REP(9) phase_peer(c, a, l, LASTREP(9) ? A.out : (float*)(A.ws + WS_GCH), l == 0, bar, (hi - lo > 1) && c.G * 64 == T);
        SEAM(pb + 9);
    };
    layer(0); layer(1);
#undef IN
#undef INR
#undef SEAM
}

extern "C" void kernel_launch(void* const* d_in, const int* in_sizes, int n_in, void* d_out, int out_size, void* d_ws, size_t ws_size, hipStream_t stream) {
    static int grid = 0;
    if (grid == 0) {
        if (n_in != 19 || out_size != T * D || ws_size < WS_END) { fprintf(stderr, "kernel_launch: unexpected shapes (n_in %d out %d ws %zu)\n", n_in, out_size, ws_size); grid = -1; return; }
        if (hipFuncSetAttribute((const void*)fwd, hipFuncAttributeMaxDynamicSharedMemorySize, LDS_BYTES) != hipSuccess) { fprintf(stderr, "kernel_launch: hipFuncSetAttribute failed\n"); grid = -1; return; }
        int dev = 0, cus = 0, per_cu = 0;
        (void)hipGetDevice(&dev); (void)hipDeviceGetAttribute(&cus, hipDeviceAttributeMultiprocessorCount, dev);
        (void)hipOccupancyMaxActiveBlocksPerMultiprocessor(&per_cu, (const void*)fwd, 512, LDS_BYTES);
        (void)hipGetLastError();
        if (per_cu < 1) fprintf(stderr, "kernel_launch: occupancy query reports %d blocks per CU\n", per_cu);
        grid = cus > 0 ? cus : 256;
    }
    if (grid < 0) return;
    (void)hipMemsetAsync((char*)d_ws + WS_CTL, 0, CTL_BYTES, stream);
    Args a{};
    for (int i = 0; i < 19; ++i) a.in[i] = (const float*)d_in[i];
    a.out = (float*)d_out; a.ws = (unsigned char*)d_ws;
#if MK_ONE_LAUNCH
    a.ph_lo = 0; a.ph_hi = NPHASE;
    hipLaunchKernelGGL(fwd, dim3(grid), dim3(512), LDS_BYTES, stream, a);
#else
    for (int p = 0; p < NPHASE; ++p) { a.ph_lo = p; a.ph_hi = p + 1; hipLaunchKernelGGL(fwd, dim3(grid), dim3(512), LDS_BYTES, stream, a); }
#endif
}
```

```cpp
#include <hip/hip_runtime.h>
#include <cstdio>
#include <cstdint>
#include <cstring>

#ifndef KO
#define KO 0
#endif
#ifndef DUP
#define DUP 0
#endif
#define ALIGN_V 0
#define REP(k) for (int rep = 0; rep < 1 + ((DUP >> (k)) & 1); ++rep)
#define LASTREP(k) (rep == ((DUP >> (k)) & 1))
#ifndef MK_ONE_LAUNCH
#define MK_ONE_LAUNCH 1
#endif

template <int CTRL> __device__ __forceinline__ int dpp_i(int x) { return __builtin_amdgcn_mov_dpp(x, CTRL, 0xf, 0xf, true); }
template <int N> __device__ __forceinline__ int lxi(int x) {
    if constexpr (N == 1) return dpp_i<0xB1>(x);
    else if constexpr (N == 2) return dpp_i<0x4E>(x);
    else if constexpr (N == 4) return dpp_i<0x1B>(dpp_i<0x141>(x));
    else if constexpr (N == 8) return dpp_i<0x128>(x);
    else if constexpr (N == 16) { const auto r = __builtin_amdgcn_permlane16_swap((unsigned)x, (unsigned)x, false, false); return (int)((threadIdx.x & 16) ? r[0] : r[1]); }
    else { const auto r = __builtin_amdgcn_permlane32_swap((unsigned)x, (unsigned)x, false, false); return (int)((threadIdx.x & 32) ? r[0] : r[1]); }
}
template <int N> __device__ __forceinline__ float lxf(float x) { return __int_as_float(lxi<N>(__float_as_int(x))); }
template <int N> __device__ __forceinline__ unsigned lxu(unsigned x) { return (unsigned)lxi<N>((int)x); }
namespace pg8 {
#define PG8_LAS __attribute__((address_space(3)))
typedef unsigned short bf16_t;
typedef short bf16x8 __attribute__((ext_vector_type(8)));
typedef float f32x4 __attribute__((ext_vector_type(4)));
typedef unsigned u32x4 __attribute__((ext_vector_type(4)));
constexpr int BM = 256, BK = 64, HALF = 128, HTB = HALF * BK * 2  , STAGE_BYTES = 8 * HTB, NXCD = 8, WGM = 8;

__host__ __device__ __forceinline__ int lds_byte(int r, int c) { const int st = (r >> 4) * 2 + (c >> 5), rr = r & 15, cc = c & 31, ob = rr * 64 + cc * 2; return st * 1024 + (ob ^ (((ob >> 9) & 1) << 5)); }
__host__ __device__ __forceinline__ void stage_rc(int b, int& R, int& C) { const int st = b / 1024, sb = b % 1024, swz = sb ^ (((sb >> 9) & 1) << 5); R = (st >> 1) * 16 + swz / 64; C = (st & 1) * 32 + (swz % 64) / 2; }
__host__ __device__ __forceinline__ int perm32(int rho) { const int n = rho >> 4, i = rho & 15; return 8 * (i >> 2) + 4 * n + (i & 3); }

struct Unit { int pm, pn; };
struct Gemm { const bf16_t* A; const bf16_t* Bt; int M, N, K; };

struct StaticOrder {
    int nM, nN, nwg, G, c;
    __host__ __device__ void init(int M, int N, int G_, int c_) { nM = M / BM; nN = N / BM; nwg = nM * nN; G = G_; c = c_; }
    __host__ __device__ bool next(int i, Unit& u) const {
        const long L = (long)i * G + c; if (L >= nwg) return false;
        int wgid = (int)L; { const int q = nwg / NXCD, r = nwg % NXCD, xcd = wgid % NXCD, off = wgid / NXCD; wgid = (xcd < r ? xcd * (q + 1) : r * (q + 1) + (xcd - r) * q) + off; }
        const int nig = WGM * nN, gid = wgid / nig, fm = gid * WGM, gsz = (nM - fm) < WGM ? (nM - fm) : WGM;
        u.pm = fm + ((wgid % nig) % gsz); u.pn = (wgid % nig) / gsz; return true;
    }
    __device__ __forceinline__ void a_ready(const Unit&) const {}
    __device__ __forceinline__ void done(const Unit&) const {}
};
__device__ __forceinline__ unsigned cvt_pk_bf16(float lo, float hi) { unsigned r; asm volatile("v_cvt_pk_bf16_f32 %0, %1, %2" : "=v"(r) : "v"(lo), "v"(hi)); return r; }
typedef unsigned u32x2v __attribute__((ext_vector_type(2)));
struct EpiResF32 {
    static constexpr bool PERM = false, AFTER_DRAIN = false;
    const float* R; float* C; int ldc;
    __device__ __forceinline__ void operator()(const f32x4 (&acc)[2][2][4][2], const Unit& u, int wr, int wc, int fr, int fq) const {
        const int row0 = u.pm * BM + wr * 64 + fr, col0 = u.pn * BM + wc * 32 + 4 * fq;
#pragma unroll
        for (int ai = 0; ai < 2; ++ai)
#pragma unroll
            for (int m = 0; m < 4; ++m) { const size_t ro = (size_t)(row0 + ai * HALF + m * 16) * ldc + col0;
#pragma unroll
                for (int bj = 0; bj < 2; ++bj)
#pragma unroll
                    for (int n = 0; n < 2; ++n) { const f32x4 r = *(const f32x4*)(R + ro + bj * HALF + n * 16); *(f32x4*)(C + ro + bj * HALF + n * 16) = acc[ai][bj][m][n] + r; } }
    }
};
struct EpiResNorm {
    static constexpr bool PERM = false, AFTER_DRAIN = false;
    const float* R; float* C; bf16_t* HB; const float* gain; float* RS; int ldc;
    __device__ __forceinline__ void operator()(const f32x4 (&acc)[2][2][4][2], const Unit& u, int wr, int wc, int fr, int fq) const {
        const int row0 = u.pm * BM + wr * 64 + fr, col0 = u.pn * BM + wc * 32 + 4 * fq;
        f32x4 gv[2][2];
#pragma unroll
        for (int bj = 0; bj < 2; ++bj)
#pragma unroll
            for (int n = 0; n < 2; ++n) gv[bj][n] = *(const f32x4*)(gain + col0 + bj * HALF + n * 16);
#pragma unroll
        for (int ai = 0; ai < 2; ++ai)
#pragma unroll
            for (int m = 0; m < 4; ++m) { const int row = row0 + ai * HALF + m * 16; const size_t ro = (size_t)row * ldc + col0; float ss = 0.f;
#pragma unroll
                for (int bj = 0; bj < 2; ++bj)
#pragma unroll
                    for (int n = 0; n < 2; ++n) { const f32x4 r = *(const f32x4*)(R + ro + bj * HALF + n * 16); const f32x4 h = acc[ai][bj][m][n] + r; *(f32x4*)(C + ro + bj * HALF + n * 16) = h;
                        ss += (h[0] * h[0] + h[1] * h[1]) + (h[2] * h[2] + h[3] * h[3]); const f32x4 y = h * gv[bj][n];
                        u32x2v w; w.x = cvt_pk_bf16(y[0], y[1]); w.y = cvt_pk_bf16(y[2], y[3]); *(u32x2v*)(HB + ro + bj * HALF + n * 16) = w; }
                ss += lxf<16>(ss); ss += lxf<32>(ss);
                if (fq == 0) RS[(size_t)row * 16 + u.pn * 4 + wc] = ss; }
    }
};
struct EpiBf16 {
    static constexpr bool PERM = true, AFTER_DRAIN = false;
    bf16_t* O; int ldc; const float* RS;
    __device__ __forceinline__ void operator()(const f32x4 (&acc)[2][2][4][2], const Unit& u, int wr, int wc, int fr, int fq) const {
        const int row0 = u.pm * BM + wr * 64 + fr; const int col0 = u.pn * BM + wc * 32 + 8 * fq;
#pragma unroll
        for (int ai = 0; ai < 2; ++ai)
#pragma unroll
            for (int m = 0; m < 4; ++m) { const int row = row0 + ai * HALF + m * 16; bf16_t* rowp = O + (size_t)row * ldc + col0;
                float sc = 1.0f; if (RS) { const f32x4 a = *(const f32x4*)(RS + (size_t)row * 16), b = *(const f32x4*)(RS + (size_t)row * 16 + 4), c2 = *(const f32x4*)(RS + (size_t)row * 16 + 8), d = *(const f32x4*)(RS + (size_t)row * 16 + 12);
                    sc = rsqrtf(((((a[0] + a[1]) + (a[2] + a[3])) + ((b[0] + b[1]) + (b[2] + b[3]))) + (((c2[0] + c2[1]) + (c2[2] + c2[3])) + ((d[0] + d[1]) + (d[2] + d[3])))) * (1.0f / 1024.0f) + 1e-6f); }
#pragma unroll
                for (int bj = 0; bj < 2; ++bj) { const f32x4 v0 = acc[ai][bj][m][0] * sc, v1 = acc[ai][bj][m][1] * sc;
                    u32x4 w; w.x = cvt_pk_bf16(v0[0], v0[1]); w.y = cvt_pk_bf16(v0[2], v0[3]); w.z = cvt_pk_bf16(v1[0], v1[1]); w.w = cvt_pk_bf16(v1[2], v1[3]);
                    *(u32x4*)(rowp + bj * HALF) = w; } }
    }
};

template <class Epi, class Sched, bool STAMP = false>
__device__ __forceinline__ void gemm_phase(PG8_LAS unsigned char* lds, const Gemm g, const Sched& S, const Epi& E, unsigned long long* stamps) {
    int tid_ = threadIdx.x; asm volatile("" : "+v"(tid_));
    const int tid = tid_, wid = __builtin_amdgcn_readfirstlane(tid >> 6), lane = tid & 63, wr = wid >> 2, wc = wid & 3, fr = lane & 15, fq = lane >> 4;
    const int K = g.K, nt = K / BK;
    int ts_lo = 0, ts_hi = 0, nts = 0; const unsigned long long rt_entry = STAMP ? (unsigned long long)wall_clock64() : 0ull;
#define PG8_STAMP() do { if (STAMP && wid == 0 && nts < 64) { const unsigned long long _c = (unsigned long long)clock64(); \
        ts_lo = (lane == nts) ? (int)(unsigned)_c : ts_lo; ts_hi = (lane == nts) ? (int)(unsigned)(_c >> 32) : ts_hi; ++nts; } } while (0)
    PG8_STAMP();
    unsigned voffA[2], voffB[2];
#pragma unroll
    for (int i = 0; i < 2; ++i) { int R, C; stage_rc(tid * 16 + i * 8192, R, C); const int Rb = Epi::PERM ? ((R & ~31) + perm32(R & 31)) : R;
        voffA[i] = (unsigned)(R * K + C) * 2u; voffB[i] = (unsigned)(Rb * K + C) * 2u; }
    const size_t kstep = (size_t)(BK * 2);
    const size_t hstep = (size_t)HALF * K * 2;
    const size_t tstep = 2 * hstep;
    const unsigned ldsw = (unsigned)wid * 1024u;
    const int aoff = lds_byte(wr * 64 + fr, fq * 8), boff = lds_byte(wc * 32 + fr, fq * 8);
#define PG8_SA(b, h) (((b) * 2 + (h)) * HTB)
#define PG8_SB(b, h) ((4 + (b) * 2 + (h)) * HTB)
#define PG8_STAGE(bufoff, gbase, voff) do { _Pragma("unroll") for (int _i = 0; _i < 2; ++_i) \
        __builtin_amdgcn_global_load_lds((const unsigned*)((const char*)(gbase) + (voff)[_i]), (PG8_LAS unsigned*)(lds + (bufoff) + ldsw + _i * 8192), 16, 0, 0); } while (0)
#define PG8_LDA(dst, b, h) do { _Pragma("unroll") for (int m = 0; m < 4; ++m) _Pragma("unroll") for (int k = 0; k < 2; ++k) dst[m][k] = *(const PG8_LAS bf16x8*)(lds + PG8_SA(b, h) + aoff + m * 2048 + k * 1024); } while (0)
#define PG8_LDB(dst, b, h) do { _Pragma("unroll") for (int n = 0; n < 2; ++n) _Pragma("unroll") for (int k = 0; k < 2; ++k) dst[n][k] = *(const PG8_LAS bf16x8*)(lds + PG8_SB(b, h) + boff + n * 2048 + k * 1024); } while (0)
#define PG8_MMA(ai, bj, At, Bt) do { __builtin_amdgcn_s_setprio(1); _Pragma("unroll") for (int m = 0; m < 4; ++m) _Pragma("unroll") for (int n = 0; n < 2; ++n) _Pragma("unroll") for (int k = 0; k < 2; ++k) \
        acc[ai][bj][m][n] = __builtin_amdgcn_mfma_f32_16x16x32_bf16(Bt[n][k], At[m][k], acc[ai][bj][m][n], 0, 0, 0); __builtin_amdgcn_s_setprio(0); } while (0)
#define PG8_WAIT_V(n) asm volatile("s_waitcnt vmcnt(" #n ")" ::: "memory")
#define PG8_WAIT_L(n) asm volatile("s_waitcnt lgkmcnt(" #n ")" ::: "memory")
#define PG8_BAR __builtin_amdgcn_s_barrier()
#define PG8_SCHED __builtin_amdgcn_sched_barrier(0)
    Unit cur, nxt; int ui = 0;
    if (!S.next(0, cur)) return;
    f32x4 acc[2][2][4][2];
#pragma unroll
    for (int a = 0; a < 2; ++a)
#pragma unroll
        for (int b = 0; b < 2; ++b)
#pragma unroll
            for (int m = 0; m < 4; ++m)
#pragma unroll
                for (int n = 0; n < 2; ++n) acc[a][b][m][n] = (f32x4){0.f, 0.f, 0.f, 0.f};
    bf16x8 At[4][2], B0[2][2], B1[2][2];
    const char* cA = (const char*)g.A + (size_t)cur.pm * tstep; const char* cB = (const char*)g.Bt + (size_t)cur.pn * tstep;
    S.a_ready(cur);
    PG8_STAGE(PG8_SB(0, 0), cB, voffB); PG8_STAGE(PG8_SA(0, 0), cA, voffA); PG8_STAGE(PG8_SB(0, 1), cB + hstep, voffB); PG8_STAGE(PG8_SA(0, 1), cA + hstep, voffA);
    if (wr == 1) PG8_BAR;
    PG8_WAIT_V(4); PG8_BAR;
    PG8_STAGE(PG8_SB(1, 0), cB + kstep, voffB); PG8_STAGE(PG8_SA(1, 0), cA + kstep, voffA); PG8_STAGE(PG8_SB(1, 1), cB + hstep + kstep, voffB);
    PG8_WAIT_V(6); PG8_BAR;
    PG8_STAMP();
    for (;;) {
        const bool has_next = S.next(ui + 1, nxt);
        const char* nA = has_next ? (const char*)g.A + (size_t)nxt.pm * tstep : cA; const char* nB = has_next ? (const char*)g.Bt + (size_t)nxt.pn * tstep : cB;
        for (int t = 0; t < nt; t += 2) {
            const bool last = (t == nt - 2);
            const char* a1 = cA + (size_t)(t + 1) * kstep;
            const char* a2 = last ? nA : cA + (size_t)(t + 2) * kstep; const char* b2 = last ? nB : cB + (size_t)(t + 2) * kstep;
            const char* a3 = a2 + kstep; const char* b3 = b2 + kstep;
            if (last && has_next) S.a_ready(nxt);
            PG8_LDB(B0, 0, 0); PG8_SCHED; PG8_LDA(At, 0, 0); PG8_STAGE(PG8_SA(1, 1), a1 + hstep, voffA);
            PG8_WAIT_L(8); PG8_BAR; PG8_WAIT_L(0); PG8_MMA(0, 0, At, B0); PG8_BAR; PG8_SCHED;
            PG8_LDB(B1, 0, 1); PG8_STAGE(PG8_SB(0, 0), b2, voffB);
            PG8_BAR; PG8_WAIT_L(0); PG8_MMA(0, 1, At, B1); PG8_BAR;
            PG8_LDA(At, 0, 1); PG8_STAGE(PG8_SA(0, 0), a2, voffA);
            PG8_BAR; PG8_WAIT_L(0); PG8_MMA(1, 0, At, B0); PG8_BAR; PG8_SCHED;
            PG8_STAGE(PG8_SB(0, 1), b2 + hstep, voffB);
            PG8_WAIT_V(6); PG8_BAR; PG8_MMA(1, 1, At, B1); PG8_BAR;
            PG8_LDB(B0, 1, 0); PG8_SCHED; PG8_LDA(At, 1, 0); PG8_STAGE(PG8_SA(0, 1), a2 + hstep, voffA);
            PG8_WAIT_L(8); PG8_BAR; PG8_WAIT_L(0); PG8_MMA(0, 0, At, B0); PG8_BAR; PG8_SCHED;
            PG8_LDB(B1, 1, 1); PG8_STAGE(PG8_SB(1, 0), b3, voffB);
            PG8_BAR; PG8_WAIT_L(0); PG8_MMA(0, 1, At, B1); PG8_BAR;
            PG8_LDA(At, 1, 1); PG8_STAGE(PG8_SA(1, 0), a3, voffA);
            PG8_BAR; PG8_WAIT_L(0); PG8_MMA(1, 0, At, B0); PG8_BAR; PG8_SCHED;
            PG8_STAGE(PG8_SB(1, 1), b3 + hstep, voffB);
            PG8_WAIT_V(6); PG8_BAR; PG8_MMA(1, 1, At, B1); PG8_BAR;
        }
        PG8_STAMP();
        if constexpr (!Epi::AFTER_DRAIN) { E(acc, cur, wr, wc, fr, fq); S.done(cur); }
        PG8_STAMP();
        if (!has_next) break;
#pragma unroll
        for (int a = 0; a < 2; ++a)
#pragma unroll
            for (int b = 0; b < 2; ++b)
#pragma unroll
                for (int m = 0; m < 4; ++m)
#pragma unroll
                    for (int n = 0; n < 2; ++n) acc[a][b][m][n] = (f32x4){0.f, 0.f, 0.f, 0.f};
        cur = nxt; cA = nA; cB = nB; ++ui;
    }
    PG8_WAIT_V(0);
    if (wr == 0) PG8_BAR;
    PG8_BAR;
    if constexpr (Epi::AFTER_DRAIN) { E.fused(acc, cur, wr, wc, fr, fq, lds, wid, lane); S.done(cur); }
    PG8_STAMP();
    if (STAMP && wid == 0) { stamps[lane] = lane < nts ? (((unsigned long long)(unsigned)ts_hi << 32) | (unsigned)ts_lo) : 0ull;
        if (lane == 62) stamps[62] = rt_entry; if (lane == 63) stamps[63] = (unsigned long long)wall_clock64(); }
#undef PG8_STAMP
#undef PG8_SA
#undef PG8_SB
#undef PG8_STAGE
#undef PG8_LDA
#undef PG8_LDB
#undef PG8_MMA
#undef PG8_WAIT_V
#undef PG8_WAIT_L
#undef PG8_BAR
#undef PG8_SCHED
}
}

using pg8::bf16_t; using pg8::bf16x8; using pg8::f32x4; using pg8::u32x4;
typedef unsigned u32x2 __attribute__((ext_vector_type(2)));
constexpr int T = 16384, D = 1024, SEQ = 2048, NPROJ = 3584, NINW = 3592, NEXP = 16384;
constexpr int EREC = 1792;
constexpr int C_GQ = 0, C_GK = 512, C_GV = 1024, C_GZ = 1536, C_SB = 2048, C_SC = 2304, C_SH = 2560, C_DQ = 2816, C_DK = 3072, C_DV = 3328;
constexpr size_t MiB = 1u << 20;
constexpr size_t WS_CTL = 0, CTL_BYTES = 1 * MiB, WS_WIN = 2 * MiB, WS_WOUT = 16 * MiB, WS_WQ = 20 * MiB, WS_KEYS = 28 * MiB, WS_WGATE = 29 * MiB, WS_VSC = 30 * MiB, WS_USC = 31 * MiB,
    WS_UT = 32 * MiB, WS_VT = 96 * MiB, WS_NBUF = 160 * MiB, WS_PROJ = 192 * MiB, WS_QP = 192 * MiB, WS_QKVC = 304 * MiB, WS_MIXED = 352 * MiB, WS_GB = 384 * MiB,
    WS_AQ = 385 * MiB, WS_AK = 393 * MiB, WS_OGDN = 401 * MiB, WS_GCH = 433 * MiB, WS_AVT = 160 * MiB  , WS_END = 505 * MiB;
constexpr int CW_BAR = 4096;
constexpr size_t WS_RS = 1 * MiB;
constexpr int LDS_BYTES = 159744;
constexpr int MISC_OFF = 159744 - 256;
constexpr int NPHASE = 21;

__device__ __forceinline__ float bf_lo(unsigned w) { return __uint_as_float(w << 16); }
__device__ __forceinline__ float bf_hi(unsigned w) { return __uint_as_float(w & 0xffff0000u); }
__device__ __forceinline__ unsigned f2bf(float f) { unsigned u = __float_as_uint(f); return (u + 0x7fffu + ((u >> 16) & 1u)) >> 16; }
__device__ __forceinline__ unsigned pk2(float lo, float hi) { return f2bf(lo) | (f2bf(hi) << 16); }
__device__ __forceinline__ float wave_sum(float v) {
    v += lxf<1>(v); v += lxf<2>(v); v += lxf<4>(v); v += lxf<8>(v); v += lxf<16>(v); v += lxf<32>(v);
    return v;
}
__device__ __forceinline__ int kperm(int x) { return (x & ~31) | (((x >> 2) & 3) << 3) | (((x >> 4) & 1) << 2) | (x & 3); }
__device__ __forceinline__ float silu_f(float x) { return x / (1.0f + __expf(-x)); }

#define XB_TMO      128
#define XB_XCNT(j)  (256  + 64 * (j))
#define XB_XSUB(j)  (1280 + 64 * (j))
#define XB_XGEN(j)  (2304 + 64 * (j))
#define XB_TOP      3328
#define XB_TOPGEN   3392
#define XCD_BAR_WORDS 3456
#define XB_SPIN_CAP (1u << 18)
#define LAS __attribute__((address_space(3)))

__device__ __forceinline__ unsigned xb_ld(unsigned* p)              { return __hip_atomic_load(p, __ATOMIC_RELAXED, __HIP_MEMORY_SCOPE_AGENT); }
__device__ __forceinline__ unsigned xb_add(unsigned* p, unsigned v) { return __hip_atomic_fetch_add(p, v, __ATOMIC_RELAXED, __HIP_MEMORY_SCOPE_AGENT); }
__device__ __forceinline__ unsigned xb_xcc_id() { return (unsigned)__builtin_amdgcn_s_getreg((3 << 11) | 20) & 0xFu; }
#define XB_SPIN(cond, bar) do { unsigned _sp = 0; while (cond) { __builtin_amdgcn_s_sleep(1); \
    if ((++_sp & 255u) == 0u) { if (xb_ld(&(bar)[XB_TMO])) break; if (_sp > XB_SPIN_CAP) { atomicAdd(&(bar)[XB_TMO], 1u); break; } } } } while (0)

struct XcdBarrier {
    unsigned* bar; unsigned x;
    volatile LAS unsigned* st;
};

__device__ __forceinline__ XcdBarrier xcd_barrier_post(unsigned* bar, volatile LAS unsigned* st) {
    XcdBarrier b; b.bar = bar; b.x = xb_xcc_id(); b.st = st;
    if (threadIdx.x == 0) (void)xb_add(&bar[XB_XCNT(b.x)], 1u);
    return b;
}
__device__ __forceinline__ void xcd_barrier_complete(unsigned* bar, unsigned x, unsigned& nloc, unsigned& nx) {
    const unsigned G = gridDim.x * gridDim.y * gridDim.z;
    unsigned sum, cnt, mine, sp = 0u;
    for (;;) {
        sum = 0u; cnt = 0u; mine = 0u;
#pragma unroll
        for (unsigned j = 0; j < 16; ++j) { const unsigned c = xb_ld(&bar[XB_XCNT(j)]); sum += c; cnt += (c > 0u) ? 1u : 0u; mine = (j == x) ? c : mine; }
        if (sum == G) break;
        __builtin_amdgcn_s_sleep(1);
        if ((++sp & 255u) == 0u) { if (xb_ld(&bar[XB_TMO])) break; if (sp > XB_SPIN_CAP) { atomicAdd(&bar[XB_TMO], 1u); break; } }
    }
    nloc = mine > 0u ? mine : 1u; nx = cnt > 0u ? cnt : 1u;
}

__device__ __forceinline__ void xcd_barrier(const XcdBarrier& b) {
    asm volatile("s_waitcnt vmcnt(0)" ::: "memory");
    __syncthreads();
    if (threadIdx.x == 0) {
        unsigned* bar = b.bar;
        __builtin_amdgcn_s_waitcnt(0);
        unsigned nloc = b.st[0], nx = b.st[1];
        if (nloc == 0u) { xcd_barrier_complete(bar, b.x, nloc, nx); b.st[0] = nloc; b.st[1] = nx; }
        const unsigned old = xb_add(&bar[XB_XSUB(b.x)], 1u);
        const unsigned gen = old / nloc;
        if (old + 1u == (gen + 1u) * nloc) {
            __builtin_amdgcn_fence(__ATOMIC_RELEASE, "agent");
            asm volatile("s_waitcnt vmcnt(0)" ::: "memory");
            const unsigned og = xb_add(&bar[XB_TOP], 1u);
            const unsigned tg = og / nx;
            if (og + 1u == (tg + 1u) * nx) xb_add(&bar[XB_TOPGEN], 1u);
            else XB_SPIN(xb_ld(&bar[XB_TOPGEN]) == tg, bar);
            __builtin_amdgcn_fence(__ATOMIC_ACQUIRE, "agent");
            xb_add(&bar[XB_XGEN(b.x)], 1u);
            asm volatile("s_waitcnt vmcnt(0)" ::: "memory");
        } else {
            XB_SPIN(xb_ld(&bar[XB_XGEN(b.x)]) == gen, bar);
            __builtin_amdgcn_fence(__ATOMIC_ACQUIRE, "agent");
            asm volatile("s_waitcnt vmcnt(0)" ::: "memory");
        }
    }
    __syncthreads();
}

struct Args { const float* in[19]; float* out; unsigned char* ws; int ph_lo, ph_hi; };
struct Ctx {
    LAS unsigned char* lds; int tid, lane, wave, G, bid;
};

struct __attribute__((packed, aligned(4))) U3 { unsigned x, y, z; };
typedef unsigned u32x6 __attribute__((ext_vector_type(6)));
typedef float f32x32 __attribute__((ext_vector_type(32)));
typedef _Float16 f16x32 __attribute__((ext_vector_type(32)));
__device__ __forceinline__ unsigned fp6_e2m3(float x) {
    const float a = fabsf(x); const float cdf = a < 2.f ? rintf(a * 8.f) : (a < 4.f ? rintf(a * 4.f) + 8.f : rintf(a * 2.f) + 16.f);
    return (unsigned)fminf(cdf, 31.f) | ((__float_as_uint(x) >> 31) << 5);
}
__device__ __forceinline__ void cvt_flat8(const float* src, unsigned char* dst, size_t n8, size_t gt, size_t NT) {
    const float4* s = (const float4*)src; u32x4* d = (u32x4*)dst;
    for (size_t i = gt; i < n8; i += NT) { const float4 a = s[2 * i], b = s[2 * i + 1]; u32x4 w; w.x = pk2(a.x, a.y); w.y = pk2(a.z, a.w); w.z = pk2(b.x, b.y); w.w = pk2(b.z, b.w); d[i] = w; }
}
__device__ __forceinline__ void cvt_transpose(const float* w, bf16_t* dst, int N, size_t gt, size_t NT) {
    const size_t items = (size_t)2 * 128 * N;
    for (size_t i = gt; i < items; i += NT) {
        const int cc = (int)(i % N), kb = (int)((i / N) % 128), l = (int)(i / ((size_t)N * 128));
        const float* s = w + ((size_t)l * 1024 + kb * 8) * N + cc; float v[8];
#pragma unroll
        for (int j = 0; j < 8; ++j) v[j] = s[(size_t)j * N];
        u32x4 o; o.x = pk2(v[0], v[1]); o.y = pk2(v[2], v[3]); o.z = pk2(v[4], v[5]); o.w = pk2(v[6], v[7]);
        *(u32x4*)(dst + ((size_t)l * N + cc) * 1024 + kb * 8) = o;
    }
}
__device__ __forceinline__ void p0_prologue(Ctx& c, const Args& A) {
    const size_t gt = (size_t)c.bid * 512 + c.tid, NT = (size_t)c.G * 512;
#pragma unroll 1
    for (int tb = 0; tb < 2; ++tb) {
        const float* src = tb ? A.in[18] : A.in[17]; unsigned char* dst = A.ws + WS_UT + (tb ? 1024 : 0);   float* vs = (float*)(A.ws + (tb ? WS_VSC : WS_USC));
        for (int row = c.bid * 8 + c.wave; row < 2 * NEXP; row += c.G * 8) {
            const float4* sp = (const float4*)(src + (size_t)row * 1024 + 16 * c.lane); float4 f[4]; float am = 0.f;
#pragma unroll
            for (int i = 0; i < 4; ++i) { f[i] = sp[i]; am = fmaxf(fmaxf(am, fmaxf(fabsf(f[i].x), fabsf(f[i].y))), fmaxf(fabsf(f[i].z), fabsf(f[i].w))); }
            am = fmaxf(am, lxf<1>(am)); am = fmaxf(am, lxf<2>(am)); am = fmaxf(am, lxf<4>(am)); am = fmaxf(am, lxf<8>(am)); am = fmaxf(am, lxf<16>(am)); am = fmaxf(am, lxf<32>(am));
            const float sc = am > 0.f ? __uint_as_float(__float_as_uint((tb ? 7.5f : 127.0f) / am) & 0x7f800000u) : 1.0f;
            if (tb) {
                unsigned long long lo = 0ull; unsigned hi = 0u;
#pragma unroll
                for (int i = 0; i < 16; ++i) { const float x = (i & 3) == 0 ? f[i >> 2].x : ((i & 3) == 1 ? f[i >> 2].y : ((i & 3) == 2 ? f[i >> 2].z : f[i >> 2].w)); const unsigned cd = fp6_e2m3(x * sc);
                    if (i < 10) lo |= (unsigned long long)cd << (6 * i); else if (i == 10) { lo |= (unsigned long long)(cd & 15u) << 60; hi |= cd >> 4; } else hi |= cd << (6 * i - 64); }
                U3 w3; w3.x = (unsigned)lo; w3.y = (unsigned)(lo >> 32); w3.z = hi;
                *(U3*)(dst + (size_t)row * EREC + 12 * c.lane) = w3;
            } else {
                u32x4 w; unsigned ww[4];
#pragma unroll
                for (int i = 0; i < 4; ++i) ww[i] = ((unsigned)(int)rintf(f[i].x * sc) & 255u) | (((unsigned)(int)rintf(f[i].y * sc) & 255u) << 8) | (((unsigned)(int)rintf(f[i].z * sc) & 255u) << 16) | (((unsigned)(int)rintf(f[i].w * sc) & 255u) << 24);
                w.x = ww[0]; w.y = ww[1]; w.z = ww[2]; w.w = ww[3];
                *(u32x4*)(dst + (size_t)row * EREC + 16 * c.lane) = w; }
            if (c.lane == 0) vs[row] = 1.0f / sc;
        }
    }
    cvt_flat8(A.in[16], A.ws + WS_KEYS, (size_t)2 * 8 * 2 * 128 * 128 / 8, gt, NT);
    cvt_transpose(A.in[13], (bf16_t*)(A.ws + WS_WOUT), 1024, gt, NT);
    cvt_transpose(A.in[15], (bf16_t*)(A.ws + WS_WQ), 2048, gt, NT);
    {
        const float* w = A.in[3]; const size_t items = (size_t)2 * 128 * NINW;
        for (size_t i = gt; i < items; i += NT) {
            const int cc = (int)(i % NINW), kb = (int)((i / NINW) % 128), l = (int)(i / ((size_t)NINW * 128));
            const float* s = w + ((size_t)l * 1024 + kb * 8) * NINW + cc; float v[8];
#pragma unroll
            for (int j = 0; j < 8; ++j) v[j] = s[(size_t)j * NINW];
            if (cc >= 2048 && cc < 2056) { float* d = (float*)(A.ws + WS_WGATE) + ((size_t)l * 8 + (cc - 2048)) * 1024 + kb * 8;
                *(float4*)d = make_float4(v[0], v[1], v[2], v[3]); *(float4*)(d + 4) = make_float4(v[4], v[5], v[6], v[7]); }
            else { const int c2 = cc < 2048 ? cc : cc - 8; u32x4 o; o.x = pk2(v[0], v[1]); o.y = pk2(v[2], v[3]); o.z = pk2(v[4], v[5]); o.w = pk2(v[6], v[7]);
                *(u32x4*)((bf16_t*)(A.ws + WS_WIN) + ((size_t)l * NPROJ + c2) * 1024 + kb * 8) = o; }
        }
    }
}

__device__ __forceinline__ void phase_norm(Ctx& c, const Args& A, const float* src, const float* gain, bf16_t* dst, const float* wgate, const float* a_log, const float* dt_bias, float* GB) {
    const int gw = c.bid * 8 + c.wave, NGW = c.G * 8, lane = c.lane;
    const bool o1 = lane & 1, o2 = lane & 2, o4 = lane & 4; const int es = ((lane & 1) << 2) | (lane & 2) | ((lane >> 2) & 1);
    float4 g[4];
#pragma unroll
    for (int j = 0; j < 4; ++j) g[j] = ((const float4*)gain)[lane + 64 * j];
    for (int m0 = gw * 2; m0 < T; m0 += NGW * 2) {
        float4 v[2][4];
#pragma unroll
        for (int rr = 0; rr < 2; ++rr)
#pragma unroll
            for (int j = 0; j < 4; ++j) v[rr][j] = ((const float4*)(src + (size_t)(m0 + rr) * D))[lane + 64 * j];
#pragma unroll
        for (int rr = 0; rr < 2; ++rr) {
            const int m = m0 + rr; float ss = 0.f;
#pragma unroll
            for (int j = 0; j < 4; ++j) { ss += (v[rr][j].x * v[rr][j].x + v[rr][j].y * v[rr][j].y) + (v[rr][j].z * v[rr][j].z + v[rr][j].w * v[rr][j].w);
                v[rr][j].x *= g[j].x; v[rr][j].y *= g[j].y; v[rr][j].z *= g[j].z; v[rr][j].w *= g[j].w; }
            float cc = 0.f;
            if (wgate) {
                float d[8];
#pragma unroll
                for (int q = 0; q < 8; ++q) { float a = 0.f;
#pragma unroll
                    for (int j = 0; j < 4; ++j) { const float4 w = ((const float4*)(wgate + q * 1024))[lane + 64 * j]; a += (v[rr][j].x * w.x + v[rr][j].y * w.y) + (v[rr][j].z * w.z + v[rr][j].w * w.w); }
                    d[q] = a; }
                float a0 = o1 ? d[4] : d[0], a1 = o1 ? d[5] : d[1], a2 = o1 ? d[6] : d[2], a3 = o1 ? d[7] : d[3];
                a0 += lxf<1>(o1 ? d[0] : d[4]); a1 += lxf<1>(o1 ? d[1] : d[5]); a2 += lxf<1>(o1 ? d[2] : d[6]); a3 += lxf<1>(o1 ? d[3] : d[7]);
                float b0 = o2 ? a2 : a0, b1 = o2 ? a3 : a1; b0 += lxf<2>(o2 ? a0 : a2); b1 += lxf<2>(o2 ? a1 : a3);
                cc = o4 ? b1 : b0; cc += lxf<4>(o4 ? b0 : b1);
                cc += lxf<8>(cc); cc += lxf<16>(cc); cc += lxf<32>(cc);
            }
            const float rstd = rsqrtf(wave_sum(ss) * (1.0f / D) + 1e-6f);
            u32x2* o8 = (u32x2*)(dst + (size_t)m * D) + lane;
#pragma unroll
            for (int j = 0; j < 4; ++j) { u32x2 w; w.x = pk2(v[rr][j].x * rstd, v[rr][j].y * rstd); w.y = pk2(v[rr][j].z * rstd, v[rr][j].w * rstd); o8[64 * j] = w; }
            if (wgate && lane < 8) { const float r = cc * rstd; float o;
                if (es < 4) o = 1.0f / (1.0f + __expf(-r));
                else { const float z = r + dt_bias[es - 4]; const float sp = z > 20.f ? z : log1pf(__expf(z)); o = -__expf(a_log[es - 4]) * sp; }
                GB[(size_t)m * 8 + es] = o; }
        }
    }
}

__device__ __forceinline__ void unpack8(const u32x4& w, float* f) { f[0] = bf_lo(w.x); f[1] = bf_hi(w.x); f[2] = bf_lo(w.y); f[3] = bf_hi(w.y); f[4] = bf_lo(w.z); f[5] = bf_hi(w.z); f[6] = bf_lo(w.w); f[7] = bf_hi(w.w); }
__device__ __forceinline__ void phase_prep(Ctx& c, const Args& A, int l) {
    const int gw = c.bid * 8 + c.wave, NGW = c.G * 8, lane = c.lane;
    const bf16_t* PROJ = (const bf16_t*)(A.ws + WS_PROJ);
    bf16_t* QKVC = (bf16_t*)(A.ws + WS_QKVC); bf16_t* AQ = (bf16_t*)(A.ws + WS_AQ); bf16_t* AK = (bf16_t*)(A.ws + WS_AK); bf16_t* MIXED = (bf16_t*)(A.ws + WS_MIXED); bf16_t* AVT = (bf16_t*)(A.ws + WS_AVT);
    const float* gconv = A.in[4] + (size_t)l * 4 * 1536; const float* sconv = A.in[8] + (size_t)l * 3 * 256;
    const float* qg = A.in[9] + l * 32; const float* kg = A.in[10] + l * 32;
    const u32x4 zero4 = {0u, 0u, 0u, 0u};
    for (int run = gw; run < T / 8; run += NGW) {
        const int t0 = run * 8, s0 = t0 & (SEQ - 1);
#pragma unroll 1
        for (int it = 0; it < 3; ++it) {
            const int ch = (it * 64 + lane) * 8;
            u32x4 rows[11];
#pragma unroll
            for (int j = 0; j < 11; ++j) rows[j] = (s0 + j - 3 >= 0) ? *(const u32x4*)(PROJ + (size_t)(t0 + j - 3) * NPROJ + ch) : zero4;
            float w[4][8];
#pragma unroll
            for (int j = 0; j < 4; ++j) { const float4 a = *(const float4*)(gconv + j * 1536 + ch), b = *(const float4*)(gconv + j * 1536 + ch + 4);
                w[j][0] = a.x; w[j][1] = a.y; w[j][2] = a.z; w[j][3] = a.w; w[j][4] = b.x; w[j][5] = b.y; w[j][6] = b.z; w[j][7] = b.w; }
#pragma unroll
            for (int i = 0; i < 8; ++i) {
                float acc[8] = {0.f, 0.f, 0.f, 0.f, 0.f, 0.f, 0.f, 0.f};
#pragma unroll
                for (int j = 0; j < 4; ++j) { float x[8]; unpack8(rows[i + j], x);
#pragma unroll
                    for (int e = 0; e < 8; ++e) acc[e] += w[j][e] * x[e]; }
                float ss = 0.f;
#pragma unroll
                for (int e = 0; e < 8; ++e) { acc[e] = silu_f(acc[e]); ss += acc[e] * acc[e]; }
                if (it < 2) {
                    ss += lxf<1>(ss); ss += lxf<2>(ss); ss += lxf<4>(ss); ss += lxf<8>(ss);
                    const float r = rsqrtf(ss + 1e-6f);
#pragma unroll
                    for (int e = 0; e < 8; ++e) acc[e] *= r; }
                u32x4 o4; o4.x = pk2(acc[0], acc[1]); o4.y = pk2(acc[2], acc[3]); o4.z = pk2(acc[4], acc[5]); o4.w = pk2(acc[6], acc[7]);
                *(u32x4*)(QKVC + (size_t)(t0 + i) * 1536 + ch) = o4;
            }
        }
        {
            u32x2 wq[8], wk[8], wv[8];
#pragma unroll
            for (int i = 0; i < 8; ++i) { const bf16_t* r = PROJ + (size_t)(t0 + i) * NPROJ + 4 * lane; wq[i] = *(const u32x2*)(r + C_DQ); wk[i] = *(const u32x2*)(r + C_DK); wv[i] = *(const u32x2*)(r + C_DV); }
            const float4 g4 = *(const float4*)(qg + 4 * (lane & 7)), h4 = *(const float4*)(kg + 4 * (lane & 7));
#pragma unroll
            for (int i = 0; i < 8; ++i) {
                float q[4] = {bf_lo(wq[i].x), bf_hi(wq[i].x), bf_lo(wq[i].y), bf_hi(wq[i].y)}, k[4] = {bf_lo(wk[i].x), bf_hi(wk[i].x), bf_lo(wk[i].y), bf_hi(wk[i].y)};
                float sq = (q[0] * q[0] + q[1] * q[1]) + (q[2] * q[2] + q[3] * q[3]), sk = (k[0] * k[0] + k[1] * k[1]) + (k[2] * k[2] + k[3] * k[3]);
                sq += lxf<1>(sq); sk += lxf<1>(sk); sq += lxf<2>(sq); sk += lxf<2>(sk); sq += lxf<4>(sq); sk += lxf<4>(sk);
                const float rq = rsqrtf(sq * (1.0f / 32.0f) + 1e-6f) * (0.17677669529663687f * 1.4426950408889634f), rk = rsqrtf(sk * (1.0f / 32.0f) + 1e-6f);
                u32x2 oq, ok; oq.x = pk2(q[0] * rq * g4.x, q[1] * rq * g4.y); oq.y = pk2(q[2] * rq * g4.z, q[3] * rq * g4.w);
                ok.x = pk2(k[0] * rk * h4.x, k[1] * rk * h4.y); ok.y = pk2(k[2] * rk * h4.z, k[3] * rk * h4.w);
                *(u32x2*)(AQ + (size_t)(t0 + i) * 256 + 4 * lane) = oq; *(u32x2*)(AK + (size_t)(t0 + i) * 256 + 4 * lane) = ok;
            }
            bf16_t* vt = AVT + ((size_t)((t0 >> 11) * 4 + (lane >> 4)) * 64 + (lane & 15) * 4) * SEQ + kperm(s0);
#pragma unroll
            for (int d = 0; d < 4; ++d) {
                unsigned e[8];
#pragma unroll
                for (int i = 0; i < 8; ++i) { const unsigned w = (d < 2) ? wv[i].x : wv[i].y; e[i] = (d & 1) ? (w >> 16) : (w & 0xffffu); }
                u32x2 lo, hi; lo.x = e[0] | (e[1] << 16); lo.y = e[2] | (e[3] << 16); hi.x = e[4] | (e[5] << 16); hi.y = e[6] | (e[7] << 16);
                *(u32x2*)(vt + (size_t)d * SEQ) = lo; *(u32x2*)(vt + (size_t)d * SEQ + 8) = hi;
            }
        }
        {
            const int ch = 4 * lane; u32x2 wc[10], wh[10], wb[8];
#pragma unroll
            for (int j = 0; j < 10; ++j) { const bool ok = (s0 + j - 2 >= 0); const bf16_t* r = PROJ + (size_t)(t0 + j - 2) * NPROJ + ch;
                wc[j] = ok ? *(const u32x2*)(r + C_SC) : (u32x2){0u, 0u}; wh[j] = ok ? *(const u32x2*)(r + C_SH) : (u32x2){0u, 0u}; }
#pragma unroll
            for (int i = 0; i < 8; ++i) wb[i] = *(const u32x2*)(PROJ + (size_t)(t0 + i) * NPROJ + C_SB + ch);
            float4 cw[3];
#pragma unroll
            for (int j = 0; j < 3; ++j) cw[j] = *(const float4*)(sconv + j * 256 + ch);
            float p[10][4];
#pragma unroll
            for (int j = 0; j < 10; ++j) { p[j][0] = bf_lo(wc[j].x) * bf_lo(wh[j].x); p[j][1] = bf_hi(wc[j].x) * bf_hi(wh[j].x); p[j][2] = bf_lo(wc[j].y) * bf_lo(wh[j].y); p[j][3] = bf_hi(wc[j].y) * bf_hi(wh[j].y); }
#pragma unroll
            for (int i = 0; i < 8; ++i) {
                const float a0 = cw[0].x * p[i][0] + cw[1].x * p[i + 1][0] + cw[2].x * p[i + 2][0], a1 = cw[0].y * p[i][1] + cw[1].y * p[i + 1][1] + cw[2].y * p[i + 2][1];
                const float a2 = cw[0].z * p[i][2] + cw[1].z * p[i + 1][2] + cw[2].z * p[i + 2][2], a3 = cw[0].w * p[i][3] + cw[1].w * p[i + 1][3] + cw[2].w * p[i + 2][3];
                u32x2 o; o.x = pk2(bf_lo(wb[i].x) * a0, bf_hi(wb[i].x) * a1); o.y = pk2(bf_lo(wb[i].y) * a2, bf_hi(wb[i].y) * a3);
                *(u32x2*)(MIXED + (size_t)(t0 + i) * 1024 + 512 + ch) = o;
            }
        }
    }
}

__device__ __forceinline__ void gdn_seq_unit(Ctx& c, const Args& A, int u) {
    const int bh = u >> 1, j0 = (u & 1) * 64, b = bh >> 2, h = bh & 3, tid = c.tid, lane = c.lane;
    const bf16_t* QKVC = (const bf16_t*)(A.ws + WS_QKVC); const float* GB = (const float*)(A.ws + WS_GB); float* OG = (float*)(A.ws + WS_OGDN);
    LAS float* kq = (LAS float*)c.lds;
    LAS float* vv = (LAS float*)(c.lds + 65536);
    LAS float* bg = (LAS float*)(c.lds + 65536 + 16384);
    float S[128];
#pragma unroll
    for (int d = 0; d < 128; ++d) S[d] = 0.f;
    for (int ck = 0; ck < 32; ++ck) {
        const int t0 = b * SEQ + ck * 64;
        __syncthreads();
        for (int e = tid; e < 64 * 128; e += 512) { const int i = e >> 7, p = (e & 127) * 2;
            const int col = p < 128 ? (C_GK + h * 128 + p) : (C_GQ + h * 128 + (p - 128));
            const unsigned w = *(const unsigned*)(QKVC + (size_t)(t0 + i) * 1536 + col); kq[i * 256 + p] = bf_lo(w); kq[i * 256 + p + 1] = bf_hi(w); }
        for (int e = tid; e < 64 * 32; e += 512) { const int i = e >> 5, p = (e & 31) * 2; const unsigned w = *(const unsigned*)(QKVC + (size_t)(t0 + i) * 1536 + C_GV + h * 128 + j0 + p); vv[i * 64 + p] = bf_lo(w); vv[i * 64 + p + 1] = bf_hi(w); }
        if (tid < 64) { bg[tid] = GB[(size_t)(t0 + tid) * 8 + h]; bg[64 + tid] = __expf(GB[(size_t)(t0 + tid) * 8 + 4 + h]); }
        __syncthreads();
        if (c.wave == 0) {
            for (int i = 0; i < 64; ++i) {
                const float beta = bg[i], al = bg[64 + i]; const LAS f32x4* kr = (const LAS f32x4*)(kq + i * 256); const LAS f32x4* qr = kr + 32;
                float ks = 0.f;
#pragma unroll
                for (int dg = 0; dg < 4; ++dg) {
#pragma unroll
                    for (int dd = 0; dd < 8; ++dd) { const int d4 = dg * 8 + dd; const f32x4 k4 = kr[d4]; ks += (k4.x * S[4 * d4] + k4.y * S[4 * d4 + 1]) + (k4.z * S[4 * d4 + 2] + k4.w * S[4 * d4 + 3]); }
                    asm volatile("" ::: "memory"); }
                const float delta = beta * (vv[i * 64 + lane] - al * ks); float o = 0.f;
#pragma unroll
                for (int dg = 0; dg < 8; ++dg) {
#pragma unroll
                    for (int dd = 0; dd < 4; ++dd) { const int d4 = dg * 4 + dd; const f32x4 k4 = kr[d4], q4 = qr[d4];
                        S[4 * d4] = al * S[4 * d4] + k4.x * delta; S[4 * d4 + 1] = al * S[4 * d4 + 1] + k4.y * delta; S[4 * d4 + 2] = al * S[4 * d4 + 2] + k4.z * delta; S[4 * d4 + 3] = al * S[4 * d4 + 3] + k4.w * delta;
                        o += (q4.x * S[4 * d4] + q4.y * S[4 * d4 + 1]) + (q4.z * S[4 * d4 + 2] + q4.w * S[4 * d4 + 3]); }
                    asm volatile("" ::: "memory"); }
                OG[(size_t)(t0 + i) * 512 + h * 128 + j0 + lane] = o * 0.08838834764831845f;
            }
        }
    }
    __syncthreads();
}
constexpr int GCH_BYTES = 73728, GCH_WM = 0, GCH_QM = 16384, GCH_KT = 32768, GCH_AM = 49152, GCH_UT = 57344;
__device__ __forceinline__ bf16x8 pack_frag(const f32x4& a, const f32x4& b) { u32x4 w; w.x = pg8::cvt_pk_bf16(a[0], a[1]); w.y = pg8::cvt_pk_bf16(a[2], a[3]); w.z = pg8::cvt_pk_bf16(b[0], b[1]); w.w = pg8::cvt_pk_bf16(b[2], b[3]); return __builtin_bit_cast(bf16x8, w); }
__device__ __forceinline__ void gdn_chunk_unit(Ctx& c, const Args& A, int unit) {
    const int tid = c.tid, lane = c.lane, wave = c.wave, fr = lane & 15, fq = lane >> 4;
    const int bh = unit >> 5, ck = unit & 31, b = bh >> 2, h = bh & 3, t0 = b * SEQ + ck * 64;
    const bf16_t* QKVC = (const bf16_t*)(A.ws + WS_QKVC); const float* GB = (const float*)(A.ws + WS_GB); float* GL = (float*)(A.ws + WS_GB + 512 * 1024);
    unsigned char* rec = A.ws + WS_GCH + (size_t)unit * GCH_BYTES;
    LAS float* gcs = (LAS float*)c.lds;
    LAS float* bet = gcs + 64;
    LAS float* Lm = (LAS float*)(c.lds + 512);
    LAS bf16_t* Tb = (LAS bf16_t*)(c.lds + 512 + 16384);
    LAS bf16_t* vt = Tb + 64 * 72;
    LAS bf16_t* kt = vt + 128 * 72;
    LAS bf16_t* k2 = kt + 128 * 72;
    __syncthreads();
    if (tid < 64) { float g = GB[(size_t)(t0 + tid) * 8 + 4 + h];
#pragma unroll
        for (int o = 1; o < 64; o <<= 1) { const float n = __shfl_up(g, o); if (lane >= o) g += n; }
        gcs[tid] = g; bet[tid] = GB[(size_t)(t0 + tid) * 8 + h]; }
    __syncthreads();
#pragma unroll 1
    for (int bb = 0; bb < 2; ++bb) {
        const int blk = wave * 2 + bb, ib = blk >> 2, jb = blk & 3;
        f32x4 kk = (f32x4){0.f, 0.f, 0.f, 0.f}, qk = (f32x4){0.f, 0.f, 0.f, 0.f};
        if (jb <= ib) {
            const bf16_t* ki = QKVC + (size_t)(t0 + ib * 16 + fr) * 1536 + C_GK + h * 128 + 8 * fq; const bf16_t* qi = QKVC + (size_t)(t0 + ib * 16 + fr) * 1536 + C_GQ + h * 128 + 8 * fq;
            const bf16_t* kj = QKVC + (size_t)(t0 + jb * 16 + fr) * 1536 + C_GK + h * 128 + 8 * fq;
#pragma unroll
            for (int ks = 0; ks < 4; ++ks) { const bf16x8 a = *(const bf16x8*)(ki + ks * 32), q = *(const bf16x8*)(qi + ks * 32), bj = *(const bf16x8*)(kj + ks * 32);
                kk = __builtin_amdgcn_mfma_f32_16x16x32_bf16(a, bj, kk, 0, 0, 0); qk = __builtin_amdgcn_mfma_f32_16x16x32_bf16(q, bj, qk, 0, 0, 0); }
        }
        const int j = jb * 16 + fr; const float gj = gcs[j]; bf16_t* AM = (bf16_t*)(rec + GCH_AM);
#pragma unroll
        for (int r = 0; r < 4; ++r) { const int i = ib * 16 + 4 * fq + r; const float dec = i >= j ? __expf(gcs[i] - gj) : 0.f;
            Lm[i * 64 + j] = i > j ? bet[i] * kk[r] * dec : 0.f;
            AM[i * 64 + kperm(j)] = (bf16_t)f2bf(qk[r] * dec * 0.08838834764831845f); }
    }
    __syncthreads();
    if (wave == 0) {
        float Tc[64];
#pragma unroll
        for (int i = 0; i < 64; ++i) { float acc = (lane == i) ? 1.f : 0.f;
#pragma unroll
            for (int j4 = 0; j4 < (i + 3) / 4; ++j4) { const f32x4 l4 = *(const LAS f32x4*)(Lm + i * 64 + 4 * j4);
#pragma unroll
                for (int x = 0; x < 4; ++x) if (4 * j4 + x < i) acc -= l4[x] * Tc[4 * j4 + x]; }
            Tc[i] = acc; Tb[i * 72 + lane] = (bf16_t)f2bf(acc); }
    } else {
        const float glast = gcs[63];
        for (int e = tid - 64; e < 64 * 16; e += 448) { const int j = e >> 4, d8 = (e & 15) * 8; const float bj = bet[j], gj = gcs[j]; const float s1 = bj * __expf(gj), s2 = __expf(glast - gj);
            const u32x4 kw = *(const u32x4*)(QKVC + (size_t)(t0 + j) * 1536 + C_GK + h * 128 + d8), vw = *(const u32x4*)(QKVC + (size_t)(t0 + j) * 1536 + C_GV + h * 128 + d8);
            const float kf[8] = {bf_lo(kw.x), bf_hi(kw.x), bf_lo(kw.y), bf_hi(kw.y), bf_lo(kw.z), bf_hi(kw.z), bf_lo(kw.w), bf_hi(kw.w)};
            const float vf[8] = {bf_lo(vw.x), bf_hi(vw.x), bf_lo(vw.y), bf_hi(vw.y), bf_lo(vw.z), bf_hi(vw.z), bf_lo(vw.w), bf_hi(vw.w)};
            const int jp = kperm(j);
#pragma unroll
            for (int x = 0; x < 8; ++x) { vt[(d8 + x) * 72 + j] = (bf16_t)f2bf(vf[x] * bj); kt[(d8 + x) * 72 + j] = (bf16_t)f2bf(kf[x] * s1); k2[(d8 + x) * 72 + jp] = (bf16_t)f2bf(kf[x] * s2); }
        }
        bf16_t* QM = (bf16_t*)(rec + GCH_QM);
        for (int e = tid - 64; e < 64 * 16; e += 448) { const int j = e >> 4, m8 = e & 15, m = m8 & 3; const float s = __expf(gcs[j]) * 0.08838834764831845f;
            const u32x4 qw = *(const u32x4*)(QKVC + (size_t)(t0 + j) * 1536 + C_GQ + h * 128 + m8 * 8);
            const int pos = (m8 >> 2) * 32 + 16 * (m & 1) + 4 * (m >> 1);
            u32x2 w0, w1; w0.x = pk2(bf_lo(qw.x) * s, bf_hi(qw.x) * s); w0.y = pk2(bf_lo(qw.y) * s, bf_hi(qw.y) * s); w1.x = pk2(bf_lo(qw.z) * s, bf_hi(qw.z) * s); w1.y = pk2(bf_lo(qw.w) * s, bf_hi(qw.w) * s);
            *(u32x2*)(QM + j * 128 + pos) = w0; *(u32x2*)(QM + j * 128 + pos + 8) = w1; }
        if (tid == 64) GL[unit] = glast;
    }
    __syncthreads();
    {
        f32x4 ua[4], wa[4];
#pragma unroll
        for (int mb = 0; mb < 4; ++mb) { ua[mb] = (f32x4){0.f, 0.f, 0.f, 0.f}; wa[mb] = (f32x4){0.f, 0.f, 0.f, 0.f}; }
#pragma unroll
        for (int ks = 0; ks < 2; ++ks) {
            const bf16x8 vf = *(const LAS bf16x8*)(vt + (16 * wave + fr) * 72 + ks * 32 + 8 * fq), kf = *(const LAS bf16x8*)(kt + (16 * wave + fr) * 72 + ks * 32 + 8 * fq);
#pragma unroll
            for (int mb = 0; mb < 4; ++mb) { const bf16x8 tf = *(const LAS bf16x8*)(Tb + (16 * mb + fr) * 72 + ks * 32 + 8 * fq);
                ua[mb] = __builtin_amdgcn_mfma_f32_16x16x32_bf16(tf, vf, ua[mb], 0, 0, 0);
                wa[mb] = __builtin_amdgcn_mfma_f32_16x16x32_bf16(kf, tf, wa[mb], 0, 0, 0); }
        }
        bf16_t* UT = (bf16_t*)(rec + GCH_UT); bf16_t* WM = (bf16_t*)(rec + GCH_WM);
#pragma unroll
        for (int mb = 0; mb < 4; ++mb) { u32x2 w; w.x = pk2(ua[mb][0], ua[mb][1]); w.y = pk2(ua[mb][2], ua[mb][3]); *(u32x2*)(UT + (16 * wave + fr) * 64 + 16 * mb + 4 * fq) = w;
            u32x2 v; v.x = pk2(wa[mb][0], wa[mb][1]); v.y = pk2(wa[mb][2], wa[mb][3]); *(u32x2*)(WM + (16 * mb + fr) * 128 + kperm(16 * wave + 4 * fq)) = v; }
        bf16_t* KT = (bf16_t*)(rec + GCH_KT);
#pragma unroll
        for (int k = 0; k < 2; ++k) { const int e = tid + 512 * k, row = e >> 3, cc = e & 7; *(u32x4*)(KT + row * 64 + cc * 8) = *(const LAS u32x4*)(k2 + row * 72 + cc * 8); }
    }
}
struct GaUnit { int t0, h; unsigned char* rec; };
__device__ __forceinline__ GaUnit ga_unit(const Args& A, int unit) { GaUnit u; const int bh = unit >> 5, ck = unit & 31; u.h = bh & 3; u.t0 = (bh >> 2) * SEQ + ck * 64; u.rec = A.ws + WS_GCH + (size_t)unit * GCH_BYTES; return u; }
__device__ __forceinline__ void ga_stage(const GaUnit& u, const bf16_t* QKVC, const LAS float* gcs, const LAS float* bet, LAS bf16_t* vt, LAS bf16_t* kt, LAS bf16_t* k2, int rel, int nth) {
    const float glast = gcs[63];
#pragma unroll 3
    for (int e = rel; e < 64 * 16; e += nth) { const int j = e >> 4, d8 = (e & 15) * 8; const float bj = bet[j], gj = gcs[j]; const float s1 = bj * __expf(gj), s2 = __expf(glast - gj);
        const u32x4 kw = *(const u32x4*)(QKVC + (size_t)(u.t0 + j) * 1536 + C_GK + u.h * 128 + d8), vw = *(const u32x4*)(QKVC + (size_t)(u.t0 + j) * 1536 + C_GV + u.h * 128 + d8);
        const float kf[8] = {bf_lo(kw.x), bf_hi(kw.x), bf_lo(kw.y), bf_hi(kw.y), bf_lo(kw.z), bf_hi(kw.z), bf_lo(kw.w), bf_hi(kw.w)};
        const float vf[8] = {bf_lo(vw.x), bf_hi(vw.x), bf_lo(vw.y), bf_hi(vw.y), bf_lo(vw.z), bf_hi(vw.z), bf_lo(vw.w), bf_hi(vw.w)};
        const int jp = kperm(j);
#pragma unroll
        for (int x = 0; x < 8; ++x) { vt[(d8 + x) * 72 + j] = (bf16_t)f2bf(vf[x] * bj); kt[(d8 + x) * 72 + j] = (bf16_t)f2bf(kf[x] * s1); k2[(d8 + x) * 72 + jp] = (bf16_t)f2bf(kf[x] * s2); }
    }
}
__device__ __forceinline__ void ga_qm(const GaUnit& u, const bf16_t* QKVC, const LAS float* gcs, int rel, int nth) {
    bf16_t* QM = (bf16_t*)(u.rec + GCH_QM);
#pragma unroll 3
    for (int e = rel; e < 64 * 16; e += nth) { const int j = e >> 4, m8 = e & 15, m = m8 & 3; const float s = __expf(gcs[j]) * 0.08838834764831845f;
        const u32x4 qw = *(const u32x4*)(QKVC + (size_t)(u.t0 + j) * 1536 + C_GQ + u.h * 128 + m8 * 8);
        const int pos = (m8 >> 2) * 32 + 16 * (m & 1) + 4 * (m >> 1);
        u32x2 w0, w1; w0.x = pk2(bf_lo(qw.x) * s, bf_hi(qw.x) * s); w0.y = pk2(bf_lo(qw.y) * s, bf_hi(qw.y) * s); w1.x = pk2(bf_lo(qw.z) * s, bf_hi(qw.z) * s); w1.y = pk2(bf_lo(qw.w) * s, bf_hi(qw.w) * s);
        *(u32x2*)(QM + j * 128 + pos) = w0; *(u32x2*)(QM + j * 128 + pos + 8) = w1; }
}
__device__ __forceinline__ void ga_uw(const GaUnit& u, const LAS bf16_t* Tb, const LAS bf16_t* vt, const LAS bf16_t* kt, const LAS bf16_t* k2, int tid, int wave, int fr, int fq) {
    f32x4 ua[4], wa[4];
#pragma unroll
    for (int mb = 0; mb < 4; ++mb) { ua[mb] = (f32x4){0.f, 0.f, 0.f, 0.f}; wa[mb] = (f32x4){0.f, 0.f, 0.f, 0.f}; }
#pragma unroll
    for (int ks = 0; ks < 2; ++ks) {
        const bf16x8 vf = *(const LAS bf16x8*)(vt + (16 * wave + fr) * 72 + ks * 32 + 8 * fq), kf = *(const LAS bf16x8*)(kt + (16 * wave + fr) * 72 + ks * 32 + 8 * fq);
#pragma unroll
        for (int mb = 0; mb < 4; ++mb) { const bf16x8 tf = *(const LAS bf16x8*)(Tb + (16 * mb + fr) * 72 + ks * 32 + 8 * fq);
            ua[mb] = __builtin_amdgcn_mfma_f32_16x16x32_bf16(tf, vf, ua[mb], 0, 0, 0);
            wa[mb] = __builtin_amdgcn_mfma_f32_16x16x32_bf16(kf, tf, wa[mb], 0, 0, 0); }
    }
    bf16_t* UT = (bf16_t*)(u.rec + GCH_UT); bf16_t* WM = (bf16_t*)(u.rec + GCH_WM);
#pragma unroll
    for (int mb = 0; mb < 4; ++mb) { u32x2 w; w.x = pk2(ua[mb][0], ua[mb][1]); w.y = pk2(ua[mb][2], ua[mb][3]); *(u32x2*)(UT + (16 * wave + fr) * 64 + 16 * mb + 4 * fq) = w;
        u32x2 v; v.x = pk2(wa[mb][0], wa[mb][1]); v.y = pk2(wa[mb][2], wa[mb][3]); *(u32x2*)(WM + (16 * mb + fr) * 128 + kperm(16 * wave + 4 * fq)) = v; }
    bf16_t* KT = (bf16_t*)(u.rec + GCH_KT);
#pragma unroll
    for (int k = 0; k < 2; ++k) { const int e = tid + 512 * k, row = e >> 3, cc = e & 7; *(u32x4*)(KT + row * 64 + cc * 8) = *(const LAS u32x4*)(k2 + row * 72 + cc * 8); }
}
__device__ __forceinline__ void gdn_chunk_pair(Ctx& c, const Args& A, int unit0, int unit1) {
    const int tid = c.tid, lane = c.lane, wave = c.wave, fr = lane & 15, fq = lane >> 4;
    const bf16_t* QKVC = (const bf16_t*)(A.ws + WS_QKVC); const float* GB = (const float*)(A.ws + WS_GB); float* GL = (float*)(A.ws + WS_GB + 512 * 1024);
    LAS float* gcs = (LAS float*)c.lds;
    LAS float* bet = gcs + 128;
    LAS float* Lm = (LAS float*)(c.lds + 1024);
    LAS bf16_t* Tb = (LAS bf16_t*)(c.lds + 33792);
    LAS bf16_t* vt = (LAS bf16_t*)(c.lds + 52224);
    LAS bf16_t* kt = vt + 128 * 72; LAS bf16_t* k2 = kt + 128 * 72;
    const GaUnit U0 = ga_unit(A, unit0), U1 = ga_unit(A, unit1);
    __syncthreads();
    if (tid < 128) { const GaUnit& u = wave ? U1 : U0; float g = GB[(size_t)(u.t0 + lane) * 8 + 4 + u.h];
#pragma unroll
        for (int o = 1; o < 64; o <<= 1) { const float n = __shfl_up(g, o); if (lane >= o) g += n; }
        gcs[wave * 64 + lane] = g; bet[wave * 64 + lane] = GB[(size_t)(u.t0 + lane) * 8 + u.h]; }
    __syncthreads();
#pragma unroll 2
    for (int bb = 0; bb < 4; ++bb) {
        const int idx = wave * 4 + bb, p = idx >> 4, blk = idx & 15, ib = blk >> 2, jb = blk & 3; const GaUnit& u = p ? U1 : U0;
        f32x4 kk = (f32x4){0.f, 0.f, 0.f, 0.f}, qk = (f32x4){0.f, 0.f, 0.f, 0.f};
        if (jb <= ib) {
            const bf16_t* ki = QKVC + (size_t)(u.t0 + ib * 16 + fr) * 1536 + C_GK + u.h * 128 + 8 * fq; const bf16_t* qi = QKVC + (size_t)(u.t0 + ib * 16 + fr) * 1536 + C_GQ + u.h * 128 + 8 * fq;
            const bf16_t* kj = QKVC + (size_t)(u.t0 + jb * 16 + fr) * 1536 + C_GK + u.h * 128 + 8 * fq;
#pragma unroll
            for (int ks = 0; ks < 4; ++ks) { const bf16x8 a = *(const bf16x8*)(ki + ks * 32), q = *(const bf16x8*)(qi + ks * 32), bj = *(const bf16x8*)(kj + ks * 32);
                kk = __builtin_amdgcn_mfma_f32_16x16x32_bf16(a, bj, kk, 0, 0, 0); qk = __builtin_amdgcn_mfma_f32_16x16x32_bf16(q, bj, qk, 0, 0, 0); }
        }
        const int j = jb * 16 + fr; const float gj = gcs[p * 64 + j]; bf16_t* AM = (bf16_t*)(u.rec + GCH_AM);
#pragma unroll
        for (int r = 0; r < 4; ++r) { const int i = ib * 16 + 4 * fq + r; const float dec = i >= j ? __expf(gcs[p * 64 + i] - gj) : 0.f;
            Lm[p * 4096 + i * 64 + j] = i > j ? bet[p * 64 + i] * kk[r] * dec : 0.f;
            AM[i * 64 + kperm(j)] = (bf16_t)f2bf(qk[r] * dec * 0.08838834764831845f); }
    }
    __syncthreads();
    if (wave < 2) {
        const LAS float* L = Lm + wave * 4096; LAS bf16_t* Tw = Tb + wave * 64 * 72;
        float Tc[64];
#pragma unroll
        for (int i = 0; i < 64; ++i) { float ac[4] = {(lane == i) ? 1.f : 0.f, 0.f, 0.f, 0.f};
#pragma unroll
            for (int j4 = 0; j4 < (i + 3) / 4; ++j4) { const f32x4 l4 = *(const LAS f32x4*)(L + i * 64 + 4 * j4);
#pragma unroll
                for (int x = 0; x < 4; ++x) if (4 * j4 + x < i) ac[x] -= l4[x] * Tc[4 * j4 + x]; }
            const float acc = (ac[0] + ac[1]) + (ac[2] + ac[3]);
            Tc[i] = acc; Tw[i * 72 + lane] = (bf16_t)f2bf(acc); }
    } else {
        ga_stage(U0, QKVC, gcs, bet, vt, kt, k2, tid - 128, 384);
        ga_qm(U0, QKVC, gcs, tid - 128, 384); ga_qm(U1, QKVC, gcs + 64, tid - 128, 384);
        if (tid == 128) { GL[unit0] = gcs[63]; GL[unit1] = gcs[127]; }
    }
    __syncthreads();
    ga_uw(U0, Tb, vt, kt, k2, tid, wave, fr, fq);
    __syncthreads();
    ga_stage(U1, QKVC, gcs + 64, bet + 64, vt, kt, k2, tid, 512);
    __syncthreads();
    ga_uw(U1, Tb + 64 * 72, vt, kt, k2, tid, wave, fr, fq);
}
__device__ __forceinline__ void gdn_scan(Ctx& c, const Args& A, int unit) {
    const int bh = unit >> 1, dv0 = (unit & 1) * 64 + 16 * (c.wave & 3); const bool active = c.wave < 4;
    const int tid = c.tid, lane = c.lane, fr = lane & 15, fq = lane >> 4, b = bh >> 2, h = bh & 3;
    constexpr int L_WM = 0, L_QM = 17408, L_KT = 34816, L_AM = 53248, L_BUF = 62464;
    const unsigned char* rec0 = A.ws + WS_GCH + (size_t)bh * 32 * GCH_BYTES; const float* GL = (const float*)(A.ws + WS_GB + 512 * 1024) + bh * 32; float* OG = (float*)(A.ws + WS_OGDN);
    f32x4 S[8];
#pragma unroll
    for (int i = 0; i < 8; ++i) S[i] = (f32x4){0.f, 0.f, 0.f, 0.f};
    u32x4 pre[14]; const int t2 = tid - 256;
#define GDN_LOAD(rec) do { _Pragma("unroll") for (int k = 0; k < 14; ++k) pre[k] = *(const u32x4*)((rec) + (size_t)(t2 + 256 * k) * 16); } while (0)
#define GDN_STORE(base) do { \
        _Pragma("unroll") for (int k = 0; k < 4; ++k) { const int q = t2 + 256 * k; *(LAS u32x4*)((base) + L_WM + (q >> 4) * 272 + (q & 15) * 16) = pre[k]; *(LAS u32x4*)((base) + L_QM + (q >> 4) * 272 + (q & 15) * 16) = pre[4 + k]; \
            *(LAS u32x4*)((base) + L_KT + (q >> 3) * 144 + (q & 7) * 16) = pre[8 + k]; } \
        _Pragma("unroll") for (int k = 0; k < 2; ++k) { const int q = t2 + 256 * k; *(LAS u32x4*)((base) + L_AM + (q >> 3) * 144 + (q & 7) * 16) = pre[12 + k]; } } while (0)
    __syncthreads();
    if (!active) { GDN_LOAD(rec0); GDN_STORE(c.lds); }
    u32x2 uwc[4], uwn[4]; float glc = GL[0], gln = 0.f;
#pragma unroll
    for (int mb = 0; mb < 4; ++mb) { uwc[mb] = *(const u32x2*)((const bf16_t*)(rec0 + GCH_UT) + (dv0 + fr) * 64 + 16 * mb + 4 * fq); uwn[mb] = uwc[mb]; }
    __syncthreads();
#pragma unroll 1
    for (int ck = 0; ck < 32; ++ck) {
        const unsigned char* rec = rec0 + (size_t)ck * GCH_BYTES; LAS unsigned char* B0 = c.lds + (ck & 1) * L_BUF; const int t0 = b * SEQ + ck * 64;
        if (ck + 1 < 32) { if (!active) GDN_LOAD(rec + GCH_BYTES); const bf16_t* UTn = (const bf16_t*)(rec + GCH_BYTES + GCH_UT);
#pragma unroll
            for (int mb = 0; mb < 4; ++mb) uwn[mb] = *(const u32x2*)(UTn + (dv0 + fr) * 64 + 16 * mb + 4 * fq); gln = GL[ck + 1]; }
        if (active) {
        bf16x8 sB[4];
#pragma unroll
        for (int ks = 0; ks < 4; ++ks) sB[ks] = pack_frag(S[2 * ks], S[2 * ks + 1]);
        f32x4 vn[4], oa[4];
#pragma unroll
        for (int mb = 0; mb < 4; ++mb) { f32x4 p = (f32x4){0.f, 0.f, 0.f, 0.f}, o = (f32x4){0.f, 0.f, 0.f, 0.f};
#pragma unroll
            for (int ks = 0; ks < 4; ++ks) { const bf16x8 aw = *(const LAS bf16x8*)(B0 + L_WM + (16 * mb + fr) * 272 + ks * 64 + fq * 16), aq = *(const LAS bf16x8*)(B0 + L_QM + (16 * mb + fr) * 272 + ks * 64 + fq * 16);
                p = __builtin_amdgcn_mfma_f32_16x16x32_bf16(aw, sB[ks], p, 0, 0, 0); o = __builtin_amdgcn_mfma_f32_16x16x32_bf16(aq, sB[ks], o, 0, 0, 0); }
            const u32x2 uw = uwc[mb];
            vn[mb] = (f32x4){bf_lo(uw.x) - p[0], bf_hi(uw.x) - p[1], bf_lo(uw.y) - p[2], bf_hi(uw.y) - p[3]}; oa[mb] = o; }
        bf16x8 vB[2];
#pragma unroll
        for (int s = 0; s < 2; ++s) vB[s] = pack_frag(vn[2 * s], vn[2 * s + 1]);
#pragma unroll
        for (int mb = 0; mb < 4; ++mb) {
#pragma unroll
            for (int s = 0; s < 2; ++s) { const bf16x8 aa = *(const LAS bf16x8*)(B0 + L_AM + (16 * mb + fr) * 144 + s * 64 + fq * 16); oa[mb] = __builtin_amdgcn_mfma_f32_16x16x32_bf16(aa, vB[s], oa[mb], 0, 0, 0); }
#pragma unroll
            for (int r = 0; r < 4; ++r) OG[(size_t)(t0 + 16 * mb + 4 * fq + r) * 512 + h * 128 + dv0 + fr] = oa[mb][r]; }
        const float gl = __expf(glc);
#pragma unroll
        for (int m8 = 0; m8 < 8; ++m8) { f32x4 s = S[m8] * gl;
#pragma unroll
            for (int s2 = 0; s2 < 2; ++s2) { const bf16x8 ak = *(const LAS bf16x8*)(B0 + L_KT + (16 * m8 + fr) * 144 + s2 * 64 + fq * 16); s = __builtin_amdgcn_mfma_f32_16x16x32_bf16(ak, vB[s2], s, 0, 0, 0); }
            S[m8] = s; }
        }
        if (ck + 1 < 32 && !active) GDN_STORE(c.lds + ((ck + 1) & 1) * L_BUF);
#pragma unroll
        for (int mb = 0; mb < 4; ++mb) uwc[mb] = uwn[mb];
        glc = gln;
        __syncthreads();
    }
#undef GDN_LOAD
#undef GDN_STORE
}
__device__ __forceinline__ int rel_bucket(int n) {
    if (n < 16) return n;
    const int v = 16 + (int)(__logf((float)n * (1.0f / 16.0f)) / 2.0794415416798357f * 16.0f);
    return v < 31 ? v : 31;
}
__device__ __forceinline__ void attn_mfma(Ctx& c, const Args& A, int l, int first_block, int nblocks) {
    const int tid = c.tid, lane = c.lane, wave = c.wave, fr = lane & 15, fq = lane >> 4;
    const bf16_t* AQ = (const bf16_t*)(A.ws + WS_AQ); const bf16_t* AK = (const bf16_t*)(A.ws + WS_AK); const bf16_t* AVT = (const bf16_t*)(A.ws + WS_AVT); bf16_t* MIXED = (bf16_t*)(A.ws + WS_MIXED);
    LAS float* bt = (LAS float*)c.lds;
    LAS float* cs = bt + 512;
    const float* rel_bias = A.in[1]; const float* lamp = A.in[11] + l * 128; const float* subln = A.in[12] + l * 64;
    const float lambda_init = 0.8f - 0.6f * __expf(-0.3f * (float)l);
    __syncthreads();
    {
        float mq = 0.f, mk = 0.f, mb = 0.f;
        for (int d = 0; d < 32; ++d) { mq = fmaxf(mq, fabsf(A.in[9][l * 32 + d])); mk = fmaxf(mk, fabsf(A.in[10][l * 32 + d])); }
        for (int i = 0; i < 128; ++i) mb = fmaxf(mb, fabsf(rel_bias[i]));
        const float cshift = 5.656854249492381f * mq * mk + mb;
        const int n = tid & 127, hh = tid >> 7; bt[hh * 128 + n] = (rel_bias[rel_bucket(n) * 4 + hh] - cshift) * 1.4426950408889634f;
        if (tid == 0) { float s01 = 0.f, s23 = 0.f; for (int d = 0; d < 32; ++d) { s01 += lamp[d] * lamp[32 + d]; s23 += lamp[64 + d] * lamp[96 + d]; } cs[0] = __expf(s01) - __expf(s23) + lambda_init; }
    }
    __syncthreads();
    const float lam = cs[0];
    bf16x8 ones; { const short o = (fr == 0) ? (short)0x3f80 : (short)0; ones = (bf16x8){o, o, o, o, o, o, o, o}; }
    constexpr int AT_K = 4096, AT_V = 4096 + 4608, AT_BUF = 9728;
    const int wg = c.bid - first_block;
#pragma unroll 1
    for (int rd = 0; rd * nblocks < 256; ++rd) {
        const int it = rd * nblocks + ((rd & 1) ? nblocks - 1 - wg : wg); if (it >= 256) continue;
        const int bh = it & 31, QB = 7 - (it >> 5), b = bh >> 2, h = bh & 3, q0 = QB * 256 + 32 * wave, nsteps = 8 * QB + 8;
        const float bfar = bt[h * 128 + 127];
        bf16x8 qf[2][2];
#pragma unroll
        for (int m = 0; m < 2; ++m)
#pragma unroll
            for (int nq = 0; nq < 2; ++nq) qf[m][nq] = *(const bf16x8*)(AQ + (size_t)(b * SEQ + q0 + nq * 16 + fr) * 256 + h * 64 + m * 32 + 8 * fq);
        f32x4 oacc[2][2][4], lacc[2][2];
#pragma unroll
        for (int m = 0; m < 2; ++m)
#pragma unroll
            for (int nq = 0; nq < 2; ++nq) { lacc[m][nq] = (f32x4){0.f, 0.f, 0.f, 0.f};
#pragma unroll
                for (int nb = 0; nb < 4; ++nb) oacc[m][nq][nb] = (f32x4){0.f, 0.f, 0.f, 0.f}; }
        const int t2 = tid & 255; const bool isK = tid < 256;
        const bf16_t* gsrc = isK ? AK + (size_t)(b * SEQ + (t2 >> 3)) * 256 + h * 64 + (t2 & 7) * 8 : AVT + ((size_t)bh * 64 + (t2 >> 2)) * SEQ + (t2 & 3) * 8;
        const size_t gstep = isK ? (size_t)32 * 256 : (size_t)32;
        const int ldst = isK ? AT_K + (t2 >> 3) * 144 + (t2 & 7) * 16 : AT_V + (t2 >> 2) * 80 + (t2 & 3) * 16;
        __syncthreads();
        u32x4 pre = *(const u32x4*)gsrc; *(LAS u32x4*)(c.lds + ldst) = pre;
        __syncthreads();
#pragma unroll 1
        for (int st = 0; st < nsteps; ++st) {
            const int k0 = st * 32; const LAS unsigned char* B0 = c.lds + (st & 1) * AT_BUF;
            if (st + 1 < nsteps) pre = *(const u32x4*)(gsrc + (size_t)(st + 1) * gstep);
            if (k0 <= q0) {
            bf16x8 kf[2][2], vf[4];
#pragma unroll
            for (int m = 0; m < 2; ++m)
#pragma unroll
                for (int kb = 0; kb < 2; ++kb) kf[m][kb] = *(const LAS bf16x8*)(B0 + AT_K + (kb * 16 + fr) * 144 + m * 64 + fq * 16);
#pragma unroll
            for (int nb = 0; nb < 4; ++nb) vf[nb] = *(const LAS bf16x8*)(B0 + AT_V + (16 * nb + fr) * 80 + fq * 16);
            const bool nearby = (k0 + 144 > q0);
            f32x4 cin[2][2];
            if (nearby) {
#pragma unroll
                for (int nq = 0; nq < 2; ++nq)
#pragma unroll
                    for (int kb = 0; kb < 2; ++kb)
#pragma unroll
                        for (int r = 0; r < 4; ++r) { const int n = (q0 + nq * 16 + fr) - (k0 + kb * 16 + 4 * fq + r); cin[nq][kb][r] = n >= 0 ? bt[h * 128 + (n > 127 ? 127 : n)] : -1.0e30f; }
            } else {
#pragma unroll
                for (int nq = 0; nq < 2; ++nq)
#pragma unroll
                    for (int kb = 0; kb < 2; ++kb) cin[nq][kb] = (f32x4){bfar, bfar, bfar, bfar};
            }
#pragma unroll
            for (int m = 0; m < 2; ++m)
#pragma unroll
                for (int nq = 0; nq < 2; ++nq) {
                    f32x4 p[2];
#pragma unroll
                    for (int kb = 0; kb < 2; ++kb) {
                        f32x4 s = __builtin_amdgcn_mfma_f32_16x16x32_bf16(kf[m][kb], qf[m][nq], cin[nq][kb], 0, 0, 0);
#pragma unroll
                        for (int r = 0; r < 4; ++r) s[r] = __builtin_amdgcn_exp2f(s[r]);
                        p[kb] = s;
                    }
                    const bf16x8 pf = pack_frag(p[0], p[1]);
#pragma unroll
                    for (int nb = 0; nb < 4; ++nb) oacc[m][nq][nb] = __builtin_amdgcn_mfma_f32_16x16x32_bf16(vf[nb], pf, oacc[m][nq][nb], 0, 0, 0);
                    lacc[m][nq] = __builtin_amdgcn_mfma_f32_16x16x32_bf16(ones, pf, lacc[m][nq], 0, 0, 0);
                }
            }
            if (st + 1 < nsteps) *(LAS u32x4*)(c.lds + ((st + 1) & 1) * AT_BUF + ldst) = pre;
            __syncthreads();
        }
#pragma unroll
        for (int nq = 0; nq < 2; ++nq) {
            const float l0 = __shfl(lacc[0][nq][0], fr), l1 = __shfl(lacc[1][nq][0], fr);
            const float i0 = 1.0f / l0, i1 = lam / l1; float ss = 0.f; f32x4 o[4];
#pragma unroll
            for (int nb = 0; nb < 4; ++nb) { o[nb] = oacc[0][nq][nb] * i0 - oacc[1][nq][nb] * i1; ss += (o[nb][0] * o[nb][0] + o[nb][1] * o[nb][1]) + (o[nb][2] * o[nb][2] + o[nb][3] * o[nb][3]); }
            ss += lxf<16>(ss); ss += lxf<32>(ss);
            const float rn = rsqrtf(ss * (1.0f / 64.0f) + 1e-6f) * (1.0f - lambda_init);
            bf16_t* orow = MIXED + (size_t)(b * SEQ + q0 + nq * 16 + fr) * 1024 + 768 + h * 64;
#pragma unroll
            for (int nb = 0; nb < 4; ++nb) { const float4 sg = *(const float4*)(subln + 16 * nb + 4 * fq);
                u32x2 w; w.x = pk2(o[nb][0] * rn * sg.x, o[nb][1] * rn * sg.y); w.y = pk2(o[nb][2] * rn * sg.z, o[nb][3] * rn * sg.w);
                *(u32x2*)(orow + 16 * nb + 4 * fq) = w; }
        }
    }
    __syncthreads();
}
__device__ __forceinline__ void phase_gdn_out(Ctx& c, const Args& A, int l) {
    const int gw = c.bid * 8 + c.wave, NGW = c.G * 8, lane = c.lane;
    const bf16_t* PROJ = (const bf16_t*)(A.ws + WS_PROJ); const float* OG = (const float*)(A.ws + WS_OGDN); bf16_t* MIXED = (bf16_t*)(A.ws + WS_MIXED);
    const float4 g0 = *(const float4*)(A.in[7] + l * 128 + (lane & 15) * 8), g1 = *(const float4*)(A.in[7] + l * 128 + (lane & 15) * 8 + 4);
    for (int run = gw; run < T / 8; run += NGW) {
        const int t0 = run * 8; float4 oa[8], ob[8]; u32x4 zz[8];
#pragma unroll
        for (int i = 0; i < 8; ++i) { const float* op = OG + (size_t)(t0 + i) * 512 + lane * 8; oa[i] = *(const float4*)op; ob[i] = *(const float4*)(op + 4); zz[i] = *(const u32x4*)(PROJ + (size_t)(t0 + i) * NPROJ + C_GZ + lane * 8); }
#pragma unroll
        for (int i = 0; i < 8; ++i) {
            float ss = (oa[i].x * oa[i].x + oa[i].y * oa[i].y) + (oa[i].z * oa[i].z + oa[i].w * oa[i].w) + (ob[i].x * ob[i].x + ob[i].y * ob[i].y) + (ob[i].z * ob[i].z + ob[i].w * ob[i].w);
            ss += lxf<1>(ss); ss += lxf<2>(ss); ss += lxf<4>(ss); ss += lxf<8>(ss);
            const float r = rsqrtf(ss * (1.0f / 128.0f) + 1e-6f);
            u32x4 w; w.x = pk2(oa[i].x * r * g0.x * silu_f(bf_lo(zz[i].x)), oa[i].y * r * g0.y * silu_f(bf_hi(zz[i].x))); w.y = pk2(oa[i].z * r * g0.z * silu_f(bf_lo(zz[i].y)), oa[i].w * r * g0.w * silu_f(bf_hi(zz[i].y)));
            w.z = pk2(ob[i].x * r * g1.x * silu_f(bf_lo(zz[i].z)), ob[i].y * r * g1.y * silu_f(bf_hi(zz[i].z))); w.w = pk2(ob[i].z * r * g1.z * silu_f(bf_lo(zz[i].w)), ob[i].w * r * g1.w * silu_f(bf_hi(zz[i].w)));
            *(u32x4*)(MIXED + (size_t)(t0 + i) * 1024 + lane * 8) = w;
        }
    }
}

__device__ __forceinline__ unsigned ord_key(float f) { const unsigned u = __float_as_uint(f); return (u & 0x80000000u) ? ~u : (u | 0x80000000u); }
__device__ __forceinline__ float ord_val(unsigned o) { return __uint_as_float((o & 0x80000000u) ? (o & 0x7fffffffu) : ~o); }
__device__ __forceinline__ float gelu_erf(float v) {
    const float av = fabsf(v), t = __builtin_amdgcn_rcpf(av * 0.2316418882f + 1.0f);
    float q = t * 0.5307027145f + (-0.7265760135f); q = q * t + 0.7107068705f; q = q * t + (-0.142248368f); q = q * t + 0.127414796f; q = q * t;
    const float e = __builtin_amdgcn_exp2f((v * v) * (-0.72134752044f)); const float m = v * (q * e);
    return v < 0.f ? m : v - m;
}
typedef __bf16 v2bf_t __attribute__((ext_vector_type(2)));
__device__ __forceinline__ float dot2bf(unsigned a, unsigned b, float acc) { return __builtin_amdgcn_fdot2_f32_bf16(__builtin_bit_cast(v2bf_t, a), __builtin_bit_cast(v2bf_t, b), acc, false); }
__device__ __forceinline__ float dot8(const u32x4& x, const u32x4& u, float acc) { acc = dot2bf(x.x, u.x, acc); acc = dot2bf(x.y, u.y, acc); acc = dot2bf(x.z, u.z, acc); return dot2bf(x.w, u.w, acc); }
__device__ __forceinline__ void axpy8(float* o, float cf, const u32x4& v) {
    o[0] += cf * bf_lo(v.x); o[1] += cf * bf_hi(v.x); o[2] += cf * bf_lo(v.y); o[3] += cf * bf_hi(v.y); o[4] += cf * bf_lo(v.z); o[5] += cf * bf_hi(v.z); o[6] += cf * bf_lo(v.w); o[7] += cf * bf_hi(v.w); }
typedef float f32x2_t __attribute__((ext_vector_type(2)));
__device__ __forceinline__ void axpy16_fp8(float* o, float cf, const u32x4& v) {
    const unsigned w[4] = {v.x, v.y, v.z, v.w};
#pragma unroll
    for (int i = 0; i < 4; ++i) { const f32x2_t a = __builtin_amdgcn_cvt_pk_f32_fp8((int)w[i], false), b = __builtin_amdgcn_cvt_pk_f32_fp8((int)w[i], true);
        o[4 * i] += cf * a.x; o[4 * i + 1] += cf * a.y; o[4 * i + 2] += cf * b.x; o[4 * i + 3] += cf * b.y; }
}
typedef _Float16 v2h_t __attribute__((ext_vector_type(2)));
__device__ __forceinline__ unsigned pkh(float a, float b) { const v2h_t h = {(_Float16)a, (_Float16)b}; return __builtin_bit_cast(unsigned, h); }
typedef _Float16 v2h_t __attribute__((ext_vector_type(2)));
__device__ __forceinline__ float dot4_fp8(unsigned uw, unsigned xlo, unsigned xhi, float acc) {
    acc = __builtin_amdgcn_fdot2(__builtin_amdgcn_cvt_scalef32_pk_f16_fp8(uw, 1.0f, false), __builtin_bit_cast(v2h_t, xlo), acc, false);
    return __builtin_amdgcn_fdot2(__builtin_amdgcn_cvt_scalef32_pk_f16_fp8(uw, 1.0f, true), __builtin_bit_cast(v2h_t, xhi), acc, false);
}
__device__ __forceinline__ float dot16_fp8(const u32x4& x0, const u32x4& x1, const u32x4& u) {
    float acc = dot4_fp8(u.x, x0.x, x0.y, 0.f); acc = dot4_fp8(u.y, x0.z, x0.w, acc); acc = dot4_fp8(u.z, x1.x, x1.y, acc); return dot4_fp8(u.w, x1.z, x1.w, acc);
}
__device__ __forceinline__ void cvt16_fp8(float* f, const u32x4& v) {
    const unsigned w[4] = {v.x, v.y, v.z, v.w};
#pragma unroll
    for (int i = 0; i < 4; ++i) { const f32x2_t a = __builtin_amdgcn_cvt_pk_f32_fp8((int)w[i], false), b = __builtin_amdgcn_cvt_pk_f32_fp8((int)w[i], true); f[4 * i] = a.x; f[4 * i + 1] = a.y; f[4 * i + 2] = b.x; f[4 * i + 3] = b.y; }
}
__device__ __forceinline__ void phase_peer(Ctx& c, const Args& A, int l, float* hdst, bool fuse_next, const XcdBarrier& bar, bool align) {
    const int tid = c.tid, lane = c.lane, wave = c.wave, fr = lane & 15, fq = lane >> 4;
    const bf16_t* QP = (const bf16_t*)(A.ws + WS_QP); const bf16_t* KEYS = (const bf16_t*)(A.ws + WS_KEYS) + (size_t)l * 16 * 128 * 128;
    const bf16_t* XF = (const bf16_t*)(A.ws + WS_NBUF); const float* RSl = (const float*)(A.ws + WS_RS); const unsigned char* U8 = A.ws + WS_UT + (size_t)l * NEXP * EREC; const unsigned char* V8 = U8 + 1024; const float* VS = (const float*)(A.ws + WS_VSC) + (size_t)l * NEXP; const float* US = (const float*)(A.ws + WS_USC) + (size_t)l * NEXP;
    LAS int* lidx = (LAS int*)c.lds;
    LAS float* lgate = (LAS float*)(c.lds + 32768);
    LAS unsigned* tkb = (LAS unsigned*)(c.lds + 65536);
    for (int blk = c.bid; blk < T / 64; blk += c.G) {
        const int tb0 = blk * 64;
        __syncthreads();
#pragma unroll 1
        for (int rrep_ = 0; rrep_ < 1 + ((DUP >> 11) & 1); ++rrep_) {
#define PEER_RLOAD(Q, Kf, st) do { const int hh_ = (st) >> 2, ks_ = (st) & 3, hp_ = (hh_ >> 1) * 8 + wave, sp_ = (hh_ & 1) * 2; \
        const bf16_t* qp_ = QP; const bf16_t* kp_ = KEYS; asm volatile("" : "+s"(qp_), "+s"(kp_) : "v"(acc[1][7]));     \
        _Pragma("unroll") for (int sb = 0; sb < 2; ++sb) Q[sb] = *(const bf16x8*)(qp_ + (size_t)(tb0 + (sp_ + sb) * 16 + fr) * 2048 + hp_ * 128 + ks_ * 32 + 8 * fq); \
        _Pragma("unroll") for (int nb = 0; nb < 8; ++nb) Kf[nb] = *(const bf16x8*)(kp_ + ((size_t)hp_ * 128 + nb * 16 + fr) * 128 + ks_ * 32 + 8 * fq); } while (0)
#define PEER_RMMA(Q, Kf) do { _Pragma("unroll") for (int nb = 0; nb < 8; ++nb) _Pragma("unroll") for (int sb = 0; sb < 2; ++sb) acc[sb][nb] = __builtin_amdgcn_mfma_f32_16x16x32_bf16(Kf[nb], Q[sb], acc[sb][nb], 0, 0, 0); } while (0)
            bf16x8 qA[2], kA[8], qB[2], kB[8]; f32x4 acc[2][8]; acc[1][7] = (f32x4){0.f, 0.f, 0.f, 0.f};
            PEER_RLOAD(qA, kA, 0);
#pragma unroll 1
            for (int hh = 0; hh < 4; ++hh) {
                const int hp = (hh >> 1) * 8 + wave, sp = (hh & 1) * 2;
#pragma unroll
                for (int sb = 0; sb < 2; ++sb)
#pragma unroll
                    for (int nb = 0; nb < 8; ++nb) acc[sb][nb] = (f32x4){0.f, 0.f, 0.f, 0.f};
                PEER_RLOAD(qB, kB, 4 * hh + 1); PEER_RMMA(qA, kA);
                PEER_RLOAD(qA, kA, 4 * hh + 2); PEER_RMMA(qB, kB);
                PEER_RLOAD(qB, kB, 4 * hh + 3); PEER_RMMA(qA, kA);
                { const int hn_ = hh < 3 ? hh + 1 : hh; PEER_RLOAD(qA, kA, 4 * hn_); }
                PEER_RMMA(qB, kB);
#define PEER_MERGE(N) do { unsigned p[16]; \
        _Pragma("unroll") for (int i = 0; i < 16; ++i) p[i] = lxu<N>(v[i]); \
        _Pragma("unroll") for (int i = 0; i < 16; ++i) v[i] = v[i] > p[15 - i] ? v[i] : p[15 - i]; \
        _Pragma("unroll") for (int j = 8; j > 0; j >>= 1) _Pragma("unroll") for (int i = 0; i < 16; ++i) { const int q = i ^ j; if (q > i) { const unsigned x = v[i], y = v[q]; v[i] = x > y ? x : y; v[q] = x > y ? y : x; } } } while (0)
#pragma unroll 1
                for (int sb = 0; sb < 2; ++sb) {
                    LAS unsigned* tk = tkb + (sp + sb) * 4096;
                    unsigned v[32];
#pragma unroll
                    for (int nb = 0; nb < 8; ++nb) { const f32x4 a_ = sb == 0 ? acc[0][nb] : acc[1][nb];
#pragma unroll
                        for (int r = 0; r < 4; ++r) v[nb * 4 + r] = (ord_key(a_[r]) & ~127u) | (unsigned)(127 - (nb * 16 + 4 * fq + r)); }
#pragma unroll
                    for (int k = 2; k <= 32; k <<= 1)
#pragma unroll
                        for (int j = k >> 1; j > 0; j >>= 1)
#pragma unroll
                            for (int i = 0; i < 32; ++i) { const int q = i ^ j; if (q > i) { const bool desc = ((i & k) == 0); const unsigned x = v[i], y = v[q]; const unsigned hi = x > y ? x : y, lo = x > y ? y : x; v[i] = desc ? hi : lo; v[q] = desc ? lo : hi; } }
                    PEER_MERGE(16); PEER_MERGE(32);
                    { u32x4 w; w.x = fq == 0 ? v[0] : (fq == 1 ? v[4] : (fq == 2 ? v[8] : v[12])); w.y = fq == 0 ? v[1] : (fq == 1 ? v[5] : (fq == 2 ? v[9] : v[13]));
                      w.z = fq == 0 ? v[2] : (fq == 1 ? v[6] : (fq == 2 ? v[10] : v[14])); w.w = fq == 0 ? v[3] : (fq == 1 ? v[7] : (fq == 2 ? v[11] : v[15]));
                      *(LAS u32x4*)(tk + (fr * 16 + hp) * 16 + 4 * fq) = w; }
                }
#undef PEER_MERGE
            }
#undef PEER_RLOAD
#undef PEER_RMMA
            __syncthreads();
#pragma unroll 1
            for (int sub = 0; sub < 4; ++sub)
            {
                const LAS unsigned* tk = tkb + sub * 4096;
                const int pp = tid >> 2, qd = tid & 3, tok = pp >> 3, h = pp & 7;
                const LAS unsigned* a = tk + (tok * 16 + 2 * h) * 16; const LAS unsigned* b = a + 16;
                unsigned v[16], s5[5];
                {
                    const float sj0 = ord_val(b[qd] & ~127u), sj1 = ord_val(b[qd + 4] & ~127u), sj2 = ord_val(b[qd + 8] & ~127u), sj3 = ord_val(b[qd + 12] & ~127u);
#pragma unroll
                    for (int i = 0; i < 16; ++i) { const float si = ord_val(a[i] & ~127u);
                        v[i] = ((i + 1) * (qd + 1) <= 16) ? ((ord_key(si + sj0) & ~255u) | (unsigned)(255 - (i * 16 + qd))) : 0u;
                        if (i < 3) s5[i] = ((i + 1) * (qd + 5) <= 16) ? ((ord_key(si + sj1) & ~255u) | (unsigned)(255 - (i * 16 + qd + 4))) : 0u;
                        if (i == 0) { s5[3] = ((qd + 9) <= 16) ? ((ord_key(si + sj2) & ~255u) | (unsigned)(255 - (qd + 8))) : 0u; s5[4] = ((qd + 13) <= 16) ? ((ord_key(si + sj3) & ~255u) | (unsigned)(255 - (qd + 12))) : 0u; } }
                }
#define PEER_CE(x, y) do { const unsigned hi_ = x > y ? x : y, lo_ = x > y ? y : x; x = hi_; y = lo_; } while (0)
                PEER_CE(s5[0], s5[1]); PEER_CE(s5[3], s5[4]); PEER_CE(s5[2], s5[4]); PEER_CE(s5[2], s5[3]); PEER_CE(s5[0], s5[3]); PEER_CE(s5[0], s5[2]); PEER_CE(s5[1], s5[4]); PEER_CE(s5[1], s5[3]); PEER_CE(s5[1], s5[2]);
#pragma unroll
                for (int t = 0; t < 5; ++t) v[15 - t] = v[15 - t] > s5[t] ? v[15 - t] : s5[t];
#pragma unroll
                for (int j = 8; j > 0; j >>= 1)
#pragma unroll
                    for (int i = 0; i < 16; ++i) { const int q = i ^ j; if (q > i) PEER_CE(v[i], v[q]); }
#define PEER_MERGE(N) do { unsigned p[16]; \
        _Pragma("unroll") for (int i = 0; i < 16; ++i) p[i] = lxu<N>(v[i]); \
        _Pragma("unroll") for (int i = 0; i < 16; ++i) v[i] = v[i] > p[15 - i] ? v[i] : p[15 - i]; \
        _Pragma("unroll") for (int j = 8; j > 0; j >>= 1) _Pragma("unroll") for (int i = 0; i < 16; ++i) { const int q = i ^ j; if (q > i) PEER_CE(v[i], v[q]); } } while (0)
                PEER_MERGE(1); PEER_MERGE(2);
#undef PEER_MERGE
#undef PEER_CE
                const float mx = ord_val(v[0] & ~255u); const int tl = sub * 16 + tok;
                unsigned m4[4]; float e4[4]; int x4[4];
#pragma unroll
                for (int t = 0; t < 4; ++t) { m4[t] = qd == 0 ? v[t] : (qd == 1 ? v[4 + t] : (qd == 2 ? v[8 + t] : v[12 + t]));
                    const int pos = 255 - (int)(m4[t] & 255u), pi = pos >> 4, pj = pos & 15;
                    e4[t] = __expf(ord_val(m4[t] & ~255u) - mx);
                    x4[t] = (127 - (int)(a[pi] & 127u)) * 128 + (127 - (int)(b[pj] & 127u)); }
                float sum = (e4[0] + e4[1]) + (e4[2] + e4[3]); sum += lxf<1>(sum); sum += lxf<2>(sum);
                const float inv = 1.0f / sum;
                { u32x4 xi; xi.x = (unsigned)x4[0]; xi.y = (unsigned)x4[1]; xi.z = (unsigned)x4[2]; xi.w = (unsigned)x4[3]; *(LAS u32x4*)(lidx + tl * 128 + h * 16 + 4 * qd) = xi;
                  f32x4 gi; gi.x = e4[0] * inv; gi.y = e4[1] * inv; gi.z = e4[2] * inv; gi.w = e4[3] * inv; *(LAS f32x4*)(lgate + tl * 128 + h * 16 + 4 * qd) = gi; }
            }
        }
        __syncthreads();
        LAS unsigned char* lbase = c.lds + 65536 + wave * 10240;
        const int es = ((lane & 1) << 2) | (lane & 2) | ((lane >> 2) & 1);
#pragma unroll 1
        for (int pass = 0; pass < 2; ++pass) {
            const int tl0 = pass * 32 + wave * 4; LAS unsigned* sl = (LAS unsigned*)lbase + pass * 512; LAS float* sg = (LAS float*)(lbase + 4096) + pass * 512; LAS unsigned short* sv = (LAS unsigned short*)(lbase + 8192) + pass * 512;
            int il[4], ih[4]; float gl[4], gh[4];
#pragma unroll
            for (int k = 0; k < 4; ++k) { const int a0 = lidx[(tl0 + k) * 128 + lane], a1 = lidx[(tl0 + k) * 128 + 64 + lane];
                gl[k] = lgate[(tl0 + k) * 128 + lane] * VS[a0]; gh[k] = lgate[(tl0 + k) * 128 + 64 + lane] * VS[a1];
                il[k] = a0 | (k << 14) | (int)(((__float_as_uint(US[a0]) >> 23) & 255u) << 16); ih[k] = a1 | (k << 14) | (int)(((__float_as_uint(US[a1]) >> 23) & 255u) << 16); }
            LAS int* ct = (LAS int*)(c.lds + 147456) + wave * 256;
            int rk[8], cn[8], pu[8];
#pragma unroll
            for (int g = 0; g < 8; ++g) { const int w = (g & 1) ? ih[g >> 1] : il[g >> 1]; const int r = (w >> 9) & 31; unsigned long long eq = ~0ull;
#pragma unroll
                for (int bt_ = 0; bt_ < 5; ++bt_) { const bool bit = (r >> bt_) & 1; const unsigned long long m = __ballot(bit); eq &= bit ? m : ~m; }
                rk[g] = (int)__builtin_amdgcn_mbcnt_hi((unsigned)(eq >> 32), __builtin_amdgcn_mbcnt_lo((unsigned)eq, 0u)); cn[g] = __builtin_popcountll(eq); }
#pragma unroll
            for (int ord = 0; ord < 2; ++ord) {
#pragma unroll
                for (int i = 0; i < 4; ++i) ct[lane + 64 * i] = 0;
#pragma unroll
                for (int g = 0; g < 8; ++g) { const int w = (g & 1) ? ih[g >> 1] : il[g >> 1]; const int r = (w >> 9) & 31; ct[ord ? (g >> 1) * 64 + r * 2 + (g & 1) : r * 8 + g] = cn[g]; }
                { const int c0 = ct[4 * lane], c1 = ct[4 * lane + 1], c2 = ct[4 * lane + 2], c3 = ct[4 * lane + 3]; int sum = (c0 + c1) + (c2 + c3);
#pragma unroll
                  for (int o = 1; o < 64; o <<= 1) { const int n = __shfl_up(sum, o); if (lane >= o) sum += n; }
                  const int ex = sum - ((c0 + c1) + (c2 + c3));
                  ct[4 * lane] = ex; ct[4 * lane + 1] = ex + c0; ct[4 * lane + 2] = ex + c0 + c1; ct[4 * lane + 3] = ex + c0 + c1 + c2; }
#pragma unroll
                for (int g = 0; g < 8; ++g) { const int w = (g & 1) ? ih[g >> 1] : il[g >> 1]; const int r = (w >> 9) & 31;
                    if (ord == 0) pu[g] = ct[r * 8 + g] + rk[g];
                    else { const int k = g >> 1, p = ct[k * 64 + r * 2 + (g & 1)] + rk[g] - 128 * k;
                        const int vp = 8 * (p >> 1) + 2 * k + (p & 1);
                        sl[pu[g]] = (unsigned)w | ((unsigned)p << 24); sg[vp] = (g & 1) ? gh[k] : gl[k]; sv[vp] = (unsigned short)(w & 16383); } }
            }
        }
        __syncthreads();
        LAS unsigned char* xw = c.lds + wave * 8192;
#pragma unroll 1
        for (int pass = 0; pass < 2; ++pass) {
            if (align && pass == 1) xcd_barrier(bar);
            const int tl0 = pass * 32 + wave * 4; const LAS unsigned* sl = (const LAS unsigned*)lbase + pass * 512; LAS float* sg = (LAS float*)(lbase + 4096) + pass * 512; const LAS unsigned short* sv = (const LAS unsigned short*)(lbase + 8192) + pass * 512;
            v2h_t out[4][8]; float xinv1;
            {
                float f[4][16]; float am = 0.f;
#pragma unroll
                for (int k = 0; k < 4; ++k) { const size_t t = (size_t)(tb0 + tl0 + k);
                    float rs; { const float4 a = *(const float4*)(RSl + t * 16), b = *(const float4*)(RSl + t * 16 + 4), c2 = *(const float4*)(RSl + t * 16 + 8), d = *(const float4*)(RSl + t * 16 + 12);
                        rs = rsqrtf(((((a.x + a.y) + (a.z + a.w)) + ((b.x + b.y) + (b.z + b.w))) + (((c2.x + c2.y) + (c2.z + c2.w)) + ((d.x + d.y) + (d.z + d.w)))) * (1.0f / 1024.0f) + 1e-6f); }
                    const u32x4 w0 = *(const u32x4*)(XF + t * 1024 + 16 * lane), w1 = *(const u32x4*)(XF + t * 1024 + 16 * lane + 8);
                    f[k][0] = bf_lo(w0.x); f[k][1] = bf_hi(w0.x); f[k][2] = bf_lo(w0.y); f[k][3] = bf_hi(w0.y); f[k][4] = bf_lo(w0.z); f[k][5] = bf_hi(w0.z); f[k][6] = bf_lo(w0.w); f[k][7] = bf_hi(w0.w);
                    f[k][8] = bf_lo(w1.x); f[k][9] = bf_hi(w1.x); f[k][10] = bf_lo(w1.y); f[k][11] = bf_hi(w1.y); f[k][12] = bf_lo(w1.z); f[k][13] = bf_hi(w1.z); f[k][14] = bf_lo(w1.w); f[k][15] = bf_hi(w1.w);
#pragma unroll
                    for (int i = 0; i < 16; ++i) { f[k][i] *= rs; am = fmaxf(am, fabsf(f[k][i])); } }
                am = fmaxf(am, lxf<1>(am)); am = fmaxf(am, lxf<2>(am)); am = fmaxf(am, lxf<4>(am)); am = fmaxf(am, lxf<8>(am)); am = fmaxf(am, lxf<16>(am)); am = fmaxf(am, lxf<32>(am));
                const float sx = am > 0.f ? __uint_as_float(__float_as_uint(127.0f / am) & 0x7f800000u) : 1.0f;
                xinv1 = __int_as_float(__builtin_amdgcn_readfirstlane(__float_as_int(1.0f / sx)));
#pragma unroll
                for (int k = 0; k < 4; ++k) { u32x4 xq; unsigned qq[4];
#pragma unroll
                    for (int i = 0; i < 4; ++i) qq[i] = ((unsigned)(int)rintf(f[k][4 * i] * sx) & 255u) | (((unsigned)(int)rintf(f[k][4 * i + 1] * sx) & 255u) << 8) | (((unsigned)(int)rintf(f[k][4 * i + 2] * sx) & 255u) << 16) | (((unsigned)(int)rintf(f[k][4 * i + 3] * sx) & 255u) << 24);
                    xq.x = qq[0]; xq.y = qq[1]; xq.z = qq[2]; xq.w = qq[3];
                    *(LAS u32x4*)(xw + k * 1024 + lane * 16) = xq; }
            }
            constexpr int NW = 8, NBW = 64;
            {
                u32x4 uA[NW], uB[NW], uC[NW], uD[NW]; unsigned mA[NW], mB[NW], mC[NW], mD[NW];
#define PEER_UISSUE(uu, mm, b) do { _Pragma("unroll") for (int s = 0; s < NW; ++s) { mm[s] = __builtin_amdgcn_readfirstlane(sl[NW * (b) + s]); uu[s] = ((const u32x4*)(U8 + (size_t)(mm[s] & 16383u) * EREC))[lane]; } } while (0)
#define PEER_UCOMPUTE(uu, mm, b) do { int d_[8]; \
        _Pragma("unroll") for (int s = 0; s < NW; ++s) { const unsigned kx_ = (mm[s] >> 14) & 3u; const u32x4 xq_ = *(const LAS u32x4*)(xw + kx_ * 1024 + lane * 16); \
            int ia_ = __builtin_amdgcn_sdot4((int)uu[s].x, (int)xq_.x, 0, false); ia_ = __builtin_amdgcn_sdot4((int)uu[s].y, (int)xq_.y, ia_, false); ia_ = __builtin_amdgcn_sdot4((int)uu[s].z, (int)xq_.z, ia_, false); ia_ = __builtin_amdgcn_sdot4((int)uu[s].w, (int)xq_.w, ia_, false); \
            d_[s] = ia_; } \
        const bool o1_ = lane & 1, o2_ = lane & 2, o4_ = lane & 4; \
        int a0_ = o1_ ? d_[4] : d_[0], a1_ = o1_ ? d_[5] : d_[1], a2_ = o1_ ? d_[6] : d_[2], a3_ = o1_ ? d_[7] : d_[3]; \
        a0_ += lxi<1>(o1_ ? d_[0] : d_[4]); a1_ += lxi<1>(o1_ ? d_[1] : d_[5]); a2_ += lxi<1>(o1_ ? d_[2] : d_[6]); a3_ += lxi<1>(o1_ ? d_[3] : d_[7]); \
        int b0_ = o2_ ? a2_ : a0_, b1_ = o2_ ? a3_ : a1_; b0_ += lxi<2>(o2_ ? a0_ : a2_); b1_ += lxi<2>(o2_ ? a1_ : a3_); \
        int ci_ = o4_ ? b1_ : b0_; ci_ += lxi<4>(o4_ ? b0_ : b1_); \
        ci_ += lxi<8>(ci_); ci_ += lxi<16>(ci_); ci_ += lxi<32>(ci_); \
        const unsigned wes_ = sl[NW * (b) + es];     \
        const int pv_ = (int)(wes_ >> 24), vp_ = 8 * (pv_ >> 1) + 2 * (int)((wes_ >> 14) & 3u) + (pv_ & 1); \
        const float cc_ = (float)ci_ * (__uint_as_float(((wes_ >> 16) & 255u) << 23) * xinv1); \
        const float cfv_ = sg[vp_] * gelu_erf(cc_); \
        if (lane < 8) sg[vp_] = __uint_as_float(pkh(cfv_, cfv_)); } while (0)
                PEER_UISSUE(uA, mA, 0); PEER_UISSUE(uB, mB, 1); PEER_UISSUE(uC, mC, 2);
#pragma unroll 1
                for (int bb = 0; bb < NBW; bb += 4) {
                    PEER_UISSUE(uD, mD, bb + 3);
                    PEER_UCOMPUTE(uA, mA, bb);
                    const int bn_ = bb + 4 < NBW ? bb + 4 : bb;
                    PEER_UISSUE(uA, mA, bn_);
                    PEER_UCOMPUTE(uB, mB, bb + 1);
                    PEER_UISSUE(uB, mB, bn_ + 1);
                    PEER_UCOMPUTE(uC, mC, bb + 2);
                    PEER_UISSUE(uC, mC, bn_ + 2);
                    PEER_UCOMPUTE(uD, mD, bb + 3);
                }
#undef PEER_UISSUE
#undef PEER_UCOMPUTE
            }
            asm volatile("s_waitcnt lgkmcnt(0)" ::: "memory");
            if (align && ALIGN_V) xcd_barrier(bar);
#pragma unroll
            for (int k = 0; k < 4; ++k)
#pragma unroll
                for (int i = 0; i < 8; ++i) out[k][i] = (v2h_t){(_Float16)0.f, (_Float16)0.f};
            {
                U3 vA[NW], vB[NW]; float cA[NW], cB[NW];
#define PEER_VISSUE(vv, cc, b) do { _Pragma("unroll") for (int s = 0; s < NW; ++s) { const unsigned e_ = (unsigned)__builtin_amdgcn_readfirstlane((int)sv[NW * (b) + s]); cc[s] = __int_as_float(__builtin_amdgcn_readfirstlane(__float_as_int(sg[NW * (b) + s]))); \
            vv[s] = ((const U3*)(V8 + (size_t)e_ * EREC))[lane]; } } while (0)
#define PEER_VCOMPUTE(vv, cc) do { \
        _Pragma("unroll") for (int k = 0; k < 4; ++k) { \
            const u32x6 w6_ = {vv[2 * k].x, vv[2 * k].y, vv[2 * k].z, vv[2 * k + 1].x, vv[2 * k + 1].y, vv[2 * k + 1].z}; const f16x32 vf_ = __builtin_amdgcn_cvt_scalef32_pk32_f16_fp6(w6_, 1.0f); \
            const v2h_t c0_ = __builtin_bit_cast(v2h_t, __float_as_uint(cc[2 * k])), c1_ = __builtin_bit_cast(v2h_t, __float_as_uint(cc[2 * k + 1])); \
            _Pragma("unroll") for (int j = 0; j < 8; ++j) { const v2h_t a_ = {vf_[2 * j], vf_[2 * j + 1]}; out[k][j] = __builtin_elementwise_fma(a_, c0_, out[k][j]); } \
            _Pragma("unroll") for (int j = 0; j < 8; ++j) { const v2h_t b_ = {vf_[16 + 2 * j], vf_[16 + 2 * j + 1]}; out[k][j] = __builtin_elementwise_fma(b_, c1_, out[k][j]); } } } while (0)
                PEER_VISSUE(vA, cA, 0);
#pragma unroll 1
                for (int bb = 0; bb < NBW; bb += 2) {
                    PEER_VISSUE(vB, cB, bb + 1);
                    PEER_VCOMPUTE(vA, cA);
                    PEER_VISSUE(vA, cA, (bb + 2 < NBW ? bb + 2 : bb));
                    PEER_VCOMPUTE(vB, cB);
                }
#undef PEER_VISSUE
#undef PEER_VCOMPUTE
            }
#pragma unroll
            for (int k = 0; k < 4; ++k) { const size_t t = (size_t)(tb0 + tl0 + k); const float* hp = A.out + t * 1024 + 16 * lane; float* hq = hdst + t * 1024 + 16 * lane;
#pragma unroll
                for (int i = 0; i < 4; ++i) { float4 h4 = *(const float4*)(hp + 4 * i); h4.x += (float)out[k][2 * i].x; h4.y += (float)out[k][2 * i].y; h4.z += (float)out[k][2 * i + 1].x; h4.w += (float)out[k][2 * i + 1].y; *(float4*)(hq + 4 * i) = h4; }
            }
#pragma unroll 1
            for (int k2 = 0; k2 < (fuse_next ? 2 : 0); ++k2) {
                int lo16 = 16 * lane; asm volatile("" : "+v"(lo16));
                const float* nx_gain = A.in[2] + (l + 1) * 1024 + lo16; const float* nx_wgate = (const float*)(A.ws + WS_WGATE) + (l + 1) * 8 * 1024 + lo16; const float* nx_alog = A.in[5] + (l + 1) * 4; const float* nx_dtb = A.in[6] + (l + 1) * 4;
                float hv[2][16], ss[2], d[2][8];
#pragma unroll
                for (int k = 0; k < 2; ++k) { const float* hq = hdst + (size_t)(tb0 + tl0 + 2 * k2 + k) * 1024 + lo16;
#pragma unroll
                    for (int i = 0; i < 4; ++i) { const float4 h4 = *(const float4*)(hq + 4 * i); hv[k][4 * i] = h4.x; hv[k][4 * i + 1] = h4.y; hv[k][4 * i + 2] = h4.z; hv[k][4 * i + 3] = h4.w; }
                    float s2 = 0.f;
#pragma unroll
                    for (int i = 0; i < 16; ++i) s2 += hv[k][i] * hv[k][i];
                    ss[k] = s2; }
#pragma unroll
                for (int i = 0; i < 4; ++i) { const float4 g4 = *(const float4*)(nx_gain + 4 * i);
#pragma unroll
                    for (int k = 0; k < 2; ++k) { hv[k][4 * i] *= g4.x; hv[k][4 * i + 1] *= g4.y; hv[k][4 * i + 2] *= g4.z; hv[k][4 * i + 3] *= g4.w; } }
#pragma unroll
                for (int qh = 0; qh < 2; ++qh) {
                    const float* wg_ = nx_wgate; if (qh) asm volatile("" : "+v"(wg_) : "v"(d[1][3]));
#pragma unroll
                    for (int q = 4 * qh; q < 4 * qh + 4; ++q) { float4 w[4];
#pragma unroll
                        for (int i = 0; i < 4; ++i) w[i] = *(const float4*)(wg_ + q * 1024 + 4 * i);
#pragma unroll
                        for (int k = 0; k < 2; ++k) { float a = 0.f;
#pragma unroll
                            for (int i = 0; i < 4; ++i) a += (hv[k][4 * i] * w[i].x + hv[k][4 * i + 1] * w[i].y) + (hv[k][4 * i + 2] * w[i].z + hv[k][4 * i + 3] * w[i].w);
                            d[k][q] = a; } } }
                const bool o1 = lane & 1, o2 = lane & 2, o4 = lane & 4;
#pragma unroll
                for (int k = 0; k < 2; ++k) { const size_t t = (size_t)(tb0 + tl0 + 2 * k2 + k);
                    float a0 = o1 ? d[k][4] : d[k][0], a1 = o1 ? d[k][5] : d[k][1], a2 = o1 ? d[k][6] : d[k][2], a3 = o1 ? d[k][7] : d[k][3];
                    a0 += lxf<1>(o1 ? d[k][0] : d[k][4]); a1 += lxf<1>(o1 ? d[k][1] : d[k][5]); a2 += lxf<1>(o1 ? d[k][2] : d[k][6]); a3 += lxf<1>(o1 ? d[k][3] : d[k][7]);
                    float b0 = o2 ? a2 : a0, b1 = o2 ? a3 : a1; b0 += lxf<2>(o2 ? a0 : a2); b1 += lxf<2>(o2 ? a1 : a3);
                    float cc = o4 ? b1 : b0; cc += lxf<4>(o4 ? b0 : b1);
                    cc += lxf<8>(cc); cc += lxf<16>(cc); cc += lxf<32>(cc);
                    const float rstd = rsqrtf(wave_sum(ss[k]) * (1.0f / D) + 1e-6f);
                    u32x4 w0, w1; w0.x = pk2(hv[k][0] * rstd, hv[k][1] * rstd); w0.y = pk2(hv[k][2] * rstd, hv[k][3] * rstd); w0.z = pk2(hv[k][4] * rstd, hv[k][5] * rstd); w0.w = pk2(hv[k][6] * rstd, hv[k][7] * rstd);
                    w1.x = pk2(hv[k][8] * rstd, hv[k][9] * rstd); w1.y = pk2(hv[k][10] * rstd, hv[k][11] * rstd); w1.z = pk2(hv[k][12] * rstd, hv[k][13] * rstd); w1.w = pk2(hv[k][14] * rstd, hv[k][15] * rstd);
                    bf16_t* xo = (bf16_t*)(A.ws + WS_NBUF) + t * 1024 + lo16; *(u32x4*)xo = w0; *(u32x4*)(xo + 8) = w1;
                    if (lane < 8) { const float r = cc * rstd; float o;
                        if (es < 4) o = 1.0f / (1.0f + __expf(-r));
                        else { const float z = r + nx_dtb[es - 4]; const float sp = z > 20.f ? z : log1pf(__expf(z)); o = -__expf(nx_alog[es - 4]) * sp; }
                        ((float*)(A.ws + WS_GB))[t * 8 + es] = o; }
                }
            }
        }
    }
    __syncthreads();
}

__device__ __forceinline__ bool relaunder(Ctx& c) { int t = threadIdx.x; asm volatile("" : "+v"(t)); c.tid = t; c.lane = t & 63; c.wave = __builtin_amdgcn_readfirstlane(t >> 6); return true; }
__global__ void __launch_bounds__(512, 2) fwd(Args a) {
    extern __shared__ __attribute__((aligned(16))) unsigned char lds_raw[];
    Ctx c; c.lds = (LAS unsigned char*)lds_raw; c.tid = threadIdx.x; c.lane = c.tid & 63; c.wave = __builtin_amdgcn_readfirstlane(c.tid >> 6); c.G = gridDim.x; c.bid = blockIdx.x;
    const Args& A = a;
    volatile LAS unsigned* MISC = (volatile LAS unsigned*)(c.lds + MISC_OFF);
    if (c.tid < 64) MISC[c.tid] = 0u;
    __syncthreads();
    const int lo = a.ph_lo, hi = a.ph_hi;
    XcdBarrier bar; bar.bar = (unsigned*)(A.ws + WS_CTL) + CW_BAR; bar.x = 0; bar.st = MISC + 8;
    if (hi - lo > 1) bar = xcd_barrier_post((unsigned*)(A.ws + WS_CTL) + CW_BAR, MISC + 8);
#define IN(k) (lo <= (k) && (k) < hi && relaunder(c))
#define INR(k) (lo <= (k) && (k) < hi)
#define SEAM(k) do { if (INR(k) && INR((k) + 1)) { xcd_barrier(bar); if ((DUP >> 14) & 1) xcd_barrier(bar); } } while (0)
    bf16_t* NBUF = (bf16_t*)(A.ws + WS_NBUF); bf16_t* PROJ = (bf16_t*)(A.ws + WS_PROJ); bf16_t* MIXED = (bf16_t*)(A.ws + WS_MIXED); bf16_t* QP = (bf16_t*)(A.ws + WS_QP);
    float* GB = (float*)(A.ws + WS_GB);
    if (IN(0)) REP(10) p0_prologue(c, a);
    SEAM(0);
    auto layer = [&](const int l) __attribute__((always_inline)) {
        const int pb = 1 + 10 * l;
        if (l == 0 && IN(pb + 0) && !(KO & (1 << 0))) REP(0) phase_norm(c, a, l == 0 ? A.in[0] : A.out, A.in[2] + l * 1024, NBUF, (const float*)(A.ws + WS_WGATE) + l * 8 * 1024, A.in[5] + l * 4, A.in[6] + l * 4, GB);
        if (l == 0) SEAM(pb + 0);
        if (IN(pb + 1) && !(KO & (1 << 1))) REP(1) { pg8::Gemm g{NBUF, (const bf16_t*)(A.ws + WS_WIN) + (size_t)l * NPROJ * 1024, T, NPROJ, 1024}; pg8::StaticOrder S; S.init(T, NPROJ, c.G, c.bid); pg8::EpiBf16 E{PROJ, NPROJ, nullptr};
            pg8::gemm_phase<pg8::EpiBf16, pg8::StaticOrder>(c.lds, g, S, E, nullptr); }
        SEAM(pb + 1);
        if (IN(pb + 2) && !(KO & (1 << 2))) REP(2) phase_prep(c, a, l);
        SEAM(pb + 2);
        if (IN(pb + 3)) REP(3) { for (int u = c.bid; u < 1024; u += 2 * c.G) { if (u + c.G < 1024) gdn_chunk_pair(c, a, u, u + c.G); else gdn_chunk_unit(c, a, u); } }
        SEAM(pb + 3);
        if (IN(pb + 4) && !(KO & (1 << 3))) REP(4) { if (c.bid < 64) { for (int rp = 0; rp < 1 + ((DUP >> 12) & 1); ++rp) gdn_scan(c, a, c.bid); } else { for (int rp = 0; rp < 1 + ((DUP >> 13) & 1); ++rp) attn_mfma(c, a, l, 64, c.G - 64); } }
        SEAM(pb + 4);
        if (IN(pb + 5) && !(KO & (1 << 4))) REP(5) phase_gdn_out(c, a, l);
        SEAM(pb + 5);
        if (IN(pb + 6) && !(KO & (1 << 5))) REP(6) { pg8::Gemm g{MIXED, (const bf16_t*)(A.ws + WS_WOUT) + (size_t)l * 1024 * 1024, T, 1024, 1024}; pg8::StaticOrder S; S.init(T, 1024, c.G, c.bid); pg8::EpiResNorm E{l == 0 ? A.in[0] : A.out, A.out, NBUF, A.in[14] + l * 1024, (float*)(A.ws + WS_RS), 1024};
            pg8::gemm_phase<pg8::EpiResNorm, pg8::StaticOrder>(c.lds, g, S, E, nullptr); }
        SEAM(pb + 6);
        if (IN(pb + 8) && !(KO & (1 << 7))) REP(8) { pg8::Gemm g{NBUF, (const bf16_t*)(A.ws + WS_WQ) + (size_t)l * 2048 * 1024, T, 2048, 1024}; pg8::StaticOrder S; S.init(T, 2048, c.G, c.bid); pg8::EpiBf16 E{QP, 2048, (const float*)(A.ws + WS_RS)};
            pg8::gemm_phase<pg8::EpiBf16, pg8::StaticOrder>(c.lds, g, S, E, nullptr); }
        SEAM(pb + 8);
        if (IN(pb + 9) && !(KO & (1 << 8))) REP(9) phase_peer(c, a, l, LASTREP(9) ? A.out : (float*)(A.ws + WS_GCH), l == 0, bar, (hi - lo > 1) && c.G * 64 == T);
        SEAM(pb + 9);
    };
    layer(0); layer(1);
#undef IN
#undef INR
#undef SEAM
}

extern "C" void kernel_launch(void* const* d_in, const int* in_sizes, int n_in, void* d_out, int out_size, void* d_ws, size_t ws_size, hipStream_t stream) {
    static int grid = 0;
    if (grid == 0) {
        if (n_in != 19 || out_size != T * D || ws_size < WS_END) { fprintf(stderr, "kernel_launch: unexpected shapes (n_in %d out %d ws %zu)\n", n_in, out_size, ws_size); grid = -1; return; }
        if (hipFuncSetAttribute((const void*)fwd, hipFuncAttributeMaxDynamicSharedMemorySize, LDS_BYTES) != hipSuccess) { fprintf(stderr, "kernel_launch: hipFuncSetAttribute failed\n"); grid = -1; return; }
        int dev = 0, cus = 0, per_cu = 0;
        (void)hipGetDevice(&dev); (void)hipDeviceGetAttribute(&cus, hipDeviceAttributeMultiprocessorCount, dev);
        (void)hipOccupancyMaxActiveBlocksPerMultiprocessor(&per_cu, (const void*)fwd, 512, LDS_BYTES);
        (void)hipGetLastError();
        if (per_cu < 1) fprintf(stderr, "kernel_launch: occupancy query reports %d blocks per CU\n", per_cu);
        grid = cus > 0 ? cus : 256;
    }
    if (grid < 0) return;
    (void)hipMemsetAsync((char*)d_ws + WS_CTL, 0, CTL_BYTES, stream);
    Args a{};
    for (int i = 0; i < 19; ++i) a.in[i] = (const float*)d_in[i];
    a.out = (float*)d_out; a.ws = (unsigned char*)d_ws;
#if MK_ONE_LAUNCH
    a.ph_lo = 0; a.ph_hi = NPHASE;
    hipLaunchKernelGGL(fwd, dim3(grid), dim3(512), LDS_BYTES, stream, a);
#else
    for (int p = 0; p < NPHASE; ++p) { a.ph_lo = p; a.ph_hi = p + 1; hipLaunchKernelGGL(fwd, dim3(grid), dim3(512), LDS_BYTES, stream, a); }
#endif
}
```

```cpp
#include <hip/hip_runtime.h>
#include <cstdio>
#include <cstdint>
#include <cstring>

#ifndef KO
#define KO 0
#endif
#ifndef DUP
#define DUP 0
#endif
#define STEP_ALIGN 0
#define ALIGN_V 0
#define REP(k) for (int rep = 0; rep < 1 + ((DUP >> (k)) & 1); ++rep)
#define LASTREP(k) (rep == ((DUP >> (k)) & 1))
#ifndef MK_ONE_LAUNCH
#define MK_ONE_LAUNCH 1
#endif

template <int CTRL> __device__ __forceinline__ int dpp_i(int x) { return __builtin_amdgcn_mov_dpp(x, CTRL, 0xf, 0xf, true); }
template <int N> __device__ __forceinline__ int lxi(int x) {
    if constexpr (N == 1) return dpp_i<0xB1>(x);
    else if constexpr (N == 2) return dpp_i<0x4E>(x);
    else if constexpr (N == 4) return dpp_i<0x1B>(dpp_i<0x141>(x));
    else if constexpr (N == 8) return dpp_i<0x128>(x);
    else if constexpr (N == 16) { const auto r = __builtin_amdgcn_permlane16_swap((unsigned)x, (unsigned)x, false, false); return (int)((threadIdx.x & 16) ? r[0] : r[1]); }
    else { const auto r = __builtin_amdgcn_permlane32_swap((unsigned)x, (unsigned)x, false, false); return (int)((threadIdx.x & 32) ? r[0] : r[1]); }
}
template <int N> __device__ __forceinline__ float lxf(float x) { return __int_as_float(lxi<N>(__float_as_int(x))); }
template <int N> __device__ __forceinline__ unsigned lxu(unsigned x) { return (unsigned)lxi<N>((int)x); }
namespace pg8 {
#define PG8_LAS __attribute__((address_space(3)))
typedef unsigned short bf16_t;
typedef short bf16x8 __attribute__((ext_vector_type(8)));
typedef float f32x4 __attribute__((ext_vector_type(4)));
typedef unsigned u32x4 __attribute__((ext_vector_type(4)));
constexpr int BM = 256, BK = 64, HALF = 128, HTB = HALF * BK * 2  , STAGE_BYTES = 8 * HTB, NXCD = 8, WGM = 8;

__host__ __device__ __forceinline__ int lds_byte(int r, int c) { const int st = (r >> 4) * 2 + (c >> 5), rr = r & 15, cc = c & 31, ob = rr * 64 + cc * 2; return st * 1024 + (ob ^ (((ob >> 9) & 1) << 5)); }
__host__ __device__ __forceinline__ void stage_rc(int b, int& R, int& C) { const int st = b / 1024, sb = b % 1024, swz = sb ^ (((sb >> 9) & 1) << 5); R = (st >> 1) * 16 + swz / 64; C = (st & 1) * 32 + (swz % 64) / 2; }
__host__ __device__ __forceinline__ int perm32(int rho) { const int n = rho >> 4, i = rho & 15; return 8 * (i >> 2) + 4 * n + (i & 3); }

struct Unit { int pm, pn; };
struct Gemm { const bf16_t* A; const bf16_t* Bt; int M, N, K; };

struct StaticOrder {
    int nM, nN, nwg, G, c;
    __host__ __device__ void init(int M, int N, int G_, int c_) { nM = M / BM; nN = N / BM; nwg = nM * nN; G = G_; c = c_; }
    __host__ __device__ bool next(int i, Unit& u) const {
        const long L = (long)i * G + c; if (L >= nwg) return false;
        int wgid = (int)L; { const int q = nwg / NXCD, r = nwg % NXCD, xcd = wgid % NXCD, off = wgid / NXCD; wgid = (xcd < r ? xcd * (q + 1) : r * (q + 1) + (xcd - r) * q) + off; }
        const int nig = WGM * nN, gid = wgid / nig, fm = gid * WGM, gsz = (nM - fm) < WGM ? (nM - fm) : WGM;
        u.pm = fm + ((wgid % nig) % gsz); u.pn = (wgid % nig) / gsz; return true;
    }
    __device__ __forceinline__ void a_ready(const Unit&) const {}
    __device__ __forceinline__ void done(const Unit&) const {}
};
__device__ __forceinline__ unsigned cvt_pk_bf16(float lo, float hi) { unsigned r; asm volatile("v_cvt_pk_bf16_f32 %0, %1, %2" : "=v"(r) : "v"(lo), "v"(hi)); return r; }
typedef unsigned u32x2v __attribute__((ext_vector_type(2)));
struct EpiResF32 {
    static constexpr bool PERM = false, AFTER_DRAIN = false;
    const float* R; float* C; int ldc;
    __device__ __forceinline__ void operator()(const f32x4 (&acc)[2][2][4][2], const Unit& u, int wr, int wc, int fr, int fq) const {
        const int row0 = u.pm * BM + wr * 64 + fr, col0 = u.pn * BM + wc * 32 + 4 * fq;
#pragma unroll
        for (int ai = 0; ai < 2; ++ai)
#pragma unroll
            for (int m = 0; m < 4; ++m) { const size_t ro = (size_t)(row0 + ai * HALF + m * 16) * ldc + col0;
#pragma unroll
                for (int bj = 0; bj < 2; ++bj)
#pragma unroll
                    for (int n = 0; n < 2; ++n) { const f32x4 r = *(const f32x4*)(R + ro + bj * HALF + n * 16); *(f32x4*)(C + ro + bj * HALF + n * 16) = acc[ai][bj][m][n] + r; } }
    }
};
struct EpiResNorm {
    static constexpr bool PERM = false, AFTER_DRAIN = false;
    const float* R; float* C; bf16_t* HB; const float* gain; float* RS; int ldc;
    __device__ __forceinline__ void operator()(const f32x4 (&acc)[2][2][4][2], const Unit& u, int wr, int wc, int fr, int fq) const {
        const int row0 = u.pm * BM + wr * 64 + fr, col0 = u.pn * BM + wc * 32 + 4 * fq;
        f32x4 gv[2][2];
#pragma unroll
        for (int bj = 0; bj < 2; ++bj)
#pragma unroll
            for (int n = 0; n < 2; ++n) gv[bj][n] = *(const f32x4*)(gain + col0 + bj * HALF + n * 16);
#pragma unroll
        for (int ai = 0; ai < 2; ++ai) {
            f32x4 rr[4][2][2];
#pragma unroll
            for (int m = 0; m < 4; ++m)
#pragma unroll
                for (int bj = 0; bj < 2; ++bj)
#pragma unroll
                    for (int n = 0; n < 2; ++n) rr[m][bj][n] = *(const f32x4*)(R + (size_t)(row0 + ai * HALF + m * 16) * ldc + col0 + bj * HALF + n * 16);
#pragma unroll
            for (int m = 0; m < 4; ++m) { const int row = row0 + ai * HALF + m * 16; const size_t ro = (size_t)row * ldc + col0; float ss = 0.f;
#pragma unroll
                for (int bj = 0; bj < 2; ++bj)
#pragma unroll
                    for (int n = 0; n < 2; ++n) { const f32x4 r = rr[m][bj][n]; const f32x4 h = acc[ai][bj][m][n] + r; *(f32x4*)(C + ro + bj * HALF + n * 16) = h;
                        ss += (h[0] * h[0] + h[1] * h[1]) + (h[2] * h[2] + h[3] * h[3]); const f32x4 y = h * gv[bj][n];
                        u32x2v w; w.x = cvt_pk_bf16(y[0], y[1]); w.y = cvt_pk_bf16(y[2], y[3]); *(u32x2v*)(HB + ro + bj * HALF + n * 16) = w; }
                ss += lxf<16>(ss); ss += lxf<32>(ss);
                if (fq == 0) RS[(size_t)row * 16 + u.pn * 4 + wc] = ss; }
        }
    }
};
struct EpiBf16 {
    static constexpr bool PERM = true, AFTER_DRAIN = false;
    bf16_t* O; int ldc; const float* RS;
    __device__ __forceinline__ void operator()(const f32x4 (&acc)[2][2][4][2], const Unit& u, int wr, int wc, int fr, int fq) const {
        const int row0 = u.pm * BM + wr * 64 + fr; const int col0 = u.pn * BM + wc * 32 + 8 * fq;
#pragma unroll
        for (int ai = 0; ai < 2; ++ai)
#pragma unroll
            for (int m = 0; m < 4; ++m) { const int row = row0 + ai * HALF + m * 16; bf16_t* rowp = O + (size_t)row * ldc + col0;
                float sc = 1.0f; if (RS) { const f32x4 a = *(const f32x4*)(RS + (size_t)row * 16), b = *(const f32x4*)(RS + (size_t)row * 16 + 4), c2 = *(const f32x4*)(RS + (size_t)row * 16 + 8), d = *(const f32x4*)(RS + (size_t)row * 16 + 12);
                    sc = rsqrtf(((((a[0] + a[1]) + (a[2] + a[3])) + ((b[0] + b[1]) + (b[2] + b[3]))) + (((c2[0] + c2[1]) + (c2[2] + c2[3])) + ((d[0] + d[1]) + (d[2] + d[3])))) * (1.0f / 1024.0f) + 1e-6f); }
#pragma unroll
                for (int bj = 0; bj < 2; ++bj) { const f32x4 v0 = acc[ai][bj][m][0] * sc, v1 = acc[ai][bj][m][1] * sc;
                    u32x4 w; w.x = cvt_pk_bf16(v0[0], v0[1]); w.y = cvt_pk_bf16(v0[2], v0[3]); w.z = cvt_pk_bf16(v1[0], v1[1]); w.w = cvt_pk_bf16(v1[2], v1[3]);
                    *(u32x4*)(rowp + bj * HALF) = w; } }
    }
};

template <class Epi, class Sched, bool STAMP = false>
__device__ __forceinline__ void gemm_phase(PG8_LAS unsigned char* lds, const Gemm g, const Sched& S, const Epi& E, unsigned long long* stamps) {
    int tid_ = threadIdx.x; asm volatile("" : "+v"(tid_));
    const int tid = tid_, wid = __builtin_amdgcn_readfirstlane(tid >> 6), lane = tid & 63, wr = wid >> 2, wc = wid & 3, fr = lane & 15, fq = lane >> 4;
    const int K = g.K, nt = K / BK;
    int ts_lo = 0, ts_hi = 0, nts = 0; const unsigned long long rt_entry = STAMP ? (unsigned long long)wall_clock64() : 0ull;
#define PG8_STAMP() do { if (STAMP && wid == 0 && nts < 64) { const unsigned long long _c = (unsigned long long)clock64(); \
        ts_lo = (lane == nts) ? (int)(unsigned)_c : ts_lo; ts_hi = (lane == nts) ? (int)(unsigned)(_c >> 32) : ts_hi; ++nts; } } while (0)
    PG8_STAMP();
    unsigned voffA[2], voffB[2];
#pragma unroll
    for (int i = 0; i < 2; ++i) { int R, C; stage_rc(tid * 16 + i * 8192, R, C); const int Rb = Epi::PERM ? ((R & ~31) + perm32(R & 31)) : R;
        voffA[i] = (unsigned)(R * K + C) * 2u; voffB[i] = (unsigned)(Rb * K + C) * 2u; }
    const size_t kstep = (size_t)(BK * 2);
    const size_t hstep = (size_t)HALF * K * 2;
    const size_t tstep = 2 * hstep;
    const unsigned ldsw = (unsigned)wid * 1024u;
    const int aoff = lds_byte(wr * 64 + fr, fq * 8), boff = lds_byte(wc * 32 + fr, fq * 8);
#define PG8_SA(b, h) (((b) * 2 + (h)) * HTB)
#define PG8_SB(b, h) ((4 + (b) * 2 + (h)) * HTB)
#define PG8_STAGE(bufoff, gbase, voff) do { _Pragma("unroll") for (int _i = 0; _i < 2; ++_i) \
        __builtin_amdgcn_global_load_lds((const unsigned*)((const char*)(gbase) + (voff)[_i]), (PG8_LAS unsigned*)(lds + (bufoff) + ldsw + _i * 8192), 16, 0, 0); } while (0)
#define PG8_LDA(dst, b, h) do { _Pragma("unroll") for (int m = 0; m < 4; ++m) _Pragma("unroll") for (int k = 0; k < 2; ++k) dst[m][k] = *(const PG8_LAS bf16x8*)(lds + PG8_SA(b, h) + aoff + m * 2048 + k * 1024); } while (0)
#define PG8_LDB(dst, b, h) do { _Pragma("unroll") for (int n = 0; n < 2; ++n) _Pragma("unroll") for (int k = 0; k < 2; ++k) dst[n][k] = *(const PG8_LAS bf16x8*)(lds + PG8_SB(b, h) + boff + n * 2048 + k * 1024); } while (0)
#define PG8_MMA(ai, bj, At, Bt) do { __builtin_amdgcn_s_setprio(1); _Pragma("unroll") for (int m = 0; m < 4; ++m) _Pragma("unroll") for (int n = 0; n < 2; ++n) _Pragma("unroll") for (int k = 0; k < 2; ++k) \
        acc[ai][bj][m][n] = __builtin_amdgcn_mfma_f32_16x16x32_bf16(Bt[n][k], At[m][k], acc[ai][bj][m][n], 0, 0, 0); __builtin_amdgcn_s_setprio(0); } while (0)
#define PG8_WAIT_V(n) asm volatile("s_waitcnt vmcnt(" #n ")" ::: "memory")
#define PG8_WAIT_L(n) asm volatile("s_waitcnt lgkmcnt(" #n ")" ::: "memory")
#define PG8_BAR __builtin_amdgcn_s_barrier()
#define PG8_SCHED __builtin_amdgcn_sched_barrier(0)
    Unit cur, nxt; int ui = 0;
    if (!S.next(0, cur)) return;
    f32x4 acc[2][2][4][2];
#pragma unroll
    for (int a = 0; a < 2; ++a)
#pragma unroll
        for (int b = 0; b < 2; ++b)
#pragma unroll
            for (int m = 0; m < 4; ++m)
#pragma unroll
                for (int n = 0; n < 2; ++n) acc[a][b][m][n] = (f32x4){0.f, 0.f, 0.f, 0.f};
    bf16x8 At[4][2], B0[2][2], B1[2][2];
    const char* cA = (const char*)g.A + (size_t)cur.pm * tstep; const char* cB = (const char*)g.Bt + (size_t)cur.pn * tstep;
    S.a_ready(cur);
    PG8_STAGE(PG8_SB(0, 0), cB, voffB); PG8_STAGE(PG8_SA(0, 0), cA, voffA); PG8_STAGE(PG8_SB(0, 1), cB + hstep, voffB); PG8_STAGE(PG8_SA(0, 1), cA + hstep, voffA);
    if (wr == 1) PG8_BAR;
    PG8_WAIT_V(4); PG8_BAR;
    PG8_STAGE(PG8_SB(1, 0), cB + kstep, voffB); PG8_STAGE(PG8_SA(1, 0), cA + kstep, voffA); PG8_STAGE(PG8_SB(1, 1), cB + hstep + kstep, voffB);
    PG8_WAIT_V(6); PG8_BAR;
    PG8_STAMP();
    for (;;) {
        const bool has_next = S.next(ui + 1, nxt);
        const char* nA = has_next ? (const char*)g.A + (size_t)nxt.pm * tstep : cA; const char* nB = has_next ? (const char*)g.Bt + (size_t)nxt.pn * tstep : cB;
        for (int t = 0; t < nt; t += 2) {
            const bool last = (t == nt - 2);
            const char* a1 = cA + (size_t)(t + 1) * kstep;
            const char* a2 = last ? nA : cA + (size_t)(t + 2) * kstep; const char* b2 = last ? nB : cB + (size_t)(t + 2) * kstep;
            const char* a3 = a2 + kstep; const char* b3 = b2 + kstep;
            if (last && has_next) S.a_ready(nxt);
            PG8_LDB(B0, 0, 0); PG8_SCHED; PG8_LDA(At, 0, 0); PG8_STAGE(PG8_SA(1, 1), a1 + hstep, voffA);
            PG8_WAIT_L(8); PG8_BAR; PG8_WAIT_L(0); PG8_MMA(0, 0, At, B0); PG8_BAR; PG8_SCHED;
            PG8_LDB(B1, 0, 1); PG8_STAGE(PG8_SB(0, 0), b2, voffB);
            PG8_BAR; PG8_WAIT_L(0); PG8_MMA(0, 1, At, B1); PG8_BAR;
            PG8_LDA(At, 0, 1); PG8_STAGE(PG8_SA(0, 0), a2, voffA);
            PG8_BAR; PG8_WAIT_L(0); PG8_MMA(1, 0, At, B0); PG8_BAR; PG8_SCHED;
            PG8_STAGE(PG8_SB(0, 1), b2 + hstep, voffB);
            PG8_WAIT_V(6); PG8_BAR; PG8_MMA(1, 1, At, B1); PG8_BAR;
            PG8_LDB(B0, 1, 0); PG8_SCHED; PG8_LDA(At, 1, 0); PG8_STAGE(PG8_SA(0, 1), a2 + hstep, voffA);
            PG8_WAIT_L(8); PG8_BAR; PG8_WAIT_L(0); PG8_MMA(0, 0, At, B0); PG8_BAR; PG8_SCHED;
            PG8_LDB(B1, 1, 1); PG8_STAGE(PG8_SB(1, 0), b3, voffB);
            PG8_BAR; PG8_WAIT_L(0); PG8_MMA(0, 1, At, B1); PG8_BAR;
            PG8_LDA(At, 1, 1); PG8_STAGE(PG8_SA(1, 0), a3, voffA);
            PG8_BAR; PG8_WAIT_L(0); PG8_MMA(1, 0, At, B0); PG8_BAR; PG8_SCHED;
            PG8_STAGE(PG8_SB(1, 1), b3 + hstep, voffB);
            PG8_WAIT_V(6); PG8_BAR; PG8_MMA(1, 1, At, B1); PG8_BAR;
        }
        PG8_STAMP();
        if constexpr (!Epi::AFTER_DRAIN) { E(acc, cur, wr, wc, fr, fq); S.done(cur); }
        PG8_STAMP();
        if (!has_next) break;
#pragma unroll
        for (int a = 0; a < 2; ++a)
#pragma unroll
            for (int b = 0; b < 2; ++b)
#pragma unroll
                for (int m = 0; m < 4; ++m)
#pragma unroll
                    for (int n = 0; n < 2; ++n) acc[a][b][m][n] = (f32x4){0.f, 0.f, 0.f, 0.f};
        cur = nxt; cA = nA; cB = nB; ++ui;
    }
    PG8_WAIT_V(0);
    if (wr == 0) PG8_BAR;
    PG8_BAR;
    if constexpr (Epi::AFTER_DRAIN) { E.fused(acc, cur, wr, wc, fr, fq, lds, wid, lane); S.done(cur); }
    PG8_STAMP();
    if (STAMP && wid == 0) { stamps[lane] = lane < nts ? (((unsigned long long)(unsigned)ts_hi << 32) | (unsigned)ts_lo) : 0ull;
        if (lane == 62) stamps[62] = rt_entry; if (lane == 63) stamps[63] = (unsigned long long)wall_clock64(); }
#undef PG8_STAMP
#undef PG8_SA
#undef PG8_SB
#undef PG8_STAGE
#undef PG8_LDA
#undef PG8_LDB
#undef PG8_MMA
#undef PG8_WAIT_V
#undef PG8_WAIT_L
#undef PG8_BAR
#undef PG8_SCHED
}
}

using pg8::bf16_t; using pg8::bf16x8; using pg8::f32x4; using pg8::u32x4;
typedef unsigned u32x2 __attribute__((ext_vector_type(2)));
constexpr int T = 16384, D = 1024, SEQ = 2048, NPROJ = 3584, NINW = 3592, NEXP = 16384;
constexpr int EREC = 1536;
constexpr int C_GQ = 0, C_GK = 512, C_GV = 1024, C_GZ = 1536, C_SB = 2048, C_SC = 2304, C_SH = 2560, C_DQ = 2816, C_DK = 3072, C_DV = 3328;
constexpr size_t MiB = 1u << 20;
constexpr size_t WS_CTL = 0, CTL_BYTES = 1 * MiB, WS_WIN = 2 * MiB, WS_WOUT = 16 * MiB, WS_WQ = 20 * MiB, WS_KEYS = 28 * MiB, WS_WGATE = 29 * MiB, WS_VSC = 30 * MiB, WS_USC = 31 * MiB,
    WS_UT = 32 * MiB, WS_VT = 96 * MiB, WS_NBUF = 160 * MiB, WS_PROJ = 192 * MiB, WS_QP = 192 * MiB, WS_QKVC = 304 * MiB, WS_MIXED = 352 * MiB, WS_GB = 384 * MiB,
    WS_AQ = 385 * MiB, WS_AK = 393 * MiB, WS_OGDN = 401 * MiB, WS_GCH = 433 * MiB, WS_AVT = 160 * MiB  , WS_END = 505 * MiB;
constexpr int CW_BAR = 4096;
constexpr size_t WS_RS = 1 * MiB;
constexpr int LDS_BYTES = 159744;
constexpr int MISC_OFF = 159744 - 256;
constexpr int NPHASE = 21;

__device__ __forceinline__ float bf_lo(unsigned w) { return __uint_as_float(w << 16); }
__device__ __forceinline__ float bf_hi(unsigned w) { return __uint_as_float(w & 0xffff0000u); }
__device__ __forceinline__ unsigned f2bf(float f) { unsigned u = __float_as_uint(f); return (u + 0x7fffu + ((u >> 16) & 1u)) >> 16; }
__device__ __forceinline__ unsigned pk2(float lo, float hi) { return f2bf(lo) | (f2bf(hi) << 16); }
__device__ __forceinline__ float wave_sum(float v) {
    v += lxf<1>(v); v += lxf<2>(v); v += lxf<4>(v); v += lxf<8>(v); v += lxf<16>(v); v += lxf<32>(v);
    return v;
}
__device__ __forceinline__ int kperm(int x) { return (x & ~31) | (((x >> 2) & 3) << 3) | (((x >> 4) & 1) << 2) | (x & 3); }
__device__ __forceinline__ float silu_f(float x) { return x / (1.0f + __expf(-x)); }

#define XB_TMO      128
#define XB_XCNT(j)  (256  + 64 * (j))
#define XB_XSUB(j)  (1280 + 64 * (j))
#define XB_XGEN(j)  (2304 + 64 * (j))
#define XB_TOP      3328
#define XB_TOPGEN   3392
#define XCD_BAR_WORDS 3456
#define XB_SPIN_CAP (1u << 18)
#define LAS __attribute__((address_space(3)))

__device__ __forceinline__ unsigned xb_ld(unsigned* p)              { return __hip_atomic_load(p, __ATOMIC_RELAXED, __HIP_MEMORY_SCOPE_AGENT); }
__device__ __forceinline__ unsigned xb_add(unsigned* p, unsigned v) { return __hip_atomic_fetch_add(p, v, __ATOMIC_RELAXED, __HIP_MEMORY_SCOPE_AGENT); }
__device__ __forceinline__ unsigned xb_xcc_id() { return (unsigned)__builtin_amdgcn_s_getreg((3 << 11) | 20) & 0xFu; }
#define XB_SPIN(cond, bar) do { unsigned _sp = 0; while (cond) { __builtin_amdgcn_s_sleep(1); \
    if ((++_sp & 255u) == 0u) { if (xb_ld(&(bar)[XB_TMO])) break; if (_sp > XB_SPIN_CAP) { atomicAdd(&(bar)[XB_TMO], 1u); break; } } } } while (0)

struct XcdBarrier {
    unsigned* bar; unsigned x;
    volatile LAS unsigned* st;
};

__device__ __forceinline__ XcdBarrier xcd_barrier_post(unsigned* bar, volatile LAS unsigned* st) {
    XcdBarrier b; b.bar = bar; b.x = xb_xcc_id(); b.st = st;
    if (threadIdx.x == 0) (void)xb_add(&bar[XB_XCNT(b.x)], 1u);
    return b;
}
__device__ __forceinline__ void xcd_barrier_complete(unsigned* bar, unsigned x, unsigned& nloc, unsigned& nx) {
    const unsigned G = gridDim.x * gridDim.y * gridDim.z;
    unsigned sum, cnt, mine, sp = 0u;
    for (;;) {
        sum = 0u; cnt = 0u; mine = 0u;
#pragma unroll
        for (unsigned j = 0; j < 16; ++j) { const unsigned c = xb_ld(&bar[XB_XCNT(j)]); sum += c; cnt += (c > 0u) ? 1u : 0u; mine = (j == x) ? c : mine; }
        if (sum == G) break;
        __builtin_amdgcn_s_sleep(1);
        if ((++sp & 255u) == 0u) { if (xb_ld(&bar[XB_TMO])) break; if (sp > XB_SPIN_CAP) { atomicAdd(&bar[XB_TMO], 1u); break; } }
    }
    nloc = mine > 0u ? mine : 1u; nx = cnt > 0u ? cnt : 1u;
}

__device__ __forceinline__ void xcd_barrier(const XcdBarrier& b) {
    asm volatile("s_waitcnt vmcnt(0)" ::: "memory");
    __syncthreads();
    if (threadIdx.x == 0) {
        unsigned* bar = b.bar;
        __builtin_amdgcn_s_waitcnt(0);
        unsigned nloc = b.st[0], nx = b.st[1];
        if (nloc == 0u) { xcd_barrier_complete(bar, b.x, nloc, nx); b.st[0] = nloc; b.st[1] = nx; }
        const unsigned old = xb_add(&bar[XB_XSUB(b.x)], 1u);
        const unsigned gen = old / nloc;
        if (old + 1u == (gen + 1u) * nloc) {
            __builtin_amdgcn_fence(__ATOMIC_RELEASE, "agent");
            asm volatile("s_waitcnt vmcnt(0)" ::: "memory");
            const unsigned og = xb_add(&bar[XB_TOP], 1u);
            const unsigned tg = og / nx;
            if (og + 1u == (tg + 1u) * nx) xb_add(&bar[XB_TOPGEN], 1u);
            else XB_SPIN(xb_ld(&bar[XB_TOPGEN]) == tg, bar);
            __builtin_amdgcn_fence(__ATOMIC_ACQUIRE, "agent");
            xb_add(&bar[XB_XGEN(b.x)], 1u);
            asm volatile("s_waitcnt vmcnt(0)" ::: "memory");
        } else {
            XB_SPIN(xb_ld(&bar[XB_XGEN(b.x)]) == gen, bar);
            __builtin_amdgcn_fence(__ATOMIC_ACQUIRE, "agent");
            asm volatile("s_waitcnt vmcnt(0)" ::: "memory");
        }
    }
    __syncthreads();
}

struct Args { const float* in[19]; float* out; unsigned char* ws; int ph_lo, ph_hi; };
struct Ctx {
    LAS unsigned char* lds; int tid, lane, wave, G, bid;
};

struct __attribute__((packed, aligned(4))) U3 { unsigned x, y, z; };
typedef unsigned u32x6 __attribute__((ext_vector_type(6)));
typedef float f32x32 __attribute__((ext_vector_type(32)));
typedef _Float16 f16x32 __attribute__((ext_vector_type(32)));
__device__ __forceinline__ unsigned fp4_e2m1(float x) {
    const float a = fabsf(x); const float cdf = a < 2.f ? rintf(a * 2.f) : (a < 4.f ? rintf(a) + 2.f : rintf(a * 0.5f) + 4.f);
    return (unsigned)fminf(cdf, 7.f) | ((__float_as_uint(x) >> 31) << 3);
}
__device__ __forceinline__ unsigned fp6_e2m3(float x) {
    const float a = fabsf(x); const float cdf = a < 2.f ? rintf(a * 8.f) : (a < 4.f ? rintf(a * 4.f) + 8.f : rintf(a * 2.f) + 16.f);
    return (unsigned)fminf(cdf, 31.f) | ((__float_as_uint(x) >> 31) << 5);
}
__device__ __forceinline__ void cvt_flat8(const float* src, unsigned char* dst, size_t n8, size_t gt, size_t NT) {
    const float4* s = (const float4*)src; u32x4* d = (u32x4*)dst;
    for (size_t i = gt; i < n8; i += NT) { const float4 a = s[2 * i], b = s[2 * i + 1]; u32x4 w; w.x = pk2(a.x, a.y); w.y = pk2(a.z, a.w); w.z = pk2(b.x, b.y); w.w = pk2(b.z, b.w); d[i] = w; }
}
__device__ __forceinline__ void cvt_transpose(const float* w, bf16_t* dst, int N, size_t gt, size_t NT) {
    const size_t items = (size_t)2 * 128 * N;
    for (size_t i = gt; i < items; i += NT) {
        const int cc = (int)(i % N), kb = (int)((i / N) % 128), l = (int)(i / ((size_t)N * 128));
        const float* s = w + ((size_t)l * 1024 + kb * 8) * N + cc; float v[8];
#pragma unroll
        for (int j = 0; j < 8; ++j) v[j] = s[(size_t)j * N];
        u32x4 o; o.x = pk2(v[0], v[1]); o.y = pk2(v[2], v[3]); o.z = pk2(v[4], v[5]); o.w = pk2(v[6], v[7]);
        *(u32x4*)(dst + ((size_t)l * N + cc) * 1024 + kb * 8) = o;
    }
}
__device__ __forceinline__ void peer_tables_convert(Ctx& c, const Args& A, int first, int last, int wid, int nw, int tb0 = 0, int tb1 = 2) {
#pragma unroll 1
    for (int tb = tb0; tb < tb1; ++tb) {
        const float* src = tb ? A.in[18] : A.in[17]; unsigned char* dst = A.ws + WS_UT + (tb ? 1024 : 0);   float* vs = (float*)(A.ws + (tb ? WS_VSC : WS_USC));
        for (int row = first + wid; row < last; row += nw) {
            const float4* sp = (const float4*)(src + (size_t)row * 1024 + 16 * c.lane); float4 f[4]; float am = 0.f;
#pragma unroll
            for (int i = 0; i < 4; ++i) { f[i] = sp[i]; am = fmaxf(fmaxf(am, fmaxf(fabsf(f[i].x), fabsf(f[i].y))), fmaxf(fabsf(f[i].z), fabsf(f[i].w))); }
            am = fmaxf(am, lxf<1>(am)); am = fmaxf(am, lxf<2>(am)); am = fmaxf(am, lxf<4>(am)); am = fmaxf(am, lxf<8>(am)); am = fmaxf(am, lxf<16>(am)); am = fmaxf(am, lxf<32>(am));
            const float sc = am > 0.f ? (tb ? 6.0f / am : __uint_as_float(__float_as_uint(127.0f / am) & 0x7f800000u)) : 1.0f;
            if (tb) {
                unsigned d0 = 0u, d1 = 0u;
#pragma unroll
                for (int i = 0; i < 16; ++i) { const float x = (i & 3) == 0 ? f[i >> 2].x : ((i & 3) == 1 ? f[i >> 2].y : ((i & 3) == 2 ? f[i >> 2].z : f[i >> 2].w)); const unsigned cd = fp4_e2m1(x * sc);
                    if (i < 8) d0 |= cd << (4 * i); else d1 |= cd << (4 * (i - 8)); }
                u32x2 w2; w2.x = d0; w2.y = d1;
                *(u32x2*)(dst + (size_t)row * EREC + 8 * c.lane) = w2;
            } else {
                u32x4 w; unsigned ww[4];
#pragma unroll
                for (int i = 0; i < 4; ++i) ww[i] = ((unsigned)(int)rintf(f[i].x * sc) & 255u) | (((unsigned)(int)rintf(f[i].y * sc) & 255u) << 8) | (((unsigned)(int)rintf(f[i].z * sc) & 255u) << 16) | (((unsigned)(int)rintf(f[i].w * sc) & 255u) << 24);
                w.x = ww[0]; w.y = ww[1]; w.z = ww[2]; w.w = ww[3];
                *(u32x4*)(dst + (size_t)row * EREC + 16 * c.lane) = w; }
            if (c.lane == 0) vs[row] = 1.0f / sc;
        }
    }
}
__device__ __forceinline__ void p0_prologue(Ctx& c, const Args& A) {
    const size_t gt = (size_t)c.bid * 512 + c.tid, NT = (size_t)c.G * 512;
    if (c.G == 256) peer_tables_convert(c, A, NEXP / 2, NEXP, c.bid * 8 + c.wave, c.G * 8);
    else peer_tables_convert(c, A, 0, 2 * NEXP, c.bid * 8 + c.wave, c.G * 8);
    cvt_flat8(A.in[16], A.ws + WS_KEYS, (size_t)2 * 8 * 2 * 128 * 128 / 8, gt, NT);
    cvt_transpose(A.in[13], (bf16_t*)(A.ws + WS_WOUT), 1024, gt, NT);
    cvt_transpose(A.in[15], (bf16_t*)(A.ws + WS_WQ), 2048, gt, NT);
    {
        const float* w = A.in[3]; const size_t items = (size_t)2 * 128 * NINW;
        for (size_t i = gt; i < items; i += NT) {
            const int cc = (int)(i % NINW), kb = (int)((i / NINW) % 128), l = (int)(i / ((size_t)NINW * 128));
            const float* s = w + ((size_t)l * 1024 + kb * 8) * NINW + cc; float v[8];
#pragma unroll
            for (int j = 0; j < 8; ++j) v[j] = s[(size_t)j * NINW];
            if (cc >= 2048 && cc < 2056) { float* d = (float*)(A.ws + WS_WGATE) + ((size_t)l * 8 + (cc - 2048)) * 1024 + kb * 8;
                *(float4*)d = make_float4(v[0], v[1], v[2], v[3]); *(float4*)(d + 4) = make_float4(v[4], v[5], v[6], v[7]); }
            else { const int c2 = cc < 2048 ? cc : cc - 8; u32x4 o; o.x = pk2(v[0], v[1]); o.y = pk2(v[2], v[3]); o.z = pk2(v[4], v[5]); o.w = pk2(v[6], v[7]);
                *(u32x4*)((bf16_t*)(A.ws + WS_WIN) + ((size_t)l * NPROJ + c2) * 1024 + kb * 8) = o; }
        }
    }
}

__device__ __forceinline__ void phase_norm(Ctx& c, const Args& A, const float* src, const float* gain, bf16_t* dst, const float* wgate, const float* a_log, const float* dt_bias, float* GB) {
    const int gw = c.bid * 8 + c.wave, NGW = c.G * 8, lane = c.lane;
    const bool o1 = lane & 1, o2 = lane & 2, o4 = lane & 4; const int es = ((lane & 1) << 2) | (lane & 2) | ((lane >> 2) & 1);
    float4 g[4];
#pragma unroll
    for (int j = 0; j < 4; ++j) g[j] = ((const float4*)gain)[lane + 64 * j];
    float4 wq_[8][4];
    if (wgate) {
        LAS float* wl = (LAS float*)c.lds;
        __syncthreads();
#pragma unroll
        for (int h2 = 0; h2 < 2; ++h2) { const int k = c.tid + 512 * h2; const float4 a = *(const float4*)(wgate + (size_t)k * NINW), b = *(const float4*)(wgate + (size_t)k * NINW + 4);
            wl[k] = a.x; wl[1024 + k] = a.y; wl[2048 + k] = a.z; wl[3072 + k] = a.w; wl[4096 + k] = b.x; wl[5120 + k] = b.y; wl[6144 + k] = b.z; wl[7168 + k] = b.w; }
        __syncthreads();
#pragma unroll
        for (int q = 0; q < 8; ++q)
#pragma unroll
            for (int j = 0; j < 4; ++j) { const f32x4 t4 = *(const LAS f32x4*)(wl + q * 1024 + 4 * (lane + 64 * j)); wq_[q][j] = make_float4(t4[0], t4[1], t4[2], t4[3]); }
        __syncthreads(); }
    for (int m0 = gw * 2; m0 < T; m0 += NGW * 2) {
        float4 v[2][4];
#pragma unroll
        for (int rr = 0; rr < 2; ++rr)
#pragma unroll
            for (int j = 0; j < 4; ++j) v[rr][j] = ((const float4*)(src + (size_t)(m0 + rr) * D))[lane + 64 * j];
#pragma unroll
        for (int rr = 0; rr < 2; ++rr) {
            const int m = m0 + rr; float ss = 0.f;
#pragma unroll
            for (int j = 0; j < 4; ++j) { ss += (v[rr][j].x * v[rr][j].x + v[rr][j].y * v[rr][j].y) + (v[rr][j].z * v[rr][j].z + v[rr][j].w * v[rr][j].w);
                v[rr][j].x *= g[j].x; v[rr][j].y *= g[j].y; v[rr][j].z *= g[j].z; v[rr][j].w *= g[j].w; }
            float cc = 0.f;
            if (wgate) {
                float d[8];
#pragma unroll
                for (int q = 0; q < 8; ++q) { float a = 0.f;
#pragma unroll
                    for (int j = 0; j < 4; ++j) { const float4 w = wq_[q][j]; a += (v[rr][j].x * w.x + v[rr][j].y * w.y) + (v[rr][j].z * w.z + v[rr][j].w * w.w); }
                    d[q] = a; }
                float a0 = o1 ? d[4] : d[0], a1 = o1 ? d[5] : d[1], a2 = o1 ? d[6] : d[2], a3 = o1 ? d[7] : d[3];
                a0 += lxf<1>(o1 ? d[0] : d[4]); a1 += lxf<1>(o1 ? d[1] : d[5]); a2 += lxf<1>(o1 ? d[2] : d[6]); a3 += lxf<1>(o1 ? d[3] : d[7]);
                float b0 = o2 ? a2 : a0, b1 = o2 ? a3 : a1; b0 += lxf<2>(o2 ? a0 : a2); b1 += lxf<2>(o2 ? a1 : a3);
                cc = o4 ? b1 : b0; cc += lxf<4>(o4 ? b0 : b1);
                cc += lxf<8>(cc); cc += lxf<16>(cc); cc += lxf<32>(cc);
            }
            const float rstd = rsqrtf(wave_sum(ss) * (1.0f / D) + 1e-6f);
            u32x2* o8 = (u32x2*)(dst + (size_t)m * D) + lane;
#pragma unroll
            for (int j = 0; j < 4; ++j) { u32x2 w; w.x = pk2(v[rr][j].x * rstd, v[rr][j].y * rstd); w.y = pk2(v[rr][j].z * rstd, v[rr][j].w * rstd); o8[64 * j] = w; }
            if (wgate && lane < 8) { const float r = cc * rstd; float o;
                if (es < 4) o = 1.0f / (1.0f + __expf(-r));
                else { const float z = r + dt_bias[es - 4]; const float sp = z > 20.f ? z : log1pf(__expf(z)); o = -__expf(a_log[es - 4]) * sp; }
                GB[(size_t)m * 8 + es] = o; }
        }
    }
}

__device__ __forceinline__ void unpack8(const u32x4& w, float* f) { f[0] = bf_lo(w.x); f[1] = bf_hi(w.x); f[2] = bf_lo(w.y); f[3] = bf_hi(w.y); f[4] = bf_lo(w.z); f[5] = bf_hi(w.z); f[6] = bf_lo(w.w); f[7] = bf_hi(w.w); }
__device__ __forceinline__ void phase_prep(Ctx& c, const Args& A, int l) {
    const int gw = c.bid * 8 + c.wave, NGW = c.G * 8, lane = c.lane;
    const bf16_t* PROJ = (const bf16_t*)(A.ws + WS_PROJ);
    bf16_t* QKVC = (bf16_t*)(A.ws + WS_QKVC); bf16_t* AQ = (bf16_t*)(A.ws + WS_AQ); bf16_t* AK = (bf16_t*)(A.ws + WS_AK); bf16_t* MIXED = (bf16_t*)(A.ws + WS_MIXED); bf16_t* AVT = (bf16_t*)(A.ws + WS_AVT);
    const float* gconv = A.in[4] + (size_t)l * 4 * 1536; const float* sconv = A.in[8] + (size_t)l * 3 * 256;
    const float* qg = A.in[9] + l * 32; const float* kg = A.in[10] + l * 32;
    const u32x4 zero4 = {0u, 0u, 0u, 0u};
    for (int run = gw; run < T / 8; run += NGW) {
        const int t0 = run * 8, s0 = t0 & (SEQ - 1);
        u32x4 rowsN[11];
#define PREP_LOADA(itx) do { const int ch_ = ((itx) * 64 + lane) * 8; \
        _Pragma("unroll") for (int j = 0; j < 11; ++j) rowsN[j] = (s0 + j - 3 >= 0) ? *(const u32x4*)(PROJ + (size_t)(t0 + j - 3) * NPROJ + ch_) : zero4; } while (0)
        PREP_LOADA(0);
#pragma unroll 1
        for (int it = 0; it < 3; ++it) {
            const int ch = (it * 64 + lane) * 8;
            u32x4 rows[11]; float w[4][8];
#pragma unroll
            for (int j = 0; j < 11; ++j) rows[j] = rowsN[j];
#pragma unroll
            for (int j = 0; j < 4; ++j) { const float4 a = *(const float4*)(gconv + j * 1536 + ch), b = *(const float4*)(gconv + j * 1536 + ch + 4);
                w[j][0] = a.x; w[j][1] = a.y; w[j][2] = a.z; w[j][3] = a.w; w[j][4] = b.x; w[j][5] = b.y; w[j][6] = b.z; w[j][7] = b.w; }
            PREP_LOADA((it + 1 < 3 ? it + 1 : it));
#pragma unroll
            for (int i = 0; i < 8; ++i) {
                float acc[8] = {0.f, 0.f, 0.f, 0.f, 0.f, 0.f, 0.f, 0.f};
#pragma unroll
                for (int j = 0; j < 4; ++j) { float x[8]; unpack8(rows[i + j], x);
#pragma unroll
                    for (int e = 0; e < 8; ++e) acc[e] += w[j][e] * x[e]; }
                float ss = 0.f;
#pragma unroll
                for (int e = 0; e < 8; ++e) { acc[e] = silu_f(acc[e]); ss += acc[e] * acc[e]; }
                if (it < 2) {
                    ss += lxf<1>(ss); ss += lxf<2>(ss); ss += lxf<4>(ss); ss += lxf<8>(ss);
                    const float r = rsqrtf(ss + 1e-6f);
#pragma unroll
                    for (int e = 0; e < 8; ++e) acc[e] *= r; }
                u32x4 o4; o4.x = pk2(acc[0], acc[1]); o4.y = pk2(acc[2], acc[3]); o4.z = pk2(acc[4], acc[5]); o4.w = pk2(acc[6], acc[7]);
                *(u32x4*)(QKVC + (size_t)(t0 + i) * 1536 + ch) = o4;
            }
        }
#undef PREP_LOADA
            u32x2 wq[8], wk[8], wv[8];
#pragma unroll
            for (int i = 0; i < 8; ++i) { const bf16_t* r = PROJ + (size_t)(t0 + i) * NPROJ + 4 * lane; wq[i] = *(const u32x2*)(r + C_DQ); wk[i] = *(const u32x2*)(r + C_DK); wv[i] = *(const u32x2*)(r + C_DV); }
            const float4 g4 = *(const float4*)(qg + 4 * (lane & 7)), h4 = *(const float4*)(kg + 4 * (lane & 7));
            const int ch = 4 * lane; u32x2 wc[10], wh[10], wb[8];
#pragma unroll
            for (int j = 0; j < 10; ++j) { const bool ok = (s0 + j - 2 >= 0); const bf16_t* r = PROJ + (size_t)(t0 + j - 2) * NPROJ + ch;
                wc[j] = ok ? *(const u32x2*)(r + C_SC) : (u32x2){0u, 0u}; wh[j] = ok ? *(const u32x2*)(r + C_SH) : (u32x2){0u, 0u}; }
#pragma unroll
            for (int i = 0; i < 8; ++i) wb[i] = *(const u32x2*)(PROJ + (size_t)(t0 + i) * NPROJ + C_SB + ch);
            float4 cw[3];
#pragma unroll
            for (int j = 0; j < 3; ++j) cw[j] = *(const float4*)(sconv + j * 256 + ch);
        {
#pragma unroll
            for (int i = 0; i < 8; ++i) {
                float q[4] = {bf_lo(wq[i].x), bf_hi(wq[i].x), bf_lo(wq[i].y), bf_hi(wq[i].y)}, k[4] = {bf_lo(wk[i].x), bf_hi(wk[i].x), bf_lo(wk[i].y), bf_hi(wk[i].y)};
                float sq = (q[0] * q[0] + q[1] * q[1]) + (q[2] * q[2] + q[3] * q[3]), sk = (k[0] * k[0] + k[1] * k[1]) + (k[2] * k[2] + k[3] * k[3]);
                sq += lxf<1>(sq); sk += lxf<1>(sk); sq += lxf<2>(sq); sk += lxf<2>(sk); sq += lxf<4>(sq); sk += lxf<4>(sk);
                const float rq = rsqrtf(sq * (1.0f / 32.0f) + 1e-6f) * (0.17677669529663687f * 1.4426950408889634f), rk = rsqrtf(sk * (1.0f / 32.0f) + 1e-6f);
                u32x2 oq, ok; oq.x = pk2(q[0] * rq * g4.x, q[1] * rq * g4.y); oq.y = pk2(q[2] * rq * g4.z, q[3] * rq * g4.w);
                ok.x = pk2(k[0] * rk * h4.x, k[1] * rk * h4.y); ok.y = pk2(k[2] * rk * h4.z, k[3] * rk * h4.w);
                *(u32x2*)(AQ + (size_t)(t0 + i) * 256 + 4 * lane) = oq; *(u32x2*)(AK + (size_t)(t0 + i) * 256 + 4 * lane) = ok;
            }
            bf16_t* vt = AVT + ((size_t)((t0 >> 11) * 4 + (lane >> 4)) * 64 + (lane & 15) * 4) * SEQ + kperm(s0);
#pragma unroll
            for (int d = 0; d < 4; ++d) {
                unsigned e[8];
#pragma unroll
                for (int i = 0; i < 8; ++i) { const unsigned w = (d < 2) ? wv[i].x : wv[i].y; e[i] = (d & 1) ? (w >> 16) : (w & 0xffffu); }
                u32x2 lo, hi; lo.x = e[0] | (e[1] << 16); lo.y = e[2] | (e[3] << 16); hi.x = e[4] | (e[5] << 16); hi.y = e[6] | (e[7] << 16);
                *(u32x2*)(vt + (size_t)d * SEQ) = lo; *(u32x2*)(vt + (size_t)d * SEQ + 8) = hi;
            }
        }
        {
            float p[10][4];
#pragma unroll
            for (int j = 0; j < 10; ++j) { p[j][0] = bf_lo(wc[j].x) * bf_lo(wh[j].x); p[j][1] = bf_hi(wc[j].x) * bf_hi(wh[j].x); p[j][2] = bf_lo(wc[j].y) * bf_lo(wh[j].y); p[j][3] = bf_hi(wc[j].y) * bf_hi(wh[j].y); }
#pragma unroll
            for (int i = 0; i < 8; ++i) {
                const float a0 = cw[0].x * p[i][0] + cw[1].x * p[i + 1][0] + cw[2].x * p[i + 2][0], a1 = cw[0].y * p[i][1] + cw[1].y * p[i + 1][1] + cw[2].y * p[i + 2][1];
                const float a2 = cw[0].z * p[i][2] + cw[1].z * p[i + 1][2] + cw[2].z * p[i + 2][2], a3 = cw[0].w * p[i][3] + cw[1].w * p[i + 1][3] + cw[2].w * p[i + 2][3];
                u32x2 o; o.x = pk2(bf_lo(wb[i].x) * a0, bf_hi(wb[i].x) * a1); o.y = pk2(bf_lo(wb[i].y) * a2, bf_hi(wb[i].y) * a3);
                *(u32x2*)(MIXED + (size_t)(t0 + i) * 1024 + 512 + ch) = o;
            }
        }
    }
}

__device__ __forceinline__ void gdn_seq_unit(Ctx& c, const Args& A, int u) {
    const int bh = u >> 1, j0 = (u & 1) * 64, b = bh >> 2, h = bh & 3, tid = c.tid, lane = c.lane;
    const bf16_t* QKVC = (const bf16_t*)(A.ws + WS_QKVC); const float* GB = (const float*)(A.ws + WS_GB); float* OG = (float*)(A.ws + WS_OGDN);
    LAS float* kq = (LAS float*)c.lds;
    LAS float* vv = (LAS float*)(c.lds + 65536);
    LAS float* bg = (LAS float*)(c.lds + 65536 + 16384);
    float S[128];
#pragma unroll
    for (int d = 0; d < 128; ++d) S[d] = 0.f;
    for (int ck = 0; ck < 32; ++ck) {
        const int t0 = b * SEQ + ck * 64;
        __syncthreads();
        for (int e = tid; e < 64 * 128; e += 512) { const int i = e >> 7, p = (e & 127) * 2;
            const int col = p < 128 ? (C_GK + h * 128 + p) : (C_GQ + h * 128 + (p - 128));
            const unsigned w = *(const unsigned*)(QKVC + (size_t)(t0 + i) * 1536 + col); kq[i * 256 + p] = bf_lo(w); kq[i * 256 + p + 1] = bf_hi(w); }
        for (int e = tid; e < 64 * 32; e += 512) { const int i = e >> 5, p = (e & 31) * 2; const unsigned w = *(const unsigned*)(QKVC + (size_t)(t0 + i) * 1536 + C_GV + h * 128 + j0 + p); vv[i * 64 + p] = bf_lo(w); vv[i * 64 + p + 1] = bf_hi(w); }
        if (tid < 64) { bg[tid] = GB[(size_t)(t0 + tid) * 8 + h]; bg[64 + tid] = __expf(GB[(size_t)(t0 + tid) * 8 + 4 + h]); }
        __syncthreads();
        if (c.wave == 0) {
            for (int i = 0; i < 64; ++i) {
                const float beta = bg[i], al = bg[64 + i]; const LAS f32x4* kr = (const LAS f32x4*)(kq + i * 256); const LAS f32x4* qr = kr + 32;
                float ks = 0.f;
#pragma unroll
                for (int dg = 0; dg < 4; ++dg) {
#pragma unroll
                    for (int dd = 0; dd < 8; ++dd) { const int d4 = dg * 8 + dd; const f32x4 k4 = kr[d4]; ks += (k4.x * S[4 * d4] + k4.y * S[4 * d4 + 1]) + (k4.z * S[4 * d4 + 2] + k4.w * S[4 * d4 + 3]); }
                    asm volatile("" ::: "memory"); }
                const float delta = beta * (vv[i * 64 + lane] - al * ks); float o = 0.f;
#pragma unroll
                for (int dg = 0; dg < 8; ++dg) {
#pragma unroll
                    for (int dd = 0; dd < 4; ++dd) { const int d4 = dg * 4 + dd; const f32x4 k4 = kr[d4], q4 = qr[d4];
                        S[4 * d4] = al * S[4 * d4] + k4.x * delta; S[4 * d4 + 1] = al * S[4 * d4 + 1] + k4.y * delta; S[4 * d4 + 2] = al * S[4 * d4 + 2] + k4.z * delta; S[4 * d4 + 3] = al * S[4 * d4 + 3] + k4.w * delta;
                        o += (q4.x * S[4 * d4] + q4.y * S[4 * d4 + 1]) + (q4.z * S[4 * d4 + 2] + q4.w * S[4 * d4 + 3]); }
                    asm volatile("" ::: "memory"); }
                OG[(size_t)(t0 + i) * 512 + h * 128 + j0 + lane] = o * 0.08838834764831845f;
            }
        }
    }
    __syncthreads();
}
constexpr int GCH_BYTES = 73728, GCH_WM = 0, GCH_QM = 16384, GCH_KT = 32768, GCH_AM = 49152, GCH_UT = 57344;
__device__ __forceinline__ bf16x8 pack_frag(const f32x4& a, const f32x4& b) { u32x4 w; w.x = pg8::cvt_pk_bf16(a[0], a[1]); w.y = pg8::cvt_pk_bf16(a[2], a[3]); w.z = pg8::cvt_pk_bf16(b[0], b[1]); w.w = pg8::cvt_pk_bf16(b[2], b[3]); return __builtin_bit_cast(bf16x8, w); }
__device__ __forceinline__ void gdn_chunk_unit(Ctx& c, const Args& A, int unit) {
    const int tid = c.tid, lane = c.lane, wave = c.wave, fr = lane & 15, fq = lane >> 4;
    const int bh = unit >> 5, ck = unit & 31, b = bh >> 2, h = bh & 3, t0 = b * SEQ + ck * 64;
    const bf16_t* QKVC = (const bf16_t*)(A.ws + WS_QKVC); const float* GB = (const float*)(A.ws + WS_GB); float* GL = (float*)(A.ws + WS_GB + 512 * 1024);
    unsigned char* rec = A.ws + WS_GCH + (size_t)unit * GCH_BYTES;
    LAS float* gcs = (LAS float*)c.lds;
    LAS float* bet = gcs + 64;
    LAS float* Lm = (LAS float*)(c.lds + 512);
    LAS bf16_t* Tb = (LAS bf16_t*)(c.lds + 512 + 16384);
    LAS bf16_t* vt = Tb + 64 * 72;
    LAS bf16_t* kt = vt + 128 * 72;
    LAS bf16_t* k2 = kt + 128 * 72;
    __syncthreads();
    if (tid < 64) { float g = GB[(size_t)(t0 + tid) * 8 + 4 + h];
#pragma unroll
        for (int o = 1; o < 64; o <<= 1) { const float n = __shfl_up(g, o); if (lane >= o) g += n; }
        gcs[tid] = g; bet[tid] = GB[(size_t)(t0 + tid) * 8 + h]; }
    __syncthreads();
#pragma unroll 1
    for (int bb = 0; bb < 2; ++bb) {
        const int blk = wave * 2 + bb, ib = blk >> 2, jb = blk & 3;
        f32x4 kk = (f32x4){0.f, 0.f, 0.f, 0.f}, qk = (f32x4){0.f, 0.f, 0.f, 0.f};
        if (jb <= ib) {
            const bf16_t* ki = QKVC + (size_t)(t0 + ib * 16 + fr) * 1536 + C_GK + h * 128 + 8 * fq; const bf16_t* qi = QKVC + (size_t)(t0 + ib * 16 + fr) * 1536 + C_GQ + h * 128 + 8 * fq;
            const bf16_t* kj = QKVC + (size_t)(t0 + jb * 16 + fr) * 1536 + C_GK + h * 128 + 8 * fq;
#pragma unroll
            for (int ks = 0; ks < 4; ++ks) { const bf16x8 a = *(const bf16x8*)(ki + ks * 32), q = *(const bf16x8*)(qi + ks * 32), bj = *(const bf16x8*)(kj + ks * 32);
                kk = __builtin_amdgcn_mfma_f32_16x16x32_bf16(a, bj, kk, 0, 0, 0); qk = __builtin_amdgcn_mfma_f32_16x16x32_bf16(q, bj, qk, 0, 0, 0); }
        }
        const int j = jb * 16 + fr; const float gj = gcs[j]; bf16_t* AM = (bf16_t*)(rec + GCH_AM);
#pragma unroll
        for (int r = 0; r < 4; ++r) { const int i = ib * 16 + 4 * fq + r; const float dec = i >= j ? __expf(gcs[i] - gj) : 0.f;
            Lm[i * 64 + j] = i > j ? bet[i] * kk[r] * dec : 0.f;
            AM[i * 64 + kperm(j)] = (bf16_t)f2bf(qk[r] * dec * 0.08838834764831845f); }
    }
    __syncthreads();
    if (wave == 0) {
        float Tc[64];
#pragma unroll
        for (int i = 0; i < 64; ++i) { float acc = (lane == i) ? 1.f : 0.f;
#pragma unroll
            for (int j4 = 0; j4 < (i + 3) / 4; ++j4) { const f32x4 l4 = *(const LAS f32x4*)(Lm + i * 64 + 4 * j4);
#pragma unroll
                for (int x = 0; x < 4; ++x) if (4 * j4 + x < i) acc -= l4[x] * Tc[4 * j4 + x]; }
            Tc[i] = acc; Tb[i * 72 + lane] = (bf16_t)f2bf(acc); }
    } else {
        const float glast = gcs[63];
        for (int e = tid - 64; e < 64 * 16; e += 448) { const int j = e >> 4, d8 = (e & 15) * 8; const float bj = bet[j], gj = gcs[j]; const float s1 = bj * __expf(gj), s2 = __expf(glast - gj);
            const u32x4 kw = *(const u32x4*)(QKVC + (size_t)(t0 + j) * 1536 + C_GK + h * 128 + d8), vw = *(const u32x4*)(QKVC + (size_t)(t0 + j) * 1536 + C_GV + h * 128 + d8);
            const float kf[8] = {bf_lo(kw.x), bf_hi(kw.x), bf_lo(kw.y), bf_hi(kw.y), bf_lo(kw.z), bf_hi(kw.z), bf_lo(kw.w), bf_hi(kw.w)};
            const float vf[8] = {bf_lo(vw.x), bf_hi(vw.x), bf_lo(vw.y), bf_hi(vw.y), bf_lo(vw.z), bf_hi(vw.z), bf_lo(vw.w), bf_hi(vw.w)};
            const int jp = kperm(j);
#pragma unroll
            for (int x = 0; x < 8; ++x) { vt[(d8 + x) * 72 + j] = (bf16_t)f2bf(vf[x] * bj); kt[(d8 + x) * 72 + j] = (bf16_t)f2bf(kf[x] * s1); k2[(d8 + x) * 72 + jp] = (bf16_t)f2bf(kf[x] * s2); }
        }
        bf16_t* QM = (bf16_t*)(rec + GCH_QM);
        for (int e = tid - 64; e < 64 * 16; e += 448) { const int j = e >> 4, m8 = e & 15, m = m8 & 3; const float s = __expf(gcs[j]) * 0.08838834764831845f;
            const u32x4 qw = *(const u32x4*)(QKVC + (size_t)(t0 + j) * 1536 + C_GQ + h * 128 + m8 * 8);
            const int pos = (m8 >> 2) * 32 + 16 * (m & 1) + 4 * (m >> 1);
            u32x2 w0, w1; w0.x = pk2(bf_lo(qw.x) * s, bf_hi(qw.x) * s); w0.y = pk2(bf_lo(qw.y) * s, bf_hi(qw.y) * s); w1.x = pk2(bf_lo(qw.z) * s, bf_hi(qw.z) * s); w1.y = pk2(bf_lo(qw.w) * s, bf_hi(qw.w) * s);
            *(u32x2*)(QM + j * 128 + pos) = w0; *(u32x2*)(QM + j * 128 + pos + 8) = w1; }
        if (tid == 64) GL[unit] = glast;
    }
    __syncthreads();
    {
        f32x4 ua[4], wa[4];
#pragma unroll
        for (int mb = 0; mb < 4; ++mb) { ua[mb] = (f32x4){0.f, 0.f, 0.f, 0.f}; wa[mb] = (f32x4){0.f, 0.f, 0.f, 0.f}; }
#pragma unroll
        for (int ks = 0; ks < 2; ++ks) {
            const bf16x8 vf = *(const LAS bf16x8*)(vt + (16 * wave + fr) * 72 + ks * 32 + 8 * fq), kf = *(const LAS bf16x8*)(kt + (16 * wave + fr) * 72 + ks * 32 + 8 * fq);
#pragma unroll
            for (int mb = 0; mb < 4; ++mb) { const bf16x8 tf = *(const LAS bf16x8*)(Tb + (16 * mb + fr) * 72 + ks * 32 + 8 * fq);
                ua[mb] = __builtin_amdgcn_mfma_f32_16x16x32_bf16(tf, vf, ua[mb], 0, 0, 0);
                wa[mb] = __builtin_amdgcn_mfma_f32_16x16x32_bf16(kf, tf, wa[mb], 0, 0, 0); }
        }
        bf16_t* UT = (bf16_t*)(rec + GCH_UT); bf16_t* WM = (bf16_t*)(rec + GCH_WM);
#pragma unroll
        for (int mb = 0; mb < 4; ++mb) { u32x2 w; w.x = pk2(ua[mb][0], ua[mb][1]); w.y = pk2(ua[mb][2], ua[mb][3]); *(u32x2*)(UT + (16 * wave + fr) * 64 + 16 * mb + 4 * fq) = w;
            u32x2 v; v.x = pk2(wa[mb][0], wa[mb][1]); v.y = pk2(wa[mb][2], wa[mb][3]); *(u32x2*)(WM + (16 * mb + fr) * 128 + kperm(16 * wave + 4 * fq)) = v; }
        bf16_t* KT = (bf16_t*)(rec + GCH_KT);
#pragma unroll
        for (int k = 0; k < 2; ++k) { const int e = tid + 512 * k, row = e >> 3, cc = e & 7; *(u32x4*)(KT + row * 64 + cc * 8) = *(const LAS u32x4*)(k2 + row * 72 + cc * 8); }
    }
}
struct GaUnit { int t0, h; unsigned char* rec; };
__device__ __forceinline__ GaUnit ga_unit(const Args& A, int unit) { GaUnit u; const int bh = unit >> 5, ck = unit & 31; u.h = bh & 3; u.t0 = (bh >> 2) * SEQ + ck * 64; u.rec = A.ws + WS_GCH + (size_t)unit * GCH_BYTES; return u; }
__device__ __forceinline__ void ga_stage(const GaUnit& u, const bf16_t* QKVC, const LAS float* gcs, const LAS float* bet, LAS bf16_t* vt, LAS bf16_t* kt, LAS bf16_t* k2, int rel, int nth) {
    const float glast = gcs[63];
#pragma unroll 3
    for (int e = rel; e < 64 * 16; e += nth) { const int j = e >> 4, d8 = (e & 15) * 8; const float bj = bet[j], gj = gcs[j]; const float s1 = bj * __expf(gj), s2 = __expf(glast - gj);
        const u32x4 kw = *(const u32x4*)(QKVC + (size_t)(u.t0 + j) * 1536 + C_GK + u.h * 128 + d8), vw = *(const u32x4*)(QKVC + (size_t)(u.t0 + j) * 1536 + C_GV + u.h * 128 + d8);
        const float kf[8] = {bf_lo(kw.x), bf_hi(kw.x), bf_lo(kw.y), bf_hi(kw.y), bf_lo(kw.z), bf_hi(kw.z), bf_lo(kw.w), bf_hi(kw.w)};
        const float vf[8] = {bf_lo(vw.x), bf_hi(vw.x), bf_lo(vw.y), bf_hi(vw.y), bf_lo(vw.z), bf_hi(vw.z), bf_lo(vw.w), bf_hi(vw.w)};
        const int jp = kperm(j);
#pragma unroll
        for (int x = 0; x < 8; ++x) { vt[(d8 + x) * 72 + j] = (bf16_t)f2bf(vf[x] * bj); kt[(d8 + x) * 72 + j] = (bf16_t)f2bf(kf[x] * s1); k2[(d8 + x) * 72 + jp] = (bf16_t)f2bf(kf[x] * s2); }
    }
}
__device__ __forceinline__ void ga_qm(const GaUnit& u, const bf16_t* QKVC, const LAS float* gcs, int rel, int nth) {
    bf16_t* QM = (bf16_t*)(u.rec + GCH_QM);
#pragma unroll 3
    for (int e = rel; e < 64 * 16; e += nth) { const int j = e >> 4, m8 = e & 15, m = m8 & 3; const float s = __expf(gcs[j]) * 0.08838834764831845f;
        const u32x4 qw = *(const u32x4*)(QKVC + (size_t)(u.t0 + j) * 1536 + C_GQ + u.h * 128 + m8 * 8);
        const int pos = (m8 >> 2) * 32 + 16 * (m & 1) + 4 * (m >> 1);
        u32x2 w0, w1; w0.x = pk2(bf_lo(qw.x) * s, bf_hi(qw.x) * s); w0.y = pk2(bf_lo(qw.y) * s, bf_hi(qw.y) * s); w1.x = pk2(bf_lo(qw.z) * s, bf_hi(qw.z) * s); w1.y = pk2(bf_lo(qw.w) * s, bf_hi(qw.w) * s);
        *(u32x2*)(QM + j * 128 + pos) = w0; *(u32x2*)(QM + j * 128 + pos + 8) = w1; }
}
__device__ __forceinline__ void ga_uw(const GaUnit& u, const LAS bf16_t* Tb, const LAS bf16_t* vt, const LAS bf16_t* kt, const LAS bf16_t* k2, int tid, int wave, int fr, int fq) {
    f32x4 ua[4], wa[4];
#pragma unroll
    for (int mb = 0; mb < 4; ++mb) { ua[mb] = (f32x4){0.f, 0.f, 0.f, 0.f}; wa[mb] = (f32x4){0.f, 0.f, 0.f, 0.f}; }
#pragma unroll
    for (int ks = 0; ks < 2; ++ks) {
        const bf16x8 vf = *(const LAS bf16x8*)(vt + (16 * wave + fr) * 72 + ks * 32 + 8 * fq), kf = *(const LAS bf16x8*)(kt + (16 * wave + fr) * 72 + ks * 32 + 8 * fq);
#pragma unroll
        for (int mb = 0; mb < 4; ++mb) { const bf16x8 tf = *(const LAS bf16x8*)(Tb + (16 * mb + fr) * 72 + ks * 32 + 8 * fq);
            ua[mb] = __builtin_amdgcn_mfma_f32_16x16x32_bf16(tf, vf, ua[mb], 0, 0, 0);
            wa[mb] = __builtin_amdgcn_mfma_f32_16x16x32_bf16(kf, tf, wa[mb], 0, 0, 0); }
    }
    bf16_t* UT = (bf16_t*)(u.rec + GCH_UT); bf16_t* WM = (bf16_t*)(u.rec + GCH_WM);
#pragma unroll
    for (int mb = 0; mb < 4; ++mb) { u32x2 w; w.x = pk2(ua[mb][0], ua[mb][1]); w.y = pk2(ua[mb][2], ua[mb][3]); *(u32x2*)(UT + (16 * wave + fr) * 64 + 16 * mb + 4 * fq) = w;
        u32x2 v; v.x = pk2(wa[mb][0], wa[mb][1]); v.y = pk2(wa[mb][2], wa[mb][3]); *(u32x2*)(WM + (16 * mb + fr) * 128 + kperm(16 * wave + 4 * fq)) = v; }
    bf16_t* KT = (bf16_t*)(u.rec + GCH_KT);
#pragma unroll
    for (int k = 0; k < 2; ++k) { const int e = tid + 512 * k, row = e >> 3, cc = e & 7; *(u32x4*)(KT + row * 64 + cc * 8) = *(const LAS u32x4*)(k2 + row * 72 + cc * 8); }
}
__device__ __forceinline__ void gdn_chunk_pair(Ctx& c, const Args& A, int unit0, int unit1) {
    const int tid = c.tid, lane = c.lane, wave = c.wave, fr = lane & 15, fq = lane >> 4;
    const bf16_t* QKVC = (const bf16_t*)(A.ws + WS_QKVC); const float* GB = (const float*)(A.ws + WS_GB); float* GL = (float*)(A.ws + WS_GB + 512 * 1024);
    LAS float* gcs = (LAS float*)c.lds;
    LAS float* bet = gcs + 128;
    LAS float* Lm = (LAS float*)(c.lds + 1024);
    LAS bf16_t* Tb = (LAS bf16_t*)(c.lds + 33792);
    LAS bf16_t* vt = (LAS bf16_t*)(c.lds + 52224);
    LAS bf16_t* kt = vt + 128 * 72; LAS bf16_t* k2 = kt + 128 * 72;
    const GaUnit U0 = ga_unit(A, unit0), U1 = ga_unit(A, unit1);
    __syncthreads();
    if (tid < 128) { const GaUnit& u = wave ? U1 : U0; float g = GB[(size_t)(u.t0 + lane) * 8 + 4 + u.h];
#pragma unroll
        for (int o = 1; o < 64; o <<= 1) { const float n = __shfl_up(g, o); if (lane >= o) g += n; }
        gcs[wave * 64 + lane] = g; bet[wave * 64 + lane] = GB[(size_t)(u.t0 + lane) * 8 + u.h]; }
    __syncthreads();
#pragma unroll 2
    for (int bb = 0; bb < 4; ++bb) {
        const int idx = wave * 4 + bb, p = idx >> 4, blk = idx & 15, ib = blk >> 2, jb = blk & 3; const GaUnit& u = p ? U1 : U0;
        f32x4 kk = (f32x4){0.f, 0.f, 0.f, 0.f}, qk = (f32x4){0.f, 0.f, 0.f, 0.f};
        if (jb <= ib) {
            const bf16_t* ki = QKVC + (size_t)(u.t0 + ib * 16 + fr) * 1536 + C_GK + u.h * 128 + 8 * fq; const bf16_t* qi = QKVC + (size_t)(u.t0 + ib * 16 + fr) * 1536 + C_GQ + u.h * 128 + 8 * fq;
            const bf16_t* kj = QKVC + (size_t)(u.t0 + jb * 16 + fr) * 1536 + C_GK + u.h * 128 + 8 * fq;
#pragma unroll
            for (int ks = 0; ks < 4; ++ks) { const bf16x8 a = *(const bf16x8*)(ki + ks * 32), q = *(const bf16x8*)(qi + ks * 32), bj = *(const bf16x8*)(kj + ks * 32);
                kk = __builtin_amdgcn_mfma_f32_16x16x32_bf16(a, bj, kk, 0, 0, 0); qk = __builtin_amdgcn_mfma_f32_16x16x32_bf16(q, bj, qk, 0, 0, 0); }
        }
        const int j = jb * 16 + fr; const float gj = gcs[p * 64 + j]; bf16_t* AM = (bf16_t*)(u.rec + GCH_AM);
#pragma unroll
        for (int r = 0; r < 4; ++r) { const int i = ib * 16 + 4 * fq + r; const float dec = i >= j ? __expf(gcs[p * 64 + i] - gj) : 0.f;
            Lm[p * 4096 + i * 64 + j] = i > j ? bet[p * 64 + i] * kk[r] * dec : 0.f;
            AM[i * 64 + kperm(j)] = (bf16_t)f2bf(qk[r] * dec * 0.08838834764831845f); }
    }
    __syncthreads();
    if (wave < 2) {
        const LAS float* L = Lm + wave * 4096; LAS bf16_t* Tw = Tb + wave * 64 * 72;
        float Tc[64];
#pragma unroll
        for (int i = 0; i < 64; ++i) { float ac[4] = {(lane == i) ? 1.f : 0.f, 0.f, 0.f, 0.f};
#pragma unroll
            for (int j4 = 0; j4 < (i + 3) / 4; ++j4) { const f32x4 l4 = *(const LAS f32x4*)(L + i * 64 + 4 * j4);
#pragma unroll
                for (int x = 0; x < 4; ++x) if (4 * j4 + x < i) ac[x] -= l4[x] * Tc[4 * j4 + x]; }
            const float acc = (ac[0] + ac[1]) + (ac[2] + ac[3]);
            Tc[i] = acc; Tw[i * 72 + lane] = (bf16_t)f2bf(acc); }
    } else {
        ga_stage(U0, QKVC, gcs, bet, vt, kt, k2, tid - 128, 384);
        ga_qm(U0, QKVC, gcs, tid - 128, 384); ga_qm(U1, QKVC, gcs + 64, tid - 128, 384);
        if (tid == 128) { GL[unit0] = gcs[63]; GL[unit1] = gcs[127]; }
    }
    __syncthreads();
    ga_uw(U0, Tb, vt, kt, k2, tid, wave, fr, fq);
    __syncthreads();
    ga_stage(U1, QKVC, gcs + 64, bet + 64, vt, kt, k2, tid, 512);
    __syncthreads();
    ga_uw(U1, Tb + 64 * 72, vt, kt, k2, tid, wave, fr, fq);
}
__device__ __forceinline__ void gdn_scan(Ctx& c, const Args& A, int unit) {
    const int bh = unit >> 1, dv0 = (unit & 1) * 64 + 16 * (c.wave & 3); const bool active = c.wave < 4;
    const int tid = c.tid, lane = c.lane, fr = lane & 15, fq = lane >> 4, b = bh >> 2, h = bh & 3;
    constexpr int L_WM = 0, L_QM = 17408, L_KT = 34816, L_AM = 53248, L_BUF = 62464;
    const unsigned char* rec0 = A.ws + WS_GCH + (size_t)bh * 32 * GCH_BYTES; const float* GL = (const float*)(A.ws + WS_GB + 512 * 1024) + bh * 32; float* OG = (float*)(A.ws + WS_OGDN);
    f32x4 S[8];
#pragma unroll
    for (int i = 0; i < 8; ++i) S[i] = (f32x4){0.f, 0.f, 0.f, 0.f};
    u32x4 pre[14]; const int t2 = tid - 256;
#define GDN_LOAD(rec) do { _Pragma("unroll") for (int k = 0; k < 14; ++k) pre[k] = *(const u32x4*)((rec) + (size_t)(t2 + 256 * k) * 16); } while (0)
#define GDN_STORE(base) do { \
        _Pragma("unroll") for (int k = 0; k < 4; ++k) { const int q = t2 + 256 * k; *(LAS u32x4*)((base) + L_WM + (q >> 4) * 272 + (q & 15) * 16) = pre[k]; *(LAS u32x4*)((base) + L_QM + (q >> 4) * 272 + (q & 15) * 16) = pre[4 + k]; \
            *(LAS u32x4*)((base) + L_KT + (q >> 3) * 144 + (q & 7) * 16) = pre[8 + k]; } \
        _Pragma("unroll") for (int k = 0; k < 2; ++k) { const int q = t2 + 256 * k; *(LAS u32x4*)((base) + L_AM + (q >> 3) * 144 + (q & 7) * 16) = pre[12 + k]; } } while (0)
    __syncthreads();
    if (!active) { GDN_LOAD(rec0); GDN_STORE(c.lds); }
    u32x2 uwc[4], uwn[4]; float glc = GL[0], gln = 0.f;
#pragma unroll
    for (int mb = 0; mb < 4; ++mb) { uwc[mb] = *(const u32x2*)((const bf16_t*)(rec0 + GCH_UT) + (dv0 + fr) * 64 + 16 * mb + 4 * fq); uwn[mb] = uwc[mb]; }
    __syncthreads();
#pragma unroll 1
    for (int ck = 0; ck < 32; ++ck) {
        const unsigned char* rec = rec0 + (size_t)ck * GCH_BYTES; LAS unsigned char* B0 = c.lds + (ck & 1) * L_BUF; const int t0 = b * SEQ + ck * 64;
        if (ck + 1 < 32) { if (!active) GDN_LOAD(rec + GCH_BYTES); const bf16_t* UTn = (const bf16_t*)(rec + GCH_BYTES + GCH_UT);
#pragma unroll
            for (int mb = 0; mb < 4; ++mb) uwn[mb] = *(const u32x2*)(UTn + (dv0 + fr) * 64 + 16 * mb + 4 * fq); gln = GL[ck + 1]; }
        if (active) {
        bf16x8 sB[4];
#pragma unroll
        for (int ks = 0; ks < 4; ++ks) sB[ks] = pack_frag(S[2 * ks], S[2 * ks + 1]);
        f32x4 vn[4], oa[4];
#pragma unroll
        for (int mb = 0; mb < 4; ++mb) { f32x4 p = (f32x4){0.f, 0.f, 0.f, 0.f}, o = (f32x4){0.f, 0.f, 0.f, 0.f};
#pragma unroll
            for (int ks = 0; ks < 4; ++ks) { const bf16x8 aw = *(const LAS bf16x8*)(B0 + L_WM + (16 * mb + fr) * 272 + ks * 64 + fq * 16), aq = *(const LAS bf16x8*)(B0 + L_QM + (16 * mb + fr) * 272 + ks * 64 + fq * 16);
                p = __builtin_amdgcn_mfma_f32_16x16x32_bf16(aw, sB[ks], p, 0, 0, 0); o = __builtin_amdgcn_mfma_f32_16x16x32_bf16(aq, sB[ks], o, 0, 0, 0); }
            const u32x2 uw = uwc[mb];
            vn[mb] = (f32x4){bf_lo(uw.x) - p[0], bf_hi(uw.x) - p[1], bf_lo(uw.y) - p[2], bf_hi(uw.y) - p[3]}; oa[mb] = o; }
        bf16x8 vB[2];
#pragma unroll
        for (int s = 0; s < 2; ++s) vB[s] = pack_frag(vn[2 * s], vn[2 * s + 1]);
#pragma unroll
        for (int mb = 0; mb < 4; ++mb) {
#pragma unroll
            for (int s = 0; s < 2; ++s) { const bf16x8 aa = *(const LAS bf16x8*)(B0 + L_AM + (16 * mb + fr) * 144 + s * 64 + fq * 16); oa[mb] = __builtin_amdgcn_mfma_f32_16x16x32_bf16(aa, vB[s], oa[mb], 0, 0, 0); }
#pragma unroll
            for (int r = 0; r < 4; ++r) OG[(size_t)(t0 + 16 * mb + 4 * fq + r) * 512 + h * 128 + dv0 + fr] = oa[mb][r]; }
        const float gl = __expf(glc);
#pragma unroll
        for (int m8 = 0; m8 < 8; ++m8) { f32x4 s = S[m8] * gl;
#pragma unroll
            for (int s2 = 0; s2 < 2; ++s2) { const bf16x8 ak = *(const LAS bf16x8*)(B0 + L_KT + (16 * m8 + fr) * 144 + s2 * 64 + fq * 16); s = __builtin_amdgcn_mfma_f32_16x16x32_bf16(ak, vB[s2], s, 0, 0, 0); }
            S[m8] = s; }
        }
        if (ck + 1 < 32 && !active) GDN_STORE(c.lds + ((ck + 1) & 1) * L_BUF);
#pragma unroll
        for (int mb = 0; mb < 4; ++mb) uwc[mb] = uwn[mb];
        glc = gln;
        __syncthreads();
    }
#undef GDN_LOAD
#undef GDN_STORE
}
__device__ __forceinline__ int rel_bucket(int n) {
    if (n < 16) return n;
    const int v = 16 + (int)(__logf((float)n * (1.0f / 16.0f)) / 2.0794415416798357f * 16.0f);
    return v < 31 ? v : 31;
}
__device__ __forceinline__ void attn_mfma(Ctx& c, const Args& A, int l, int first_block, int nblocks) {
    const int tid = c.tid, lane = c.lane, wave = c.wave, fr = lane & 15, fq = lane >> 4;
    const bf16_t* AQ = (const bf16_t*)(A.ws + WS_AQ); const bf16_t* AK = (const bf16_t*)(A.ws + WS_AK); const bf16_t* AVT = (const bf16_t*)(A.ws + WS_AVT); bf16_t* MIXED = (bf16_t*)(A.ws + WS_MIXED);
    LAS float* bt = (LAS float*)c.lds;
    LAS float* cs = bt + 512;
    const float* rel_bias = A.in[1]; const float* lamp = A.in[11] + l * 128; const float* subln = A.in[12] + l * 64;
    const float lambda_init = 0.8f - 0.6f * __expf(-0.3f * (float)l);
    __syncthreads();
    {
        float mq = 0.f, mk = 0.f, mb = 0.f;
        for (int d = 0; d < 32; ++d) { mq = fmaxf(mq, fabsf(A.in[9][l * 32 + d])); mk = fmaxf(mk, fabsf(A.in[10][l * 32 + d])); }
        for (int i = 0; i < 128; ++i) mb = fmaxf(mb, fabsf(rel_bias[i]));
        const float cshift = 5.656854249492381f * mq * mk + mb;
        const int n = tid & 127, hh = tid >> 7; bt[hh * 128 + n] = (rel_bias[rel_bucket(n) * 4 + hh] - cshift) * 1.4426950408889634f;
        if (tid == 0) { float s01 = 0.f, s23 = 0.f; for (int d = 0; d < 32; ++d) { s01 += lamp[d] * lamp[32 + d]; s23 += lamp[64 + d] * lamp[96 + d]; } cs[0] = __expf(s01) - __expf(s23) + lambda_init; }
    }
    __syncthreads();
    const float lam = cs[0];
    bf16x8 ones; { const short o = (fr == 0) ? (short)0x3f80 : (short)0; ones = (bf16x8){o, o, o, o, o, o, o, o}; }
    constexpr int AT_K = 4096, AT_V = 4096 + 4608, AT_BUF = 9728;
    const int wg = c.bid - first_block;
#pragma unroll 1
    for (int rd = 0; rd * nblocks < 256; ++rd) {
        const int it = rd * nblocks + ((rd & 1) ? nblocks - 1 - wg : wg); if (it >= 256) continue;
        const int bh = it & 31, QB = 7 - (it >> 5), b = bh >> 2, h = bh & 3, q0 = QB * 256 + 32 * wave, nsteps = 8 * QB + 8;
        const float bfar = bt[h * 128 + 127];
        bf16x8 qf[2][2];
#pragma unroll
        for (int m = 0; m < 2; ++m)
#pragma unroll
            for (int nq = 0; nq < 2; ++nq) qf[m][nq] = *(const bf16x8*)(AQ + (size_t)(b * SEQ + q0 + nq * 16 + fr) * 256 + h * 64 + m * 32 + 8 * fq);
        f32x4 oacc[2][2][4], lacc[2][2];
#pragma unroll
        for (int m = 0; m < 2; ++m)
#pragma unroll
            for (int nq = 0; nq < 2; ++nq) { lacc[m][nq] = (f32x4){0.f, 0.f, 0.f, 0.f};
#pragma unroll
                for (int nb = 0; nb < 4; ++nb) oacc[m][nq][nb] = (f32x4){0.f, 0.f, 0.f, 0.f}; }
        const int t2 = tid & 255; const bool isK = tid < 256;
        const bf16_t* gsrc = isK ? AK + (size_t)(b * SEQ + (t2 >> 3)) * 256 + h * 64 + (t2 & 7) * 8 : AVT + ((size_t)bh * 64 + (t2 >> 2)) * SEQ + (t2 & 3) * 8;
        const size_t gstep = isK ? (size_t)32 * 256 : (size_t)32;
        const int ldst = isK ? AT_K + (t2 >> 3) * 144 + (t2 & 7) * 16 : AT_V + (t2 >> 2) * 80 + (t2 & 3) * 16;
        __syncthreads();
        u32x4 pre = *(const u32x4*)gsrc; *(LAS u32x4*)(c.lds + ldst) = pre;
        __syncthreads();
#pragma unroll 1
        for (int st = 0; st < nsteps; ++st) {
            const int k0 = st * 32; const LAS unsigned char* B0 = c.lds + (st & 1) * AT_BUF;
            if (st + 1 < nsteps) pre = *(const u32x4*)(gsrc + (size_t)(st + 1) * gstep);
            if (k0 <= q0) {
            bf16x8 kf[2][2], vf[4];
#pragma unroll
            for (int m = 0; m < 2; ++m)
#pragma unroll
                for (int kb = 0; kb < 2; ++kb) kf[m][kb] = *(const LAS bf16x8*)(B0 + AT_K + (kb * 16 + fr) * 144 + m * 64 + fq * 16);
#pragma unroll
            for (int nb = 0; nb < 4; ++nb) vf[nb] = *(const LAS bf16x8*)(B0 + AT_V + (16 * nb + fr) * 80 + fq * 16);
            const bool nearby = (k0 + 144 > q0);
            f32x4 cin[2][2];
            if (nearby) {
#pragma unroll
                for (int nq = 0; nq < 2; ++nq)
#pragma unroll
                    for (int kb = 0; kb < 2; ++kb)
#pragma unroll
                        for (int r = 0; r < 4; ++r) { const int n = (q0 + nq * 16 + fr) - (k0 + kb * 16 + 4 * fq + r); cin[nq][kb][r] = n >= 0 ? bt[h * 128 + (n > 127 ? 127 : n)] : -1.0e30f; }
            } else {
#pragma unroll
                for (int nq = 0; nq < 2; ++nq)
#pragma unroll
                    for (int kb = 0; kb < 2; ++kb) cin[nq][kb] = (f32x4){bfar, bfar, bfar, bfar};
            }
#pragma unroll
            for (int m = 0; m < 2; ++m)
#pragma unroll
                for (int nq = 0; nq < 2; ++nq) {
                    f32x4 p[2];
#pragma unroll
                    for (int kb = 0; kb < 2; ++kb) {
                        f32x4 s = __builtin_amdgcn_mfma_f32_16x16x32_bf16(kf[m][kb], qf[m][nq], cin[nq][kb], 0, 0, 0);
#pragma unroll
                        for (int r = 0; r < 4; ++r) s[r] = __builtin_amdgcn_exp2f(s[r]);
                        p[kb] = s;
                    }
                    const bf16x8 pf = pack_frag(p[0], p[1]);
#pragma unroll
                    for (int nb = 0; nb < 4; ++nb) oacc[m][nq][nb] = __builtin_amdgcn_mfma_f32_16x16x32_bf16(vf[nb], pf, oacc[m][nq][nb], 0, 0, 0);
                    lacc[m][nq] = __builtin_amdgcn_mfma_f32_16x16x32_bf16(ones, pf, lacc[m][nq], 0, 0, 0);
                }
            }
            if (st + 1 < nsteps) *(LAS u32x4*)(c.lds + ((st + 1) & 1) * AT_BUF + ldst) = pre;
            __syncthreads();
        }
#pragma unroll
        for (int nq = 0; nq < 2; ++nq) {
            const float l0 = __shfl(lacc[0][nq][0], fr), l1 = __shfl(lacc[1][nq][0], fr);
            const float i0 = 1.0f / l0, i1 = lam / l1; float ss = 0.f; f32x4 o[4];
#pragma unroll
            for (int nb = 0; nb < 4; ++nb) { o[nb] = oacc[0][nq][nb] * i0 - oacc[1][nq][nb] * i1; ss += (o[nb][0] * o[nb][0] + o[nb][1] * o[nb][1]) + (o[nb][2] * o[nb][2] + o[nb][3] * o[nb][3]); }
            ss += lxf<16>(ss); ss += lxf<32>(ss);
            const float rn = rsqrtf(ss * (1.0f / 64.0f) + 1e-6f) * (1.0f - lambda_init);
            bf16_t* orow = MIXED + (size_t)(b * SEQ + q0 + nq * 16 + fr) * 1024 + 768 + h * 64;
#pragma unroll
            for (int nb = 0; nb < 4; ++nb) { const float4 sg = *(const float4*)(subln + 16 * nb + 4 * fq);
                u32x2 w; w.x = pk2(o[nb][0] * rn * sg.x, o[nb][1] * rn * sg.y); w.y = pk2(o[nb][2] * rn * sg.z, o[nb][3] * rn * sg.w);
                *(u32x2*)(orow + 16 * nb + 4 * fq) = w; }
        }
    }
    __syncthreads();
}
__device__ __forceinline__ void phase_gdn_out(Ctx& c, const Args& A, int l) {
    const int gw = c.bid * 8 + c.wave, NGW = c.G * 8, lane = c.lane;
    const bf16_t* PROJ = (const bf16_t*)(A.ws + WS_PROJ); const float* OG = (const float*)(A.ws + WS_OGDN); bf16_t* MIXED = (bf16_t*)(A.ws + WS_MIXED);
    const float4 g0 = *(const float4*)(A.in[7] + l * 128 + (lane & 15) * 8), g1 = *(const float4*)(A.in[7] + l * 128 + (lane & 15) * 8 + 4);
    for (int run = gw; run < T / 8; run += NGW) {
        const int t0 = run * 8; float4 oa[8], ob[8]; u32x4 zz[8];
#pragma unroll
        for (int i = 0; i < 8; ++i) { const float* op = OG + (size_t)(t0 + i) * 512 + lane * 8; oa[i] = *(const float4*)op; ob[i] = *(const float4*)(op + 4); zz[i] = *(const u32x4*)(PROJ + (size_t)(t0 + i) * NPROJ + C_GZ + lane * 8); }
#pragma unroll
        for (int i = 0; i < 8; ++i) {
            float ss = (oa[i].x * oa[i].x + oa[i].y * oa[i].y) + (oa[i].z * oa[i].z + oa[i].w * oa[i].w) + (ob[i].x * ob[i].x + ob[i].y * ob[i].y) + (ob[i].z * ob[i].z + ob[i].w * ob[i].w);
            ss += lxf<1>(ss); ss += lxf<2>(ss); ss += lxf<4>(ss); ss += lxf<8>(ss);
            const float r = rsqrtf(ss * (1.0f / 128.0f) + 1e-6f);
            u32x4 w; w.x = pk2(oa[i].x * r * g0.x * silu_f(bf_lo(zz[i].x)), oa[i].y * r * g0.y * silu_f(bf_hi(zz[i].x))); w.y = pk2(oa[i].z * r * g0.z * silu_f(bf_lo(zz[i].y)), oa[i].w * r * g0.w * silu_f(bf_hi(zz[i].y)));
            w.z = pk2(ob[i].x * r * g1.x * silu_f(bf_lo(zz[i].z)), ob[i].y * r * g1.y * silu_f(bf_hi(zz[i].z))); w.w = pk2(ob[i].z * r * g1.z * silu_f(bf_lo(zz[i].w)), ob[i].w * r * g1.w * silu_f(bf_hi(zz[i].w)));
            *(u32x4*)(MIXED + (size_t)(t0 + i) * 1024 + lane * 8) = w;
        }
    }
}

__device__ __forceinline__ unsigned ord_key(float f) { const unsigned u = __float_as_uint(f); return (u & 0x80000000u) ? ~u : (u | 0x80000000u); }
__device__ __forceinline__ float ord_val(unsigned o) { return __uint_as_float((o & 0x80000000u) ? (o & 0x7fffffffu) : ~o); }
__device__ __forceinline__ float gelu_erf(float v) {
    const float av = fabsf(v), t = __builtin_amdgcn_rcpf(av * 0.2316418882f + 1.0f);
    float q = t * 0.5307027145f + (-0.7265760135f); q = q * t + 0.7107068705f; q = q * t + (-0.142248368f); q = q * t + 0.127414796f; q = q * t;
    const float e = __builtin_amdgcn_exp2f((v * v) * (-0.72134752044f)); const float m = v * (q * e);
    return v < 0.f ? m : v - m;
}
typedef __bf16 v2bf_t __attribute__((ext_vector_type(2)));
__device__ __forceinline__ float dot2bf(unsigned a, unsigned b, float acc) { return __builtin_amdgcn_fdot2_f32_bf16(__builtin_bit_cast(v2bf_t, a), __builtin_bit_cast(v2bf_t, b), acc, false); }
__device__ __forceinline__ float dot8(const u32x4& x, const u32x4& u, float acc) { acc = dot2bf(x.x, u.x, acc); acc = dot2bf(x.y, u.y, acc); acc = dot2bf(x.z, u.z, acc); return dot2bf(x.w, u.w, acc); }
__device__ __forceinline__ void axpy8(float* o, float cf, const u32x4& v) {
    o[0] += cf * bf_lo(v.x); o[1] += cf * bf_hi(v.x); o[2] += cf * bf_lo(v.y); o[3] += cf * bf_hi(v.y); o[4] += cf * bf_lo(v.z); o[5] += cf * bf_hi(v.z); o[6] += cf * bf_lo(v.w); o[7] += cf * bf_hi(v.w); }
typedef float f32x2_t __attribute__((ext_vector_type(2)));
__device__ __forceinline__ void axpy16_fp8(float* o, float cf, const u32x4& v) {
    const unsigned w[4] = {v.x, v.y, v.z, v.w};
#pragma unroll
    for (int i = 0; i < 4; ++i) { const f32x2_t a = __builtin_amdgcn_cvt_pk_f32_fp8((int)w[i], false), b = __builtin_amdgcn_cvt_pk_f32_fp8((int)w[i], true);
        o[4 * i] += cf * a.x; o[4 * i + 1] += cf * a.y; o[4 * i + 2] += cf * b.x; o[4 * i + 3] += cf * b.y; }
}
typedef _Float16 v2h_t __attribute__((ext_vector_type(2)));
__device__ __forceinline__ unsigned pkh(float a, float b) { const v2h_t h = {(_Float16)a, (_Float16)b}; return __builtin_bit_cast(unsigned, h); }
typedef _Float16 v2h_t __attribute__((ext_vector_type(2)));
__device__ __forceinline__ float dot4_fp8(unsigned uw, unsigned xlo, unsigned xhi, float acc) {
    acc = __builtin_amdgcn_fdot2(__builtin_amdgcn_cvt_scalef32_pk_f16_fp8(uw, 1.0f, false), __builtin_bit_cast(v2h_t, xlo), acc, false);
    return __builtin_amdgcn_fdot2(__builtin_amdgcn_cvt_scalef32_pk_f16_fp8(uw, 1.0f, true), __builtin_bit_cast(v2h_t, xhi), acc, false);
}
__device__ __forceinline__ float dot16_fp8(const u32x4& x0, const u32x4& x1, const u32x4& u) {
    float acc = dot4_fp8(u.x, x0.x, x0.y, 0.f); acc = dot4_fp8(u.y, x0.z, x0.w, acc); acc = dot4_fp8(u.z, x1.x, x1.y, acc); return dot4_fp8(u.w, x1.z, x1.w, acc);
}
__device__ __forceinline__ void cvt16_fp8(float* f, const u32x4& v) {
    const unsigned w[4] = {v.x, v.y, v.z, v.w};
#pragma unroll
    for (int i = 0; i < 4; ++i) { const f32x2_t a = __builtin_amdgcn_cvt_pk_f32_fp8((int)w[i], false), b = __builtin_amdgcn_cvt_pk_f32_fp8((int)w[i], true); f[4 * i] = a.x; f[4 * i + 1] = a.y; f[4 * i + 2] = b.x; f[4 * i + 3] = b.y; }
}
__device__ __forceinline__ void phase_peer(Ctx& c, const Args& A, int l, float* hdst, bool fuse_next, const XcdBarrier& bar, bool align) {
    const int tid = c.tid, lane = c.lane, wave = c.wave, fr = lane & 15, fq = lane >> 4;
    const bf16_t* QP = (const bf16_t*)(A.ws + WS_QP); const bf16_t* KEYS = (const bf16_t*)(A.ws + WS_KEYS) + (size_t)l * 16 * 128 * 128;
    const bf16_t* XF = (const bf16_t*)(A.ws + WS_NBUF); const float* RSl = (const float*)(A.ws + WS_RS); const unsigned char* U8 = A.ws + WS_UT + (size_t)l * NEXP * EREC; const unsigned char* V8 = U8 + 1024; const float* VS = (const float*)(A.ws + WS_VSC) + (size_t)l * NEXP; const float* US = (const float*)(A.ws + WS_USC) + (size_t)l * NEXP;
    LAS int* lidx = (LAS int*)c.lds;
    LAS float* lgate = (LAS float*)(c.lds + 32768);
    LAS unsigned* tkb = (LAS unsigned*)(c.lds + 65536);
    for (int blk = c.bid; blk < T / 64; blk += c.G) {
        const int tb0 = blk * 64;
        __syncthreads();
#pragma unroll 1
        for (int rrep_ = 0; rrep_ < 1 + ((DUP >> 11) & 1); ++rrep_) {
#define PEER_RLOAD(Q, Kf, st) do { const int hh_ = (st) >> 2, ks_ = (st) & 3, hp_ = (hh_ >> 1) * 8 + wave, sp_ = (hh_ & 1) * 2; \
        const bf16_t* qp_ = QP; const bf16_t* kp_ = KEYS; asm volatile("" : "+s"(qp_), "+s"(kp_) : "v"(acc[1][7]));     \
        _Pragma("unroll") for (int sb = 0; sb < 2; ++sb) Q[sb] = *(const bf16x8*)(qp_ + (size_t)(tb0 + (sp_ + sb) * 16 + fr) * 2048 + hp_ * 128 + ks_ * 32 + 8 * fq); \
        _Pragma("unroll") for (int nb = 0; nb < 8; ++nb) Kf[nb] = *(const bf16x8*)(kp_ + ((size_t)hp_ * 128 + nb * 16 + fr) * 128 + ks_ * 32 + 8 * fq); } while (0)
#define PEER_RMMA(Q, Kf) do { _Pragma("unroll") for (int nb = 0; nb < 8; ++nb) _Pragma("unroll") for (int sb = 0; sb < 2; ++sb) acc[sb][nb] = __builtin_amdgcn_mfma_f32_16x16x32_bf16(Kf[nb], Q[sb], acc[sb][nb], 0, 0, 0); } while (0)
            bf16x8 qA[2], kA[8], qB[2], kB[8]; f32x4 acc[2][8]; acc[1][7] = (f32x4){0.f, 0.f, 0.f, 0.f};
            PEER_RLOAD(qA, kA, 0);
#pragma unroll 1
            for (int hh = 0; hh < 4; ++hh) {
                const int hp = (hh >> 1) * 8 + wave, sp = (hh & 1) * 2;
#pragma unroll
                for (int sb = 0; sb < 2; ++sb)
#pragma unroll
                    for (int nb = 0; nb < 8; ++nb) acc[sb][nb] = (f32x4){0.f, 0.f, 0.f, 0.f};
                PEER_RLOAD(qB, kB, 4 * hh + 1); PEER_RMMA(qA, kA);
                PEER_RLOAD(qA, kA, 4 * hh + 2); PEER_RMMA(qB, kB);
                PEER_RLOAD(qB, kB, 4 * hh + 3); PEER_RMMA(qA, kA);
                { const int hn_ = hh < 3 ? hh + 1 : hh; PEER_RLOAD(qA, kA, 4 * hn_); }
                PEER_RMMA(qB, kB);
#define PEER_MERGE(N) do { unsigned p[16]; \
        _Pragma("unroll") for (int i = 0; i < 16; ++i) p[i] = lxu<N>(v[i]); \
        _Pragma("unroll") for (int i = 0; i < 16; ++i) v[i] = v[i] > p[15 - i] ? v[i] : p[15 - i]; \
        _Pragma("unroll") for (int j = 8; j > 0; j >>= 1) _Pragma("unroll") for (int i = 0; i < 16; ++i) { const int q = i ^ j; if (q > i) { const unsigned x = v[i], y = v[q]; v[i] = x > y ? x : y; v[q] = x > y ? y : x; } } } while (0)
#pragma unroll 1
                for (int sb = 0; sb < 2; ++sb) {
                    LAS unsigned* tk = tkb + (sp + sb) * 4096;
                    unsigned v[32];
#pragma unroll
                    for (int nb = 0; nb < 8; ++nb) { const f32x4 a_ = sb == 0 ? acc[0][nb] : acc[1][nb];
#pragma unroll
                        for (int r = 0; r < 4; ++r) v[nb * 4 + r] = (ord_key(a_[r]) & ~127u) | (unsigned)(127 - (nb * 16 + 4 * fq + r)); }
#pragma unroll
                    for (int k = 2; k <= 32; k <<= 1)
#pragma unroll
                        for (int j = k >> 1; j > 0; j >>= 1)
#pragma unroll
                            for (int i = 0; i < 32; ++i) { const int q = i ^ j; if (q > i) { const bool desc = ((i & k) == 0); const unsigned x = v[i], y = v[q]; const unsigned hi = x > y ? x : y, lo = x > y ? y : x; v[i] = desc ? hi : lo; v[q] = desc ? lo : hi; } }
                    PEER_MERGE(16); PEER_MERGE(32);
                    { u32x4 w; w.x = fq == 0 ? v[0] : (fq == 1 ? v[4] : (fq == 2 ? v[8] : v[12])); w.y = fq == 0 ? v[1] : (fq == 1 ? v[5] : (fq == 2 ? v[9] : v[13]));
                      w.z = fq == 0 ? v[2] : (fq == 1 ? v[6] : (fq == 2 ? v[10] : v[14])); w.w = fq == 0 ? v[3] : (fq == 1 ? v[7] : (fq == 2 ? v[11] : v[15]));
                      *(LAS u32x4*)(tk + (fr * 16 + hp) * 16 + 4 * fq) = w; }
                }
#undef PEER_MERGE
            }
#undef PEER_RLOAD
#undef PEER_RMMA
            __syncthreads();
#pragma unroll 1
            for (int sub = 0; sub < 4; ++sub)
            {
                const LAS unsigned* tk = tkb + sub * 4096;
                const int pp = tid >> 2, qd = tid & 3, tok = pp >> 3, h = pp & 7;
                const LAS unsigned* a = tk + (tok * 16 + 2 * h) * 16; const LAS unsigned* b = a + 16;
                unsigned v[16], s5[5];
                {
                    const float sj0 = ord_val(b[qd] & ~127u), sj1 = ord_val(b[qd + 4] & ~127u), sj2 = ord_val(b[qd + 8] & ~127u), sj3 = ord_val(b[qd + 12] & ~127u);
#pragma unroll
                    for (int i = 0; i < 16; ++i) { const float si = ord_val(a[i] & ~127u);
                        v[i] = ((i + 1) * (qd + 1) <= 16) ? ((ord_key(si + sj0) & ~255u) | (unsigned)(255 - (i * 16 + qd))) : 0u;
                        if (i < 3) s5[i] = ((i + 1) * (qd + 5) <= 16) ? ((ord_key(si + sj1) & ~255u) | (unsigned)(255 - (i * 16 + qd + 4))) : 0u;
                        if (i == 0) { s5[3] = ((qd + 9) <= 16) ? ((ord_key(si + sj2) & ~255u) | (unsigned)(255 - (qd + 8))) : 0u; s5[4] = ((qd + 13) <= 16) ? ((ord_key(si + sj3) & ~255u) | (unsigned)(255 - (qd + 12))) : 0u; } }
                }
#define PEER_CE(x, y) do { const unsigned hi_ = x > y ? x : y, lo_ = x > y ? y : x; x = hi_; y = lo_; } while (0)
                PEER_CE(s5[0], s5[1]); PEER_CE(s5[3], s5[4]); PEER_CE(s5[2], s5[4]); PEER_CE(s5[2], s5[3]); PEER_CE(s5[0], s5[3]); PEER_CE(s5[0], s5[2]); PEER_CE(s5[1], s5[4]); PEER_CE(s5[1], s5[3]); PEER_CE(s5[1], s5[2]);
#pragma unroll
                for (int t = 0; t < 5; ++t) v[15 - t] = v[15 - t] > s5[t] ? v[15 - t] : s5[t];
#pragma unroll
                for (int j = 8; j > 0; j >>= 1)
#pragma unroll
                    for (int i = 0; i < 16; ++i) { const int q = i ^ j; if (q > i) PEER_CE(v[i], v[q]); }
#define PEER_MERGE(N) do { unsigned p[16]; \
        _Pragma("unroll") for (int i = 0; i < 16; ++i) p[i] = lxu<N>(v[i]); \
        _Pragma("unroll") for (int i = 0; i < 16; ++i) v[i] = v[i] > p[15 - i] ? v[i] : p[15 - i]; \
        _Pragma("unroll") for (int j = 8; j > 0; j >>= 1) _Pragma("unroll") for (int i = 0; i < 16; ++i) { const int q = i ^ j; if (q > i) PEER_CE(v[i], v[q]); } } while (0)
                PEER_MERGE(1); PEER_MERGE(2);
#undef PEER_MERGE
#undef PEER_CE
                const float mx = ord_val(v[0] & ~255u); const int tl = sub * 16 + tok;
                unsigned m4[4]; float e4[4]; int x4[4];
#pragma unroll
                for (int t = 0; t < 4; ++t) { m4[t] = qd == 0 ? v[t] : (qd == 1 ? v[4 + t] : (qd == 2 ? v[8 + t] : v[12 + t]));
                    const int pos = 255 - (int)(m4[t] & 255u), pi = pos >> 4, pj = pos & 15;
                    e4[t] = __expf(ord_val(m4[t] & ~255u) - mx);
                    x4[t] = (127 - (int)(a[pi] & 127u)) * 128 + (127 - (int)(b[pj] & 127u)); }
                float sum = (e4[0] + e4[1]) + (e4[2] + e4[3]); sum += lxf<1>(sum); sum += lxf<2>(sum);
                const float inv = 1.0f / sum;
                { u32x4 xi; xi.x = (unsigned)x4[0]; xi.y = (unsigned)x4[1]; xi.z = (unsigned)x4[2]; xi.w = (unsigned)x4[3]; *(LAS u32x4*)(lidx + tl * 128 + h * 16 + 4 * qd) = xi;
                  f32x4 gi; gi.x = e4[0] * inv; gi.y = e4[1] * inv; gi.z = e4[2] * inv; gi.w = e4[3] * inv; *(LAS f32x4*)(lgate + tl * 128 + h * 16 + 4 * qd) = gi; }
            }
        }
        __syncthreads();
        LAS unsigned char* lbase = c.lds + 65536 + wave * 10240;
        const int es = ((lane & 1) << 2) | (lane & 2) | ((lane >> 2) & 1);
#pragma unroll 1
        for (int pass = 0; pass < 2; ++pass) {
            const int tl0 = pass * 32 + wave * 4; LAS unsigned* sl = (LAS unsigned*)lbase + pass * 512; LAS float* sg = (LAS float*)(lbase + 4096) + pass * 512; LAS unsigned short* sv = (LAS unsigned short*)(lbase + 8192) + pass * 512;
            int il[4], ih[4]; float gl[4], gh[4];
#pragma unroll
            for (int k = 0; k < 4; ++k) { const int a0 = lidx[(tl0 + k) * 128 + lane], a1 = lidx[(tl0 + k) * 128 + 64 + lane];
                gl[k] = lgate[(tl0 + k) * 128 + lane] * VS[a0]; gh[k] = lgate[(tl0 + k) * 128 + 64 + lane] * VS[a1];
                il[k] = a0 | (k << 14) | (int)(((__float_as_uint(US[a0]) >> 23) & 255u) << 16); ih[k] = a1 | (k << 14) | (int)(((__float_as_uint(US[a1]) >> 23) & 255u) << 16); }
            LAS int* ct = (LAS int*)(c.lds + 147456) + wave * 256;
            int rk[8], cn[8], pu[8];
#pragma unroll
            for (int g = 0; g < 8; ++g) { const int w = (g & 1) ? ih[g >> 1] : il[g >> 1]; const int r = (w >> 9) & 31; unsigned long long eq = ~0ull;
#pragma unroll
                for (int bt_ = 0; bt_ < 5; ++bt_) { const bool bit = (r >> bt_) & 1; const unsigned long long m = __ballot(bit); eq &= bit ? m : ~m; }
                rk[g] = (int)__builtin_amdgcn_mbcnt_hi((unsigned)(eq >> 32), __builtin_amdgcn_mbcnt_lo((unsigned)eq, 0u)); cn[g] = __builtin_popcountll(eq); }
#pragma unroll
            for (int ord = 0; ord < 2; ++ord) {
#pragma unroll
                for (int i = 0; i < 4; ++i) ct[lane + 64 * i] = 0;
#pragma unroll
                for (int g = 0; g < 8; ++g) { const int w = (g & 1) ? ih[g >> 1] : il[g >> 1]; const int r = (w >> 9) & 31; ct[ord ? (g >> 1) * 64 + r * 2 + (g & 1) : r * 8 + g] = cn[g]; }
                { const int c0 = ct[4 * lane], c1 = ct[4 * lane + 1], c2 = ct[4 * lane + 2], c3 = ct[4 * lane + 3]; int sum = (c0 + c1) + (c2 + c3);
#pragma unroll
                  for (int o = 1; o < 64; o <<= 1) { const int n = __shfl_up(sum, o); if (lane >= o) sum += n; }
                  const int ex = sum - ((c0 + c1) + (c2 + c3));
                  ct[4 * lane] = ex; ct[4 * lane + 1] = ex + c0; ct[4 * lane + 2] = ex + c0 + c1; ct[4 * lane + 3] = ex + c0 + c1 + c2; }
#pragma unroll
                for (int g = 0; g < 8; ++g) { const int w = (g & 1) ? ih[g >> 1] : il[g >> 1]; const int r = (w >> 9) & 31;
                    if (ord == 0) pu[g] = ct[r * 8 + g] + rk[g];
                    else { const int k = g >> 1, p = ct[k * 64 + r * 2 + (g & 1)] + rk[g] - 128 * k;
                        const int vp = 8 * (p >> 1) + 2 * k + (p & 1);
                        sl[pu[g]] = (unsigned)w | ((unsigned)p << 24); sg[vp] = (g & 1) ? gh[k] : gl[k]; } }
            }
        }
        __syncthreads();
        const auto rsT = __builtin_amdgcn_make_buffer_rsrc((void*)U8, 0, NEXP * EREC, 0x00020000);
        const int lo16i = lane * 16, lo8i = 1024 + lane * 8;
#pragma unroll 1
        for (int step = 0; step < 4; ++step) {
            const bool grpB = wave >= 4; const int kind = grpB ? (step >> 1) : (step & 1), pass = grpB ? (step & 1) : (step >> 1);
            LAS unsigned char* xw = c.lds + wave * 8192 + pass * 4096;
            if (align && step == 2 && STEP_ALIGN) xcd_barrier(bar);
            const int tl0 = pass * 32 + wave * 4; const LAS unsigned* sl = (const LAS unsigned*)lbase + pass * 512; LAS float* sg = (LAS float*)(lbase + 4096) + pass * 512; const LAS unsigned short* sv = (const LAS unsigned short*)(lbase + 8192) + pass * 512;
            v2h_t out[4][8]; float xinv1;
            constexpr int NW = 8, NBW = 64;
            if (kind == 0) {
            __builtin_amdgcn_s_setprio(1);
            {
                float f[4][16]; float am = 0.f;
#pragma unroll
                for (int k = 0; k < 4; ++k) { const size_t t = (size_t)(tb0 + tl0 + k);
                    float rs; { const float4 a = *(const float4*)(RSl + t * 16), b = *(const float4*)(RSl + t * 16 + 4), c2 = *(const float4*)(RSl + t * 16 + 8), d = *(const float4*)(RSl + t * 16 + 12);
                        rs = rsqrtf(((((a.x + a.y) + (a.z + a.w)) + ((b.x + b.y) + (b.z + b.w))) + (((c2.x + c2.y) + (c2.z + c2.w)) + ((d.x + d.y) + (d.z + d.w)))) * (1.0f / 1024.0f) + 1e-6f); }
                    const u32x4 w0 = *(const u32x4*)(XF + t * 1024 + 16 * lane), w1 = *(const u32x4*)(XF + t * 1024 + 16 * lane + 8);
                    f[k][0] = bf_lo(w0.x); f[k][1] = bf_hi(w0.x); f[k][2] = bf_lo(w0.y); f[k][3] = bf_hi(w0.y); f[k][4] = bf_lo(w0.z); f[k][5] = bf_hi(w0.z); f[k][6] = bf_lo(w0.w); f[k][7] = bf_hi(w0.w);
                    f[k][8] = bf_lo(w1.x); f[k][9] = bf_hi(w1.x); f[k][10] = bf_lo(w1.y); f[k][11] = bf_hi(w1.y); f[k][12] = bf_lo(w1.z); f[k][13] = bf_hi(w1.z); f[k][14] = bf_lo(w1.w); f[k][15] = bf_hi(w1.w);
#pragma unroll
                    for (int i = 0; i < 16; ++i) { f[k][i] *= rs; am = fmaxf(am, fabsf(f[k][i])); } }
                am = fmaxf(am, lxf<1>(am)); am = fmaxf(am, lxf<2>(am)); am = fmaxf(am, lxf<4>(am)); am = fmaxf(am, lxf<8>(am)); am = fmaxf(am, lxf<16>(am)); am = fmaxf(am, lxf<32>(am));
                const float sx = am > 0.f ? __uint_as_float(__float_as_uint(127.0f / am) & 0x7f800000u) : 1.0f;
                xinv1 = __int_as_float(__builtin_amdgcn_readfirstlane(__float_as_int(1.0f / sx)));
#pragma unroll
                for (int k = 0; k < 4; ++k) { u32x4 xq; unsigned qq[4];
#pragma unroll
                    for (int i = 0; i < 4; ++i) qq[i] = ((unsigned)(int)rintf(f[k][4 * i] * sx) & 255u) | (((unsigned)(int)rintf(f[k][4 * i + 1] * sx) & 255u) << 8) | (((unsigned)(int)rintf(f[k][4 * i + 2] * sx) & 255u) << 16) | (((unsigned)(int)rintf(f[k][4 * i + 3] * sx) & 255u) << 24);
                    xq.x = qq[0]; xq.y = qq[1]; xq.z = qq[2]; xq.w = qq[3];
                    *(LAS u32x4*)(xw + k * 1024 + lane * 16) = xq; }
            }
            {
                u32x4 uA[NW], uB[NW], uC[NW], uD[NW]; unsigned mA[NW], mB[NW], mC[NW], mD[NW];
#define PEER_UISSUE(uu, mm, b) do { _Pragma("unroll") for (int s = 0; s < NW; ++s) { mm[s] = __builtin_amdgcn_readfirstlane(sl[NW * (b) + s]); uu[s] = __builtin_bit_cast(u32x4, __builtin_amdgcn_raw_buffer_load_b128(rsT, lo16i, (int)((mm[s] & 16383u) * (unsigned)EREC), 0)); } } while (0)
#define PEER_UCOMPUTE(uu, mm, b) do { int d_[8]; \
        _Pragma("unroll") for (int s = 0; s < NW; ++s) { const unsigned kx_ = (mm[s] >> 14) & 3u; const u32x4 xq_ = *(const LAS u32x4*)(xw + kx_ * 1024 + lane * 16); \
            int ia_ = __builtin_amdgcn_sdot4((int)uu[s].x, (int)xq_.x, 0, false); ia_ = __builtin_amdgcn_sdot4((int)uu[s].y, (int)xq_.y, ia_, false); ia_ = __builtin_amdgcn_sdot4((int)uu[s].z, (int)xq_.z, ia_, false); ia_ = __builtin_amdgcn_sdot4((int)uu[s].w, (int)xq_.w, ia_, false); \
            d_[s] = ia_; } \
        const bool o1_ = lane & 1, o2_ = lane & 2, o4_ = lane & 4; \
        int a0_ = o1_ ? d_[4] : d_[0], a1_ = o1_ ? d_[5] : d_[1], a2_ = o1_ ? d_[6] : d_[2], a3_ = o1_ ? d_[7] : d_[3]; \
        a0_ += lxi<1>(o1_ ? d_[0] : d_[4]); a1_ += lxi<1>(o1_ ? d_[1] : d_[5]); a2_ += lxi<1>(o1_ ? d_[2] : d_[6]); a3_ += lxi<1>(o1_ ? d_[3] : d_[7]); \
        int b0_ = o2_ ? a2_ : a0_, b1_ = o2_ ? a3_ : a1_; b0_ += lxi<2>(o2_ ? a0_ : a2_); b1_ += lxi<2>(o2_ ? a1_ : a3_); \
        int ci_ = o4_ ? b1_ : b0_; ci_ += lxi<4>(o4_ ? b0_ : b1_); \
        ci_ += lxi<8>(ci_); ci_ += lxi<16>(ci_); ci_ += lxi<32>(ci_); \
        const unsigned wes_ = sl[NW * (b) + es];     \
        const int pv_ = (int)(wes_ >> 24), vp_ = 8 * (pv_ >> 1) + 2 * (int)((wes_ >> 14) & 3u) + (pv_ & 1); \
        const float cc_ = (float)ci_ * (__uint_as_float(((wes_ >> 16) & 255u) << 23) * xinv1); \
        const float cfv_ = sg[vp_] * gelu_erf(cc_); \
        if (lane < 8) sg[vp_] = __uint_as_float((pkh(cfv_, cfv_) & 0xffff0000u) | (wes_ & 16383u)); } while (0)
                PEER_UISSUE(uA, mA, 0); PEER_UISSUE(uB, mB, 1); PEER_UISSUE(uC, mC, 2);
#pragma unroll 1
                for (int bb = 0; bb < NBW; bb += 4) {
                    PEER_UISSUE(uD, mD, bb + 3);
                    PEER_UCOMPUTE(uA, mA, bb);
                    const int bn_ = bb + 4 < NBW ? bb + 4 : bb;
                    PEER_UISSUE(uA, mA, bn_);
                    PEER_UCOMPUTE(uB, mB, bb + 1);
                    PEER_UISSUE(uB, mB, bn_ + 1);
                    PEER_UCOMPUTE(uC, mC, bb + 2);
                    PEER_UISSUE(uC, mC, bn_ + 2);
                    PEER_UCOMPUTE(uD, mD, bb + 3);
                }
#undef PEER_UISSUE
#undef PEER_UCOMPUTE
            }
            asm volatile("s_waitcnt lgkmcnt(0)" ::: "memory");
            __builtin_amdgcn_s_setprio(0);
            } else {
#pragma unroll
            for (int k = 0; k < 4; ++k)
#pragma unroll
                for (int i = 0; i < 8; ++i) out[k][i] = (v2h_t){(_Float16)0.f, (_Float16)0.f};
            float4 hres[4][4];
#pragma unroll
            for (int k = 0; k < 4; ++k)
#pragma unroll
                for (int i = 0; i < 4; ++i) hres[k][i] = *(const float4*)(A.out + (size_t)(tb0 + tl0 + k) * 1024 + 16 * lane + 4 * i);
            {
                u32x2 vA[NW], vB[NW]; float cA[NW], cB[NW];
#define PEER_VISSUE(vv, cc, b) do { _Pragma("unroll") for (int s = 0; s < NW; ++s) { const unsigned w_ = (unsigned)__builtin_amdgcn_readfirstlane(__float_as_int(sg[NW * (b) + s])); const unsigned e_ = w_ & 16383u; cc[s] = __uint_as_float((w_ & 0xffff0000u) | (w_ >> 16)); \
            vv[s] = __builtin_bit_cast(u32x2, __builtin_amdgcn_raw_buffer_load_b64(rsT, lo8i, (int)(e_ * (unsigned)EREC), 0)); } } while (0)
#define PEER_VCOMPUTE(vv, cc) do {     \
        _Pragma("unroll") for (int s = 0; s < NW; ++s) { const v2h_t c_ = __builtin_bit_cast(v2h_t, __float_as_uint(cc[s])); \
            _Pragma("unroll") for (int d = 0; d < 2; ++d) { const unsigned w_ = d ? vv[s].y : vv[s].x; \
                out[s >> 1][4 * d] = __builtin_elementwise_fma(__builtin_bit_cast(v2h_t, __builtin_amdgcn_cvt_scalef32_pk_f16_fp4(w_, 1.0f, 0)), c_, out[s >> 1][4 * d]); \
                out[s >> 1][4 * d + 1] = __builtin_elementwise_fma(__builtin_bit_cast(v2h_t, __builtin_amdgcn_cvt_scalef32_pk_f16_fp4(w_, 1.0f, 1)), c_, out[s >> 1][4 * d + 1]); \
                out[s >> 1][4 * d + 2] = __builtin_elementwise_fma(__builtin_bit_cast(v2h_t, __builtin_amdgcn_cvt_scalef32_pk_f16_fp4(w_, 1.0f, 2)), c_, out[s >> 1][4 * d + 2]); \
                out[s >> 1][4 * d + 3] = __builtin_elementwise_fma(__builtin_bit_cast(v2h_t, __builtin_amdgcn_cvt_scalef32_pk_f16_fp4(w_, 1.0f, 3)), c_, out[s >> 1][4 * d + 3]); } } } while (0)
                PEER_VISSUE(vA, cA, 0);
#pragma unroll 1
                for (int bb = 0; bb < NBW; bb += 2) {
                    PEER_VISSUE(vB, cB, bb + 1);
                    PEER_VCOMPUTE(vA, cA);
                    PEER_VISSUE(vA, cA, (bb + 2 < NBW ? bb + 2 : bb));
                    PEER_VCOMPUTE(vB, cB);
                }
#undef PEER_VISSUE
#undef PEER_VCOMPUTE
            }
#pragma unroll
            for (int k = 0; k < 4; ++k) { const size_t t = (size_t)(tb0 + tl0 + k); const float* hp = A.out + t * 1024 + 16 * lane; float* hq = hdst + t * 1024 + 16 * lane;
#pragma unroll
                for (int i = 0; i < 4; ++i) { float4 h4 = hres[k][i]; h4.x += (float)out[k][2 * i].x; h4.y += (float)out[k][2 * i].y; h4.z += (float)out[k][2 * i + 1].x; h4.w += (float)out[k][2 * i + 1].y; *(float4*)(hq + 4 * i) = h4; }
            }
#pragma unroll 1
            for (int k2 = 0; k2 < (fuse_next ? 2 : 0); ++k2) {
                int lo16 = 16 * lane; asm volatile("" : "+v"(lo16));
                const float* nx_gain = A.in[2] + (l + 1) * 1024 + lo16; const float* nx_wgate = (const float*)(A.ws + WS_WGATE) + (l + 1) * 8 * 1024 + lo16; const float* nx_alog = A.in[5] + (l + 1) * 4; const float* nx_dtb = A.in[6] + (l + 1) * 4;
                float hv[2][16], ss[2], d[2][8];
#pragma unroll
                for (int k = 0; k < 2; ++k) { const float* hq = hdst + (size_t)(tb0 + tl0 + 2 * k2 + k) * 1024 + lo16;
#pragma unroll
                    for (int i = 0; i < 4; ++i) { const float4 h4 = *(const float4*)(hq + 4 * i); hv[k][4 * i] = h4.x; hv[k][4 * i + 1] = h4.y; hv[k][4 * i + 2] = h4.z; hv[k][4 * i + 3] = h4.w; }
                    float s2 = 0.f;
#pragma unroll
                    for (int i = 0; i < 16; ++i) s2 += hv[k][i] * hv[k][i];
                    ss[k] = s2; }
#pragma unroll
                for (int i = 0; i < 4; ++i) { const float4 g4 = *(const float4*)(nx_gain + 4 * i);
#pragma unroll
                    for (int k = 0; k < 2; ++k) { hv[k][4 * i] *= g4.x; hv[k][4 * i + 1] *= g4.y; hv[k][4 * i + 2] *= g4.z; hv[k][4 * i + 3] *= g4.w; } }
#pragma unroll
                for (int qh = 0; qh < 2; ++qh) {
                    const float* wg_ = nx_wgate; if (qh) asm volatile("" : "+v"(wg_) : "v"(d[1][3]));
#pragma unroll
                    for (int q = 4 * qh; q < 4 * qh + 4; ++q) { float4 w[4];
#pragma unroll
                        for (int i = 0; i < 4; ++i) w[i] = *(const float4*)(wg_ + q * 1024 + 4 * i);
#pragma unroll
                        for (int k = 0; k < 2; ++k) { float a = 0.f;
#pragma unroll
                            for (int i = 0; i < 4; ++i) a += (hv[k][4 * i] * w[i].x + hv[k][4 * i + 1] * w[i].y) + (hv[k][4 * i + 2] * w[i].z + hv[k][4 * i + 3] * w[i].w);
                            d[k][q] = a; } } }
                const bool o1 = lane & 1, o2 = lane & 2, o4 = lane & 4;
#pragma unroll
                for (int k = 0; k < 2; ++k) { const size_t t = (size_t)(tb0 + tl0 + 2 * k2 + k);
                    float a0 = o1 ? d[k][4] : d[k][0], a1 = o1 ? d[k][5] : d[k][1], a2 = o1 ? d[k][6] : d[k][2], a3 = o1 ? d[k][7] : d[k][3];
                    a0 += lxf<1>(o1 ? d[k][0] : d[k][4]); a1 += lxf<1>(o1 ? d[k][1] : d[k][5]); a2 += lxf<1>(o1 ? d[k][2] : d[k][6]); a3 += lxf<1>(o1 ? d[k][3] : d[k][7]);
                    float b0 = o2 ? a2 : a0, b1 = o2 ? a3 : a1; b0 += lxf<2>(o2 ? a0 : a2); b1 += lxf<2>(o2 ? a1 : a3);
                    float cc = o4 ? b1 : b0; cc += lxf<4>(o4 ? b0 : b1);
                    cc += lxf<8>(cc); cc += lxf<16>(cc); cc += lxf<32>(cc);
                    const float rstd = rsqrtf(wave_sum(ss[k]) * (1.0f / D) + 1e-6f);
                    u32x4 w0, w1; w0.x = pk2(hv[k][0] * rstd, hv[k][1] * rstd); w0.y = pk2(hv[k][2] * rstd, hv[k][3] * rstd); w0.z = pk2(hv[k][4] * rstd, hv[k][5] * rstd); w0.w = pk2(hv[k][6] * rstd, hv[k][7] * rstd);
                    w1.x = pk2(hv[k][8] * rstd, hv[k][9] * rstd); w1.y = pk2(hv[k][10] * rstd, hv[k][11] * rstd); w1.z = pk2(hv[k][12] * rstd, hv[k][13] * rstd); w1.w = pk2(hv[k][14] * rstd, hv[k][15] * rstd);
                    bf16_t* xo = (bf16_t*)(A.ws + WS_NBUF) + t * 1024 + lo16; *(u32x4*)xo = w0; *(u32x4*)(xo + 8) = w1;
                    if (lane < 8) { const float r = cc * rstd; float o;
                        if (es < 4) o = 1.0f / (1.0f + __expf(-r));
                        else { const float z = r + nx_dtb[es - 4]; const float sp = z > 20.f ? z : log1pf(__expf(z)); o = -__expf(nx_alog[es - 4]) * sp; }
                        ((float*)(A.ws + WS_GB))[t * 8 + es] = o; }
                }
            }
            }
        }
    }
    __syncthreads();
}

__device__ __forceinline__ bool relaunder(Ctx& c) { int t = threadIdx.x; asm volatile("" : "+v"(t)); c.tid = t; c.lane = t & 63; c.wave = __builtin_amdgcn_readfirstlane(t >> 6); return true; }
__global__ void __launch_bounds__(512, 2) fwd(Args a) {
    extern __shared__ __attribute__((aligned(16))) unsigned char lds_raw[];
    Ctx c; c.lds = (LAS unsigned char*)lds_raw; c.tid = threadIdx.x; c.lane = c.tid & 63; c.wave = __builtin_amdgcn_readfirstlane(c.tid >> 6); c.G = gridDim.x; c.bid = blockIdx.x;
    const Args& A = a;
    volatile LAS unsigned* MISC = (volatile LAS unsigned*)(c.lds + MISC_OFF);
    if (c.tid < 64) MISC[c.tid] = 0u;
    __syncthreads();
    const int lo = a.ph_lo, hi = a.ph_hi;
    XcdBarrier bar; bar.bar = (unsigned*)(A.ws + WS_CTL) + CW_BAR; bar.x = 0; bar.st = MISC + 8;
    if (hi - lo > 1) bar = xcd_barrier_post((unsigned*)(A.ws + WS_CTL) + CW_BAR, MISC + 8);
#define IN(k) (lo <= (k) && (k) < hi && relaunder(c))
#define INR(k) (lo <= (k) && (k) < hi)
#define SEAM(k) do { if (INR(k) && INR((k) + 1)) { xcd_barrier(bar); if ((DUP >> 14) & 1) xcd_barrier(bar); } } while (0)
    bf16_t* NBUF = (bf16_t*)(A.ws + WS_NBUF); bf16_t* PROJ = (bf16_t*)(A.ws + WS_PROJ); bf16_t* MIXED = (bf16_t*)(A.ws + WS_MIXED); bf16_t* QP = (bf16_t*)(A.ws + WS_QP);
    float* GB = (float*)(A.ws + WS_GB);
    if (IN(0)) { REP(10) p0_prologue(c, a);
        phase_norm(c, a, A.in[0], A.in[2], NBUF, A.in[3] + 2048, A.in[5], A.in[6], GB); }
    SEAM(0);
    auto layer = [&](const int l) __attribute__((always_inline)) {
        const int pb = 1 + 10 * l;
        if (IN(pb + 1) && !(KO & (1 << 1))) REP(1) { pg8::Gemm g{NBUF, (const bf16_t*)(A.ws + WS_WIN) + (size_t)l * NPROJ * 1024, T, NPROJ, 1024}; pg8::StaticOrder S; S.init(T, NPROJ, c.G, c.bid); pg8::EpiBf16 E{PROJ, NPROJ, nullptr};
            pg8::gemm_phase<pg8::EpiBf16, pg8::StaticOrder>(c.lds, g, S, E, nullptr);
            if (c.G == 256 && c.bid >= 128) { const int wid_ = (c.bid - 128) * 8 + c.wave;
                if (l == 0) { peer_tables_convert(c, a, 0, NEXP / 2, wid_, 128 * 8, 0, 1); peer_tables_convert(c, a, NEXP, NEXP + NEXP / 4, wid_, 128 * 8); }
                else peer_tables_convert(c, a, NEXP + NEXP / 2, 2 * NEXP, wid_, 128 * 8); } }
        SEAM(pb + 1);
        const bool own_chunk = (c.G * 64 == T) && INR(pb + 2) && INR(pb + 3);
        if (IN(pb + 2) && !(KO & (1 << 2))) REP(2) phase_prep(c, a, l);
        if (own_chunk) { asm volatile("s_waitcnt vmcnt(0)" ::: "memory"); __builtin_amdgcn_fence(__ATOMIC_RELEASE, "workgroup"); __syncthreads(); __builtin_amdgcn_fence(__ATOMIC_ACQUIRE, "workgroup"); }
        else SEAM(pb + 2);
        if (IN(pb + 3)) REP(3) {
            if (own_chunk) { const int ub = ((c.bid >> 5) << 7) | (c.bid & 31);
                gdn_chunk_pair(c, a, ub, ub + 32); gdn_chunk_pair(c, a, ub + 64, ub + 96); }
            else { for (int u = c.bid; u < 1024; u += 2 * c.G) { if (u + c.G < 1024) gdn_chunk_pair(c, a, u, u + c.G); else gdn_chunk_unit(c, a, u); } } }
        SEAM(pb + 3);
        if (IN(pb + 4) && !(KO & (1 << 3))) REP(4) { if (c.bid < 64) { for (int rp = 0; rp < 1 + ((DUP >> 12) & 1); ++rp) gdn_scan(c, a, c.bid); } else { for (int rp = 0; rp < 1 + ((DUP >> 13) & 1); ++rp) attn_mfma(c, a, l, 64, c.G - 64);
                   if (c.G == 256 && c.bid >= 128) { if (l == 0) peer_tables_convert(c, a, 0, NEXP / 2, (c.bid - 128) * 8 + c.wave, 128 * 8, 1, 2);
                                                     else peer_tables_convert(c, a, NEXP + NEXP / 4, NEXP + NEXP / 2, (c.bid - 128) * 8 + c.wave, 128 * 8); } } }
        SEAM(pb + 4);
        if (IN(pb + 5) && !(KO & (1 << 4))) REP(5) phase_gdn_out(c, a, l);
        SEAM(pb + 5);
        if (IN(pb + 6) && !(KO & (1 << 5))) REP(6) { pg8::Gemm g{MIXED, (const bf16_t*)(A.ws + WS_WOUT) + (size_t)l * 1024 * 1024, T, 1024, 1024}; pg8::StaticOrder S; S.init(T, 1024, c.G, c.bid); pg8::EpiResNorm E{l == 0 ? A.in[0] : A.out, A.out, NBUF, A.in[14] + l * 1024, (float*)(A.ws + WS_RS), 1024};
            pg8::gemm_phase<pg8::EpiResNorm, pg8::StaticOrder>(c.lds, g, S, E, nullptr); }
        SEAM(pb + 6);
        if (IN(pb + 8) && !(KO & (1 << 7))) REP(8) { pg8::Gemm g{NBUF, (const bf16_t*)(A.ws + WS_WQ) + (size_t)l * 2048 * 1024, T, 2048, 1024}; pg8::StaticOrder S; S.init(T, 2048, c.G, c.bid); pg8::EpiBf16 E{QP, 2048, (const float*)(A.ws + WS_RS)};
            pg8::gemm_phase<pg8::EpiBf16, pg8::StaticOrder>(c.lds, g, S, E, nullptr); }
        SEAM(pb + 8);
        if (IN(pb + 9) && !(KO & (1 << 8))) REP(9) phase_peer(c, a, l, LASTREP(9) ? A.out : (float*)(A.ws + WS_GCH), l == 0, bar, (hi - lo > 1) && c.G * 64 == T);
        SEAM(pb + 9);
    };
    layer(0); layer(1);
#undef IN
#undef INR
#undef SEAM
}

extern "C" void kernel_launch(void* const* d_in, const int* in_sizes, int n_in, void* d_out, int out_size, void* d_ws, size_t ws_size, hipStream_t stream) {
    static int grid = 0;
    if (grid == 0) {
        if (n_in != 19 || out_size != T * D || ws_size < WS_END) { fprintf(stderr, "kernel_launch: unexpected shapes (n_in %d out %d ws %zu)\n", n_in, out_size, ws_size); grid = -1; return; }
        if (hipFuncSetAttribute((const void*)fwd, hipFuncAttributeMaxDynamicSharedMemorySize, LDS_BYTES) != hipSuccess) { fprintf(stderr, "kernel_launch: hipFuncSetAttribute failed\n"); grid = -1; return; }
        int dev = 0, cus = 0, per_cu = 0;
        (void)hipGetDevice(&dev); (void)hipDeviceGetAttribute(&cus, hipDeviceAttributeMultiprocessorCount, dev);
        (void)hipOccupancyMaxActiveBlocksPerMultiprocessor(&per_cu, (const void*)fwd, 512, LDS_BYTES);
        (void)hipGetLastError();
        if (per_cu < 1) fprintf(stderr, "kernel_launch: occupancy query reports %d blocks per CU\n", per_cu);
        grid = cus > 0 ? cus : 256;
    }
    if (grid < 0) return;
    (void)hipMemsetAsync((char*)d_ws + WS_CTL, 0, CTL_BYTES, stream);
    Args a{};
    for (int i = 0; i < 19; ++i) a.in[i] = (const float*)d_in[i];
    a.out = (float*)d_out; a.ws = (unsigned char*)d_ws;
#if MK_ONE_LAUNCH
    a.ph_lo = 0; a.ph_hi = NPHASE;
    hipLaunchKernelGGL(fwd, dim3(grid), dim3(512), LDS_BYTES, stream, a);
#else
    for (int p = 0; p < NPHASE; ++p) { a.ph_lo = p; a.ph_hi = p + 1; hipLaunchKernelGGL(fwd, dim3(grid), dim3(512), LDS_BYTES, stream, a); }
#endif
}
```
